# Optimizing an MI355X kernel written in HIP

```python
import math
import jax
import jax.numpy as jnp
from jax import lax
import numpy as np

D_MODEL = 1024
BATCH = 8
SEQ = 2048
DEPTH = 2
DEC_BATCH = 128
DEC_SEQ = 1
PAST_LEN = 16384
PAGE_SIZE = 128

MLSTM_HEADS = 4
MLSTM_WIDTH = D_MODEL
MLSTM_HEAD_DIM = MLSTM_WIDTH // MLSTM_HEADS
CHUNK = 128
S5_WIDTH = D_MODEL // 2
S5_GROUP = 16
S5_GROUPS = S5_WIDTH // S5_GROUP
S5_STATE = 64
D_FF = -(-(8 * D_MODEL) // (3 * 256)) * 256
P_TOTAL = 4 * MLSTM_WIDTH + 2 * MLSTM_HEADS + S5_WIDTH + 2 * D_MODEL
EPS = 1e-6

kernel_name = "mlstm_s5_gated_hybrid_step"


def rmsnorm(x, g):
    xf = x.astype(jnp.float32)
    return xf * lax.rsqrt(jnp.mean(xf * xf, axis=-1, keepdims=True) + EPS) * g.astype(jnp.float32)


def mlstm_chunk_step(carry, xs):
    C, n, m = carry
    q, k, v, ig, lf = xs
    L = q.shape[-2]
    causal = jnp.tril(jnp.ones((L, L), dtype=bool))
    b = jnp.cumsum(lf, axis=-1)
    dmat = b[..., :, None] - b[..., None, :] + ig[..., None, :]
    dmat = jnp.where(causal, dmat, -jnp.inf)
    inter = b + m[..., None]
    m_t = jnp.maximum(inter, jnp.max(dmat, axis=-1))
    w_inter = jnp.exp(inter - m_t)
    w_intra = jnp.exp(dmat - m_t[..., None])
    s = jnp.einsum('bhtd,bhsd->bhts', q, k) * w_intra
    num = w_inter[..., None] * jnp.einsum('bhtd,bhde->bhte', q, C) + jnp.einsum('bhts,bhse->bhte', s, v)
    den = w_inter * jnp.einsum('bhtd,bhd->bht', q, n) + jnp.sum(s, axis=-1)
    h = num / jnp.maximum(jnp.abs(den), jnp.exp(-m_t))[..., None]
    b_last = b[..., -1]
    g = b_last[..., None] - b + ig
    m_new = jnp.maximum(b_last + m, jnp.max(g, axis=-1))
    a = jnp.exp(b_last + m - m_new)
    wk = jnp.exp(g - m_new[..., None])
    C_new = a[..., None, None] * C + jnp.einsum('bhs,bhsd,bhse->bhde', wk, k, v)
    n_new = a[..., None] * n + jnp.einsum('bhs,bhsd->bhd', wk, k)
    return (C_new, n_new, m_new), h


def mlstm_mixer(q, k, v, ig, lf, C0, n0, m0):
    B, S = q.shape[0], q.shape[1]
    L = CHUNK if S % CHUNK == 0 else S
    nc = S // L

    def to_chunks(t):
        t = t.reshape((B, nc, L) + t.shape[2:])
        return jnp.moveaxis(t, (1, 2), (0, 3))

    xs = (to_chunks(q), to_chunks(k), to_chunks(v), to_chunks(ig), to_chunks(lf))
    (C, n, m), hs = lax.scan(mlstm_chunk_step, (C0, n0, m0), xs)
    hs = jnp.moveaxis(hs, (0, 3), (1, 2)).reshape(B, S, MLSTM_HEADS, MLSTM_HEAD_DIM)
    return hs, C, n, m


def s5_combine(e1, e2):
    a1r, a1i, b1r, b1i = e1
    a2r, a2i, b2r, b2i = e2
    return (a2r * a1r - a2i * a1i,
            a2r * a1i + a2i * a1r,
            a2r * b1r - a2i * b1i + b2r,
            a2r * b1i + a2i * b1r + b2i)


def s5_mixer(u, s0_re, s0_im, A_re, A_im, log_dt, B_re, B_im, C_re, C_im, D_skip):
    Bsz, S = u.shape[0], u.shape[1]
    ug = u.reshape(Bsz, S, S5_GROUPS, S5_GROUP)
    dt = jnp.exp(log_dt.astype(jnp.float32))[:, None]
    A_re = A_re.astype(jnp.float32)
    A_im = A_im.astype(jnp.float32)
    mag = jnp.exp(dt * A_re)
    abar_re = mag * jnp.cos(dt * A_im)
    abar_im = mag * jnp.sin(dt * A_im)
    den = A_re * A_re + A_im * A_im
    nr = abar_re - 1.0
    ni = abar_im
    f_re = (nr * A_re + ni * A_im) / den
    f_im = (ni * A_re - nr * A_im) / den
    B_re = B_re.astype(jnp.float32)
    B_im = B_im.astype(jnp.float32)
    bbar_re = f_re[..., None] * B_re - f_im[..., None] * B_im
    bbar_im = f_re[..., None] * B_im + f_im[..., None] * B_re
    bu_re = jnp.einsum('gpc,bsgc->bsgp', bbar_re, ug)
    bu_im = jnp.einsum('gpc,bsgc->bsgp', bbar_im, ug)
    bu_re = bu_re.at[:, 0].add(abar_re * s0_re - abar_im * s0_im)
    bu_im = bu_im.at[:, 0].add(abar_re * s0_im + abar_im * s0_re)
    a_re = jnp.broadcast_to(abar_re, bu_re.shape)
    a_im = jnp.broadcast_to(abar_im, bu_im.shape)
    _, _, s_re, s_im = lax.associative_scan(s5_combine, (a_re, a_im, bu_re, bu_im), axis=1)
    y = (jnp.einsum('gcp,bsgp->bsgc', C_re.astype(jnp.float32), s_re)
         - jnp.einsum('gcp,bsgp->bsgc', C_im.astype(jnp.float32), s_im))
    y = y.reshape(Bsz, S, S5_WIDTH) + D_skip.astype(jnp.float32) * u
    return y, s_re[:, -1], s_im[:, -1]


def hybrid_layer(x, state, p):
    C0, n0, m0, sr0, si0 = state
    (g_mix, w_in, b_in, g_hn, w_a, A_re, A_im, log_dt, B_re, B_im, C_re, C_im, D_skip,
     w_glu, b_glu, w_b, w_out, g_ffn, w_ff1, w_ff3, w_ff2) = p
    f32 = jnp.float32
    Bsz, S = x.shape[0], x.shape[1]
    H, DH, DA = MLSTM_HEADS, MLSTM_HEAD_DIM, MLSTM_WIDTH
    h = rmsnorm(x, g_mix)
    proj = h @ w_in.astype(f32) + b_in.astype(f32)
    offsets = [DA, 2 * DA, 3 * DA, 4 * DA, 4 * DA + H, 4 * DA + 2 * H, 4 * DA + 2 * H + S5_WIDTH]
    q, k, v, o, ig, fg, u, gl = jnp.split(proj, offsets, axis=-1)
    q = q.reshape(Bsz, S, H, DH)
    k = k.reshape(Bsz, S, H, DH) * (DH ** -0.5)
    v = v.reshape(Bsz, S, H, DH)
    lf = jax.nn.log_sigmoid(fg)
    hA, C, n, m = mlstm_mixer(q, k, v, ig, lf, C0.astype(f32), n0.astype(f32), m0.astype(f32))
    hA = hA * lax.rsqrt(jnp.mean(hA * hA, axis=-1, keepdims=True) + EPS)
    hA = hA.reshape(Bsz, S, DA) * g_hn.astype(f32)
    yA = (jax.nn.sigmoid(o) * hA) @ w_a.astype(f32)
    yS, sr, si = s5_mixer(u, sr0.astype(f32), si0.astype(f32), A_re, A_im, log_dt, B_re, B_im, C_re, C_im, D_skip)
    yS = jax.nn.gelu(yS)
    yS = yS * jax.nn.sigmoid(yS @ w_glu.astype(f32) + b_glu.astype(f32))
    yB = yS @ w_b.astype(f32)
    gA, gB = jnp.split(gl, 2, axis=-1)
    mix = (jax.nn.sigmoid(gA) * yA + jax.nn.sigmoid(gB) * yB) @ w_out.astype(f32)
    x = x.astype(f32) + mix
    hf = rmsnorm(x, g_ffn)
    x = x + (jax.nn.silu(hf @ w_ff1.astype(f32)) * (hf @ w_ff3.astype(f32))) @ w_ff2.astype(f32)
    return x, (C, n, m, sr, si)


def setup_inputs(seed: int = 0) -> dict:
    key = jax.random.key(seed)
    ks = jax.random.split(key, 32)
    f32 = jnp.float32

    def nrm(k, shape, scale):
        return jax.random.normal(k, shape, f32) * scale

    x_prompt = nrm(ks[0], (BATCH, SEQ, D_MODEL), 1.0)
    x_sample = nrm(ks[1], (DEC_BATCH, DEC_SEQ, D_MODEL), 1.0)
    state_mlstm_C = nrm(ks[2], (DEPTH, DEC_BATCH, MLSTM_HEADS, MLSTM_HEAD_DIM, MLSTM_HEAD_DIM), 0.05)
    state_mlstm_n = nrm(ks[3], (DEPTH, DEC_BATCH, MLSTM_HEADS, MLSTM_HEAD_DIM), 0.5)
    state_mlstm_m = nrm(ks[4], (DEPTH, DEC_BATCH, MLSTM_HEADS), 1.0)
    state_s5_re = nrm(ks[5], (DEPTH, DEC_BATCH, S5_GROUPS, S5_STATE), 0.5)
    state_s5_im = nrm(ks[6], (DEPTH, DEC_BATCH, S5_GROUPS, S5_STATE), 0.5)
    norm_mix_g = 1.0 + nrm(ks[7], (DEPTH, D_MODEL), 0.02)
    w_in = nrm(ks[8], (DEPTH, D_MODEL, P_TOTAL), D_MODEL ** -0.5)
    b_in = nrm(ks[9], (DEPTH, P_TOTAL), 0.02)
    f_off = 4 * MLSTM_WIDTH + MLSTM_HEADS
    b_in = b_in.at[:, f_off:f_off + MLSTM_HEADS].add(jnp.linspace(3.0, 6.0, MLSTM_HEADS, dtype=f32))
    mlstm_norm_g = 1.0 + nrm(ks[10], (DEPTH, MLSTM_WIDTH), 0.02)
    w_a = nrm(ks[11], (DEPTH, MLSTM_WIDTH, D_MODEL), MLSTM_WIDTH ** -0.5)
    n_idx = jnp.arange(S5_STATE, dtype=f32)
    s5_A_re = -0.5 + nrm(ks[12], (DEPTH, S5_GROUPS, S5_STATE), 0.01)
    s5_A_im = math.pi * n_idx + nrm(ks[13], (DEPTH, S5_GROUPS, S5_STATE), 0.01)
    s5_log_dt = jax.random.uniform(ks[14], (DEPTH, S5_GROUPS), f32, math.log(1e-3), math.log(1e-1))
    s5_B_re = nrm(ks[15], (DEPTH, S5_GROUPS, S5_STATE, S5_GROUP), (2 * S5_GROUP) ** -0.5)
    s5_B_im = nrm(ks[16], (DEPTH, S5_GROUPS, S5_STATE, S5_GROUP), (2 * S5_GROUP) ** -0.5)
    s5_C_re = nrm(ks[17], (DEPTH, S5_GROUPS, S5_GROUP, S5_STATE), S5_STATE ** -0.5)
    s5_C_im = nrm(ks[18], (DEPTH, S5_GROUPS, S5_GROUP, S5_STATE), S5_STATE ** -0.5)
    s5_D = nrm(ks[19], (DEPTH, S5_WIDTH), 0.5)
    w_glu = nrm(ks[20], (DEPTH, S5_WIDTH, S5_WIDTH), S5_WIDTH ** -0.5)
    b_glu = nrm(ks[21], (DEPTH, S5_WIDTH), 0.02)
    w_b = nrm(ks[22], (DEPTH, S5_WIDTH, D_MODEL), S5_WIDTH ** -0.5)
    w_out = nrm(ks[23], (DEPTH, D_MODEL, D_MODEL), D_MODEL ** -0.5)
    norm_ffn_g = 1.0 + nrm(ks[24], (DEPTH, D_MODEL), 0.02)
    w_ff1 = nrm(ks[25], (DEPTH, D_MODEL, D_FF), D_MODEL ** -0.5)
    w_ff3 = nrm(ks[26], (DEPTH, D_MODEL, D_FF), D_MODEL ** -0.5)
    w_ff2 = nrm(ks[27], (DEPTH, D_FF, D_MODEL), D_FF ** -0.5)
    norm_final_g = 1.0 + nrm(ks[28], (D_MODEL,), 0.02)
    return {
        "x_prompt": x_prompt, "x_sample": x_sample,
        "state_mlstm_C": state_mlstm_C, "state_mlstm_n": state_mlstm_n, "state_mlstm_m": state_mlstm_m,
        "state_s5_re": state_s5_re, "state_s5_im": state_s5_im,
        "norm_mix_g": norm_mix_g, "w_in": w_in, "b_in": b_in, "mlstm_norm_g": mlstm_norm_g, "w_a": w_a,
        "s5_A_re": s5_A_re, "s5_A_im": s5_A_im, "s5_log_dt": s5_log_dt,
        "s5_B_re": s5_B_re, "s5_B_im": s5_B_im, "s5_C_re": s5_C_re, "s5_C_im": s5_C_im, "s5_D": s5_D,
        "w_glu": w_glu, "b_glu": b_glu, "w_b": w_b, "w_out": w_out,
        "norm_ffn_g": norm_ffn_g, "w_ff1": w_ff1, "w_ff3": w_ff3, "w_ff2": w_ff2,
        "norm_final_g": norm_final_g,
    }


def reference(x_prompt, x_sample, state_mlstm_C, state_mlstm_n, state_mlstm_m, state_s5_re, state_s5_im,
              norm_mix_g, w_in, b_in, mlstm_norm_g, w_a, s5_A_re, s5_A_im, s5_log_dt,
              s5_B_re, s5_B_im, s5_C_re, s5_C_im, s5_D, w_glu, b_glu, w_b, w_out,
              norm_ffn_g, w_ff1, w_ff3, w_ff2, norm_final_g):
    f32 = jnp.float32
    Bp = x_prompt.shape[0]
    xp = x_prompt
    xs = x_sample
    pC, pn, pm, psr, psi = [], [], [], [], []
    sC, sn, sm, ssr, ssi = [], [], [], [], []
    for l in range(DEPTH):
        p = (norm_mix_g[l], w_in[l], b_in[l], mlstm_norm_g[l], w_a[l], s5_A_re[l], s5_A_im[l], s5_log_dt[l],
             s5_B_re[l], s5_B_im[l], s5_C_re[l], s5_C_im[l], s5_D[l], w_glu[l], b_glu[l], w_b[l], w_out[l],
             norm_ffn_g[l], w_ff1[l], w_ff3[l], w_ff2[l])
        zero_state = (jnp.zeros((Bp, MLSTM_HEADS, MLSTM_HEAD_DIM, MLSTM_HEAD_DIM), f32),
                      jnp.zeros((Bp, MLSTM_HEADS, MLSTM_HEAD_DIM), f32),
                      jnp.zeros((Bp, MLSTM_HEADS), f32),
                      jnp.zeros((Bp, S5_GROUPS, S5_STATE), f32),
                      jnp.zeros((Bp, S5_GROUPS, S5_STATE), f32))
        xp, st_p = hybrid_layer(xp, zero_state, p)
        past_state = (state_mlstm_C[l], state_mlstm_n[l], state_mlstm_m[l], state_s5_re[l], state_s5_im[l])
        xs, st_s = hybrid_layer(xs, past_state, p)
        pC.append(st_p[0]); pn.append(st_p[1]); pm.append(st_p[2]); psr.append(st_p[3]); psi.append(st_p[4])
        sC.append(st_s[0]); sn.append(st_s[1]); sm.append(st_s[2]); ssr.append(st_s[3]); ssi.append(st_s[4])
    y_prompt = rmsnorm(xp, norm_final_g).astype(x_prompt.dtype)
    y_sample = rmsnorm(xs, norm_final_g).astype(x_sample.dtype)
    new_C_prompt = jnp.stack(pC)
    new_n_prompt = jnp.stack(pn)
    new_m_prompt = jnp.stack(pm)
    new_s5_re_prompt = jnp.stack(psr)
    new_s5_im_prompt = jnp.stack(psi)
    new_C_sample = jnp.stack(sC)
    new_n_sample = jnp.stack(sn)
    new_m_sample = jnp.stack(sm)
    new_s5_re_sample = jnp.stack(ssr)
    new_s5_im_sample = jnp.stack(ssi)
    return (y_prompt, y_sample, new_C_prompt, new_n_prompt, new_m_prompt, new_s5_re_prompt, new_s5_im_prompt,
            new_C_sample, new_n_sample, new_m_sample, new_s5_re_sample, new_s5_im_sample)
```

```cpp
#include <hip/hip_runtime.h>
#include <hip/hip_cooperative_groups.h>
#include <cstdio>
#include <cstring>
namespace cg = cooperative_groups;

#define LAS __attribute__((address_space(3)))
typedef unsigned short bf16_t;
typedef short bf16x8 __attribute__((ext_vector_type(8)));
typedef short bf16x4 __attribute__((ext_vector_type(4)));
typedef float f32x4 __attribute__((ext_vector_type(4)));
typedef unsigned u32x4 __attribute__((ext_vector_type(4)));
typedef unsigned u32x2 __attribute__((ext_vector_type(2)));

constexpr int NP = 16384, NS = 128, NT = 16512, DM = 1024, NG1 = 6656, DFF = 2816, PTOT = 6664;
constexpr int LDS_BYTES = 150 * 1024;
#ifndef DUPMASK
#define DUPMASK 0
#endif
#define REP(bit) for (int rep_ = 0; rep_ < ((DUPMASK & (bit)) ? 2 : 1); ++rep_)
constexpr size_t O_YP = 0, O_YS = 16777216, O_CP = 16908288, O_NP = 21102592, O_MP = 21118976, O_SRP = 21119040, O_SIP = 21151808,
                 O_CS = 21184576, O_NS = 88293440, O_MS = 88555584, O_SRS = 88556608, O_SIS = 89080896;

struct TJob { const float* src; const float* scale; bf16_t* dst; int ldn, c0, ncols, K, mode, r0, tile0, ntn, nwrite, pad; };

struct Params {
  const float *x_prompt, *x_sample, *st_C, *st_n, *st_m, *st_sre, *st_sim;
  const float *g_mix, *w_in, *b_in, *g_hn, *w_a, *A_re, *A_im, *log_dt, *B_re, *B_im, *C_re, *C_im, *D_skip, *w_glu, *b_glu, *w_b, *w_out,
      *g_ffn, *w_ff1, *w_ff3, *w_ff2, *g_final;
  float* out;
  bf16_t *WinT[2], *WgT[2], *WgluT[2], *WaT[2], *WbT[2], *WoT[2], *W13T[2], *W2T[2];
  float *abar[2], *bbar[2];
  bf16_t *xb, *Pb, *St, *ysb, *ys2, *xa, *mg, *act;
  float *X1, *X2, *gat, *hss, *Eend; bf16_t *hA, *t1;
  unsigned long long *ssA, *ssB;
  unsigned* bar;
  bf16_t *Kt[2], *Gm[2], *Hm[2]; float *a16[2], *E2;
  TJob jobs[22];
  int njobs, total_tiles;
};

__device__ __forceinline__ bf16_t f2bf(float f) { return __builtin_bit_cast(bf16_t, (__bf16)f); }
__device__ __forceinline__ float bf2f(unsigned b) { return __uint_as_float(b << 16); }
typedef float f32x2 __attribute__((ext_vector_type(2)));
typedef __bf16 bf16x2v __attribute__((ext_vector_type(2)));
__device__ __forceinline__ unsigned pack2(float lo, float hi) { const f32x2 v = {lo, hi}; const bf16x2v b = __builtin_convertvector(v, bf16x2v); return __builtin_bit_cast(unsigned, b); }
__device__ __forceinline__ u32x2 pack4(f32x4 v) { u32x2 r; r.x = pack2(v[0], v[1]); r.y = pack2(v[2], v[3]); return r; }
__device__ __forceinline__ f32x4 unpack4(u32x2 u) { f32x4 r; r[0] = bf2f(u.x & 0xffffu); r[1] = bf2f(u.x >> 16); r[2] = bf2f(u.y & 0xffffu); r[3] = bf2f(u.y >> 16); return r; }
__device__ __forceinline__ float sigmoidf_(float x) { return __builtin_amdgcn_rcpf(1.0f + __expf(-x)); }
__device__ __forceinline__ float gelu_tanh(float x) { float z = 0.7978845608f * (x + 0.044715f * x * x * x); float e = __expf(2.0f * z); float th = 1.0f - 2.0f * __builtin_amdgcn_rcpf(e + 1.0f); return 0.5f * x * (1.0f + th); }
__device__ __forceinline__ int tidx() { int t = threadIdx.x; asm volatile("" : "+v"(t)); return t; }
#define LDS_BARRIER() do { asm volatile("s_waitcnt lgkmcnt(0)" ::: "memory"); __builtin_amdgcn_s_barrier(); asm volatile("" ::: "memory"); } while (0)
__device__ __forceinline__ float wave_sum(float v) { for (int o = 32; o > 0; o >>= 1) v += __shfl_xor(v, o); return v; }

namespace pg8 {
constexpr int BM = 256, BK = 64, HALF = 128, HTB = HALF * BK * 2, STAGE_BYTES = 8 * HTB, NXCD = 8, WGM = 8;
__host__ __device__ __forceinline__ int lds_byte(int r, int c) { const int st = (r >> 4) * 2 + (c >> 5), rr = r & 15, cc = c & 31, ob = rr * 64 + cc * 2; return st * 1024 + (ob ^ (((ob >> 9) & 1) << 5)); }
__host__ __device__ __forceinline__ void stage_rc(int b, int& R, int& C) { const int st = b / 1024, sb = b % 1024, swz = sb ^ (((sb >> 9) & 1) << 5); R = (st >> 1) * 16 + swz / 64; C = (st & 1) * 32 + (swz % 64) / 2; }
__host__ __device__ __forceinline__ int perm32(int rho) { const int n = rho >> 4, i = rho & 15; return 8 * (i >> 2) + 4 * n + (i & 3); }
struct Unit { int pm, pn; };
struct Gemm { const bf16_t* A; const bf16_t* Bt; int M, N, K; };
struct StaticOrder {
  int nM, nN, nwg, G, c;
  __device__ void init(int M, int N, int G_, int c_) { nM = M / BM; nN = N / BM; nwg = nM * nN; G = G_; c = c_; }
  __device__ bool next(int i, Unit& u) const {
    const long L = (long)i * G + c; if (L >= nwg) return false;
    int wgid = (int)L; { const int q = nwg / NXCD, r = nwg % NXCD, xcd = wgid % NXCD, off = wgid / NXCD; wgid = (xcd < r ? xcd * (q + 1) : r * (q + 1) + (xcd - r) * q) + off; }
    const int nig = WGM * nN, gid = wgid / nig, fm = gid * WGM, gsz = (nM - fm) < WGM ? (nM - fm) : WGM;
    u.pm = fm + ((wgid % nig) % gsz); u.pn = (wgid % nig) / gsz; return true;
  }
};

template <class Epi, class Sched>
__device__ __forceinline__ void gemm_phase(LAS unsigned char* lds, const Gemm g, const Sched& S, const Epi& E) {
  const int tid = tidx(), wid = __builtin_amdgcn_readfirstlane(tid >> 6), lane = tid & 63, wr = wid >> 2, wc = wid & 3, fr = lane & 15, fq = lane >> 4;
  const int K = g.K, nt = K / BK;
  unsigned voffA[2], voffB[2];
#pragma unroll
  for (int i = 0; i < 2; ++i) { int R, C; stage_rc(tid * 16 + i * 8192, R, C); voffA[i] = (unsigned)(R * K + C) * 2u; const int Rb = Epi::PERM ? ((R & ~31) + perm32(R & 31)) : R; voffB[i] = (unsigned)(Rb * K + C) * 2u; }
  const size_t kstep = (size_t)(BK * 2);
  const size_t hstep = (size_t)HALF * K * 2;
  const size_t tstep = 2 * hstep;
  const unsigned ldsw = (unsigned)wid * 1024u;
  const int aoff = lds_byte(wr * 64 + fr, fq * 8), boff = lds_byte(wc * 32 + fr, fq * 8);
#define PG8_SA(b, h) (((b) * 2 + (h)) * HTB)
#define PG8_SB(b, h) ((4 + (b) * 2 + (h)) * HTB)
#define PG8_STAGE(bufoff, gbase, voff) do { _Pragma("unroll") for (int _i = 0; _i < 2; ++_i) \
    __builtin_amdgcn_global_load_lds((const unsigned*)((const char*)(gbase) + (voff)[_i]), (LAS unsigned*)(lds + (bufoff) + ldsw + _i * 8192), 16, 0, 0); } while (0)
#define PG8_LDA(dst, b, h) do { _Pragma("unroll") for (int m = 0; m < 4; ++m) _Pragma("unroll") for (int k = 0; k < 2; ++k) dst[m][k] = *(const LAS bf16x8*)(lds + PG8_SA(b, h) + aoff + m * 2048 + k * 1024); } while (0)
#define PG8_LDB(dst, b, h) do { _Pragma("unroll") for (int n = 0; n < 2; ++n) _Pragma("unroll") for (int k = 0; k < 2; ++k) dst[n][k] = *(const LAS bf16x8*)(lds + PG8_SB(b, h) + boff + n * 2048 + k * 1024); } while (0)
#define PG8_MMA(ai, bj, At, Bt) do { __builtin_amdgcn_s_setprio(1); _Pragma("unroll") for (int m = 0; m < 4; ++m) _Pragma("unroll") for (int n = 0; n < 2; ++n) _Pragma("unroll") for (int k = 0; k < 2; ++k) \
    acc[ai][bj][m][n] = __builtin_amdgcn_mfma_f32_16x16x32_bf16(Bt[n][k], At[m][k], acc[ai][bj][m][n], 0, 0, 0); __builtin_amdgcn_s_setprio(0); } while (0)
#define PG8_WAIT_V(n) asm volatile("s_waitcnt vmcnt(" #n ")" ::: "memory")
#define PG8_WAIT_L(n) asm volatile("s_waitcnt lgkmcnt(" #n ")" ::: "memory")
#define PG8_BAR __builtin_amdgcn_s_barrier()
#define PG8_SCHED __builtin_amdgcn_sched_barrier(0)
  Unit cur, nxt; int ui = 0;
  if (!S.next(0, cur)) return;
  f32x4 acc[2][2][4][2];
#pragma unroll
  for (int a = 0; a < 2; ++a)
#pragma unroll
    for (int b = 0; b < 2; ++b)
#pragma unroll
      for (int m = 0; m < 4; ++m)
#pragma unroll
        for (int n = 0; n < 2; ++n) acc[a][b][m][n] = (f32x4){0.f, 0.f, 0.f, 0.f};
  bf16x8 At[4][2], B0[2][2], B1[2][2];
  const char* cA = (const char*)g.A + (size_t)cur.pm * tstep; const char* cB = (const char*)g.Bt + (size_t)cur.pn * tstep;
  PG8_STAGE(PG8_SB(0, 0), cB, voffB); PG8_STAGE(PG8_SA(0, 0), cA, voffA); PG8_STAGE(PG8_SB(0, 1), cB + hstep, voffB); PG8_STAGE(PG8_SA(0, 1), cA + hstep, voffA);
  if (wr == 1) PG8_BAR;
  PG8_WAIT_V(4); PG8_BAR;
  PG8_STAGE(PG8_SB(1, 0), cB + kstep, voffB); PG8_STAGE(PG8_SA(1, 0), cA + kstep, voffA); PG8_STAGE(PG8_SB(1, 1), cB + hstep + kstep, voffB);
  PG8_WAIT_V(6); PG8_BAR;
  for (;;) {
    const bool has_next = S.next(ui + 1, nxt);
    const char* nA = has_next ? (const char*)g.A + (size_t)nxt.pm * tstep : cA; const char* nB = has_next ? (const char*)g.Bt + (size_t)nxt.pn * tstep : cB;
    for (int t = 0; t < nt; t += 2) {
      const bool last = (t == nt - 2);
      const char* a1 = cA + (size_t)(t + 1) * kstep;
      const char* a2 = last ? nA : cA + (size_t)(t + 2) * kstep; const char* b2 = last ? nB : cB + (size_t)(t + 2) * kstep;
      const char* a3 = a2 + kstep; const char* b3 = b2 + kstep;
      PG8_LDB(B0, 0, 0); PG8_SCHED; PG8_LDA(At, 0, 0); PG8_STAGE(PG8_SA(1, 1), a1 + hstep, voffA);
      PG8_WAIT_L(8); PG8_BAR; PG8_WAIT_L(0); PG8_MMA(0, 0, At, B0); PG8_BAR; PG8_SCHED;
      PG8_LDB(B1, 0, 1); PG8_STAGE(PG8_SB(0, 0), b2, voffB);
      PG8_BAR; PG8_WAIT_L(0); PG8_MMA(0, 1, At, B1); PG8_BAR;
      PG8_LDA(At, 0, 1); PG8_STAGE(PG8_SA(0, 0), a2, voffA);
      PG8_BAR; PG8_WAIT_L(0); PG8_MMA(1, 0, At, B0); PG8_BAR; PG8_SCHED;
      PG8_STAGE(PG8_SB(0, 1), b2 + hstep, voffB);
      PG8_WAIT_V(6); PG8_BAR; PG8_MMA(1, 1, At, B1); PG8_BAR;
      PG8_LDB(B0, 1, 0); PG8_SCHED; PG8_LDA(At, 1, 0); PG8_STAGE(PG8_SA(0, 1), a2 + hstep, voffA);
      PG8_WAIT_L(8); PG8_BAR; PG8_WAIT_L(0); PG8_MMA(0, 0, At, B0); PG8_BAR; PG8_SCHED;
      PG8_LDB(B1, 1, 1); PG8_STAGE(PG8_SB(1, 0), b3, voffB);
      PG8_BAR; PG8_WAIT_L(0); PG8_MMA(0, 1, At, B1); PG8_BAR;
      PG8_LDA(At, 1, 1); PG8_STAGE(PG8_SA(1, 0), a3, voffA);
      PG8_BAR; PG8_WAIT_L(0); PG8_MMA(1, 0, At, B0); PG8_BAR; PG8_SCHED;
      PG8_STAGE(PG8_SB(1, 1), b3 + hstep, voffB);
      PG8_WAIT_V(6); PG8_BAR; PG8_MMA(1, 1, At, B1); PG8_BAR;
    }
    E(acc, cur, wr, wc, fr, fq);
    if (!has_next) break;
#pragma unroll
    for (int a = 0; a < 2; ++a)
#pragma unroll
      for (int b = 0; b < 2; ++b)
#pragma unroll
        for (int m = 0; m < 4; ++m)
#pragma unroll
          for (int n = 0; n < 2; ++n) acc[a][b][m][n] = (f32x4){0.f, 0.f, 0.f, 0.f};
    cur = nxt; cA = nA; cB = nB; ++ui;
  }
  PG8_WAIT_V(0);
  if (wr == 0) PG8_BAR;
  PG8_BAR;
#undef PG8_SA
#undef PG8_SB
#undef PG8_STAGE
#undef PG8_LDA
#undef PG8_LDB
#undef PG8_MMA
#undef PG8_WAIT_V
#undef PG8_WAIT_L
#undef PG8_BAR
#undef PG8_SCHED
}
}

typedef unsigned long long u64;
__device__ __forceinline__ u64 ss_fix(float ss) { return (u64)(ss * 16777216.0f); }
__device__ __forceinline__ float rs_of(u64 q) { const float f = (float)(unsigned)(q >> 32) * 4294967296.0f + (float)(unsigned)q; return rsqrtf(f * (1.0f / (16777216.0f * 1024.0f)) + 1e-6f); }
__device__ __forceinline__ void ss_add(u64* p, float ss) { __hip_atomic_fetch_add(p, ss_fix(ss), __ATOMIC_RELAXED, __HIP_MEMORY_SCOPE_AGENT); }
__device__ __forceinline__ int qcol(int cbase, int q) { return cbase + (q >> 1) * 128 + (q & 1) * 16; }
__device__ __forceinline__ f32x4 unlo(u32x4 u) { return unpack4((u32x2){u[0], u[1]}); }
__device__ __forceinline__ f32x4 unhi(u32x4 u) { return unpack4((u32x2){u[2], u[3]}); }
__device__ __forceinline__ u32x4 pack8(f32x4 a, f32x4 b) { const u32x2 p = pack4(a), q = pack4(b); return (u32x4){p.x, p.y, q.x, q.y}; }
struct F1 {
  static constexpr bool NEEDR = true, STAT = false, PERM = true; static constexpr int RB = 8;
  const float* bias; bf16_t* Pb; const u64* rs; u64* ss;
  struct ColData { f32x4 b[4]; }; struct RowData { u64 s; };
  __device__ __forceinline__ void load_cols(int cbase, ColData& cd) const {
#pragma unroll
    for (int q = 0; q < 4; ++q) { const int col = cbase + (q >> 1) * 128 + (q & 1) * 4; cd.b[q] = *(const f32x4*)(bias + (col < 4096 ? col : col + 8)); } }
  __device__ __forceinline__ void load_row(int row, int, RowData& rd) const { rd.s = rs[row]; }
  __device__ __forceinline__ float apply(int row, int cbase, const f32x4 (&v)[4], const ColData& cd, const RowData& rd) const {
    const float r = rs_of(rd.s);
    const int blk = cbase >> 8;
    const bool isk = blk >= 4 && blk < 8, issig = (blk >= 12 && blk < 16) || blk >= 18;
#pragma unroll
    for (int bj = 0; bj < 2; ++bj) {
      u32x4 pk;
#pragma unroll
      for (int n = 0; n < 2; ++n) {
        f32x4 o = v[bj * 2 + n] * r + cd.b[bj * 2 + n];
        if (isk) o = o * 0.0625f;
        else if (issig) { o[0] = sigmoidf_(o[0]); o[1] = sigmoidf_(o[1]); o[2] = sigmoidf_(o[2]); o[3] = sigmoidf_(o[3]); }
        const u32x2 p2 = pack4(o); pk[2 * n] = p2.x; pk[2 * n + 1] = p2.y;
      }
      *(u32x4*)(Pb + (size_t)row * NG1 + cbase + bj * 128) = pk;
    }
    return 0.f;
  }
  __device__ __forceinline__ float rowscale(int row) const { return rs_of(rs[row]); }
  __device__ __forceinline__ float operator()(int row, int col, f32x4 v, float r) const {
    const int bi = col < 4096 ? col : col + 8;
    const f32x4 b4 = *(const f32x4*)(bias + bi);
    f32x4 o = v * r + b4;
    if (col >= 1024 && col < 2048) o = o * 0.0625f;
    else if ((col >= 3072 && col < 4096) || col >= 4608) { o[0] = sigmoidf_(o[0]); o[1] = sigmoidf_(o[1]); o[2] = sigmoidf_(o[2]); o[3] = sigmoidf_(o[3]); }
    *(u32x2*)(Pb + (size_t)row * NG1 + col) = pack4(o);
    return 0.f;
  }
};
struct Fg {
  static constexpr bool NEEDR = true, STAT = false;
  const float* bias; float* gat; const u64* rs; u64* ss;
  __device__ __forceinline__ float rowscale(int row) const { return rs_of(rs[row]); }
  __device__ __forceinline__ float operator()(int row, int col, f32x4 v, float r) const {
    if (col < 8) {
      const f32x4 b4 = *(const f32x4*)(bias + col);
      f32x4 o = v * r + b4;
      if (col >= 4) {
#pragma unroll
        for (int i = 0; i < 4; ++i) { const float x = o[i]; o[i] = fminf(x, 0.f) - log1pf(__expf(-fabsf(x))); }
      }
      *(f32x4*)(gat + (size_t)row * 8 + col) = o;
    }
    return 0.f;
  }
};
struct Fglu {
  static constexpr bool NEEDR = false, STAT = false, PERM = true; static constexpr int RB = 8;
  const float* bias; const bf16_t* ysb; bf16_t* ys2; u64* ss;
  struct ColData { f32x4 b[4]; }; struct RowData { u32x4 y[2]; };
  __device__ __forceinline__ void load_cols(int cbase, ColData& cd) const {
#pragma unroll
    for (int q = 0; q < 4; ++q) cd.b[q] = *(const f32x4*)(bias + cbase + (q >> 1) * 128 + (q & 1) * 4); }
  __device__ __forceinline__ void load_row(int row, int cbase, RowData& rd) const {
#pragma unroll
    for (int bj = 0; bj < 2; ++bj) rd.y[bj] = *(const u32x4*)(ysb + (size_t)row * 512 + cbase + bj * 128); }
  __device__ __forceinline__ float apply(int row, int cbase, const f32x4 (&v)[4], const ColData& cd, const RowData& rd) const {
#pragma unroll
    for (int bj = 0; bj < 2; ++bj) {
      const f32x4 y0 = unlo(rd.y[bj]), y1 = unhi(rd.y[bj]); f32x4 o0, o1;
#pragma unroll
      for (int i = 0; i < 4; ++i) { o0[i] = y0[i] * sigmoidf_(v[bj * 2][i] + cd.b[bj * 2][i]); o1[i] = y1[i] * sigmoidf_(v[bj * 2 + 1][i] + cd.b[bj * 2 + 1][i]); }
      *(u32x4*)(ys2 + (size_t)row * 512 + cbase + bj * 128) = pack8(o0, o1);
    }
    return 0.f;
  }
  __device__ __forceinline__ float rowscale(int) const { return 1.f; }
  __device__ __forceinline__ float operator()(int row, int col, f32x4 v, float) const {
    const f32x4 b4 = *(const f32x4*)(bias + col);
    const f32x4 y = unpack4(*(const u32x2*)(ysb + (size_t)row * 512 + col));
    f32x4 o;
#pragma unroll
    for (int i = 0; i < 4; ++i) o[i] = y[i] * sigmoidf_(v[i] + b4[i]);
    *(u32x2*)(ys2 + (size_t)row * 512 + col) = pack4(o);
    return 0.f;
  }
};
struct Fa {
  static constexpr bool NEEDR = false, STAT = false, PERM = true; static constexpr int RB = 8;
  const bf16_t* Pb; bf16_t* t1; u64* ss;
  struct ColData { int dummy; }; struct RowData { u32x4 g[2]; };
  __device__ __forceinline__ void load_cols(int, ColData&) const {}
  __device__ __forceinline__ void load_row(int row, int cbase, RowData& rd) const {
#pragma unroll
    for (int bj = 0; bj < 2; ++bj) rd.g[bj] = *(const u32x4*)(Pb + (size_t)row * NG1 + 4608 + cbase + bj * 128); }
  __device__ __forceinline__ float apply(int row, int cbase, const f32x4 (&v)[4], const ColData&, const RowData& rd) const {
#pragma unroll
    for (int bj = 0; bj < 2; ++bj) *(u32x4*)(t1 + (size_t)row * DM + cbase + bj * 128) = pack8(unlo(rd.g[bj]) * v[bj * 2], unhi(rd.g[bj]) * v[bj * 2 + 1]);
    return 0.f;
  }
  __device__ __forceinline__ float rowscale(int) const { return 1.f; }
  __device__ __forceinline__ float operator()(int row, int col, f32x4 v, float) const {
    const f32x4 sg = unpack4(*(const u32x2*)(Pb + (size_t)row * NG1 + 4608 + col));
    *(u32x2*)(t1 + (size_t)row * DM + col) = pack4(sg * v);
    return 0.f;
  }
};
struct Fb {
  static constexpr bool NEEDR = false, STAT = false, PERM = true; static constexpr int RB = 4;
  const bf16_t* Pb; const bf16_t* t1; bf16_t* mg; u64* ss;
  struct ColData { int dummy; }; struct RowData { u32x4 g[2]; u32x4 t[2]; };
  __device__ __forceinline__ void load_cols(int, ColData&) const {}
  __device__ __forceinline__ void load_row(int row, int cbase, RowData& rd) const {
#pragma unroll
    for (int bj = 0; bj < 2; ++bj) { rd.g[bj] = *(const u32x4*)(Pb + (size_t)row * NG1 + 5632 + cbase + bj * 128); rd.t[bj] = *(const u32x4*)(t1 + (size_t)row * DM + cbase + bj * 128); } }
  __device__ __forceinline__ float apply(int row, int cbase, const f32x4 (&v)[4], const ColData&, const RowData& rd) const {
#pragma unroll
    for (int bj = 0; bj < 2; ++bj) *(u32x4*)(mg + (size_t)row * DM + cbase + bj * 128) = pack8(unlo(rd.t[bj]) + unlo(rd.g[bj]) * v[bj * 2], unhi(rd.t[bj]) + unhi(rd.g[bj]) * v[bj * 2 + 1]);
    return 0.f;
  }
  __device__ __forceinline__ float rowscale(int) const { return 1.f; }
  __device__ __forceinline__ float operator()(int row, int col, f32x4 v, float) const {
    const f32x4 sg = unpack4(*(const u32x2*)(Pb + (size_t)row * NG1 + 5632 + col));
    const f32x4 t = unpack4(*(const u32x2*)(t1 + (size_t)row * DM + col));
    *(u32x2*)(mg + (size_t)row * DM + col) = pack4(t + sg * v);
    return 0.f;
  }
};
struct Fres {
  static constexpr bool NEEDR = false, STAT = true, PERM = true; static constexpr int RB = 4;
  const float *xinP, *xinS; float* xo; bf16_t* xb; u64* ss;
  struct ColData { int dummy; }; struct RowData { f32x4 x[4]; };
  __device__ __forceinline__ void load_cols(int, ColData&) const {}
  __device__ __forceinline__ void load_row(int row, int cbase, RowData& rd) const {
#pragma unroll
    for (int q = 0; q < 4; ++q) rd.x[q] = *(const f32x4*)(xinP + (size_t)row * DM + cbase + (q >> 1) * 128 + (q & 1) * 4); }
  __device__ __forceinline__ float apply(int row, int cbase, const f32x4 (&v)[4], const ColData&, const RowData& rd) const {
    float s = 0.f;
#pragma unroll
    for (int bj = 0; bj < 2; ++bj) {
      const f32x4 o0 = rd.x[bj * 2] + v[bj * 2], o1 = rd.x[bj * 2 + 1] + v[bj * 2 + 1];
      float* xp = xo + (size_t)row * DM + cbase + bj * 128;
      *(f32x4*)xp = o0; *(f32x4*)(xp + 4) = o1;
      const u32x2 p0 = pack4(o0), p1 = pack4(o1);
      *(u32x4*)(xb + (size_t)row * DM + cbase + bj * 128) = (u32x4){p0.x, p0.y, p1.x, p1.y};
      s += (o0[0] * o0[0] + o0[1] * o0[1]) + (o0[2] * o0[2] + o0[3] * o0[3]) + (o1[0] * o1[0] + o1[1] * o1[1]) + (o1[2] * o1[2] + o1[3] * o1[3]);
    }
    return s;
  }
  __device__ __forceinline__ float rowscale(int) const { return 1.f; }
  __device__ __forceinline__ float operator()(int row, int col, f32x4 v, float) const {
    const float* xi = row < NP ? xinP + (size_t)row * DM : xinS + (size_t)(row - NP) * DM;
    const f32x4 o = *(const f32x4*)(xi + col) + v;
    *(f32x4*)(xo + (size_t)row * DM + col) = o;
    *(u32x2*)(xb + (size_t)row * DM + col) = pack4(o);
    return (o[0] * o[0] + o[1] * o[1]) + (o[2] * o[2] + o[3] * o[3]);
  }
};
struct F13 {
  const u64* rs; bf16_t* act;
  __device__ __forceinline__ float rowscale(int row) const { return rs_of(rs[row]); }
  __device__ __forceinline__ f32x4 glu(f32x4 a1, f32x4 a3, float r) const {
    f32x4 o;
#pragma unroll
    for (int i = 0; i < 4; ++i) { const float x1 = a1[i] * r, x3 = a3[i] * r; o[i] = x1 * sigmoidf_(x1) * x3; }
    return o;
  }
  __device__ __forceinline__ void pair(int row, int j, f32x4 a1, f32x4 a3, float r) const { *(u32x2*)(act + (size_t)row * DFF + j) = pack4(glu(a1, a3, r)); }
};

template <class F> struct EpiMain {
  static constexpr bool PERM = F::PERM;
  F f;
  __device__ __forceinline__ void operator()(const f32x4 (&acc)[2][2][4][2], const pg8::Unit& u, int wr, int wc, int fr, int fq) const {
    const int rbase = u.pm * 256 + wr * 64 + fr, cbase = u.pn * 256 + wc * 32 + (F::PERM ? 8 : 4) * fq;
    typename F::ColData cd; f.load_cols(cbase, cd);
#pragma unroll
    for (int b0 = 0; b0 < 8; b0 += F::RB) {
      typename F::RowData rd[F::RB];
#pragma unroll
      for (int k = 0; k < F::RB; ++k) { const int i = b0 + k; f.load_row(rbase + (i >> 2) * 128 + (i & 3) * 16, cbase, rd[k]); }
      __builtin_amdgcn_sched_barrier(0);
#pragma unroll
      for (int k = 0; k < F::RB; ++k) {
        const int i = b0 + k, ai = i >> 2, m = i & 3, row = rbase + ai * 128 + m * 16;
        const f32x4 v[4] = {acc[ai][0][m][0], acc[ai][0][m][1], acc[ai][1][m][0], acc[ai][1][m][1]};
        float s = f.apply(row, cbase, v, cd, rd[k]);
        if (F::STAT) { s += __shfl_xor(s, 16); s += __shfl_xor(s, 32); if (fq == 0) ss_add(f.ss + row, s); }
      }
      __builtin_amdgcn_sched_barrier(0);
    }
  }
};
struct EpiMain13 {
  static constexpr bool PERM = true;
  F13 f;
  __device__ __forceinline__ void operator()(const f32x4 (&acc)[2][2][4][2], const pg8::Unit& u, int wr, int wc, int fr, int fq) const {
    const int rbase = u.pm * 256 + wr * 64 + fr, jbase = u.pn * 128 + wc * 32 + 8 * fq;
    u64 sq[8];
#pragma unroll
    for (int i = 0; i < 8; ++i) sq[i] = f.rs[rbase + (i >> 2) * 128 + (i & 3) * 16];
    __builtin_amdgcn_sched_barrier(0);
#pragma unroll
    for (int i = 0; i < 8; ++i) {
      const int ai = i >> 2, m = i & 3, row = rbase + ai * 128 + m * 16;
      const float r = rs_of(sq[i]);
      *(u32x4*)(f.act + (size_t)row * DFF + jbase) = pack8(f.glu(acc[ai][0][m][0], acc[ai][1][m][0], r), f.glu(acc[ai][0][m][1], acc[ai][1][m][1], r));
    }
  }
};

template <int NACC>
__device__ __forceinline__ void skinny_unit(const bf16_t* A, int K, const bf16_t* Bt, int row0, int brow0, int bstep, float* red, f32x4 (&out)[NACC]) {
  const int tid = tidx(), w = tid >> 6, lane = tid & 63, g4 = lane >> 4, l15 = lane & 15;
  const int nks = K >> 8, kbase = w * (K >> 3) + 8 * g4;
  f32x4 acc[8][NACC];
#pragma unroll
  for (int rt = 0; rt < 8; ++rt)
#pragma unroll
    for (int i = 0; i < NACC; ++i) acc[rt][i] = (f32x4){0.f, 0.f, 0.f, 0.f};
  const bf16_t* ap = A + (size_t)(row0 + l15) * K + kbase;
  const bf16_t* bp = Bt + (size_t)(brow0 + l15) * K + kbase;
  for (int ks = 0; ks < nks; ks += 2) {
    const bool two = ks + 1 < nks;
    bf16x8 a0[8], a1[8], b0[NACC], b1[NACC];
#pragma unroll
    for (int rt = 0; rt < 8; ++rt) a0[rt] = *(const bf16x8*)(ap + (size_t)16 * rt * K + 32 * ks);
#pragma unroll
    for (int i = 0; i < NACC; ++i) b0[i] = *(const bf16x8*)(bp + (size_t)bstep * i * K + 32 * ks);
    if (two) {
#pragma unroll
      for (int rt = 0; rt < 8; ++rt) a1[rt] = *(const bf16x8*)(ap + (size_t)16 * rt * K + 32 * ks + 32);
#pragma unroll
      for (int i = 0; i < NACC; ++i) b1[i] = *(const bf16x8*)(bp + (size_t)bstep * i * K + 32 * ks + 32);
    }
#pragma unroll
    for (int rt = 0; rt < 8; ++rt)
#pragma unroll
      for (int i = 0; i < NACC; ++i) acc[rt][i] = __builtin_amdgcn_mfma_f32_16x16x32_bf16(b0[i], a0[rt], acc[rt][i], 0, 0, 0);
    if (two) {
#pragma unroll
      for (int rt = 0; rt < 8; ++rt)
#pragma unroll
        for (int i = 0; i < NACC; ++i) acc[rt][i] = __builtin_amdgcn_mfma_f32_16x16x32_bf16(b1[i], a1[rt], acc[rt][i], 0, 0, 0);
    }
  }
#pragma unroll
  for (int rt = 0; rt < 8; ++rt)
#pragma unroll
    for (int i = 0; i < NACC; ++i) *(f32x4*)(red + (size_t)(((w * 8 + rt) * NACC + i) * 64 + lane) * 4) = acc[rt][i];
  __syncthreads();
#pragma unroll
  for (int i = 0; i < NACC; ++i) {
    f32x4 t = (f32x4){0.f, 0.f, 0.f, 0.f};
#pragma unroll
    for (int ww = 0; ww < 8; ++ww) t += *(const f32x4*)(red + (size_t)(((ww * 8 + w) * NACC + i) * 64 + lane) * 4);
    out[i] = t;
  }
}
template <class F>
__device__ __forceinline__ void skinny_run(const F& f, const bf16_t* A, int K, const bf16_t* Bt, int rowbase, int nrt, int ncu, int bid, int G, unsigned char* shm, int c0 = 0) {
  const int tid = tidx(), w = tid >> 6, lane = tid & 63, g = lane >> 4;
  const int total = nrt * ncu, nc = G - c0;
  if (bid < c0) return;
  for (int su = (G - 1 - bid); su < total; su += nc) {
    const int rt = su / ncu, cu = su - rt * ncu;
    const int row0 = rowbase + rt * 128, arow = row0 + 16 * w + (lane & 15);
    f32x4 acc[1];
    skinny_unit<1>(A, K, Bt, row0, 16 * cu, 16, (float*)shm, acc);
    const float rs = F::NEEDR ? f.rowscale(arow) : 1.f;
    float ss = f(arow, 16 * cu + 4 * g, acc[0], rs);
    if (F::STAT) { ss += __shfl_xor(ss, 16); ss += __shfl_xor(ss, 32); if (g == 0) ss_add(f.ss + arow, ss); }
    __syncthreads();
  }
}
__device__ __forceinline__ void skinny_run13(const F13& f, const bf16_t* A, const bf16_t* Bt, int bid, int G, unsigned char* shm) {
  const int tid = tidx(), w = tid >> 6, lane = tid & 63, g = lane >> 4;
  const int c0 = ((NP / 256) * (2 * DFF / 256)) % G, nc = G - c0;
  if (bid < c0) return;
  for (int su = (G - 1 - bid); su < DFF / 16; su += nc) {
    const int arow = NP + 16 * w + (lane & 15);
    f32x4 acc[2];
    skinny_unit<2>(A, 1024, Bt, NP, ((16 * su) >> 7) * 256 + ((16 * su) & 127), 128, (float*)shm, acc);
    f.pair(arow, 16 * su + 4 * g, acc[0], acc[1], f.rowscale(arow));
    __syncthreads();
  }
}
template <class F>
__device__ __forceinline__ void gemm_all(LAS unsigned char* lds, unsigned char* shm, const bf16_t* A, const bf16_t* Bt, int N, int K, const F& f, int bid, int G) {
  pg8::Gemm g; g.A = A; g.Bt = Bt; g.M = NP; g.N = N; g.K = K;
  pg8::StaticOrder S; S.init(NP, N, G, bid);
  EpiMain<F> E; E.f = f;
  REP(F::STAT ? 0 : 512) pg8::gemm_phase(lds, g, S, E);
  REP(F::STAT ? 0 : 256) skinny_run(f, A, K, Bt, NP, 1, N / 16, bid, G, shm, ((NP / 256) * (N / 256)) % G);
}

__device__ __forceinline__ void prep_s5tables(const Params& P, int item, unsigned char* shm);
__device__ __forceinline__ void prep_phase(const Params& P, unsigned char* shm, int bid, int G) {
  const int tid = tidx(), w = tid >> 6, lane = tid & 63;
  bf16_t* T = (bf16_t*)shm;
  for (int t0 = 4 * bid; t0 < P.total_tiles; t0 += 4 * G) {
    f32x4 v0[4], v1[4]; float sc[4];
    const int kk = tid >> 3, jq = tid & 7, nn = jq * 8;
#pragma unroll
    for (int u = 0; u < 4; ++u) {
      const int tile = t0 + u;
      v0[u] = (f32x4){0.f, 0.f, 0.f, 0.f}; v1[u] = v0[u]; sc[u] = 1.f;
      if (tile < P.total_tiles) {
        int ji = 0;
        while (ji + 1 < P.njobs && P.jobs[ji + 1].tile0 <= tile) ++ji;
        const TJob& J = P.jobs[ji];
        const int lt = tile - J.tile0, tn = lt % J.ntn, tk = lt / J.ntn, k0 = tk * 64, n0 = tn * 64;
        if (n0 + nn < J.ncols) { const float* sp = J.src + (size_t)(k0 + kk) * J.ldn + J.c0 + n0 + nn; v0[u] = *(const f32x4*)sp; v1[u] = *(const f32x4*)(sp + 4); }
        if (J.scale) sc[u] = J.scale[k0 + kk];
      }
    }
#pragma unroll
    for (int u = 0; u < 4; ++u) {
      bf16_t* Tu = T + u * (64 * 72);
      const int kx = kk ^ (8 * jq);
#pragma unroll
      for (int i = 0; i < 4; ++i) { Tu[(nn + i) * 72 + kx] = f2bf(v0[u][i] * sc[u]); Tu[(nn + 4 + i) * 72 + kx] = f2bf(v1[u][i] * sc[u]); }
    }
    __syncthreads();
#pragma unroll
    for (int u = 0; u < 4; ++u) {
      const int tile = t0 + u;
      if (tile < P.total_tiles) {
        int ji = 0;
        while (ji + 1 < P.njobs && P.jobs[ji + 1].tile0 <= tile) ++ji;
        const TJob& J = P.jobs[ji];
        const int lt = tile - J.tile0, tn = lt % J.ntn, tk = lt / J.ntn, k0 = tk * 64, n0 = tn * 64;
        const int n = tid >> 3, k8 = (tid & 7) * 8, gn = n0 + n;
        if (gn < J.nwrite) {
          const int dr = J.mode == 0 ? J.r0 + gn : ((gn >> 7) * 256 + (J.mode == 2 ? 128 : 0) + (gn & 127));
          *(u32x4*)(J.dst + (size_t)dr * J.K + k0 + k8) = *(const u32x4*)(T + u * (64 * 72) + n * 72 + (k8 ^ (8 * ((n >> 3) & 7))));
        }
      }
    }
    __syncthreads();
  }
  for (int i = bid * 512 + tid; i < 2 * 2048; i += G * 512) {
    const int l = i >> 11, gp = i & 2047, g = gp >> 6, p = gp & 63;
    const float dt = expf(P.log_dt[l * 32 + g]);
    const float Ar = P.A_re[l * 2048 + gp], Ai = P.A_im[l * 2048 + gp];
    const float mag = expf(dt * Ar);
    float sn, cs; sincosf(dt * Ai, &sn, &cs);
    const float abr = mag * cs, abi = mag * sn;
    const float den = Ar * Ar + Ai * Ai, nr = abr - 1.0f, ni = abi;
    const float fre = (nr * Ar + ni * Ai) / den, fim = (ni * Ar - nr * Ai) / den;
    P.abar[l][gp] = abr; P.abar[l][2048 + gp] = abi;
    for (int c = 0; c < 16; ++c) {
      const float Br = P.B_re[(size_t)l * 32768 + gp * 16 + c], Bi = P.B_im[(size_t)l * 32768 + gp * 16 + c];
      P.bbar[l][(g * 16 + c) * 64 + p] = fre * Br - fim * Bi;
      P.bbar[l][32768 + (g * 16 + c) * 64 + p] = fre * Bi + fim * Br;
    }
  }
  for (int it = bid; it < 64; it += G) prep_s5tables(P, it, shm);
  for (int row = bid * 8 + w; row < NT; row += G * 8) {
    const float* xr = row < NP ? P.x_prompt + (size_t)row * DM : P.x_sample + (size_t)(row - NP) * DM;
    float ss = 0.f;
#pragma unroll
    for (int i = 0; i < 4; ++i) {
      const f32x4 v = *(const f32x4*)(xr + 256 * i + 4 * lane);
      ss += (v[0] * v[0] + v[1] * v[1]) + (v[2] * v[2] + v[3] * v[3]);
      *(u32x2*)(P.xb + (size_t)row * DM + 256 * i + 4 * lane) = pack4(v);
    }
    ss = wave_sum(ss);
    if (lane == 0) P.ssA[row] = ss_fix(ss);
  }
}

__device__ __forceinline__ void mlstm_scalars(const float* gat, int b, int h, float* sA, float* sM, float* sB, float* chain) {
  const int tid = tidx(), w = tid >> 6, lane = tid & 63;
  for (int cc = w; cc < 16; cc += 8) {
    const int t0 = cc * 128 + 2 * lane; const size_t r0 = (size_t)b * 2048 + t0;
    const float ig0 = gat[r0 * 8 + h], lf0 = gat[r0 * 8 + 4 + h], ig1 = gat[(r0 + 1) * 8 + h], lf1 = gat[(r0 + 1) * 8 + 4 + h];
    float x = lf0 + lf1;
    for (int off = 1; off < 64; off <<= 1) { const float y = __shfl_up(x, off); if (lane >= off) x += y; }
    const float b1 = x, b0 = x - lf1, a0 = ig0 - b0, a1 = ig1 - b1;
    float cm = fmaxf(a0, a1);
    for (int off = 1; off < 64; off <<= 1) { const float y = __shfl_up(cm, off); if (lane >= off) cm = fmaxf(cm, y); }
    const float prev = __shfl_up(cm, 1); const float cm0 = lane ? fmaxf(prev, a0) : a0;
    sB[t0] = b0; sB[t0 + 1] = b1; sA[t0] = a0; sA[t0 + 1] = a1; sM[t0] = cm0; sM[t0 + 1] = cm;
    if (lane == 63) { chain[33 + cc] = b1; chain[49 + cc] = cm; }
  }
  __syncthreads();
  if (tid == 0) { float m = 0.f; for (int cc = 0; cc < 16; ++cc) { chain[cc] = m; const float ml = fmaxf(m, chain[49 + cc]); chain[17 + cc] = ml; m = chain[33 + cc] + ml; } chain[16] = m; }
  __syncthreads();
  for (int t = tid; t < 2048; t += 512) sM[t] = fmaxf(chain[t >> 7], sM[t]);
  __syncthreads();
}

__device__ __forceinline__ void m1_item(const Params& P, int item, unsigned char* shm) {
  const int tid = tidx(), w = __builtin_amdgcn_readfirstlane(tid >> 6), lane = tid & 63, g = lane >> 4;
  const int b = item >> 6, h = (item >> 4) & 3, c = item & 15;
  float* sA = (float*)shm; float* sM = sA + 2048; float* sB = sM + 2048; float* chain = sB + 2048;
  mlstm_scalars(P.gat, b, h, sA, sM, sB, chain);
  const int row0 = b * 2048 + c * 128, t = 16 * w + (lane & 15);
  const bf16_t* qp = P.Pb + (size_t)(row0 + t) * NG1 + h * 256 + 8 * g;
  bf16x8 qf[8];
#pragma unroll
  for (int ks = 0; ks < 8; ++ks) qf[ks] = *(const bf16x8*)(qp + 32 * ks);
  const float Mt = sM[c * 128 + t];
  bf16_t* sp = P.St + (size_t)item * 16384 + t * 128;
#pragma unroll
  for (int sg = 0; sg < 8; sg += 4) {
    if (sg <= w) {
      bf16x8 kf[4][8];
#pragma unroll
      for (int u = 0; u < 4; ++u) {
        if (sg + u <= w) {
          const bf16_t* kp = P.Pb + (size_t)(row0 + 16 * (sg + u) + (lane & 15)) * NG1 + 1024 + h * 256 + 8 * g;
#pragma unroll
          for (int ks = 0; ks < 8; ++ks) kf[u][ks] = *(const bf16x8*)(kp + 32 * ks);
        }
      }
#pragma unroll
      for (int u = 0; u < 4; ++u) {
        const int st = sg + u;
        f32x4 acc = (f32x4){0.f, 0.f, 0.f, 0.f};
        if (st <= w) {
#pragma unroll
          for (int ks = 0; ks < 8; ++ks) acc = __builtin_amdgcn_mfma_f32_16x16x32_bf16(kf[u][ks], qf[ks], acc, 0, 0, 0);
#pragma unroll
          for (int r = 0; r < 4; ++r) { const int s2 = 16 * st + 4 * g + r; acc[r] = (s2 <= t) ? acc[r] * __expf(sA[c * 128 + s2] - Mt) : 0.f; }
        }
        *(u32x2*)(sp + 16 * st + 4 * g) = pack4(acc);
      }
    } else {
#pragma unroll
      for (int u = 0; u < 4; ++u) *(u32x2*)(sp + 16 * (sg + u) + 4 * g) = (u32x2){0u, 0u};
    }
  }
  __syncthreads();
}

__device__ __forceinline__ bf16x8 trread8(unsigned a0, unsigned a1) {
  bf16x4 lo, hi;
  asm volatile("ds_read_b64_tr_b16 %0, %2\n\tds_read_b64_tr_b16 %1, %3\n\ts_waitcnt lgkmcnt(0)" : "=&v"(lo), "=&v"(hi) : "v"(a0), "v"(a1) : "memory");
  return __builtin_shufflevector(lo, hi, 0, 1, 2, 3, 4, 5, 6, 7);
}
__device__ __forceinline__ void trread8x3(unsigned a0, unsigned a1, unsigned a2, unsigned dlt, bf16x8& r0, bf16x8& r1, bf16x8& r2) {
  bf16x4 l0, h0, l1, h1, l2, h2;
  asm volatile("ds_read_b64_tr_b16 %0, %6\n\tds_read_b64_tr_b16 %1, %7\n\tds_read_b64_tr_b16 %2, %8\n\tds_read_b64_tr_b16 %3, %9\n\tds_read_b64_tr_b16 %4, %10\n\tds_read_b64_tr_b16 %5, %11\n\ts_waitcnt lgkmcnt(0)"
               : "=&v"(l0), "=&v"(h0), "=&v"(l1), "=&v"(h1), "=&v"(l2), "=&v"(h2)
               : "v"(a0), "v"(a0 + dlt), "v"(a1), "v"(a1 + dlt), "v"(a2), "v"(a2 + dlt) : "memory");
  r0 = __builtin_shufflevector(l0, h0, 0, 1, 2, 3, 4, 5, 6, 7); r1 = __builtin_shufflevector(l1, h1, 0, 1, 2, 3, 4, 5, 6, 7); r2 = __builtin_shufflevector(l2, h2, 0, 1, 2, 3, 4, 5, 6, 7);
}
__device__ __forceinline__ void trread8x2(unsigned a0, unsigned a1, unsigned dlt, bf16x8& r0, bf16x8& r1) {
  bf16x4 l0, h0, l1, h1;
  asm volatile("ds_read_b64_tr_b16 %0, %4\n\tds_read_b64_tr_b16 %1, %5\n\tds_read_b64_tr_b16 %2, %6\n\tds_read_b64_tr_b16 %3, %7\n\ts_waitcnt lgkmcnt(0)"
               : "=&v"(l0), "=&v"(h0), "=&v"(l1), "=&v"(h1) : "v"(a0), "v"(a0 + dlt), "v"(a1), "v"(a1 + dlt) : "memory");
  r0 = __builtin_shufflevector(l0, h0, 0, 1, 2, 3, 4, 5, 6, 7); r1 = __builtin_shufflevector(l1, h1, 0, 1, 2, 3, 4, 5, 6, 7);
}

constexpr int KS_STRIDE = 272, VS_STRIDE = 56;
constexpr int M2_K = 0, M2_V = 69632, M2_CL = 83968, M2_SC = 110080;
__device__ __forceinline__ void m2_item(const Params& P, int l, int item, unsigned char* shm) {
  const int tid = tidx(), w = __builtin_amdgcn_readfirstlane(tid >> 6), lane = tid & 63, g = lane >> 4, l15 = lane & 15;
  const int bh = item >> 3, j = item & 7, b = bh >> 2, h = bh & 3;
  bf16_t* Ksh = (bf16_t*)(shm + M2_K); bf16_t* Vsh = (bf16_t*)(shm + M2_V); bf16_t* Cl = (bf16_t*)(shm + M2_CL);
  float* sA = (float*)(shm + M2_SC); float* sM = sA + 2048; float* sB = sM + 2048; float* chain = sB + 2048;
  const unsigned lbase = (unsigned)(size_t)shm;
  u32x4 kreg[8]; u32x4 vreg;
  const int vs = tid >> 2, vpc = tid & 3;
  {
    const int row0 = b * 2048;
#pragma unroll
    for (int i = 0; i < 8; ++i) { const int piece = tid + 512 * i, s = piece >> 5, pc = piece & 31; kreg[i] = *(const u32x4*)(P.Pb + (size_t)(row0 + s) * NG1 + 1024 + h * 256 + 8 * pc); }
    vreg = *(const u32x4*)(P.Pb + (size_t)(row0 + vs) * NG1 + 2048 + h * 256 + 32 * j + 8 * vpc);
  }
  bf16x8 qf[8], sf[4];
  {
    const int t = 16 * w + l15;
#pragma unroll
    for (int ks = 0; ks < 8; ++ks) qf[ks] = (bf16x8){0, 0, 0, 0, 0, 0, 0, 0};
    const bf16_t* sp0 = P.St + (size_t)(bh * 16) * 16384 + t * 128 + 8 * g;
#pragma unroll
    for (int ks = 0; ks < 4; ++ks) sf[ks] = *(const bf16x8*)(sp0 + 32 * ks);
  }
  mlstm_scalars(P.gat, b, h, sA, sM, sB, chain);
  f32x4 Cacc[2][3];
#pragma unroll
  for (int dt = 0; dt < 2; ++dt)
#pragma unroll
    for (int et = 0; et < 3; ++et) Cacc[dt][et] = (f32x4){0.f, 0.f, 0.f, 0.f};
  const int trq = l15 >> 2, trp = lane & 3;
#define M2_WRITE_KV(cc) do { \
    const float ml_ = chain[17 + (cc)]; \
    _Pragma("unroll") for (int i = 0; i < 8; ++i) { const int piece = tid + 512 * i, s = piece >> 5, pc = piece & 31; \
      const float wk = __expf(sA[(cc) * 128 + s] - ml_); u32x4 sc; \
      _Pragma("unroll") for (int e = 0; e < 4; ++e) { const unsigned u = kreg[i][e]; sc[e] = pack2(bf2f(u & 0xffffu) * wk, bf2f(u >> 16) * wk); } \
      *(u32x4*)(Ksh + s * KS_STRIDE + 8 * pc) = sc; } \
    *(u32x4*)(Vsh + vs * VS_STRIDE + 8 * vpc) = vreg; \
    if (vpc == 0) { unsigned zz = 0u; asm volatile("" : "+v"(zz)); const u32x4 z = (u32x4){zz, zz, zz, zz}; u32x4 o1 = z; o1[0] = 0x3F80u; \
      *(u32x4*)(Vsh + vs * VS_STRIDE + 32) = o1; *(u32x4*)(Vsh + vs * VS_STRIDE + 40) = z; } } while (0)
  M2_WRITE_KV(0);
  __syncthreads();
  for (int c = 0; c < 16; ++c) {
    const int row0 = b * 2048 + c * 128;
    const float mlast = chain[17 + c], mprev = chain[c];
    if (c < 15) {
      const int nrow0 = row0 + 128;
#pragma unroll
      for (int i = 0; i < 8; ++i) { const int piece = tid + 512 * i, s = piece >> 5, pc = piece & 31; kreg[i] = *(const u32x4*)(P.Pb + (size_t)(nrow0 + s) * NG1 + 1024 + h * 256 + 8 * pc); }
      vreg = *(const u32x4*)(P.Pb + (size_t)(nrow0 + vs) * NG1 + 2048 + h * 256 + 32 * j + 8 * vpc);
    }
    {
      const int t = 16 * w + l15, row = row0 + t;
      f32x4 acc[3]; acc[0] = (f32x4){0.f, 0.f, 0.f, 0.f}; acc[1] = acc[0]; acc[2] = acc[0];
      const float Mt = sM[c * 128 + t];
      if (c > 0) {
#pragma unroll
        for (int ks = 0; ks < 8; ++ks) {
          bf16x8 cf[3];
#pragma unroll
          for (int et = 0; et < 3; ++et) cf[et] = *(const bf16x8*)(Cl + (16 * et + l15) * KS_STRIDE + 32 * ks + 8 * g);
          __builtin_amdgcn_sched_barrier(0);
#pragma unroll
          for (int et = 0; et < 3; ++et) acc[et] = __builtin_amdgcn_mfma_f32_16x16x32_bf16(cf[et], qf[ks], acc[et], 0, 0, 0);
          __builtin_amdgcn_sched_barrier(0);
        }
        const float wi = __expf(mprev - Mt);
        acc[0] *= wi; acc[1] *= wi; acc[2] *= wi;
      }
      const float ac = __expf(mprev - mlast);
#pragma unroll
      for (int dt = 0; dt < 2; ++dt)
#pragma unroll
        for (int et = 0; et < 3; ++et) Cacc[dt][et] *= ac;
#pragma unroll
      for (int ks = 0; ks < 4; ++ks) {
        bf16x8 kf[2], vf[3];
        const unsigned va = lbase + M2_V + (unsigned)((32 * ks + 8 * g + trq) * VS_STRIDE + 4 * trp) * 2u;
        const unsigned ka = lbase + M2_K + (unsigned)((32 * ks + 8 * g + trq) * KS_STRIDE + 32 * w + 4 * trp) * 2u;
        trread8x3(va, va + 32u, va + 64u, 4u * VS_STRIDE * 2u, vf[0], vf[1], vf[2]);
        trread8x2(ka, ka + 32u, 4u * KS_STRIDE * 2u, kf[0], kf[1]);
#pragma unroll
        for (int et = 0; et < 3; ++et) acc[et] = __builtin_amdgcn_mfma_f32_16x16x32_bf16(vf[et], sf[ks], acc[et], 0, 0, 0);
#pragma unroll
        for (int dt = 0; dt < 2; ++dt)
#pragma unroll
          for (int et = 0; et < 3; ++et) Cacc[dt][et] = __builtin_amdgcn_mfma_f32_16x16x32_bf16(kf[dt], vf[et], Cacc[dt][et], 0, 0, 0);
      }
      if (c < 15) {
        const bf16_t* qp = P.Pb + (size_t)(row + 128) * NG1 + h * 256 + 8 * g;
#pragma unroll
        for (int ks = 0; ks < 8; ++ks) qf[ks] = *(const bf16x8*)(qp + 32 * ks);
        const bf16_t* sp = P.St + (size_t)(bh * 16 + c + 1) * 16384 + t * 128 + 8 * g;
#pragma unroll
        for (int ks = 0; ks < 4; ++ks) sf[ks] = *(const bf16x8*)(sp + 32 * ks);
      }
      const float den = __shfl(acc[2][0], l15);
      const float dd = fmaxf(fabsf(den), __expf(-(sB[c * 128 + t] + Mt)));
      const float inv = __builtin_amdgcn_rcpf(dd);
      const f32x4 o0 = acc[0] * inv, o1 = acc[1] * inv;
      bf16_t* hp = P.hA + (size_t)row * DM + h * 256 + 32 * j + 4 * g;
      *(u32x2*)hp = pack4(o0); *(u32x2*)(hp + 16) = pack4(o1);
      float ss = (o0[0] * o0[0] + o0[1] * o0[1]) + (o0[2] * o0[2] + o0[3] * o0[3]) + (o1[0] * o1[0] + o1[1] * o1[1]) + (o1[2] * o1[2] + o1[3] * o1[3]);
      ss += __shfl_xor(ss, 16); ss += __shfl_xor(ss, 32);
      if (g == 0) P.hss[(size_t)row * 32 + h * 8 + j] = ss;
    }
    LDS_BARRIER();
#pragma unroll
    for (int dt = 0; dt < 2; ++dt)
#pragma unroll
      for (int et = 0; et < 3; ++et) *(u32x2*)(Cl + (16 * et + l15) * KS_STRIDE + 32 * w + 16 * dt + 4 * g) = pack4(Cacc[dt][et]);
    if (c < 15) M2_WRITE_KV(c + 1);
    LDS_BARRIER();
  }
#undef M2_WRITE_KV
  const size_t sidx = (size_t)(l * 8 + b) * 4 + h;
#pragma unroll
  for (int dt = 0; dt < 2; ++dt)
#pragma unroll
    for (int r = 0; r < 4; ++r) {
      const int d = 32 * w + 16 * dt + 4 * g + r;
      P.out[O_CP + sidx * 65536 + (size_t)d * 256 + 32 * j + l15] = Cacc[dt][0][r];
      P.out[O_CP + sidx * 65536 + (size_t)d * 256 + 32 * j + 16 + l15] = Cacc[dt][1][r];
      if (j == 0 && l15 == 0) P.out[O_NP + sidx * 256 + d] = Cacc[dt][2][r];
    }
  if (j == 0 && tid == 0) P.out[O_MP + sidx] = chain[16];
  __syncthreads();
}

__device__ __forceinline__ void msample_item(const Params& P, int l, int item, unsigned char* shm) {
  const int tid = tidx(), w = tid >> 6, lane = tid & 63;
  const int b = item >> 2, h = item & 3, row = NP + b;
  float* q = (float*)shm; float* k = q + 256; float* v = k + 256; float* red = v + 256; float* red2 = red + 2048;
  if (tid < 256) {
    const bf16_t* pr = P.Pb + (size_t)row * NG1 + h * 256 + tid;
    q[tid] = bf2f(pr[0]); k[tid] = bf2f(pr[1024]); v[tid] = bf2f(pr[2048]);
  }
  const float ig = P.gat[(size_t)row * 8 + h], lf = P.gat[(size_t)row * 8 + 4 + h];
  const size_t sidx = (size_t)(l * 128 + b) * 4 + h;
  const float m0 = P.st_m[sidx];
  const float inter = lf + m0, mt = fmaxf(inter, ig), wi = __expf(inter - mt), wa = __expf(ig - mt);
  __syncthreads();
  const float* C0 = P.st_C + sidx * 65536; float* Co = P.out + O_CS + sidx * 65536;
  const float* n0 = P.st_n + sidx * 256;
  const f32x4 v4 = *(const f32x4*)(v + 4 * lane);
  f32x4 acc = (f32x4){0.f, 0.f, 0.f, 0.f};
#pragma unroll 8
  for (int dd = 0; dd < 32; ++dd) {
    const int d = 32 * w + dd;
    const f32x4 c4 = __builtin_nontemporal_load((const f32x4*)(C0 + (size_t)d * 256 + 4 * lane));
    const float kd = wa * k[d], qd = q[d];
    __builtin_nontemporal_store(c4 * wi + v4 * kd, (f32x4*)(Co + (size_t)d * 256 + 4 * lane));
    acc += c4 * qd;
  }
  *(f32x4*)(red + w * 256 + 4 * lane) = acc;
  float qk = 0.f, qn = 0.f;
#pragma unroll
  for (int i = 0; i < 4; ++i) { const int d = lane + 64 * i; qk += q[d] * k[d]; qn += q[d] * n0[d]; }
  qk = wave_sum(qk); qn = wave_sum(qn);
  __syncthreads();
  const float s = qk * wa, den = wi * qn + s, ddn = fmaxf(fabsf(den), __expf(-mt));
  float hval = 0.f;
  if (tid < 256) {
    float num = 0.f;
#pragma unroll
    for (int i = 0; i < 8; ++i) num += red[i * 256 + tid];
    hval = (wi * num + s * v[tid]) / ddn;
    P.hA[(size_t)row * DM + h * 256 + tid] = f2bf(hval);
    P.out[O_NS + sidx * 256 + tid] = wi * n0[tid] + wa * k[tid];
  }
  float ss = wave_sum(hval * hval);
  if (lane == 0) red2[w] = ss;
  __syncthreads();
  if (tid < 8) P.hss[(size_t)row * 32 + h * 8 + tid] = tid == 0 ? (red2[0] + red2[1] + red2[2] + red2[3]) : 0.f;
  if (tid == 0) P.out[O_MS + sidx] = mt;
  __syncthreads();
}

__device__ __forceinline__ void s5_load_C(const Params& P, int l, int g, float* Csh) {
  for (int i = tidx(); i < 2048; i += 512) { const int ri = i >> 10, c = (i >> 6) & 15, p = i & 63;
    Csh[ri * 1088 + c * 68 + p] = (ri ? P.C_im : P.C_re)[(size_t)l * 32768 + (g * 16 + c) * 64 + p]; }
}
__device__ __forceinline__ void s5_sample_item(const Params& P, int l, int item, unsigned char* shm) {
  const int tid = tidx(), w = tid >> 6, lane = tid & 63;
  const int g = item & 31, bs0 = (item >> 5) * 16 + 2 * w;
  float* Csh = (float*)shm; float* sbuf = Csh + 2176 + w * 2176;
  s5_load_C(P, l, g, Csh);
  const float are = P.abar[l][g * 64 + lane], aim = P.abar[l][2048 + g * 64 + lane];
  float bre[16], bim[16];
#pragma unroll
  for (int c = 0; c < 16; ++c) { bre[c] = P.bbar[l][(g * 16 + c) * 64 + lane]; bim[c] = P.bbar[l][32768 + (g * 16 + c) * 64 + lane]; }
  const int ch = lane >> 2, pq = lane & 3;
  const float Dc = P.D_skip[l * 512 + g * 16 + ch];
  __syncthreads();
#pragma unroll
  for (int rep = 0; rep < 2; ++rep) {
    const int bs = bs0 + rep, row = NP + bs;
    const size_t o = ((size_t)(l * 128 + bs) * 32 + g) * 64 + lane;
    const float s0r = P.st_sre[o], s0i = P.st_sim[o];
    const bf16_t* up = P.Pb + (size_t)row * NG1 + 4096 + g * 16;
    const u32x4 u0 = *(const u32x4*)up, u1 = *(const u32x4*)(up + 8);
    float br = 0.f, bi = 0.f;
#pragma unroll
    for (int i = 0; i < 4; ++i) {
      const float ua = bf2f(u0[i] & 0xffffu), ub = bf2f(u0[i] >> 16), uc = bf2f(u1[i] & 0xffffu), ud = bf2f(u1[i] >> 16);
      br += bre[2 * i] * ua + bre[2 * i + 1] * ub + bre[8 + 2 * i] * uc + bre[8 + 2 * i + 1] * ud;
      bi += bim[2 * i] * ua + bim[2 * i + 1] * ub + bim[8 + 2 * i] * uc + bim[8 + 2 * i + 1] * ud;
    }
    const float sr = are * s0r - aim * s0i + br, si = are * s0i + aim * s0r + bi;
    P.out[O_SRS + o] = sr; P.out[O_SIS + o] = si;
    sbuf[rep * 136 + lane] = sr; sbuf[rep * 136 + 68 + lane] = si;
    asm volatile("s_waitcnt lgkmcnt(0)" ::: "memory");
    float acc = 0.f;
#pragma unroll
    for (int p4 = 0; p4 < 4; ++p4) {
      const int p0 = 16 * pq + 4 * p4;
      const f32x4 vr = *(const f32x4*)(sbuf + rep * 136 + p0), vi = *(const f32x4*)(sbuf + rep * 136 + 68 + p0);
      const f32x4 cr = *(const f32x4*)(Csh + ch * 68 + p0), ci = *(const f32x4*)(Csh + 1088 + ch * 68 + p0);
      acc += (cr[0] * vr[0] + cr[1] * vr[1]) + (cr[2] * vr[2] + cr[3] * vr[3]) - (ci[0] * vi[0] + ci[1] * vi[1]) - (ci[2] * vi[2] + ci[3] * vi[3]);
    }
    acc += __shfl_xor(acc, 1); acc += __shfl_xor(acc, 2);
    if (pq == 0) {
      const float uc = bf2f(up[ch]);
      P.ysb[(size_t)row * 512 + g * 16 + ch] = f2bf(gelu_tanh(acc + Dc * uc));
    }
  }
  __syncthreads();
}

__device__ __forceinline__ void prep_s5tables(const Params& P, int item, unsigned char* shm) {
  const int tid = tidx(), l = item >> 5, g = item & 31;
  float* pwr = (float*)shm; float* pwi = pwr + 17 * 64; float* bbr = pwi + 17 * 64; float* bbi = bbr + 1024; float* Ccr = bbi + 1024; float* Cci = Ccr + 1024;
  if (tid < 64) {
    const int p = tid, gp = g * 64 + p;
    const float dt = expf(P.log_dt[l * 32 + g]);
    const float Ar = P.A_re[l * 2048 + gp], Ai = P.A_im[l * 2048 + gp];
    const float mag = expf(dt * Ar);
    float sn, cs; sincosf(dt * Ai, &sn, &cs);
    const float abr = mag * cs, abi = mag * sn;
    const float den = Ar * Ar + Ai * Ai, nr = abr - 1.0f, ni = abi;
    const float fre = (nr * Ar + ni * Ai) / den, fim = (ni * Ar - nr * Ai) / den;
    float pr = 1.f, pi = 0.f;
    for (int t = 0; t <= 16; ++t) { pwr[t * 64 + p] = pr; pwi[t * 64 + p] = pi; const float a = pr * abr - pi * abi, b = pr * abi + pi * abr; pr = a; pi = b; }
    for (int c = 0; c < 16; ++c) {
      const float Br = P.B_re[(size_t)l * 32768 + gp * 16 + c], Bi = P.B_im[(size_t)l * 32768 + gp * 16 + c];
      bbr[p * 16 + c] = fre * Br - fim * Bi; bbi[p * 16 + c] = fre * Bi + fim * Br;
    }
  }
  for (int i = tid; i < 1024; i += 512) { Ccr[i] = P.C_re[(size_t)l * 32768 + g * 1024 + i]; Cci[i] = P.C_im[(size_t)l * 32768 + g * 1024 + i]; }
  __syncthreads();
  bf16_t* Kt = P.Kt[l] + (size_t)g * 17 * 256; bf16_t* Gm = P.Gm[l] + (size_t)g * 32768; bf16_t* Hm = P.Hm[l] + (size_t)g * 32768;
  for (int o = tid; o < 17 * 256; o += 512) {
    const int tau = o >> 8, c = (o >> 4) & 15, c2 = o & 15;
    float acc = 0.f;
    if (tau < 16) for (int p = 0; p < 64; ++p) {
      const float pr = pwr[tau * 64 + p], pi = pwi[tau * 64 + p], br = bbr[p * 16 + c2], bi = bbi[p * 16 + c2];
      const float zr = pr * br - pi * bi, zi = pr * bi + pi * br;
      acc += Ccr[c * 64 + p] * zr - Cci[c * 64 + p] * zi;
    }
    Kt[o] = f2bf(acc);
  }
  for (int o = tid; o < 32768; o += 512) {
    { const int tc = o >> 7, q = o & 127, t = tc >> 4, c = tc & 15, p = q & 63;
      const float cr = Ccr[c * 64 + p], ci = Cci[c * 64 + p], pr = pwr[(t + 1) * 64 + p], pi = pwi[(t + 1) * 64 + p];
      Gm[o] = f2bf(q < 64 ? (cr * pr - ci * pi) : -(cr * pi + ci * pr)); }
    { const int q = o >> 8, jc = o & 255, j = jc >> 4, c2 = jc & 15, p = q & 63;
      const float pr = pwr[(15 - j) * 64 + p], pi = pwi[(15 - j) * 64 + p], br = bbr[p * 16 + c2], bi = bbi[p * 16 + c2];
      Hm[o] = f2bf(q < 64 ? (pr * br - pi * bi) : (pr * bi + pi * br)); }
  }
  if (tid < 64) { P.a16[l][g * 64 + tid] = pwr[16 * 64 + tid]; P.a16[l][2048 + g * 64 + tid] = pwi[16 * 64 + tid]; }
  __syncthreads();
}
constexpr int S3_R0 = 0, S3_SIN = 69632, S3_KT = 69632 + 34816;
__device__ __forceinline__ void s5_stage3_item(const Params& P, int l, int item, unsigned char* shm) {
  const int tid = tidx(), w = tid >> 6, lane = tid & 63, g4 = lane >> 4, l15 = lane & 15;
  const int b = item >> 5, g = item & 31;
  float* Ebuf = (float*)(shm + S3_R0); bf16_t* Gsh = (bf16_t*)(shm + S3_R0); bf16_t* Sin = (bf16_t*)(shm + S3_SIN); bf16_t* Ksh = (bf16_t*)(shm + S3_KT);
  { bf16_t* Hsh = (bf16_t*)(shm + S3_R0); const bf16_t* Hm = P.Hm[l] + (size_t)g * 32768;
#pragma unroll
    for (int i = 0; i < 8; ++i) { const int piece = tid + 512 * i, r = piece >> 5, pc = piece & 31; *(u32x4*)(Hsh + r * 264 + 8 * pc) = *(const u32x4*)(Hm + r * 256 + 8 * pc); } }
  { const bf16_t* Kt = P.Kt[l] + (size_t)g * 17 * 256; for (int i = tid; i < 544; i += 512) *(u32x4*)(Ksh + 8 * i) = *(const u32x4*)(Kt + 8 * i); }
  const int n = 16 * w + l15, r0 = b * 2048 + n * 16;
  bf16x8 uf[8];
#pragma unroll
  for (int ks = 0; ks < 8; ++ks) uf[ks] = *(const bf16x8*)(P.Pb + (size_t)(r0 + 2 * ks + (g4 >> 1)) * NG1 + 4096 + g * 16 + 8 * (g4 & 1));
  __syncthreads();
  {
    const bf16_t* Hsh = (const bf16_t*)(shm + S3_R0);
    f32x4 eacc[8];
#pragma unroll
    for (int qt = 0; qt < 8; ++qt) {
      eacc[qt] = (f32x4){0.f, 0.f, 0.f, 0.f};
#pragma unroll
      for (int ks = 0; ks < 8; ++ks) { const bf16x8 x = *(const bf16x8*)(Hsh + (16 * qt + l15) * 264 + 32 * ks + 8 * g4); eacc[qt] = __builtin_amdgcn_mfma_f32_16x16x32_bf16(x, uf[ks], eacc[qt], 0, 0, 0); }
    }
    __syncthreads();
#pragma unroll
    for (int qt = 0; qt < 8; ++qt) *(f32x4*)(Ebuf + n * 128 + 16 * qt + 4 * g4) = eacc[qt];
  }
  __syncthreads();
  {
    const float ar = P.a16[l][g * 64 + lane], ai = P.a16[l][2048 + g * 64 + lane];
    float lr[16], li[16], sr = 0.f, si = 0.f;
#pragma unroll
    for (int k = 0; k < 16; ++k) {
      lr[k] = sr; li[k] = si;
      const float er = Ebuf[(16 * w + k) * 128 + lane], ei = Ebuf[(16 * w + k) * 128 + 64 + lane];
      const float nr = ar * sr - ai * si + er, ni = ar * si + ai * sr + ei; sr = nr; si = ni;
    }
    float* wend = (float*)(shm + S3_KT + 8704);
    wend[w * 128 + lane] = sr; wend[w * 128 + 64 + lane] = si;
    float br = ar, bi = ai;
#pragma unroll
    for (int i = 0; i < 4; ++i) { const float nr = br * br - bi * bi, ni = 2.f * br * bi; br = nr; bi = ni; }
    __syncthreads();
    float cr = 0.f, ci = 0.f;
    for (int w2 = 0; w2 < w; ++w2) { const float er = wend[w2 * 128 + lane], ei = wend[w2 * 128 + 64 + lane]; const float nr = br * cr - bi * ci + er, ni = br * ci + bi * cr + ei; cr = nr; ci = ni; }
    float pr = 1.f, pi = 0.f;
#pragma unroll
    for (int k = 0; k < 16; ++k) {
      Sin[(16 * w + k) * 136 + lane] = f2bf(lr[k] + pr * cr - pi * ci); Sin[(16 * w + k) * 136 + 64 + lane] = f2bf(li[k] + pr * ci + pi * cr);
      const float nr = pr * ar - pi * ai, ni = pr * ai + pi * ar; pr = nr; pi = ni;
    }
    if (w == 7) { const size_t o = ((size_t)(l * 8 + b) * 32 + g) * 64 + lane; P.out[O_SRP + o] = sr + pr * cr - pi * ci; P.out[O_SIP + o] = si + pr * ci + pi * cr; }
  }
  __syncthreads();
  { const bf16_t* Gm = P.Gm[l] + (size_t)g * 32768;
#pragma unroll
    for (int i = 0; i < 8; ++i) { const int piece = tid + 512 * i, r = piece >> 4, pc = piece & 15; *(u32x4*)(Gsh + r * 136 + 8 * pc) = *(const u32x4*)(Gm + r * 128 + 8 * pc); } }
  __syncthreads();
  bf16x8 sf[4];
#pragma unroll
  for (int k2 = 0; k2 < 4; ++k2) sf[k2] = *(const bf16x8*)(Sin + n * 136 + 32 * k2 + 8 * g4);
  const f32x4 D4 = *(const f32x4*)(P.D_skip + l * 512 + g * 16 + 4 * g4);
#pragma unroll
  for (int t = 0; t < 16; ++t) {
    f32x4 acc = (f32x4){0.f, 0.f, 0.f, 0.f};
    const int row = r0 + t;
    const f32x4 u4 = unpack4(*(const u32x2*)(P.Pb + (size_t)row * NG1 + 4096 + g * 16 + 4 * g4));
#pragma unroll
    for (int ks = 0; ks <= (t >> 1); ++ks) {
      const int tau = t - (2 * ks + (g4 >> 1)), idx = tau >= 0 ? tau : 16;
      const bf16x8 x = *(const bf16x8*)(Ksh + (idx * 16 + l15) * 16 + 8 * (g4 & 1));
      acc = __builtin_amdgcn_mfma_f32_16x16x32_bf16(x, uf[ks], acc, 0, 0, 0);
    }
#pragma unroll
    for (int k2 = 0; k2 < 4; ++k2) { const bf16x8 x = *(const bf16x8*)(Gsh + (t * 16 + l15) * 136 + 32 * k2 + 8 * g4); acc = __builtin_amdgcn_mfma_f32_16x16x32_bf16(x, sf[k2], acc, 0, 0, 0); }
    f32x4 y;
#pragma unroll
    for (int r = 0; r < 4; ++r) y[r] = gelu_tanh(acc[r] + D4[r] * u4[r]);
    *(u32x2*)(P.ysb + (size_t)row * 512 + g * 16 + 4 * g4) = pack4(y);
  }
  __syncthreads();
}

__device__ __forceinline__ void headnorm_rows(const Params& P, int l, int bid, int G) {
  const int w = tidx() >> 6, lane = tidx() & 63;
  for (int row = bid * 8 + w; row < NT; row += G * 8) {
    if (lane == 0) { P.ssA[row] = 0ull; P.ssB[row] = 0ull; }
#pragma unroll
    for (int h = 0; h < 4; ++h) {
      const f32x4 s0 = *(const f32x4*)(P.hss + (size_t)row * 32 + h * 8), s1 = *(const f32x4*)(P.hss + (size_t)row * 32 + h * 8 + 4);
      const float ss = (s0[0] + s0[1]) + (s0[2] + s0[3]) + (s1[0] + s1[1]) + (s1[2] + s1[3]);
      const float rh = rsqrtf(ss * (1.0f / 256.0f) + 1e-6f);
      const int col = h * 256 + 4 * lane;
      const f32x4 hv = unpack4(*(const u32x2*)(P.hA + (size_t)row * DM + col));
      const f32x4 so = unpack4(*(const u32x2*)(P.Pb + (size_t)row * NG1 + 3072 + col));
      const f32x4 gh = *(const f32x4*)(P.g_hn + l * 1024 + col);
      *(u32x2*)(P.xa + (size_t)row * DM + col) = pack4(so * hv * gh * rh);
    }
  }
}
__device__ __forceinline__ void final_rows(const Params& P, int bid, int G) {
  const int w = tidx() >> 6, lane = tidx() & 63;
  for (int row = bid * 8 + w; row < NT; row += G * 8) {
    const float rs = rs_of(P.ssA[row]);
    float* o = row < NP ? P.out + O_YP + (size_t)row * DM : P.out + O_YS + (size_t)(row - NP) * DM;
#pragma unroll
    for (int i = 0; i < 4; ++i) {
      const int col = 256 * i + 4 * lane;
      const f32x4 v = *(const f32x4*)(P.X2 + (size_t)row * DM + col);
      const f32x4 gf = *(const f32x4*)(P.g_final + col);
      *(f32x4*)(o + col) = v * gf * rs;
    }
  }
}


#define XB_TMO      128
#define XB_XCNT(j)  (256  + 64 * (j))
#define XB_XSUB(j)  (1280 + 64 * (j))
#define XB_XGEN(j)  (2304 + 64 * (j))
#define XB_TOP      3328
#define XB_TOPGEN   3392
#define XCD_BAR_WORDS 3456
#define XB_SPIN_CAP (1u << 22)
__device__ __forceinline__ unsigned xb_ld(unsigned* p)              { return __hip_atomic_load(p, __ATOMIC_RELAXED, __HIP_MEMORY_SCOPE_AGENT); }
__device__ __forceinline__ unsigned xb_add(unsigned* p, unsigned v) { return __hip_atomic_fetch_add(p, v, __ATOMIC_RELAXED, __HIP_MEMORY_SCOPE_AGENT); }
__device__ __forceinline__ unsigned xb_xcc_id() { return (unsigned)__builtin_amdgcn_s_getreg((3 << 11) | 20) & 0xFu; }
#define XB_SPIN(cond, bar) do { unsigned _sp = 0; while (cond) { __builtin_amdgcn_s_sleep(1); \
    if ((++_sp & 255u) == 0u) { if (xb_ld(&(bar)[XB_TMO])) break; if (_sp > XB_SPIN_CAP) { atomicAdd(&(bar)[XB_TMO], 1u); break; } } } } while (0)
struct XcdBarrier { unsigned* bar; unsigned x; volatile LAS unsigned* st; };
__device__ __forceinline__ XcdBarrier xcd_barrier_post(unsigned* bar, volatile LAS unsigned* st) {
  XcdBarrier b; b.bar = bar; b.x = xb_xcc_id(); b.st = st;
  if (threadIdx.x == 0) (void)xb_add(&bar[XB_XCNT(b.x)], 1u);
  return b;
}
__device__ __forceinline__ void xcd_barrier_complete(unsigned* bar, unsigned x, unsigned& nloc, unsigned& nx) {
  const unsigned G = gridDim.x * gridDim.y * gridDim.z;
  unsigned sum, cnt, mine, sp = 0u;
  for (;;) {
    sum = 0u; cnt = 0u; mine = 0u;
#pragma unroll
    for (unsigned j = 0; j < 16; ++j) { const unsigned c = xb_ld(&bar[XB_XCNT(j)]); sum += c; cnt += (c > 0u) ? 1u : 0u; mine = (j == x) ? c : mine; }
    if (sum == G) break;
    __builtin_amdgcn_s_sleep(1);
    if ((++sp & 255u) == 0u) { if (xb_ld(&bar[XB_TMO])) break; if (sp > XB_SPIN_CAP) { atomicAdd(&bar[XB_TMO], 1u); break; } }
  }
  nloc = mine > 0u ? mine : 1u; nx = cnt > 0u ? cnt : 1u;
}
__device__ __forceinline__ void xcd_barrier(const XcdBarrier& b) {
  asm volatile("s_waitcnt vmcnt(0)" ::: "memory");
  __syncthreads();
  if (threadIdx.x == 0) {
    unsigned* bar = b.bar;
    __builtin_amdgcn_s_waitcnt(0);
    unsigned nloc = b.st[0], nx = b.st[1];
    if (nloc == 0u) { xcd_barrier_complete(bar, b.x, nloc, nx); b.st[0] = nloc; b.st[1] = nx; }
    const unsigned old = xb_add(&bar[XB_XSUB(b.x)], 1u);
    const unsigned gen = old / nloc;
    if (old + 1u == (gen + 1u) * nloc) {
      __builtin_amdgcn_fence(__ATOMIC_RELEASE, "agent");
      asm volatile("s_waitcnt vmcnt(0)" ::: "memory");
      const unsigned og = xb_add(&bar[XB_TOP], 1u);
      const unsigned tg = og / nx;
      if (og + 1u == (tg + 1u) * nx) xb_add(&bar[XB_TOPGEN], 1u);
      else XB_SPIN(xb_ld(&bar[XB_TOPGEN]) == tg, bar);
      __builtin_amdgcn_fence(__ATOMIC_ACQUIRE, "agent");
      xb_add(&bar[XB_XGEN(b.x)], 1u);
      asm volatile("s_waitcnt vmcnt(0)" ::: "memory");
    } else {
      XB_SPIN(xb_ld(&bar[XB_XGEN(b.x)]) == gen, bar);
      __builtin_amdgcn_fence(__ATOMIC_ACQUIRE, "agent");
      asm volatile("s_waitcnt vmcnt(0)" ::: "memory");
    }
  }
  __syncthreads();
}

__global__ void __launch_bounds__(512) mega(const Params P) {
  extern __shared__ __attribute__((aligned(16))) unsigned char shm[];
  cg::grid_group grid = cg::this_grid();
  LAS unsigned char* lds = (LAS unsigned char*)shm;
  const int bid = blockIdx.x, G = gridDim.x;

  volatile LAS unsigned* xst = (volatile LAS unsigned*)(lds + LDS_BYTES - 16);
  if (threadIdx.x == 0) { xst[0] = 0u; xst[1] = 0u; }
  if (bid == 0) for (int i = threadIdx.x; i < XCD_BAR_WORDS; i += 512) P.bar[i] = 0u;
  REP(1) prep_phase(P, shm, bid, G);
  grid.sync();
  const XcdBarrier xb = xcd_barrier_post(P.bar, xst);

  for (int l = 0; l < 2; ++l) {
    REP(2) {
      F1 f; f.bias = P.b_in + l * PTOT; f.Pb = P.Pb; f.rs = P.ssA; f.ss = nullptr;
      gemm_all(lds, shm, P.xb, P.WinT[l], NG1, 1024, f, bid, G);
      Fg fg; fg.bias = P.b_in + l * PTOT + 4096; fg.gat = P.gat; fg.rs = P.ssA; fg.ss = nullptr;
      REP(256) skinny_run(fg, P.xb, 1024, P.WgT[l], 0, 129, 1, bid, G, shm, ((NP / 256) * (NG1 / 256)) % G);
    }
    xcd_barrier(xb);
    REP(4) for (int kk = 0, nk = (1280 + G - 1) / G; kk < nk; ++kk) {
      const int it = bid + ((bid & 1) ? nk - 1 - kk : kk) * G;
      if (it >= 1280) continue;
      if (it < 512) { REP(1024) m1_item(P, it, shm); }
      else if (it < 1024) { REP(2048) msample_item(P, l, it - 512, shm); }
      else { REP(8192) s5_sample_item(P, l, it - 1024, shm); }
    }
    xcd_barrier(xb);
    REP(8) for (int it = bid; it < 256; it += G) m2_item(P, l, G == 256 ? (((it & 7) * 4 + (it >> 6)) * 8 + ((it >> 3) & 7)) : it, shm);
    REP(16) for (int it = bid; it < 256; it += G) s5_stage3_item(P, l, G == 256 ? ((it & 7) * 32 + (it >> 3)) : it, shm);
    xcd_barrier(xb);
    REP(32) {
      Fglu f; f.bias = P.b_glu + l * 512; f.ysb = P.ysb; f.ys2 = P.ys2; f.ss = nullptr;
      gemm_all(lds, shm, P.ysb, P.WgluT[l], 512, 512, f, bid, G);
      headnorm_rows(P, l, bid, G);
    }
    xcd_barrier(xb);
    REP(32) {
      Fa fa; fa.Pb = P.Pb; fa.t1 = P.t1; fa.ss = nullptr;
      gemm_all(lds, shm, P.xa, P.WaT[l], 1024, 1024, fa, bid, G);
      Fb fb; fb.Pb = P.Pb; fb.t1 = P.t1; fb.mg = P.mg; fb.ss = nullptr;
      gemm_all(lds, shm, P.ys2, P.WbT[l], 1024, 512, fb, bid, G);
    }
    xcd_barrier(xb);
    REP(32) {
      Fres f; f.xinP = l == 0 ? P.x_prompt : P.X2; f.xinS = l == 0 ? P.x_sample : P.X2 + (size_t)NP * DM; f.xo = P.X1; f.xb = P.xb; f.ss = P.ssB;
      gemm_all(lds, shm, P.mg, P.WoT[l], 1024, 1024, f, bid, G);
    }
    xcd_barrier(xb);
    REP(64) {
      F13 f; f.rs = P.ssB; f.act = P.act;
      pg8::Gemm g; g.A = P.xb; g.Bt = P.W13T[l]; g.M = NP; g.N = 2 * DFF; g.K = 1024;
      pg8::StaticOrder S; S.init(NP, 2 * DFF, G, bid);
      EpiMain13 E; E.f = f;
      REP(512) pg8::gemm_phase(lds, g, S, E);
      REP(256) skinny_run13(f, P.xb, P.W13T[l], bid, G, shm);
    }
    xcd_barrier(xb);
    REP(64) {
      Fres f; f.xinP = P.X1; f.xinS = P.X1 + (size_t)NP * DM; f.xo = P.X2; f.xb = P.xb; f.ss = P.ssA;
      gemm_all(lds, shm, P.act, P.W2T[l], 1024, DFF, f, bid, G);
    }
    xcd_barrier(xb);
  }
  final_rows(P, bid, G);
}

extern "C" void kernel_launch(void* const* d_in, const int* in_sizes, int n_in, void* d_out, int out_size, void* d_ws, size_t ws_size, hipStream_t stream) {
  constexpr size_t kDynLds = LDS_BYTES;
  static int grid_blocks = 0;
  if (!grid_blocks) {
    int dev = 0, cus = 0, per_cu = 0;
    (void)hipGetDevice(&dev);
    (void)hipDeviceGetAttribute(&cus, hipDeviceAttributeMultiprocessorCount, dev);
    (void)hipFuncSetAttribute((const void*)mega, hipFuncAttributeMaxDynamicSharedMemorySize, (int)kDynLds);
    (void)hipOccupancyMaxActiveBlocksPerMultiprocessor(&per_cu, mega, 512, kDynLds);
    if (per_cu > 1) per_cu = 1;
    grid_blocks = cus * per_cu;
    if (grid_blocks > 256) grid_blocks = 256;
  }
  Params p;
  memset(&p, 0, sizeof(p));
  const float* const* in = (const float* const*)d_in;
  p.x_prompt = in[0]; p.x_sample = in[1]; p.st_C = in[2]; p.st_n = in[3]; p.st_m = in[4]; p.st_sre = in[5]; p.st_sim = in[6];
  p.g_mix = in[7]; p.w_in = in[8]; p.b_in = in[9]; p.g_hn = in[10]; p.w_a = in[11]; p.A_re = in[12]; p.A_im = in[13]; p.log_dt = in[14];
  p.B_re = in[15]; p.B_im = in[16]; p.C_re = in[17]; p.C_im = in[18]; p.D_skip = in[19]; p.w_glu = in[20]; p.b_glu = in[21]; p.w_b = in[22]; p.w_out = in[23];
  p.g_ffn = in[24]; p.w_ff1 = in[25]; p.w_ff3 = in[26]; p.w_ff2 = in[27]; p.g_final = in[28];
  p.out = (float*)d_out;
  char* base = (char*)d_ws; size_t off = 0;
  auto alloc = [&](size_t bytes) { char* r = base + off; off += (bytes + 255) & ~(size_t)255; return r; };
  for (int l = 0; l < 2; ++l) {
    p.WinT[l] = (bf16_t*)alloc((size_t)NG1 * 1024 * 2); p.WgT[l] = (bf16_t*)alloc(16 * 1024 * 2); p.WgluT[l] = (bf16_t*)alloc(512 * 512 * 2);
    p.WaT[l] = (bf16_t*)alloc(1024 * 1024 * 2); p.WbT[l] = (bf16_t*)alloc(1024 * 512 * 2); p.WoT[l] = (bf16_t*)alloc(1024 * 1024 * 2);
    p.W13T[l] = (bf16_t*)alloc((size_t)2 * DFF * 1024 * 2); p.W2T[l] = (bf16_t*)alloc((size_t)1024 * DFF * 2);
    p.abar[l] = (float*)alloc(4096 * 4); p.bbar[l] = (float*)alloc(65536 * 4);
  }
  p.xb = (bf16_t*)alloc((size_t)NT * DM * 2); p.Pb = (bf16_t*)alloc((size_t)NT * NG1 * 2); p.St = (bf16_t*)alloc((size_t)512 * 16384 * 2);
  p.ysb = (bf16_t*)alloc((size_t)NT * 512 * 2); p.ys2 = (bf16_t*)alloc((size_t)NT * 512 * 2); p.xa = (bf16_t*)alloc((size_t)NT * DM * 2);
  p.mg = (bf16_t*)alloc((size_t)NT * DM * 2); p.act = (bf16_t*)alloc((size_t)NT * DFF * 2);
  p.X1 = (float*)alloc((size_t)NT * DM * 4); p.X2 = (float*)alloc((size_t)NT * DM * 4);
  p.ssA = (unsigned long long*)alloc((size_t)NT * 8); p.ssB = (unsigned long long*)alloc((size_t)NT * 8); p.bar = (unsigned*)alloc(XCD_BAR_WORDS * 4);
  for (int l = 0; l < 2; ++l) { p.Kt[l] = (bf16_t*)alloc(32 * 17 * 256 * 2); p.Gm[l] = (bf16_t*)alloc(32 * 32768 * 2); p.Hm[l] = (bf16_t*)alloc(32 * 32768 * 2); p.a16[l] = (float*)alloc(4096 * 4); }
  p.E2 = (float*)alloc((size_t)8 * 128 * 32 * 128 * 4);
  p.gat = (float*)alloc((size_t)NT * 8 * 4); p.hA = (bf16_t*)alloc((size_t)NT * DM * 2); p.hss = (float*)alloc((size_t)NT * 32 * 4);
  p.t1 = (bf16_t*)alloc((size_t)NT * DM * 2); p.Eend = (float*)alloc((size_t)2 * 524288 * 4);
  int nj = 0, tile0 = 0;
  auto job = [&](const float* src, const float* scale, bf16_t* dst, int ldn, int c0, int ncols, int K, int mode, int r0, int nwrite) {
    TJob& J = p.jobs[nj++]; J.src = src; J.scale = scale; J.dst = dst; J.ldn = ldn; J.c0 = c0; J.ncols = ncols; J.K = K; J.mode = mode; J.r0 = r0;
    J.tile0 = tile0; J.ntn = (ncols + 63) / 64; J.nwrite = nwrite; J.pad = 0; tile0 += J.ntn * (K / 64);
  };
  for (int l = 0; l < 2; ++l) {
    const float* win = p.w_in + (size_t)l * 1024 * PTOT; const float* gm = p.g_mix + l * 1024; const float* gf = p.g_ffn + l * 1024;
    job(win, gm, p.WinT[l], PTOT, 0, 4096, 1024, 0, 0, 4096);
    job(win, gm, p.WinT[l], PTOT, 4104, 512, 1024, 0, 4096, 512);
    job(win, gm, p.WinT[l], PTOT, 4616, 2048, 1024, 0, 4608, 2048);
    job(win, gm, p.WgT[l], PTOT, 4096, 8, 1024, 0, 0, 16);
    job(p.w_glu + (size_t)l * 512 * 512, nullptr, p.WgluT[l], 512, 0, 512, 512, 0, 0, 512);
    job(p.w_a + (size_t)l * 1024 * 1024, nullptr, p.WaT[l], 1024, 0, 1024, 1024, 0, 0, 1024);
    job(p.w_b + (size_t)l * 512 * 1024, nullptr, p.WbT[l], 1024, 0, 1024, 512, 0, 0, 1024);
    job(p.w_out + (size_t)l * 1024 * 1024, nullptr, p.WoT[l], 1024, 0, 1024, 1024, 0, 0, 1024);
    job(p.w_ff1 + (size_t)l * 1024 * DFF, gf, p.W13T[l], DFF, 0, DFF, 1024, 1, 0, DFF);
    job(p.w_ff3 + (size_t)l * 1024 * DFF, gf, p.W13T[l], DFF, 0, DFF, 1024, 2, 0, DFF);
    job(p.w_ff2 + (size_t)l * DFF * 1024, nullptr, p.W2T[l], 1024, 0, 1024, DFF, 0, 0, 1024);
  }
  p.njobs = nj; p.total_tiles = tile0;
  void* args[] = {&p};
  hipError_t e = hipLaunchCooperativeKernel((void*)mega, dim3(grid_blocks), dim3(512), args, kDynLds, stream);
  if (e != hipSuccess) fprintf(stderr, "cooperative launch failed: %s (grid %d)\n", hipGetErrorString(e), grid_blocks);
}
```

```cpp
#include <hip/hip_runtime.h>
#include <hip/hip_cooperative_groups.h>
#include <cstdio>
#include <cstring>
namespace cg = cooperative_groups;

#define LAS __attribute__((address_space(3)))
typedef unsigned short bf16_t;
typedef short bf16x8 __attribute__((ext_vector_type(8)));
typedef short bf16x4 __attribute__((ext_vector_type(4)));
typedef float f32x4 __attribute__((ext_vector_type(4)));
typedef unsigned u32x4 __attribute__((ext_vector_type(4)));
typedef unsigned u32x2 __attribute__((ext_vector_type(2)));

constexpr int NP = 16384, NS = 128, NT = 16512, DM = 1024, NG1 = 6656, DFF = 2816, PTOT = 6664;
constexpr int LDS_BYTES = 150 * 1024;
#ifndef DUPMASK
#define DUPMASK 0
#endif
#define REP(bit) for (int rep_ = 0; rep_ < ((DUPMASK & (bit)) ? 2 : 1); ++rep_)
constexpr size_t O_YP = 0, O_YS = 16777216, O_CP = 16908288, O_NP = 21102592, O_MP = 21118976, O_SRP = 21119040, O_SIP = 21151808,
                 O_CS = 21184576, O_NS = 88293440, O_MS = 88555584, O_SRS = 88556608, O_SIS = 89080896;

struct TJob { const float* src; const float* scale; bf16_t* dst; int ldn, c0, ncols, K, mode, r0, tile0, ntn, nwrite, pad; };

struct Params {
  const float *x_prompt, *x_sample, *st_C, *st_n, *st_m, *st_sre, *st_sim;
  const float *g_mix, *w_in, *b_in, *g_hn, *w_a, *A_re, *A_im, *log_dt, *B_re, *B_im, *C_re, *C_im, *D_skip, *w_glu, *b_glu, *w_b, *w_out,
      *g_ffn, *w_ff1, *w_ff3, *w_ff2, *g_final;
  float* out;
  bf16_t *WinT[2], *WgT[2], *WgluT[2], *WaT[2], *WbT[2], *WoT[2], *W13T[2], *W2T[2];
  float *abar[2], *bbar[2];
  bf16_t *xb, *Pb, *St, *ysb, *ys2, *xa, *mg, *act;
  float *X1, *X2, *gat, *hss, *Eend; bf16_t *hA, *t1;
  unsigned long long *ssA, *ssB;
  unsigned* bar;
  bf16_t *Kt[2], *Gm[2], *Hm[2]; float *a16[2], *E2;
  TJob jobs[22];
  int njobs, total_tiles;
};

__device__ __forceinline__ bf16_t f2bf(float f) { return __builtin_bit_cast(bf16_t, (__bf16)f); }
__device__ __forceinline__ float bf2f(unsigned b) { return __uint_as_float(b << 16); }
typedef float f32x2 __attribute__((ext_vector_type(2)));
typedef __bf16 bf16x2v __attribute__((ext_vector_type(2)));
__device__ __forceinline__ unsigned pack2(float lo, float hi) { const f32x2 v = {lo, hi}; const bf16x2v b = __builtin_convertvector(v, bf16x2v); return __builtin_bit_cast(unsigned, b); }
__device__ __forceinline__ u32x2 pack4(f32x4 v) { u32x2 r; r.x = pack2(v[0], v[1]); r.y = pack2(v[2], v[3]); return r; }
__device__ __forceinline__ f32x4 unpack4(u32x2 u) { f32x4 r; r[0] = bf2f(u.x & 0xffffu); r[1] = bf2f(u.x >> 16); r[2] = bf2f(u.y & 0xffffu); r[3] = bf2f(u.y >> 16); return r; }
__device__ __forceinline__ float sigmoidf_(float x) { return __builtin_amdgcn_rcpf(1.0f + __expf(-x)); }
__device__ __forceinline__ float gelu_tanh(float x) { float z = 0.7978845608f * (x + 0.044715f * x * x * x); float e = __expf(2.0f * z); float th = 1.0f - 2.0f * __builtin_amdgcn_rcpf(e + 1.0f); return 0.5f * x * (1.0f + th); }
__device__ __forceinline__ int tidx() { int t = threadIdx.x; asm volatile("" : "+v"(t)); return t; }
#define LDS_BARRIER() do { asm volatile("s_waitcnt lgkmcnt(0)" ::: "memory"); __builtin_amdgcn_s_barrier(); asm volatile("" ::: "memory"); } while (0)
__device__ __forceinline__ float wave_sum(float v) { for (int o = 32; o > 0; o >>= 1) v += __shfl_xor(v, o); return v; }

namespace pg8 {
constexpr int BM = 256, BK = 64, HALF = 128, HTB = HALF * BK * 2, STAGE_BYTES = 8 * HTB, NXCD = 8, WGM = 8;
__host__ __device__ __forceinline__ int lds_byte(int r, int c) { const int st = (r >> 4) * 2 + (c >> 5), rr = r & 15, cc = c & 31, ob = rr * 64 + cc * 2; return st * 1024 + (ob ^ (((ob >> 9) & 1) << 5)); }
__host__ __device__ __forceinline__ void stage_rc(int b, int& R, int& C) { const int st = b / 1024, sb = b % 1024, swz = sb ^ (((sb >> 9) & 1) << 5); R = (st >> 1) * 16 + swz / 64; C = (st & 1) * 32 + (swz % 64) / 2; }
__host__ __device__ __forceinline__ int perm32(int rho) { const int n = rho >> 4, i = rho & 15; return 8 * (i >> 2) + 4 * n + (i & 3); }
struct Unit { int pm, pn; };
struct Gemm { const bf16_t* A; const bf16_t* Bt; int M, N, K; };
struct StaticOrder {
  int nM, nN, nwg, G, c;
  __device__ void init(int M, int N, int G_, int c_) { nM = M / BM; nN = N / BM; nwg = nM * nN; G = G_; c = c_; }
  __device__ bool next(int i, Unit& u) const {
    const long L = (long)i * G + c; if (L >= nwg) return false;
    int wgid = (int)L; { const int q = nwg / NXCD, r = nwg % NXCD, xcd = wgid % NXCD, off = wgid / NXCD; wgid = (xcd < r ? xcd * (q + 1) : r * (q + 1) + (xcd - r) * q) + off; }
    const int nig = WGM * nN, gid = wgid / nig, fm = gid * WGM, gsz = (nM - fm) < WGM ? (nM - fm) : WGM;
    u.pm = fm + ((wgid % nig) % gsz); u.pn = (wgid % nig) / gsz; return true;
  }
};

template <class Epi, class Sched>
__device__ __forceinline__ void gemm_phase(LAS unsigned char* lds, const Gemm g, const Sched& S, const Epi& E) {
  const int tid = tidx(), wid = __builtin_amdgcn_readfirstlane(tid >> 6), lane = tid & 63, wr = wid >> 2, wc = wid & 3, fr = lane & 15, fq = lane >> 4;
  const int K = g.K, nt = K / BK;
  unsigned voffA[2], voffB[2];
#pragma unroll
  for (int i = 0; i < 2; ++i) { int R, C; stage_rc(tid * 16 + i * 8192, R, C); voffA[i] = (unsigned)(R * K + C) * 2u; const int Rb = Epi::PERM ? ((R & ~31) + perm32(R & 31)) : R; voffB[i] = (unsigned)(Rb * K + C) * 2u; }
  const size_t kstep = (size_t)(BK * 2);
  const size_t hstep = (size_t)HALF * K * 2;
  const size_t tstep = 2 * hstep;
  const unsigned ldsw = (unsigned)wid * 1024u;
  const int aoff = lds_byte(wr * 64 + fr, fq * 8), boff = lds_byte(wc * 32 + fr, fq * 8);
#define PG8_SA(b, h) (((b) * 2 + (h)) * HTB)
#define PG8_SB(b, h) ((4 + (b) * 2 + (h)) * HTB)
#define PG8_STAGE(bufoff, gbase, voff) do { _Pragma("unroll") for (int _i = 0; _i < 2; ++_i) \
    __builtin_amdgcn_global_load_lds((const unsigned*)((const char*)(gbase) + (voff)[_i]), (LAS unsigned*)(lds + (bufoff) + ldsw + _i * 8192), 16, 0, 0); } while (0)
#define PG8_LDA(dst, b, h) do { _Pragma("unroll") for (int m = 0; m < 4; ++m) _Pragma("unroll") for (int k = 0; k < 2; ++k) dst[m][k] = *(const LAS bf16x8*)(lds + PG8_SA(b, h) + aoff + m * 2048 + k * 1024); } while (0)
#define PG8_LDB(dst, b, h) do { _Pragma("unroll") for (int n = 0; n < 2; ++n) _Pragma("unroll") for (int k = 0; k < 2; ++k) dst[n][k] = *(const LAS bf16x8*)(lds + PG8_SB(b, h) + boff + n * 2048 + k * 1024); } while (0)
#define PG8_MMA(ai, bj, At, Bt) do { __builtin_amdgcn_s_setprio(1); _Pragma("unroll") for (int m = 0; m < 4; ++m) _Pragma("unroll") for (int n = 0; n < 2; ++n) _Pragma("unroll") for (int k = 0; k < 2; ++k) \
    acc[ai][bj][m][n] = __builtin_amdgcn_mfma_f32_16x16x32_bf16(Bt[n][k], At[m][k], acc[ai][bj][m][n], 0, 0, 0); __builtin_amdgcn_s_setprio(0); } while (0)
#define PG8_WAIT_V(n) asm volatile("s_waitcnt vmcnt(" #n ")" ::: "memory")
#define PG8_WAIT_L(n) asm volatile("s_waitcnt lgkmcnt(" #n ")" ::: "memory")
#define PG8_BAR __builtin_amdgcn_s_barrier()
#define PG8_SCHED __builtin_amdgcn_sched_barrier(0)
  Unit cur, nxt; int ui = 0;
  if (!S.next(0, cur)) return;
  f32x4 acc[2][2][4][2];
#pragma unroll
  for (int a = 0; a < 2; ++a)
#pragma unroll
    for (int b = 0; b < 2; ++b)
#pragma unroll
      for (int m = 0; m < 4; ++m)
#pragma unroll
        for (int n = 0; n < 2; ++n) acc[a][b][m][n] = (f32x4){0.f, 0.f, 0.f, 0.f};
  bf16x8 At[4][2], B0[2][2], B1[2][2];
  const char* cA = (const char*)g.A + (size_t)cur.pm * tstep; const char* cB = (const char*)g.Bt + (size_t)cur.pn * tstep;
  PG8_STAGE(PG8_SB(0, 0), cB, voffB); PG8_STAGE(PG8_SA(0, 0), cA, voffA); PG8_STAGE(PG8_SB(0, 1), cB + hstep, voffB); PG8_STAGE(PG8_SA(0, 1), cA + hstep, voffA);
  if (wr == 1) PG8_BAR;
  PG8_WAIT_V(4); PG8_BAR;
  PG8_STAGE(PG8_SB(1, 0), cB + kstep, voffB); PG8_STAGE(PG8_SA(1, 0), cA + kstep, voffA); PG8_STAGE(PG8_SB(1, 1), cB + hstep + kstep, voffB);
  PG8_WAIT_V(6); PG8_BAR;
  for (;;) {
    const bool has_next = S.next(ui + 1, nxt);
    const char* nA = has_next ? (const char*)g.A + (size_t)nxt.pm * tstep : cA; const char* nB = has_next ? (const char*)g.Bt + (size_t)nxt.pn * tstep : cB;
    for (int t = 0; t < nt; t += 2) {
      const bool last = (t == nt - 2);
      const char* a1 = cA + (size_t)(t + 1) * kstep;
      const char* a2 = last ? nA : cA + (size_t)(t + 2) * kstep; const char* b2 = last ? nB : cB + (size_t)(t + 2) * kstep;
      const char* a3 = a2 + kstep; const char* b3 = b2 + kstep;
      PG8_LDB(B0, 0, 0); PG8_SCHED; PG8_LDA(At, 0, 0); PG8_STAGE(PG8_SA(1, 1), a1 + hstep, voffA);
      PG8_WAIT_L(8); PG8_BAR; PG8_WAIT_L(0); PG8_MMA(0, 0, At, B0); PG8_BAR; PG8_SCHED;
      PG8_LDB(B1, 0, 1); PG8_STAGE(PG8_SB(0, 0), b2, voffB);
      PG8_BAR; PG8_WAIT_L(0); PG8_MMA(0, 1, At, B1); PG8_BAR;
      PG8_LDA(At, 0, 1); PG8_STAGE(PG8_SA(0, 0), a2, voffA);
      PG8_BAR; PG8_WAIT_L(0); PG8_MMA(1, 0, At, B0); PG8_BAR; PG8_SCHED;
      PG8_STAGE(PG8_SB(0, 1), b2 + hstep, voffB);
      PG8_WAIT_V(6); PG8_BAR; PG8_MMA(1, 1, At, B1); PG8_BAR;
      PG8_LDB(B0, 1, 0); PG8_SCHED; PG8_LDA(At, 1, 0); PG8_STAGE(PG8_SA(0, 1), a2 + hstep, voffA);
      PG8_WAIT_L(8); PG8_BAR; PG8_WAIT_L(0); PG8_MMA(0, 0, At, B0); PG8_BAR; PG8_SCHED;
      PG8_LDB(B1, 1, 1); PG8_STAGE(PG8_SB(1, 0), b3, voffB);
      PG8_BAR; PG8_WAIT_L(0); PG8_MMA(0, 1, At, B1); PG8_BAR;
      PG8_LDA(At, 1, 1); PG8_STAGE(PG8_SA(1, 0), a3, voffA);
      PG8_BAR; PG8_WAIT_L(0); PG8_MMA(1, 0, At, B0); PG8_BAR; PG8_SCHED;
      PG8_STAGE(PG8_SB(1, 1), b3 + hstep, voffB);
      PG8_WAIT_V(6); PG8_BAR; PG8_MMA(1, 1, At, B1); PG8_BAR;
    }
    E(acc, cur, wr, wc, fr, fq);
    if (!has_next) break;
#pragma unroll
    for (int a = 0; a < 2; ++a)
#pragma unroll
      for (int b = 0; b < 2; ++b)
#pragma unroll
        for (int m = 0; m < 4; ++m)
#pragma unroll
          for (int n = 0; n < 2; ++n) acc[a][b][m][n] = (f32x4){0.f, 0.f, 0.f, 0.f};
    cur = nxt; cA = nA; cB = nB; ++ui;
  }
  PG8_WAIT_V(0);
  if (wr == 0) PG8_BAR;
  PG8_BAR;
#undef PG8_SA
#undef PG8_SB
#undef PG8_STAGE
#undef PG8_LDA
#undef PG8_LDB
#undef PG8_MMA
#undef PG8_WAIT_V
#undef PG8_WAIT_L
#undef PG8_BAR
#undef PG8_SCHED
}
}

typedef unsigned long long u64;
__device__ __forceinline__ u64 ss_fix(float ss) { return (u64)(ss * 16777216.0f); }
__device__ __forceinline__ float rs_of(u64 q) { const float f = (float)(unsigned)(q >> 32) * 4294967296.0f + (float)(unsigned)q; return rsqrtf(f * (1.0f / (16777216.0f * 1024.0f)) + 1e-6f); }
__device__ __forceinline__ void ss_add(u64* p, float ss) { __hip_atomic_fetch_add(p, ss_fix(ss), __ATOMIC_RELAXED, __HIP_MEMORY_SCOPE_AGENT); }
__device__ __forceinline__ int qcol(int cbase, int q) { return cbase + (q >> 1) * 128 + (q & 1) * 16; }
__device__ __forceinline__ f32x4 unlo(u32x4 u) { return unpack4((u32x2){u[0], u[1]}); }
__device__ __forceinline__ f32x4 unhi(u32x4 u) { return unpack4((u32x2){u[2], u[3]}); }
__device__ __forceinline__ u32x4 pack8(f32x4 a, f32x4 b) { const u32x2 p = pack4(a), q = pack4(b); return (u32x4){p.x, p.y, q.x, q.y}; }
struct F1 {
  static constexpr bool NEEDR = true, STAT = false, PERM = true; static constexpr int RB = 8;
  const float* bias; bf16_t* Pb; const u64* rs; u64* ss;
  struct ColData { f32x4 b[4]; }; struct RowData { u64 s; };
  __device__ __forceinline__ void load_cols(int cbase, ColData& cd) const {
#pragma unroll
    for (int q = 0; q < 4; ++q) { const int col = cbase + (q >> 1) * 128 + (q & 1) * 4; cd.b[q] = *(const f32x4*)(bias + (col < 4096 ? col : col + 8)); } }
  __device__ __forceinline__ void load_row(int row, int, RowData& rd) const { rd.s = rs[row]; }
  __device__ __forceinline__ float apply(int row, int cbase, const f32x4 (&v)[4], const ColData& cd, const RowData& rd) const {
    const float r = rs_of(rd.s);
    const int blk = cbase >> 8;
    const bool isk = blk >= 4 && blk < 8, issig = (blk >= 12 && blk < 16) || blk >= 18;
#pragma unroll
    for (int bj = 0; bj < 2; ++bj) {
      u32x4 pk;
#pragma unroll
      for (int n = 0; n < 2; ++n) {
        f32x4 o = v[bj * 2 + n] * r + cd.b[bj * 2 + n];
        if (isk) o = o * 0.0625f;
        else if (issig) { o[0] = sigmoidf_(o[0]); o[1] = sigmoidf_(o[1]); o[2] = sigmoidf_(o[2]); o[3] = sigmoidf_(o[3]); }
        const u32x2 p2 = pack4(o); pk[2 * n] = p2.x; pk[2 * n + 1] = p2.y;
      }
      *(u32x4*)(Pb + (size_t)row * NG1 + cbase + bj * 128) = pk;
    }
    return 0.f;
  }
  __device__ __forceinline__ float rowscale(int row) const { return rs_of(rs[row]); }
  __device__ __forceinline__ float operator()(int row, int col, f32x4 v, float r) const {
    const int bi = col < 4096 ? col : col + 8;
    const f32x4 b4 = *(const f32x4*)(bias + bi);
    f32x4 o = v * r + b4;
    if (col >= 1024 && col < 2048) o = o * 0.0625f;
    else if ((col >= 3072 && col < 4096) || col >= 4608) { o[0] = sigmoidf_(o[0]); o[1] = sigmoidf_(o[1]); o[2] = sigmoidf_(o[2]); o[3] = sigmoidf_(o[3]); }
    *(u32x2*)(Pb + (size_t)row * NG1 + col) = pack4(o);
    return 0.f;
  }
};
struct Fg {
  static constexpr bool NEEDR = true, STAT = false;
  const float* bias; float* gat; const u64* rs; u64* ss;
  __device__ __forceinline__ float rowscale(int row) const { return rs_of(rs[row]); }
  __device__ __forceinline__ float operator()(int row, int col, f32x4 v, float r) const {
    if (col < 8) {
      const f32x4 b4 = *(const f32x4*)(bias + col);
      f32x4 o = v * r + b4;
      if (col >= 4) {
#pragma unroll
        for (int i = 0; i < 4; ++i) { const float x = o[i]; o[i] = fminf(x, 0.f) - log1pf(__expf(-fabsf(x))); }
      }
      *(f32x4*)(gat + (size_t)row * 8 + col) = o;
    }
    return 0.f;
  }
};
struct Fglu {
  static constexpr bool NEEDR = false, STAT = false, PERM = true; static constexpr int RB = 8;
  const float* bias; const bf16_t* ysb; bf16_t* ys2; u64* ss;
  struct ColData { f32x4 b[4]; }; struct RowData { u32x4 y[2]; };
  __device__ __forceinline__ void load_cols(int cbase, ColData& cd) const {
#pragma unroll
    for (int q = 0; q < 4; ++q) cd.b[q] = *(const f32x4*)(bias + cbase + (q >> 1) * 128 + (q & 1) * 4); }
  __device__ __forceinline__ void load_row(int row, int cbase, RowData& rd) const {
#pragma unroll
    for (int bj = 0; bj < 2; ++bj) rd.y[bj] = *(const u32x4*)(ysb + (size_t)row * 512 + cbase + bj * 128); }
  __device__ __forceinline__ float apply(int row, int cbase, const f32x4 (&v)[4], const ColData& cd, const RowData& rd) const {
#pragma unroll
    for (int bj = 0; bj < 2; ++bj) {
      const f32x4 y0 = unlo(rd.y[bj]), y1 = unhi(rd.y[bj]); f32x4 o0, o1;
#pragma unroll
      for (int i = 0; i < 4; ++i) { o0[i] = y0[i] * sigmoidf_(v[bj * 2][i] + cd.b[bj * 2][i]); o1[i] = y1[i] * sigmoidf_(v[bj * 2 + 1][i] + cd.b[bj * 2 + 1][i]); }
      *(u32x4*)(ys2 + (size_t)row * 512 + cbase + bj * 128) = pack8(o0, o1);
    }
    return 0.f;
  }
  __device__ __forceinline__ float rowscale(int) const { return 1.f; }
  __device__ __forceinline__ float operator()(int row, int col, f32x4 v, float) const {
    const f32x4 b4 = *(const f32x4*)(bias + col);
    const f32x4 y = unpack4(*(const u32x2*)(ysb + (size_t)row * 512 + col));
    f32x4 o;
#pragma unroll
    for (int i = 0; i < 4; ++i) o[i] = y[i] * sigmoidf_(v[i] + b4[i]);
    *(u32x2*)(ys2 + (size_t)row * 512 + col) = pack4(o);
    return 0.f;
  }
};
struct Fa {
  static constexpr bool NEEDR = false, STAT = false, PERM = true; static constexpr int RB = 8;
  const bf16_t* Pb; bf16_t* t1; u64* ss;
  struct ColData { int dummy; }; struct RowData { u32x4 g[2]; };
  __device__ __forceinline__ void load_cols(int, ColData&) const {}
  __device__ __forceinline__ void load_row(int row, int cbase, RowData& rd) const {
#pragma unroll
    for (int bj = 0; bj < 2; ++bj) rd.g[bj] = *(const u32x4*)(Pb + (size_t)row * NG1 + 4608 + cbase + bj * 128); }
  __device__ __forceinline__ float apply(int row, int cbase, const f32x4 (&v)[4], const ColData&, const RowData& rd) const {
#pragma unroll
    for (int bj = 0; bj < 2; ++bj) *(u32x4*)(t1 + (size_t)row * DM + cbase + bj * 128) = pack8(unlo(rd.g[bj]) * v[bj * 2], unhi(rd.g[bj]) * v[bj * 2 + 1]);
    return 0.f;
  }
  __device__ __forceinline__ float rowscale(int) const { return 1.f; }
  __device__ __forceinline__ float operator()(int row, int col, f32x4 v, float) const {
    const f32x4 sg = unpack4(*(const u32x2*)(Pb + (size_t)row * NG1 + 4608 + col));
    *(u32x2*)(t1 + (size_t)row * DM + col) = pack4(sg * v);
    return 0.f;
  }
};
struct Fb {
  static constexpr bool NEEDR = false, STAT = false, PERM = true; static constexpr int RB = 4;
  const bf16_t* Pb; const bf16_t* t1; bf16_t* mg; u64* ss;
  struct ColData { int dummy; }; struct RowData { u32x4 g[2]; u32x4 t[2]; };
  __device__ __forceinline__ void load_cols(int, ColData&) const {}
  __device__ __forceinline__ void load_row(int row, int cbase, RowData& rd) const {
#pragma unroll
    for (int bj = 0; bj < 2; ++bj) { rd.g[bj] = *(const u32x4*)(Pb + (size_t)row * NG1 + 5632 + cbase + bj * 128); rd.t[bj] = *(const u32x4*)(t1 + (size_t)row * DM + cbase + bj * 128); } }
  __device__ __forceinline__ float apply(int row, int cbase, const f32x4 (&v)[4], const ColData&, const RowData& rd) const {
#pragma unroll
    for (int bj = 0; bj < 2; ++bj) *(u32x4*)(mg + (size_t)row * DM + cbase + bj * 128) = pack8(unlo(rd.t[bj]) + unlo(rd.g[bj]) * v[bj * 2], unhi(rd.t[bj]) + unhi(rd.g[bj]) * v[bj * 2 + 1]);
    return 0.f;
  }
  __device__ __forceinline__ float rowscale(int) const { return 1.f; }
  __device__ __forceinline__ float operator()(int row, int col, f32x4 v, float) const {
    const f32x4 sg = unpack4(*(const u32x2*)(Pb + (size_t)row * NG1 + 5632 + col));
    const f32x4 t = unpack4(*(const u32x2*)(t1 + (size_t)row * DM + col));
    *(u32x2*)(mg + (size_t)row * DM + col) = pack4(t + sg * v);
    return 0.f;
  }
};
struct Fres {
  static constexpr bool NEEDR = false, STAT = true, PERM = true; static constexpr int RB = 4;
  const float *xinP, *xinS; float* xo; bf16_t* xb; u64* ss;
  struct ColData { int dummy; }; struct RowData { f32x4 x[4]; };
  __device__ __forceinline__ void load_cols(int, ColData&) const {}
  __device__ __forceinline__ void load_row(int row, int cbase, RowData& rd) const {
#pragma unroll
    for (int q = 0; q < 4; ++q) rd.x[q] = *(const f32x4*)(xinP + (size_t)row * DM + cbase + (q >> 1) * 128 + (q & 1) * 4); }
  __device__ __forceinline__ float apply(int row, int cbase, const f32x4 (&v)[4], const ColData&, const RowData& rd) const {
    float s = 0.f;
#pragma unroll
    for (int bj = 0; bj < 2; ++bj) {
      const f32x4 o0 = rd.x[bj * 2] + v[bj * 2], o1 = rd.x[bj * 2 + 1] + v[bj * 2 + 1];
      float* xp = xo + (size_t)row * DM + cbase + bj * 128;
      *(f32x4*)xp = o0; *(f32x4*)(xp + 4) = o1;
      const u32x2 p0 = pack4(o0), p1 = pack4(o1);
      *(u32x4*)(xb + (size_t)row * DM + cbase + bj * 128) = (u32x4){p0.x, p0.y, p1.x, p1.y};
      s += (o0[0] * o0[0] + o0[1] * o0[1]) + (o0[2] * o0[2] + o0[3] * o0[3]) + (o1[0] * o1[0] + o1[1] * o1[1]) + (o1[2] * o1[2] + o1[3] * o1[3]);
    }
    return s;
  }
  __device__ __forceinline__ float rowscale(int) const { return 1.f; }
  __device__ __forceinline__ float operator()(int row, int col, f32x4 v, float) const {
    const float* xi = row < NP ? xinP + (size_t)row * DM : xinS + (size_t)(row - NP) * DM;
    const f32x4 o = *(const f32x4*)(xi + col) + v;
    *(f32x4*)(xo + (size_t)row * DM + col) = o;
    *(u32x2*)(xb + (size_t)row * DM + col) = pack4(o);
    return (o[0] * o[0] + o[1] * o[1]) + (o[2] * o[2] + o[3] * o[3]);
  }
};
struct F13 {
  const u64* rs; bf16_t* act;
  __device__ __forceinline__ float rowscale(int row) const { return rs_of(rs[row]); }
  __device__ __forceinline__ f32x4 glu(f32x4 a1, f32x4 a3, float r) const {
    f32x4 o;
#pragma unroll
    for (int i = 0; i < 4; ++i) { const float x1 = a1[i] * r, x3 = a3[i] * r; o[i] = x1 * sigmoidf_(x1) * x3; }
    return o;
  }
  __device__ __forceinline__ void pair(int row, int j, f32x4 a1, f32x4 a3, float r) const { *(u32x2*)(act + (size_t)row * DFF + j) = pack4(glu(a1, a3, r)); }
};

template <class F> struct EpiMain {
  static constexpr bool PERM = F::PERM;
  F f; int coff;
  __device__ __forceinline__ void operator()(const f32x4 (&acc)[2][2][4][2], const pg8::Unit& u, int wr, int wc, int fr, int fq) const {
    const int rbase = u.pm * 256 + wr * 64 + fr, cbase = coff + u.pn * 256 + wc * 32 + (F::PERM ? 8 : 4) * fq;
    typename F::ColData cd; f.load_cols(cbase, cd);
#pragma unroll
    for (int b0 = 0; b0 < 8; b0 += F::RB) {
      typename F::RowData rd[F::RB];
#pragma unroll
      for (int k = 0; k < F::RB; ++k) { const int i = b0 + k; f.load_row(rbase + (i >> 2) * 128 + (i & 3) * 16, cbase, rd[k]); }
      __builtin_amdgcn_sched_barrier(0);
#pragma unroll
      for (int k = 0; k < F::RB; ++k) {
        const int i = b0 + k, ai = i >> 2, m = i & 3, row = rbase + ai * 128 + m * 16;
        const f32x4 v[4] = {acc[ai][0][m][0], acc[ai][0][m][1], acc[ai][1][m][0], acc[ai][1][m][1]};
        float s = f.apply(row, cbase, v, cd, rd[k]);
        if (F::STAT) { s += __shfl_xor(s, 16); s += __shfl_xor(s, 32); if (fq == 0) ss_add(f.ss + row, s); }
      }
      __builtin_amdgcn_sched_barrier(0);
    }
  }
};
struct EpiMain13 {
  static constexpr bool PERM = true;
  F13 f;
  __device__ __forceinline__ void operator()(const f32x4 (&acc)[2][2][4][2], const pg8::Unit& u, int wr, int wc, int fr, int fq) const {
    const int rbase = u.pm * 256 + wr * 64 + fr, jbase = u.pn * 128 + wc * 32 + 8 * fq;
    u64 sq[8];
#pragma unroll
    for (int i = 0; i < 8; ++i) sq[i] = f.rs[rbase + (i >> 2) * 128 + (i & 3) * 16];
    __builtin_amdgcn_sched_barrier(0);
#pragma unroll
    for (int i = 0; i < 8; ++i) {
      const int ai = i >> 2, m = i & 3, row = rbase + ai * 128 + m * 16;
      const float r = rs_of(sq[i]);
      *(u32x4*)(f.act + (size_t)row * DFF + jbase) = pack8(f.glu(acc[ai][0][m][0], acc[ai][1][m][0], r), f.glu(acc[ai][0][m][1], acc[ai][1][m][1], r));
    }
  }
};

template <int NACC>
__device__ __forceinline__ void skinny_unit(const bf16_t* A, int K, const bf16_t* Bt, int row0, int brow0, int bstep, float* red, f32x4 (&out)[NACC]) {
  const int tid = tidx(), w = tid >> 6, lane = tid & 63, g4 = lane >> 4, l15 = lane & 15;
  const int nks = K >> 8, kbase = w * (K >> 3) + 8 * g4;
  f32x4 acc[8][NACC];
#pragma unroll
  for (int rt = 0; rt < 8; ++rt)
#pragma unroll
    for (int i = 0; i < NACC; ++i) acc[rt][i] = (f32x4){0.f, 0.f, 0.f, 0.f};
  const bf16_t* ap = A + (size_t)(row0 + l15) * K + kbase;
  const bf16_t* bp = Bt + (size_t)(brow0 + l15) * K + kbase;
  for (int ks = 0; ks < nks; ks += 2) {
    const bool two = ks + 1 < nks;
    bf16x8 a0[8], a1[8], b0[NACC], b1[NACC];
#pragma unroll
    for (int rt = 0; rt < 8; ++rt) a0[rt] = *(const bf16x8*)(ap + (size_t)16 * rt * K + 32 * ks);
#pragma unroll
    for (int i = 0; i < NACC; ++i) b0[i] = *(const bf16x8*)(bp + (size_t)bstep * i * K + 32 * ks);
    if (two) {
#pragma unroll
      for (int rt = 0; rt < 8; ++rt) a1[rt] = *(const bf16x8*)(ap + (size_t)16 * rt * K + 32 * ks + 32);
#pragma unroll
      for (int i = 0; i < NACC; ++i) b1[i] = *(const bf16x8*)(bp + (size_t)bstep * i * K + 32 * ks + 32);
    }
#pragma unroll
    for (int rt = 0; rt < 8; ++rt)
#pragma unroll
      for (int i = 0; i < NACC; ++i) acc[rt][i] = __builtin_amdgcn_mfma_f32_16x16x32_bf16(b0[i], a0[rt], acc[rt][i], 0, 0, 0);
    if (two) {
#pragma unroll
      for (int rt = 0; rt < 8; ++rt)
#pragma unroll
        for (int i = 0; i < NACC; ++i) acc[rt][i] = __builtin_amdgcn_mfma_f32_16x16x32_bf16(b1[i], a1[rt], acc[rt][i], 0, 0, 0);
    }
  }
#pragma unroll
  for (int rt = 0; rt < 8; ++rt)
#pragma unroll
    for (int i = 0; i < NACC; ++i) *(f32x4*)(red + (size_t)(((w * 8 + rt) * NACC + i) * 64 + lane) * 4) = acc[rt][i];
  __syncthreads();
#pragma unroll
  for (int i = 0; i < NACC; ++i) {
    f32x4 t = (f32x4){0.f, 0.f, 0.f, 0.f};
#pragma unroll
    for (int ww = 0; ww < 8; ++ww) t += *(const f32x4*)(red + (size_t)(((ww * 8 + w) * NACC + i) * 64 + lane) * 4);
    out[i] = t;
  }
}
template <class F>
__device__ __forceinline__ void skinny_run(const F& f, const bf16_t* A, int K, const bf16_t* Bt, int rowbase, int nrt, int ncu, int bid, int G, unsigned char* shm, int c0 = 0) {
  const int tid = tidx(), w = tid >> 6, lane = tid & 63, g = lane >> 4;
  const int total = nrt * ncu, nc = G - c0;
  if (bid < c0) return;
  for (int su = (G - 1 - bid); su < total; su += nc) {
    const int rt = su / ncu, cu = su - rt * ncu;
    const int row0 = rowbase + rt * 128, arow = row0 + 16 * w + (lane & 15);
    f32x4 acc[1];
    skinny_unit<1>(A, K, Bt, row0, 16 * cu, 16, (float*)shm, acc);
    const float rs = F::NEEDR ? f.rowscale(arow) : 1.f;
    float ss = f(arow, 16 * cu + 4 * g, acc[0], rs);
    if (F::STAT) { ss += __shfl_xor(ss, 16); ss += __shfl_xor(ss, 32); if (g == 0) ss_add(f.ss + arow, ss); }
    __syncthreads();
  }
}
__device__ __forceinline__ void skinny_run13(const F13& f, const bf16_t* A, const bf16_t* Bt, int bid, int G, unsigned char* shm) {
  const int tid = tidx(), w = tid >> 6, lane = tid & 63, g = lane >> 4;
  const int c0 = ((NP / 256) * (2 * DFF / 256)) % G, nc = G - c0;
  if (bid < c0) return;
  for (int su = (G - 1 - bid); su < DFF / 16; su += nc) {
    const int arow = NP + 16 * w + (lane & 15);
    f32x4 acc[2];
    skinny_unit<2>(A, 1024, Bt, NP, ((16 * su) >> 7) * 256 + ((16 * su) & 127), 128, (float*)shm, acc);
    f.pair(arow, 16 * su + 4 * g, acc[0], acc[1], f.rowscale(arow));
    __syncthreads();
  }
}
template <class F>
__device__ __forceinline__ void gemm_all(LAS unsigned char* lds, unsigned char* shm, const bf16_t* A, const bf16_t* Bt, int N, int K, const F& f, int bid, int G) {
  pg8::Gemm g; g.A = A; g.Bt = Bt; g.M = NP; g.N = N; g.K = K;
  pg8::StaticOrder S; S.init(NP, N, G, bid);
  EpiMain<F> E; E.f = f; E.coff = 0;
  REP(F::STAT ? 0 : 512) pg8::gemm_phase(lds, g, S, E);
  REP(F::STAT ? 0 : 256) skinny_run(f, A, K, Bt, NP, 1, N / 16, bid, G, shm, ((NP / 256) * (N / 256)) % G);
}

template <class F>
__device__ __forceinline__ void gemm_main_window(LAS unsigned char* lds, const bf16_t* A, const bf16_t* Bt, int N, int K, const F& f, int coff, int bid, int G) {
  pg8::Gemm g; g.A = A; g.Bt = Bt; g.M = NP; g.N = N; g.K = K;
  pg8::StaticOrder S; S.init(NP, N, G, bid);
  EpiMain<F> E; E.f = f; E.coff = coff;
  pg8::gemm_phase(lds, g, S, E);
}

__device__ __forceinline__ void prep_s5tables(const Params& P, int item, unsigned char* shm);
__device__ __forceinline__ void prep_phase(const Params& P, unsigned char* shm, int bid, int G) {
  const int tid = tidx(), w = tid >> 6, lane = tid & 63;
  bf16_t* T = (bf16_t*)shm;
  for (int t0 = 4 * bid; t0 < P.total_tiles; t0 += 4 * G) {
    f32x4 v0[4], v1[4]; float sc[4];
    const int kk = tid >> 3, jq = tid & 7, nn = jq * 8;
#pragma unroll
    for (int u = 0; u < 4; ++u) {
      const int tile = t0 + u;
      v0[u] = (f32x4){0.f, 0.f, 0.f, 0.f}; v1[u] = v0[u]; sc[u] = 1.f;
      if (tile < P.total_tiles) {
        int ji = 0;
        while (ji + 1 < P.njobs && P.jobs[ji + 1].tile0 <= tile) ++ji;
        const TJob& J = P.jobs[ji];
        const int lt = tile - J.tile0, tn = lt % J.ntn, tk = lt / J.ntn, k0 = tk * 64, n0 = tn * 64;
        if (n0 + nn < J.ncols) { const float* sp = J.src + (size_t)(k0 + kk) * J.ldn + J.c0 + n0 + nn; v0[u] = *(const f32x4*)sp; v1[u] = *(const f32x4*)(sp + 4); }
        if (J.scale) sc[u] = J.scale[k0 + kk];
      }
    }
#pragma unroll
    for (int u = 0; u < 4; ++u) {
      bf16_t* Tu = T + u * (64 * 72);
      const int kx = kk ^ (8 * jq);
#pragma unroll
      for (int i = 0; i < 4; ++i) { Tu[(nn + i) * 72 + kx] = f2bf(v0[u][i] * sc[u]); Tu[(nn + 4 + i) * 72 + kx] = f2bf(v1[u][i] * sc[u]); }
    }
    __syncthreads();
#pragma unroll
    for (int u = 0; u < 4; ++u) {
      const int tile = t0 + u;
      if (tile < P.total_tiles) {
        int ji = 0;
        while (ji + 1 < P.njobs && P.jobs[ji + 1].tile0 <= tile) ++ji;
        const TJob& J = P.jobs[ji];
        const int lt = tile - J.tile0, tn = lt % J.ntn, tk = lt / J.ntn, k0 = tk * 64, n0 = tn * 64;
        const int n = tid >> 3, k8 = (tid & 7) * 8, gn = n0 + n;
        if (gn < J.nwrite) {
          const int dr = J.mode == 0 ? J.r0 + gn : ((gn >> 7) * 256 + (J.mode == 2 ? 128 : 0) + (gn & 127));
          *(u32x4*)(J.dst + (size_t)dr * J.K + k0 + k8) = *(const u32x4*)(T + u * (64 * 72) + n * 72 + (k8 ^ (8 * ((n >> 3) & 7))));
        }
      }
    }
    __syncthreads();
  }
  for (int i = bid * 512 + tid; i < 2 * 2048; i += G * 512) {
    const int l = i >> 11, gp = i & 2047, g = gp >> 6, p = gp & 63;
    const float dt = expf(P.log_dt[l * 32 + g]);
    const float Ar = P.A_re[l * 2048 + gp], Ai = P.A_im[l * 2048 + gp];
    const float mag = expf(dt * Ar);
    float sn, cs; sincosf(dt * Ai, &sn, &cs);
    const float abr = mag * cs, abi = mag * sn;
    const float den = Ar * Ar + Ai * Ai, nr = abr - 1.0f, ni = abi;
    const float fre = (nr * Ar + ni * Ai) / den, fim = (ni * Ar - nr * Ai) / den;
    P.abar[l][gp] = abr; P.abar[l][2048 + gp] = abi;
    for (int c = 0; c < 16; ++c) {
      const float Br = P.B_re[(size_t)l * 32768 + gp * 16 + c], Bi = P.B_im[(size_t)l * 32768 + gp * 16 + c];
      P.bbar[l][(g * 16 + c) * 64 + p] = fre * Br - fim * Bi;
      P.bbar[l][32768 + (g * 16 + c) * 64 + p] = fre * Bi + fim * Br;
    }
  }
  for (int it = bid; it < 64; it += G) prep_s5tables(P, it, shm);
  for (int row = bid * 8 + w; row < NT; row += G * 8) {
    const float* xr = row < NP ? P.x_prompt + (size_t)row * DM : P.x_sample + (size_t)(row - NP) * DM;
    float ss = 0.f;
#pragma unroll
    for (int i = 0; i < 4; ++i) {
      const f32x4 v = *(const f32x4*)(xr + 256 * i + 4 * lane);
      ss += (v[0] * v[0] + v[1] * v[1]) + (v[2] * v[2] + v[3] * v[3]);
      *(u32x2*)(P.xb + (size_t)row * DM + 256 * i + 4 * lane) = pack4(v);
    }
    ss = wave_sum(ss);
    if (lane == 0) P.ssA[row] = ss_fix(ss);
  }
}

__device__ __forceinline__ void mlstm_scalars(const float* gat, int b, int h, float* sA, float* sM, float* sB, float* chain) {
  const int tid = tidx(), w = tid >> 6, lane = tid & 63;
  for (int cc = w; cc < 16; cc += 8) {
    const int t0 = cc * 128 + 2 * lane; const size_t r0 = (size_t)b * 2048 + t0;
    const float ig0 = gat[r0 * 8 + h], lf0 = gat[r0 * 8 + 4 + h], ig1 = gat[(r0 + 1) * 8 + h], lf1 = gat[(r0 + 1) * 8 + 4 + h];
    float x = lf0 + lf1;
    for (int off = 1; off < 64; off <<= 1) { const float y = __shfl_up(x, off); if (lane >= off) x += y; }
    const float b1 = x, b0 = x - lf1, a0 = ig0 - b0, a1 = ig1 - b1;
    float cm = fmaxf(a0, a1);
    for (int off = 1; off < 64; off <<= 1) { const float y = __shfl_up(cm, off); if (lane >= off) cm = fmaxf(cm, y); }
    const float prev = __shfl_up(cm, 1); const float cm0 = lane ? fmaxf(prev, a0) : a0;
    sB[t0] = b0; sB[t0 + 1] = b1; sA[t0] = a0; sA[t0 + 1] = a1; sM[t0] = cm0; sM[t0 + 1] = cm;
    if (lane == 63) { chain[33 + cc] = b1; chain[49 + cc] = cm; }
  }
  __syncthreads();
  if (tid == 0) { float m = 0.f; for (int cc = 0; cc < 16; ++cc) { chain[cc] = m; const float ml = fmaxf(m, chain[49 + cc]); chain[17 + cc] = ml; m = chain[33 + cc] + ml; } chain[16] = m; }
  __syncthreads();
  for (int t = tid; t < 2048; t += 512) sM[t] = fmaxf(chain[t >> 7], sM[t]);
  __syncthreads();
}

__device__ __forceinline__ void m1_item(const Params& P, int item, unsigned char* shm) {
  const int tid = tidx(), w = __builtin_amdgcn_readfirstlane(tid >> 6), lane = tid & 63, g = lane >> 4;
  const int b = item >> 6, h = (item >> 4) & 3, c = item & 15;
  float* sA = (float*)shm; float* sM = sA + 2048; float* sB = sM + 2048; float* chain = sB + 2048;
  mlstm_scalars(P.gat, b, h, sA, sM, sB, chain);
  const int row0 = b * 2048 + c * 128, t = 16 * w + (lane & 15);
  const bf16_t* qp = P.Pb + (size_t)(row0 + t) * NG1 + h * 256 + 8 * g;
  bf16x8 qf[8];
#pragma unroll
  for (int ks = 0; ks < 8; ++ks) qf[ks] = *(const bf16x8*)(qp + 32 * ks);
  const float Mt = sM[c * 128 + t];
  bf16_t* sp = P.St + (size_t)item * 16384 + t * 128;
#pragma unroll
  for (int sg = 0; sg < 8; sg += 4) {
    if (sg <= w) {
      bf16x8 kf[4][8];
#pragma unroll
      for (int u = 0; u < 4; ++u) {
        if (sg + u <= w) {
          const bf16_t* kp = P.Pb + (size_t)(row0 + 16 * (sg + u) + (lane & 15)) * NG1 + 1024 + h * 256 + 8 * g;
#pragma unroll
          for (int ks = 0; ks < 8; ++ks) kf[u][ks] = *(const bf16x8*)(kp + 32 * ks);
        }
      }
#pragma unroll
      for (int u = 0; u < 4; ++u) {
        const int st = sg + u;
        f32x4 acc = (f32x4){0.f, 0.f, 0.f, 0.f};
        if (st <= w) {
#pragma unroll
          for (int ks = 0; ks < 8; ++ks) acc = __builtin_amdgcn_mfma_f32_16x16x32_bf16(kf[u][ks], qf[ks], acc, 0, 0, 0);
#pragma unroll
          for (int r = 0; r < 4; ++r) { const int s2 = 16 * st + 4 * g + r; acc[r] = (s2 <= t) ? acc[r] * __expf(sA[c * 128 + s2] - Mt) : 0.f; }
        }
        *(u32x2*)(sp + 16 * st + 4 * g) = pack4(acc);
      }
    } else {
#pragma unroll
      for (int u = 0; u < 4; ++u) *(u32x2*)(sp + 16 * (sg + u) + 4 * g) = (u32x2){0u, 0u};
    }
  }
  __syncthreads();
}

__device__ __forceinline__ bf16x8 trread8(unsigned a0, unsigned a1) {
  bf16x4 lo, hi;
  asm volatile("ds_read_b64_tr_b16 %0, %2\n\tds_read_b64_tr_b16 %1, %3\n\ts_waitcnt lgkmcnt(0)" : "=&v"(lo), "=&v"(hi) : "v"(a0), "v"(a1) : "memory");
  return __builtin_shufflevector(lo, hi, 0, 1, 2, 3, 4, 5, 6, 7);
}
__device__ __forceinline__ void trread8x3(unsigned a0, unsigned a1, unsigned a2, unsigned dlt, bf16x8& r0, bf16x8& r1, bf16x8& r2) {
  bf16x4 l0, h0, l1, h1, l2, h2;
  asm volatile("ds_read_b64_tr_b16 %0, %6\n\tds_read_b64_tr_b16 %1, %7\n\tds_read_b64_tr_b16 %2, %8\n\tds_read_b64_tr_b16 %3, %9\n\tds_read_b64_tr_b16 %4, %10\n\tds_read_b64_tr_b16 %5, %11\n\ts_waitcnt lgkmcnt(0)"
               : "=&v"(l0), "=&v"(h0), "=&v"(l1), "=&v"(h1), "=&v"(l2), "=&v"(h2)
               : "v"(a0), "v"(a0 + dlt), "v"(a1), "v"(a1 + dlt), "v"(a2), "v"(a2 + dlt) : "memory");
  r0 = __builtin_shufflevector(l0, h0, 0, 1, 2, 3, 4, 5, 6, 7); r1 = __builtin_shufflevector(l1, h1, 0, 1, 2, 3, 4, 5, 6, 7); r2 = __builtin_shufflevector(l2, h2, 0, 1, 2, 3, 4, 5, 6, 7);
}
__device__ __forceinline__ void trread8x2(unsigned a0, unsigned a1, unsigned dlt, bf16x8& r0, bf16x8& r1) {
  bf16x4 l0, h0, l1, h1;
  asm volatile("ds_read_b64_tr_b16 %0, %4\n\tds_read_b64_tr_b16 %1, %5\n\tds_read_b64_tr_b16 %2, %6\n\tds_read_b64_tr_b16 %3, %7\n\ts_waitcnt lgkmcnt(0)"
               : "=&v"(l0), "=&v"(h0), "=&v"(l1), "=&v"(h1) : "v"(a0), "v"(a0 + dlt), "v"(a1), "v"(a1 + dlt) : "memory");
  r0 = __builtin_shufflevector(l0, h0, 0, 1, 2, 3, 4, 5, 6, 7); r1 = __builtin_shufflevector(l1, h1, 0, 1, 2, 3, 4, 5, 6, 7);
}

constexpr int KS_STRIDE = 272, VS_STRIDE = 56;
constexpr int M2_K = 0, M2_V = 69632, M2_CL = 83968, M2_SC = 110080;
__device__ __forceinline__ void m2_item(const Params& P, int l, int item, unsigned char* shm) {
  const int tid = tidx(), w = __builtin_amdgcn_readfirstlane(tid >> 6), lane = tid & 63, g = lane >> 4, l15 = lane & 15;
  const int bh = item >> 3, j = item & 7, b = bh >> 2, h = bh & 3;
  bf16_t* Ksh = (bf16_t*)(shm + M2_K); bf16_t* Vsh = (bf16_t*)(shm + M2_V); bf16_t* Cl = (bf16_t*)(shm + M2_CL);
  float* sA = (float*)(shm + M2_SC); float* sM = sA + 2048; float* sB = sM + 2048; float* chain = sB + 2048;
  const unsigned lbase = (unsigned)(size_t)shm;
  u32x4 kreg[8]; u32x4 vreg;
  const int vs = tid >> 2, vpc = tid & 3;
  {
    const int row0 = b * 2048;
#pragma unroll
    for (int i = 0; i < 8; ++i) { const int piece = tid + 512 * i, s = piece >> 5, pc = piece & 31; kreg[i] = *(const u32x4*)(P.Pb + (size_t)(row0 + s) * NG1 + 1024 + h * 256 + 8 * pc); }
    vreg = *(const u32x4*)(P.Pb + (size_t)(row0 + vs) * NG1 + 2048 + h * 256 + 32 * j + 8 * vpc);
  }
  bf16x8 qf[8], sf[4];
  {
    const int t = 16 * w + l15;
#pragma unroll
    for (int ks = 0; ks < 8; ++ks) qf[ks] = (bf16x8){0, 0, 0, 0, 0, 0, 0, 0};
    const bf16_t* sp0 = P.St + (size_t)(bh * 16) * 16384 + t * 128 + 8 * g;
#pragma unroll
    for (int ks = 0; ks < 4; ++ks) sf[ks] = *(const bf16x8*)(sp0 + 32 * ks);
  }
  mlstm_scalars(P.gat, b, h, sA, sM, sB, chain);
  f32x4 Cacc[2][3];
#pragma unroll
  for (int dt = 0; dt < 2; ++dt)
#pragma unroll
    for (int et = 0; et < 3; ++et) Cacc[dt][et] = (f32x4){0.f, 0.f, 0.f, 0.f};
  const int trq = l15 >> 2, trp = lane & 3;
#define M2_WRITE_KV(cc) do { \
    const float ml_ = chain[17 + (cc)]; \
    _Pragma("unroll") for (int i = 0; i < 8; ++i) { const int piece = tid + 512 * i, s = piece >> 5, pc = piece & 31; \
      const float wk = __expf(sA[(cc) * 128 + s] - ml_); u32x4 sc; \
      _Pragma("unroll") for (int e = 0; e < 4; ++e) { const unsigned u = kreg[i][e]; sc[e] = pack2(bf2f(u & 0xffffu) * wk, bf2f(u >> 16) * wk); } \
      *(u32x4*)(Ksh + s * KS_STRIDE + 8 * pc) = sc; } \
    *(u32x4*)(Vsh + vs * VS_STRIDE + 8 * vpc) = vreg; \
    if (vpc == 0) { unsigned zz = 0u; asm volatile("" : "+v"(zz)); const u32x4 z = (u32x4){zz, zz, zz, zz}; u32x4 o1 = z; o1[0] = 0x3F80u; \
      *(u32x4*)(Vsh + vs * VS_STRIDE + 32) = o1; *(u32x4*)(Vsh + vs * VS_STRIDE + 40) = z; } } while (0)
  M2_WRITE_KV(0);
  __syncthreads();
  for (int c = 0; c < 16; ++c) {
    const int row0 = b * 2048 + c * 128;
    const float mlast = chain[17 + c], mprev = chain[c];
    if (c < 15) {
      const int nrow0 = row0 + 128;
#pragma unroll
      for (int i = 0; i < 8; ++i) { const int piece = tid + 512 * i, s = piece >> 5, pc = piece & 31; kreg[i] = *(const u32x4*)(P.Pb + (size_t)(nrow0 + s) * NG1 + 1024 + h * 256 + 8 * pc); }
      vreg = *(const u32x4*)(P.Pb + (size_t)(nrow0 + vs) * NG1 + 2048 + h * 256 + 32 * j + 8 * vpc);
    }
    {
      const int t = 16 * w + l15, row = row0 + t;
      f32x4 acc[3]; acc[0] = (f32x4){0.f, 0.f, 0.f, 0.f}; acc[1] = acc[0]; acc[2] = acc[0];
      const float Mt = sM[c * 128 + t];
      if (c > 0) {
#pragma unroll
        for (int ks = 0; ks < 8; ++ks) {
          bf16x8 cf[3];
#pragma unroll
          for (int et = 0; et < 3; ++et) cf[et] = *(const bf16x8*)(Cl + (16 * et + l15) * KS_STRIDE + 32 * ks + 8 * g);
          __builtin_amdgcn_sched_barrier(0);
#pragma unroll
          for (int et = 0; et < 3; ++et) acc[et] = __builtin_amdgcn_mfma_f32_16x16x32_bf16(cf[et], qf[ks], acc[et], 0, 0, 0);
          __builtin_amdgcn_sched_barrier(0);
        }
        const float wi = __expf(mprev - Mt);
        acc[0] *= wi; acc[1] *= wi; acc[2] *= wi;
      }
      const float ac = __expf(mprev - mlast);
#pragma unroll
      for (int dt = 0; dt < 2; ++dt)
#pragma unroll
        for (int et = 0; et < 3; ++et) Cacc[dt][et] *= ac;
#pragma unroll
      for (int ks = 0; ks < 4; ++ks) {
        bf16x8 kf[2], vf[3];
        const unsigned va = lbase + M2_V + (unsigned)((32 * ks + 8 * g + trq) * VS_STRIDE + 4 * trp) * 2u;
        const unsigned ka = lbase + M2_K + (unsigned)((32 * ks + 8 * g + trq) * KS_STRIDE + 32 * w + 4 * trp) * 2u;
        trread8x3(va, va + 32u, va + 64u, 4u * VS_STRIDE * 2u, vf[0], vf[1], vf[2]);
        trread8x2(ka, ka + 32u, 4u * KS_STRIDE * 2u, kf[0], kf[1]);
#pragma unroll
        for (int et = 0; et < 3; ++et) acc[et] = __builtin_amdgcn_mfma_f32_16x16x32_bf16(vf[et], sf[ks], acc[et], 0, 0, 0);
#pragma unroll
        for (int dt = 0; dt < 2; ++dt)
#pragma unroll
          for (int et = 0; et < 3; ++et) Cacc[dt][et] = __builtin_amdgcn_mfma_f32_16x16x32_bf16(kf[dt], vf[et], Cacc[dt][et], 0, 0, 0);
      }
      if (c < 15) {
        const bf16_t* qp = P.Pb + (size_t)(row + 128) * NG1 + h * 256 + 8 * g;
#pragma unroll
        for (int ks = 0; ks < 8; ++ks) qf[ks] = *(const bf16x8*)(qp + 32 * ks);
        const bf16_t* sp = P.St + (size_t)(bh * 16 + c + 1) * 16384 + t * 128 + 8 * g;
#pragma unroll
        for (int ks = 0; ks < 4; ++ks) sf[ks] = *(const bf16x8*)(sp + 32 * ks);
      }
      const float den = __shfl(acc[2][0], l15);
      const float dd = fmaxf(fabsf(den), __expf(-(sB[c * 128 + t] + Mt)));
      const float inv = __builtin_amdgcn_rcpf(dd);
      const f32x4 o0 = acc[0] * inv, o1 = acc[1] * inv;
      bf16_t* hp = P.hA + (size_t)row * DM + h * 256 + 32 * j + 4 * g;
      *(u32x2*)hp = pack4(o0); *(u32x2*)(hp + 16) = pack4(o1);
      float ss = (o0[0] * o0[0] + o0[1] * o0[1]) + (o0[2] * o0[2] + o0[3] * o0[3]) + (o1[0] * o1[0] + o1[1] * o1[1]) + (o1[2] * o1[2] + o1[3] * o1[3]);
      ss += __shfl_xor(ss, 16); ss += __shfl_xor(ss, 32);
      if (g == 0) P.hss[(size_t)row * 32 + h * 8 + j] = ss;
    }
    LDS_BARRIER();
#pragma unroll
    for (int dt = 0; dt < 2; ++dt)
#pragma unroll
      for (int et = 0; et < 3; ++et) *(u32x2*)(Cl + (16 * et + l15) * KS_STRIDE + 32 * w + 16 * dt + 4 * g) = pack4(Cacc[dt][et]);
    if (c < 15) M2_WRITE_KV(c + 1);
    LDS_BARRIER();
  }
#undef M2_WRITE_KV
  const size_t sidx = (size_t)(l * 8 + b) * 4 + h;
#pragma unroll
  for (int dt = 0; dt < 2; ++dt)
#pragma unroll
    for (int r = 0; r < 4; ++r) {
      const int d = 32 * w + 16 * dt + 4 * g + r;
      P.out[O_CP + sidx * 65536 + (size_t)d * 256 + 32 * j + l15] = Cacc[dt][0][r];
      P.out[O_CP + sidx * 65536 + (size_t)d * 256 + 32 * j + 16 + l15] = Cacc[dt][1][r];
      if (j == 0 && l15 == 0) P.out[O_NP + sidx * 256 + d] = Cacc[dt][2][r];
    }
  if (j == 0 && tid == 0) P.out[O_MP + sidx] = chain[16];
  __syncthreads();
}

__device__ __forceinline__ void msample_item(const Params& P, int l, int item, unsigned char* shm) {
  const int tid = tidx(), w = tid >> 6, lane = tid & 63;
  const int b = item >> 2, h = item & 3, row = NP + b;
  float* q = (float*)shm; float* k = q + 256; float* v = k + 256; float* red = v + 256; float* red2 = red + 2048;
  if (tid < 256) {
    const bf16_t* pr = P.Pb + (size_t)row * NG1 + h * 256 + tid;
    q[tid] = bf2f(pr[0]); k[tid] = bf2f(pr[1024]); v[tid] = bf2f(pr[2048]);
  }
  const float ig = P.gat[(size_t)row * 8 + h], lf = P.gat[(size_t)row * 8 + 4 + h];
  const size_t sidx = (size_t)(l * 128 + b) * 4 + h;
  const float m0 = P.st_m[sidx];
  const float inter = lf + m0, mt = fmaxf(inter, ig), wi = __expf(inter - mt), wa = __expf(ig - mt);
  __syncthreads();
  const float* C0 = P.st_C + sidx * 65536; float* Co = P.out + O_CS + sidx * 65536;
  const float* n0 = P.st_n + sidx * 256;
  const f32x4 v4 = *(const f32x4*)(v + 4 * lane);
  f32x4 acc = (f32x4){0.f, 0.f, 0.f, 0.f};
#pragma unroll 8
  for (int dd = 0; dd < 32; ++dd) {
    const int d = 32 * w + dd;
    const f32x4 c4 = __builtin_nontemporal_load((const f32x4*)(C0 + (size_t)d * 256 + 4 * lane));
    const float kd = wa * k[d], qd = q[d];
    __builtin_nontemporal_store(c4 * wi + v4 * kd, (f32x4*)(Co + (size_t)d * 256 + 4 * lane));
    acc += c4 * qd;
  }
  *(f32x4*)(red + w * 256 + 4 * lane) = acc;
  float qk = 0.f, qn = 0.f;
#pragma unroll
  for (int i = 0; i < 4; ++i) { const int d = lane + 64 * i; qk += q[d] * k[d]; qn += q[d] * n0[d]; }
  qk = wave_sum(qk); qn = wave_sum(qn);
  __syncthreads();
  const float s = qk * wa, den = wi * qn + s, ddn = fmaxf(fabsf(den), __expf(-mt));
  float hval = 0.f;
  if (tid < 256) {
    float num = 0.f;
#pragma unroll
    for (int i = 0; i < 8; ++i) num += red[i * 256 + tid];
    hval = (wi * num + s * v[tid]) / ddn;
    P.hA[(size_t)row * DM + h * 256 + tid] = f2bf(hval);
    P.out[O_NS + sidx * 256 + tid] = wi * n0[tid] + wa * k[tid];
  }
  float ss = wave_sum(hval * hval);
  if (lane == 0) red2[w] = ss;
  __syncthreads();
  if (tid < 8) P.hss[(size_t)row * 32 + h * 8 + tid] = tid == 0 ? (red2[0] + red2[1] + red2[2] + red2[3]) : 0.f;
  if (tid == 0) P.out[O_MS + sidx] = mt;
  __syncthreads();
}

__device__ __forceinline__ void s5_load_C(const Params& P, int l, int g, float* Csh) {
  for (int i = tidx(); i < 2048; i += 512) { const int ri = i >> 10, c = (i >> 6) & 15, p = i & 63;
    Csh[ri * 1088 + c * 68 + p] = (ri ? P.C_im : P.C_re)[(size_t)l * 32768 + (g * 16 + c) * 64 + p]; }
}
__device__ __forceinline__ void s5_sample_item(const Params& P, int l, int item, unsigned char* shm) {
  const int tid = tidx(), w = tid >> 6, lane = tid & 63;
  const int g = item & 31, bs0 = (item >> 5) * 16 + 2 * w;
  float* Csh = (float*)shm; float* sbuf = Csh + 2176 + w * 2176;
  s5_load_C(P, l, g, Csh);
  const float are = P.abar[l][g * 64 + lane], aim = P.abar[l][2048 + g * 64 + lane];
  float bre[16], bim[16];
#pragma unroll
  for (int c = 0; c < 16; ++c) { bre[c] = P.bbar[l][(g * 16 + c) * 64 + lane]; bim[c] = P.bbar[l][32768 + (g * 16 + c) * 64 + lane]; }
  const int ch = lane >> 2, pq = lane & 3;
  const float Dc = P.D_skip[l * 512 + g * 16 + ch];
  __syncthreads();
#pragma unroll
  for (int rep = 0; rep < 2; ++rep) {
    const int bs = bs0 + rep, row = NP + bs;
    const size_t o = ((size_t)(l * 128 + bs) * 32 + g) * 64 + lane;
    const float s0r = P.st_sre[o], s0i = P.st_sim[o];
    const bf16_t* up = P.Pb + (size_t)row * NG1 + 4096 + g * 16;
    const u32x4 u0 = *(const u32x4*)up, u1 = *(const u32x4*)(up + 8);
    float br = 0.f, bi = 0.f;
#pragma unroll
    for (int i = 0; i < 4; ++i) {
      const float ua = bf2f(u0[i] & 0xffffu), ub = bf2f(u0[i] >> 16), uc = bf2f(u1[i] & 0xffffu), ud = bf2f(u1[i] >> 16);
      br += bre[2 * i] * ua + bre[2 * i + 1] * ub + bre[8 + 2 * i] * uc + bre[8 + 2 * i + 1] * ud;
      bi += bim[2 * i] * ua + bim[2 * i + 1] * ub + bim[8 + 2 * i] * uc + bim[8 + 2 * i + 1] * ud;
    }
    const float sr = are * s0r - aim * s0i + br, si = are * s0i + aim * s0r + bi;
    P.out[O_SRS + o] = sr; P.out[O_SIS + o] = si;
    sbuf[rep * 136 + lane] = sr; sbuf[rep * 136 + 68 + lane] = si;
    asm volatile("s_waitcnt lgkmcnt(0)" ::: "memory");
    float acc = 0.f;
#pragma unroll
    for (int p4 = 0; p4 < 4; ++p4) {
      const int p0 = 16 * pq + 4 * p4;
      const f32x4 vr = *(const f32x4*)(sbuf + rep * 136 + p0), vi = *(const f32x4*)(sbuf + rep * 136 + 68 + p0);
      const f32x4 cr = *(const f32x4*)(Csh + ch * 68 + p0), ci = *(const f32x4*)(Csh + 1088 + ch * 68 + p0);
      acc += (cr[0] * vr[0] + cr[1] * vr[1]) + (cr[2] * vr[2] + cr[3] * vr[3]) - (ci[0] * vi[0] + ci[1] * vi[1]) - (ci[2] * vi[2] + ci[3] * vi[3]);
    }
    acc += __shfl_xor(acc, 1); acc += __shfl_xor(acc, 2);
    if (pq == 0) {
      const float uc = bf2f(up[ch]);
      P.ysb[(size_t)row * 512 + g * 16 + ch] = f2bf(gelu_tanh(acc + Dc * uc));
    }
  }
  __syncthreads();
}

__device__ __forceinline__ void prep_s5tables(const Params& P, int item, unsigned char* shm) {
  const int tid = tidx(), l = item >> 5, g = item & 31;
  float* pwr = (float*)shm; float* pwi = pwr + 17 * 64; float* bbr = pwi + 17 * 64; float* bbi = bbr + 1024; float* Ccr = bbi + 1024; float* Cci = Ccr + 1024;
  if (tid < 64) {
    const int p = tid, gp = g * 64 + p;
    const float dt = expf(P.log_dt[l * 32 + g]);
    const float Ar = P.A_re[l * 2048 + gp], Ai = P.A_im[l * 2048 + gp];
    const float mag = expf(dt * Ar);
    float sn, cs; sincosf(dt * Ai, &sn, &cs);
    const float abr = mag * cs, abi = mag * sn;
    const float den = Ar * Ar + Ai * Ai, nr = abr - 1.0f, ni = abi;
    const float fre = (nr * Ar + ni * Ai) / den, fim = (ni * Ar - nr * Ai) / den;
    float pr = 1.f, pi = 0.f;
    for (int t = 0; t <= 16; ++t) { pwr[t * 64 + p] = pr; pwi[t * 64 + p] = pi; const float a = pr * abr - pi * abi, b = pr * abi + pi * abr; pr = a; pi = b; }
    for (int c = 0; c < 16; ++c) {
      const float Br = P.B_re[(size_t)l * 32768 + gp * 16 + c], Bi = P.B_im[(size_t)l * 32768 + gp * 16 + c];
      bbr[p * 16 + c] = fre * Br - fim * Bi; bbi[p * 16 + c] = fre * Bi + fim * Br;
    }
  }
  for (int i = tid; i < 1024; i += 512) { Ccr[i] = P.C_re[(size_t)l * 32768 + g * 1024 + i]; Cci[i] = P.C_im[(size_t)l * 32768 + g * 1024 + i]; }
  __syncthreads();
  bf16_t* Kt = P.Kt[l] + (size_t)g * 17 * 256; bf16_t* Gm = P.Gm[l] + (size_t)g * 32768; bf16_t* Hm = P.Hm[l] + (size_t)g * 32768;
  for (int o = tid; o < 17 * 256; o += 512) {
    const int tau = o >> 8, c = (o >> 4) & 15, c2 = o & 15;
    float acc = 0.f;
    if (tau < 16) for (int p = 0; p < 64; ++p) {
      const float pr = pwr[tau * 64 + p], pi = pwi[tau * 64 + p], br = bbr[p * 16 + c2], bi = bbi[p * 16 + c2];
      const float zr = pr * br - pi * bi, zi = pr * bi + pi * br;
      acc += Ccr[c * 64 + p] * zr - Cci[c * 64 + p] * zi;
    }
    Kt[o] = f2bf(acc);
  }
  for (int o = tid; o < 32768; o += 512) {
    { const int tc = o >> 7, q = o & 127, t = tc >> 4, c = tc & 15, p = q & 63;
      const float cr = Ccr[c * 64 + p], ci = Cci[c * 64 + p], pr = pwr[(t + 1) * 64 + p], pi = pwi[(t + 1) * 64 + p];
      Gm[o] = f2bf(q < 64 ? (cr * pr - ci * pi) : -(cr * pi + ci * pr)); }
    { const int q = o >> 8, jc = o & 255, j = jc >> 4, c2 = jc & 15, p = q & 63;
      const float pr = pwr[(15 - j) * 64 + p], pi = pwi[(15 - j) * 64 + p], br = bbr[p * 16 + c2], bi = bbi[p * 16 + c2];
      Hm[o] = f2bf(q < 64 ? (pr * br - pi * bi) : (pr * bi + pi * br)); }
  }
  if (tid < 64) { P.a16[l][g * 64 + tid] = pwr[16 * 64 + tid]; P.a16[l][2048 + g * 64 + tid] = pwi[16 * 64 + tid]; }
  __syncthreads();
}
constexpr int S3_R0 = 0, S3_SIN = 69632, S3_KT = 69632 + 34816;
__device__ __forceinline__ void s5_stage3_item(const Params& P, int l, int item, unsigned char* shm) {
  const int tid = tidx(), w = tid >> 6, lane = tid & 63, g4 = lane >> 4, l15 = lane & 15;
  const int b = item >> 5, g = item & 31;
  float* Ebuf = (float*)(shm + S3_R0); bf16_t* Gsh = (bf16_t*)(shm + S3_R0); bf16_t* Sin = (bf16_t*)(shm + S3_SIN); bf16_t* Ksh = (bf16_t*)(shm + S3_KT);
  { bf16_t* Hsh = (bf16_t*)(shm + S3_R0); const bf16_t* Hm = P.Hm[l] + (size_t)g * 32768;
#pragma unroll
    for (int i = 0; i < 8; ++i) { const int piece = tid + 512 * i, r = piece >> 5, pc = piece & 31; *(u32x4*)(Hsh + r * 264 + 8 * pc) = *(const u32x4*)(Hm + r * 256 + 8 * pc); } }
  { const bf16_t* Kt = P.Kt[l] + (size_t)g * 17 * 256; for (int i = tid; i < 544; i += 512) *(u32x4*)(Ksh + 8 * i) = *(const u32x4*)(Kt + 8 * i); }
  const int n = 16 * w + l15, r0 = b * 2048 + n * 16;
  bf16x8 uf[8];
#pragma unroll
  for (int ks = 0; ks < 8; ++ks) uf[ks] = *(const bf16x8*)(P.Pb + (size_t)(r0 + 2 * ks + (g4 >> 1)) * NG1 + 4096 + g * 16 + 8 * (g4 & 1));
  __syncthreads();
  {
    const bf16_t* Hsh = (const bf16_t*)(shm + S3_R0);
    f32x4 eacc[8];
#pragma unroll
    for (int qt = 0; qt < 8; ++qt) {
      eacc[qt] = (f32x4){0.f, 0.f, 0.f, 0.f};
#pragma unroll
      for (int ks = 0; ks < 8; ++ks) { const bf16x8 x = *(const bf16x8*)(Hsh + (16 * qt + l15) * 264 + 32 * ks + 8 * g4); eacc[qt] = __builtin_amdgcn_mfma_f32_16x16x32_bf16(x, uf[ks], eacc[qt], 0, 0, 0); }
    }
    __syncthreads();
#pragma unroll
    for (int qt = 0; qt < 8; ++qt) *(f32x4*)(Ebuf + n * 128 + 16 * qt + 4 * g4) = eacc[qt];
  }
  __syncthreads();
  {
    const float ar = P.a16[l][g * 64 + lane], ai = P.a16[l][2048 + g * 64 + lane];
    float lr[16], li[16], sr = 0.f, si = 0.f;
#pragma unroll
    for (int k = 0; k < 16; ++k) {
      lr[k] = sr; li[k] = si;
      const float er = Ebuf[(16 * w + k) * 128 + lane], ei = Ebuf[(16 * w + k) * 128 + 64 + lane];
      const float nr = ar * sr - ai * si + er, ni = ar * si + ai * sr + ei; sr = nr; si = ni;
    }
    float* wend = (float*)(shm + S3_KT + 8704);
    wend[w * 128 + lane] = sr; wend[w * 128 + 64 + lane] = si;
    float br = ar, bi = ai;
#pragma unroll
    for (int i = 0; i < 4; ++i) { const float nr = br * br - bi * bi, ni = 2.f * br * bi; br = nr; bi = ni; }
    __syncthreads();
    float cr = 0.f, ci = 0.f;
    for (int w2 = 0; w2 < w; ++w2) { const float er = wend[w2 * 128 + lane], ei = wend[w2 * 128 + 64 + lane]; const float nr = br * cr - bi * ci + er, ni = br * ci + bi * cr + ei; cr = nr; ci = ni; }
    float pr = 1.f, pi = 0.f;
#pragma unroll
    for (int k = 0; k < 16; ++k) {
      Sin[(16 * w + k) * 136 + lane] = f2bf(lr[k] + pr * cr - pi * ci); Sin[(16 * w + k) * 136 + 64 + lane] = f2bf(li[k] + pr * ci + pi * cr);
      const float nr = pr * ar - pi * ai, ni = pr * ai + pi * ar; pr = nr; pi = ni;
    }
    if (w == 7) { const size_t o = ((size_t)(l * 8 + b) * 32 + g) * 64 + lane; P.out[O_SRP + o] = sr + pr * cr - pi * ci; P.out[O_SIP + o] = si + pr * ci + pi * cr; }
  }
  __syncthreads();
  { const bf16_t* Gm = P.Gm[l] + (size_t)g * 32768;
#pragma unroll
    for (int i = 0; i < 8; ++i) { const int piece = tid + 512 * i, r = piece >> 4, pc = piece & 15; *(u32x4*)(Gsh + r * 136 + 8 * pc) = *(const u32x4*)(Gm + r * 128 + 8 * pc); } }
  __syncthreads();
  bf16x8 sf[4];
#pragma unroll
  for (int k2 = 0; k2 < 4; ++k2) sf[k2] = *(const bf16x8*)(Sin + n * 136 + 32 * k2 + 8 * g4);
  const f32x4 D4 = *(const f32x4*)(P.D_skip + l * 512 + g * 16 + 4 * g4);
#pragma unroll
  for (int t = 0; t < 16; ++t) {
    f32x4 acc = (f32x4){0.f, 0.f, 0.f, 0.f};
    const int row = r0 + t;
    const f32x4 u4 = unpack4(*(const u32x2*)(P.Pb + (size_t)row * NG1 + 4096 + g * 16 + 4 * g4));
#pragma unroll
    for (int ks = 0; ks <= (t >> 1); ++ks) {
      const int tau = t - (2 * ks + (g4 >> 1)), idx = tau >= 0 ? tau : 16;
      const bf16x8 x = *(const bf16x8*)(Ksh + (idx * 16 + l15) * 16 + 8 * (g4 & 1));
      acc = __builtin_amdgcn_mfma_f32_16x16x32_bf16(x, uf[ks], acc, 0, 0, 0);
    }
#pragma unroll
    for (int k2 = 0; k2 < 4; ++k2) { const bf16x8 x = *(const bf16x8*)(Gsh + (t * 16 + l15) * 136 + 32 * k2 + 8 * g4); acc = __builtin_amdgcn_mfma_f32_16x16x32_bf16(x, sf[k2], acc, 0, 0, 0); }
    f32x4 y;
#pragma unroll
    for (int r = 0; r < 4; ++r) y[r] = gelu_tanh(acc[r] + D4[r] * u4[r]);
    *(u32x2*)(P.ysb + (size_t)row * 512 + g * 16 + 4 * g4) = pack4(y);
  }
  __syncthreads();
}

__device__ __forceinline__ void headnorm_rows(const Params& P, int l, int bid, int G) {
  const int w = tidx() >> 6, lane = tidx() & 63;
  for (int row = bid * 8 + w; row < NT; row += G * 8) {
    if (lane == 0) { P.ssA[row] = 0ull; P.ssB[row] = 0ull; }
#pragma unroll
    for (int h = 0; h < 4; ++h) {
      const f32x4 s0 = *(const f32x4*)(P.hss + (size_t)row * 32 + h * 8), s1 = *(const f32x4*)(P.hss + (size_t)row * 32 + h * 8 + 4);
      const float ss = (s0[0] + s0[1]) + (s0[2] + s0[3]) + (s1[0] + s1[1]) + (s1[2] + s1[3]);
      const float rh = rsqrtf(ss * (1.0f / 256.0f) + 1e-6f);
      const int col = h * 256 + 4 * lane;
      const f32x4 hv = unpack4(*(const u32x2*)(P.hA + (size_t)row * DM + col));
      const f32x4 so = unpack4(*(const u32x2*)(P.Pb + (size_t)row * NG1 + 3072 + col));
      const f32x4 gh = *(const f32x4*)(P.g_hn + l * 1024 + col);
      *(u32x2*)(P.xa + (size_t)row * DM + col) = pack4(so * hv * gh * rh);
    }
  }
}
__device__ __forceinline__ void final_rows(const Params& P, int bid, int G) {
  const int w = tidx() >> 6, lane = tidx() & 63;
  for (int row = bid * 8 + w; row < NT; row += G * 8) {
    const float rs = rs_of(P.ssA[row]);
    float* o = row < NP ? P.out + O_YP + (size_t)row * DM : P.out + O_YS + (size_t)(row - NP) * DM;
#pragma unroll
    for (int i = 0; i < 4; ++i) {
      const int col = 256 * i + 4 * lane;
      const f32x4 v = *(const f32x4*)(P.X2 + (size_t)row * DM + col);
      const f32x4 gf = *(const f32x4*)(P.g_final + col);
      *(f32x4*)(o + col) = v * gf * rs;
    }
  }
}


#define XB_TMO      128
#define XB_XCNT(j)  (256  + 64 * (j))
#define XB_XSUB(j)  (1280 + 64 * (j))
#define XB_XGEN(j)  (2304 + 64 * (j))
#define XB_TOP      3328
#define XB_TOPGEN   3392
#define XCD_BAR_WORDS 3456
#define XB_SPIN_CAP (1u << 22)
__device__ __forceinline__ unsigned xb_ld(unsigned* p)              { return __hip_atomic_load(p, __ATOMIC_RELAXED, __HIP_MEMORY_SCOPE_AGENT); }
__device__ __forceinline__ unsigned xb_add(unsigned* p, unsigned v) { return __hip_atomic_fetch_add(p, v, __ATOMIC_RELAXED, __HIP_MEMORY_SCOPE_AGENT); }
__device__ __forceinline__ unsigned xb_xcc_id() { return (unsigned)__builtin_amdgcn_s_getreg((3 << 11) | 20) & 0xFu; }
#define XB_SPIN(cond, bar) do { unsigned _sp = 0; while (cond) { __builtin_amdgcn_s_sleep(1); \
    if ((++_sp & 255u) == 0u) { if (xb_ld(&(bar)[XB_TMO])) break; if (_sp > XB_SPIN_CAP) { atomicAdd(&(bar)[XB_TMO], 1u); break; } } } } while (0)
struct XcdBarrier { unsigned* bar; unsigned x; volatile LAS unsigned* st; };
__device__ __forceinline__ XcdBarrier xcd_barrier_post(unsigned* bar, volatile LAS unsigned* st) {
  XcdBarrier b; b.bar = bar; b.x = xb_xcc_id(); b.st = st;
  if (threadIdx.x == 0) (void)xb_add(&bar[XB_XCNT(b.x)], 1u);
  return b;
}
__device__ __forceinline__ void xcd_barrier_complete(unsigned* bar, unsigned x, unsigned& nloc, unsigned& nx) {
  const unsigned G = gridDim.x * gridDim.y * gridDim.z;
  unsigned sum, cnt, mine, sp = 0u;
  for (;;) {
    sum = 0u; cnt = 0u; mine = 0u;
#pragma unroll
    for (unsigned j = 0; j < 16; ++j) { const unsigned c = xb_ld(&bar[XB_XCNT(j)]); sum += c; cnt += (c > 0u) ? 1u : 0u; mine = (j == x) ? c : mine; }
    if (sum == G) break;
    __builtin_amdgcn_s_sleep(1);
    if ((++sp & 255u) == 0u) { if (xb_ld(&bar[XB_TMO])) break; if (sp > XB_SPIN_CAP) { atomicAdd(&bar[XB_TMO], 1u); break; } }
  }
  nloc = mine > 0u ? mine : 1u; nx = cnt > 0u ? cnt : 1u;
}
__device__ __forceinline__ void xcd_barrier(const XcdBarrier& b) {
  asm volatile("s_waitcnt vmcnt(0)" ::: "memory");
  __syncthreads();
  if (threadIdx.x == 0) {
    unsigned* bar = b.bar;
    __builtin_amdgcn_s_waitcnt(0);
    unsigned nloc = b.st[0], nx = b.st[1];
    if (nloc == 0u) { xcd_barrier_complete(bar, b.x, nloc, nx); b.st[0] = nloc; b.st[1] = nx; }
    const unsigned old = xb_add(&bar[XB_XSUB(b.x)], 1u);
    const unsigned gen = old / nloc;
    if (old + 1u == (gen + 1u) * nloc) {
      __builtin_amdgcn_fence(__ATOMIC_RELEASE, "agent");
      asm volatile("s_waitcnt vmcnt(0)" ::: "memory");
      const unsigned og = xb_add(&bar[XB_TOP], 1u);
      const unsigned tg = og / nx;
      if (og + 1u == (tg + 1u) * nx) xb_add(&bar[XB_TOPGEN], 1u);
      else XB_SPIN(xb_ld(&bar[XB_TOPGEN]) == tg, bar);
      __builtin_amdgcn_fence(__ATOMIC_ACQUIRE, "agent");
      xb_add(&bar[XB_XGEN(b.x)], 1u);
      asm volatile("s_waitcnt vmcnt(0)" ::: "memory");
    } else {
      XB_SPIN(xb_ld(&bar[XB_XGEN(b.x)]) == gen, bar);
      __builtin_amdgcn_fence(__ATOMIC_ACQUIRE, "agent");
      asm volatile("s_waitcnt vmcnt(0)" ::: "memory");
    }
  }
  __syncthreads();
}

__global__ void __launch_bounds__(512) mega(const Params P) {
  extern __shared__ __attribute__((aligned(16))) unsigned char shm[];
  cg::grid_group grid = cg::this_grid();
  LAS unsigned char* lds = (LAS unsigned char*)shm;
  const int bid = blockIdx.x, G = gridDim.x;

  volatile LAS unsigned* xst = (volatile LAS unsigned*)(lds + LDS_BYTES - 16);
  if (threadIdx.x == 0) { xst[0] = 0u; xst[1] = 0u; }
  if (bid == 0) for (int i = threadIdx.x; i < XCD_BAR_WORDS; i += 512) P.bar[i] = 0u;
  REP(1) prep_phase(P, shm, bid, G);
  grid.sync();
  const XcdBarrier xb = xcd_barrier_post(P.bar, xst);

  for (int l = 0; l < 2; ++l) {
    REP(2) {
      F1 f; f.bias = P.b_in + l * PTOT; f.Pb = P.Pb; f.rs = P.ssA; f.ss = nullptr;
      gemm_main_window(lds, P.xb, P.WinT[l], 4096, 1024, f, 0, bid, G);
      gemm_main_window(lds, P.xb, P.WinT[l] + (size_t)4608 * 1024, 2048, 1024, f, 4608, bid, G);
      skinny_run(f, P.xb, 1024, P.WinT[l], NP, 1, NG1 / 16, bid, G, shm, 0);
      Fg fg; fg.bias = P.b_in + l * PTOT + 4096; fg.gat = P.gat; fg.rs = P.ssA; fg.ss = nullptr;
      REP(256) skinny_run(fg, P.xb, 1024, P.WgT[l], 0, 129, 1, bid, G, shm, 0);
    }
    xcd_barrier(xb);
    { F1 f; f.bias = P.b_in + l * PTOT; f.Pb = P.Pb; f.rs = P.ssA; f.ss = nullptr;
      gemm_main_window(lds, P.xb, P.WinT[l] + (size_t)4096 * 1024, 512, 1024, f, 4096, bid, G); }
    {
      const int n1 = G == 256 ? (bid < 128 ? 1 : 3) : (512 - bid + G - 1) / G;
      for (int j = 0; j < n1; ++j) m1_item(P, G == 256 ? (bid < 128 ? bid : 128 + (bid - 128) * 3 + j) : bid + j * G, shm);
      for (int it = bid; it < 512; it += G) msample_item(P, l, it, shm);
      for (int it = bid; it < 256; it += G) s5_sample_item(P, l, it, shm);
    }
    xcd_barrier(xb);
    REP(8) for (int it = bid; it < 256; it += G) m2_item(P, l, G == 256 ? (((it & 7) * 4 + (it >> 6)) * 8 + ((it >> 3) & 7)) : it, shm);
    REP(16) for (int it = bid; it < 256; it += G) s5_stage3_item(P, l, G == 256 ? ((it & 7) * 32 + (it >> 3)) : it, shm);
    xcd_barrier(xb);
    REP(32) {
      Fglu f; f.bias = P.b_glu + l * 512; f.ysb = P.ysb; f.ys2 = P.ys2; f.ss = nullptr;
      gemm_all(lds, shm, P.ysb, P.WgluT[l], 512, 512, f, bid, G);
      headnorm_rows(P, l, bid, G);
    }
    xcd_barrier(xb);
    REP(32) {
      Fa fa; fa.Pb = P.Pb; fa.t1 = P.t1; fa.ss = nullptr;
      gemm_all(lds, shm, P.xa, P.WaT[l], 1024, 1024, fa, bid, G);
      Fb fb; fb.Pb = P.Pb; fb.t1 = P.t1; fb.mg = P.mg; fb.ss = nullptr;
      gemm_all(lds, shm, P.ys2, P.WbT[l], 1024, 512, fb, bid, G);
    }
    xcd_barrier(xb);
    REP(32) {
      Fres f; f.xinP = l == 0 ? P.x_prompt : P.X2; f.xinS = l == 0 ? P.x_sample : P.X2 + (size_t)NP * DM; f.xo = P.X1; f.xb = P.xb; f.ss = P.ssB;
      gemm_all(lds, shm, P.mg, P.WoT[l], 1024, 1024, f, bid, G);
    }
    xcd_barrier(xb);
    REP(64) {
      F13 f; f.rs = P.ssB; f.act = P.act;
      pg8::Gemm g; g.A = P.xb; g.Bt = P.W13T[l]; g.M = NP; g.N = 2 * DFF; g.K = 1024;
      pg8::StaticOrder S; S.init(NP, 2 * DFF, G, bid);
      EpiMain13 E; E.f = f;
      REP(512) pg8::gemm_phase(lds, g, S, E);
      REP(256) skinny_run13(f, P.xb, P.W13T[l], bid, G, shm);
    }
    xcd_barrier(xb);
    REP(64) {
      Fres f; f.xinP = P.X1; f.xinS = P.X1 + (size_t)NP * DM; f.xo = P.X2; f.xb = P.xb; f.ss = P.ssA;
      gemm_all(lds, shm, P.act, P.W2T[l], 1024, DFF, f, bid, G);
    }
    xcd_barrier(xb);
  }
  final_rows(P, bid, G);
}

extern "C" void kernel_launch(void* const* d_in, const int* in_sizes, int n_in, void* d_out, int out_size, void* d_ws, size_t ws_size, hipStream_t stream) {
  constexpr size_t kDynLds = LDS_BYTES;
  static int grid_blocks = 0;
  if (!grid_blocks) {
    int dev = 0, cus = 0, per_cu = 0;
    (void)hipGetDevice(&dev);
    (void)hipDeviceGetAttribute(&cus, hipDeviceAttributeMultiprocessorCount, dev);
    (void)hipFuncSetAttribute((const void*)mega, hipFuncAttributeMaxDynamicSharedMemorySize, (int)kDynLds);
    (void)hipOccupancyMaxActiveBlocksPerMultiprocessor(&per_cu, mega, 512, kDynLds);
    if (per_cu > 1) per_cu = 1;
    grid_blocks = cus * per_cu;
    if (grid_blocks > 256) grid_blocks = 256;
  }
  Params p;
  memset(&p, 0, sizeof(p));
  const float* const* in = (const float* const*)d_in;
  p.x_prompt = in[0]; p.x_sample = in[1]; p.st_C = in[2]; p.st_n = in[3]; p.st_m = in[4]; p.st_sre = in[5]; p.st_sim = in[6];
  p.g_mix = in[7]; p.w_in = in[8]; p.b_in = in[9]; p.g_hn = in[10]; p.w_a = in[11]; p.A_re = in[12]; p.A_im = in[13]; p.log_dt = in[14];
  p.B_re = in[15]; p.B_im = in[16]; p.C_re = in[17]; p.C_im = in[18]; p.D_skip = in[19]; p.w_glu = in[20]; p.b_glu = in[21]; p.w_b = in[22]; p.w_out = in[23];
  p.g_ffn = in[24]; p.w_ff1 = in[25]; p.w_ff3 = in[26]; p.w_ff2 = in[27]; p.g_final = in[28];
  p.out = (float*)d_out;
  char* base = (char*)d_ws; size_t off = 0;
  auto alloc = [&](size_t bytes) { char* r = base + off; off += (bytes + 255) & ~(size_t)255; return r; };
  for (int l = 0; l < 2; ++l) {
    p.WinT[l] = (bf16_t*)alloc((size_t)NG1 * 1024 * 2); p.WgT[l] = (bf16_t*)alloc(16 * 1024 * 2); p.WgluT[l] = (bf16_t*)alloc(512 * 512 * 2);
    p.WaT[l] = (bf16_t*)alloc(1024 * 1024 * 2); p.WbT[l] = (bf16_t*)alloc(1024 * 512 * 2); p.WoT[l] = (bf16_t*)alloc(1024 * 1024 * 2);
    p.W13T[l] = (bf16_t*)alloc((size_t)2 * DFF * 1024 * 2); p.W2T[l] = (bf16_t*)alloc((size_t)1024 * DFF * 2);
    p.abar[l] = (float*)alloc(4096 * 4); p.bbar[l] = (float*)alloc(65536 * 4);
  }
  p.xb = (bf16_t*)alloc((size_t)NT * DM * 2); p.Pb = (bf16_t*)alloc((size_t)NT * NG1 * 2); p.St = (bf16_t*)alloc((size_t)512 * 16384 * 2);
  p.ysb = (bf16_t*)alloc((size_t)NT * 512 * 2); p.ys2 = (bf16_t*)alloc((size_t)NT * 512 * 2); p.xa = (bf16_t*)alloc((size_t)NT * DM * 2);
  p.mg = (bf16_t*)alloc((size_t)NT * DM * 2); p.act = (bf16_t*)alloc((size_t)NT * DFF * 2);
  p.X1 = (float*)alloc((size_t)NT * DM * 4); p.X2 = (float*)alloc((size_t)NT * DM * 4);
  p.ssA = (unsigned long long*)alloc((size_t)NT * 8); p.ssB = (unsigned long long*)alloc((size_t)NT * 8); p.bar = (unsigned*)alloc(XCD_BAR_WORDS * 4);
  for (int l = 0; l < 2; ++l) { p.Kt[l] = (bf16_t*)alloc(32 * 17 * 256 * 2); p.Gm[l] = (bf16_t*)alloc(32 * 32768 * 2); p.Hm[l] = (bf16_t*)alloc(32 * 32768 * 2); p.a16[l] = (float*)alloc(4096 * 4); }
  p.E2 = (float*)alloc((size_t)8 * 128 * 32 * 128 * 4);
  p.gat = (float*)alloc((size_t)NT * 8 * 4); p.hA = (bf16_t*)alloc((size_t)NT * DM * 2); p.hss = (float*)alloc((size_t)NT * 32 * 4);
  p.t1 = (bf16_t*)alloc((size_t)NT * DM * 2); p.Eend = (float*)alloc((size_t)2 * 524288 * 4);
  int nj = 0, tile0 = 0;
  auto job = [&](const float* src, const float* scale, bf16_t* dst, int ldn, int c0, int ncols, int K, int mode, int r0, int nwrite) {
    TJob& J = p.jobs[nj++]; J.src = src; J.scale = scale; J.dst = dst; J.ldn = ldn; J.c0 = c0; J.ncols = ncols; J.K = K; J.mode = mode; J.r0 = r0;
    J.tile0 = tile0; J.ntn = (ncols + 63) / 64; J.nwrite = nwrite; J.pad = 0; tile0 += J.ntn * (K / 64);
  };
  for (int l = 0; l < 2; ++l) {
    const float* win = p.w_in + (size_t)l * 1024 * PTOT; const float* gm = p.g_mix + l * 1024; const float* gf = p.g_ffn + l * 1024;
    job(win, gm, p.WinT[l], PTOT, 0, 4096, 1024, 0, 0, 4096);
    job(win, gm, p.WinT[l], PTOT, 4104, 512, 1024, 0, 4096, 512);
    job(win, gm, p.WinT[l], PTOT, 4616, 2048, 1024, 0, 4608, 2048);
    job(win, gm, p.WgT[l], PTOT, 4096, 8, 1024, 0, 0, 16);
    job(p.w_glu + (size_t)l * 512 * 512, nullptr, p.WgluT[l], 512, 0, 512, 512, 0, 0, 512);
    job(p.w_a + (size_t)l * 1024 * 1024, nullptr, p.WaT[l], 1024, 0, 1024, 1024, 0, 0, 1024);
    job(p.w_b + (size_t)l * 512 * 1024, nullptr, p.WbT[l], 1024, 0, 1024, 512, 0, 0, 1024);
    job(p.w_out + (size_t)l * 1024 * 1024, nullptr, p.WoT[l], 1024, 0, 1024, 1024, 0, 0, 1024);
    job(p.w_ff1 + (size_t)l * 1024 * DFF, gf, p.W13T[l], DFF, 0, DFF, 1024, 1, 0, DFF);
    job(p.w_ff3 + (size_t)l * 1024 * DFF, gf, p.W13T[l], DFF, 0, DFF, 1024, 2, 0, DFF);
    job(p.w_ff2 + (size_t)l * DFF * 1024, nullptr, p.W2T[l], 1024, 0, 1024, DFF, 0, 0, 1024);
  }
  p.njobs = nj; p.total_tiles = tile0;
  void* args[] = {&p};
  hipError_t e = hipLaunchCooperativeKernel((void*)mega, dim3(grid_blocks), dim3(512), args, kDynLds, stream);
  if (e != hipSuccess) fprintf(stderr, "cooperative launch failed: %s (grid %d)\n", hipGetErrorString(e), grid_blocks);
}
```

```cpp
#include <hip/hip_runtime.h>
#include <hip/hip_cooperative_groups.h>
#include <cstdio>
#include <cstring>
namespace cg = cooperative_groups;

#define LAS __attribute__((address_space(3)))
typedef unsigned short bf16_t;
typedef short bf16x8 __attribute__((ext_vector_type(8)));
typedef short bf16x4 __attribute__((ext_vector_type(4)));
typedef float f32x4 __attribute__((ext_vector_type(4)));
typedef unsigned u32x4 __attribute__((ext_vector_type(4)));
typedef unsigned u32x2 __attribute__((ext_vector_type(2)));

constexpr int NP = 16384, NS = 128, NT = 16512, DM = 1024, NG1 = 6656, DFF = 2816, PTOT = 6664;
constexpr int LDS_BYTES = 150 * 1024;
#ifndef DUPMASK
#define DUPMASK 0
#endif
#define REP(bit) for (int rep_ = 0; rep_ < ((DUPMASK & (bit)) ? 2 : 1); ++rep_)
constexpr size_t O_YP = 0, O_YS = 16777216, O_CP = 16908288, O_NP = 21102592, O_MP = 21118976, O_SRP = 21119040, O_SIP = 21151808,
                 O_CS = 21184576, O_NS = 88293440, O_MS = 88555584, O_SRS = 88556608, O_SIS = 89080896;

struct TJob { const float* src; const float* scale; bf16_t* dst; int ldn, c0, ncols, K, mode, r0, tile0, ntn, nwrite, pad; };

struct Params {
  const float *x_prompt, *x_sample, *st_C, *st_n, *st_m, *st_sre, *st_sim;
  const float *g_mix, *w_in, *b_in, *g_hn, *w_a, *A_re, *A_im, *log_dt, *B_re, *B_im, *C_re, *C_im, *D_skip, *w_glu, *b_glu, *w_b, *w_out,
      *g_ffn, *w_ff1, *w_ff3, *w_ff2, *g_final;
  float* out;
  bf16_t *WinT[2], *WgT[2], *WgluT[2], *WaT[2], *WbT[2], *WoT[2], *W13T[2], *W2T[2];
  float *abar[2], *bbar[2];
  bf16_t *xb, *Pb, *St, *ysb, *ys2, *xa, *mg, *act;
  float *X1, *X2, *gat, *hss, *Eend; bf16_t *hA, *t1;
  unsigned long long *ssA, *ssB;
  unsigned* bar;
  bf16_t *Kt[2], *Gm[2], *Hm[2]; float *a16[2], *E2;
  TJob jobs[22];
  int njobs, total_tiles;
};

__device__ __forceinline__ bf16_t f2bf(float f) { return __builtin_bit_cast(bf16_t, (__bf16)f); }
__device__ __forceinline__ float bf2f(unsigned b) { return __uint_as_float(b << 16); }
typedef float f32x2 __attribute__((ext_vector_type(2)));
typedef __bf16 bf16x2v __attribute__((ext_vector_type(2)));
__device__ __forceinline__ unsigned pack2(float lo, float hi) { const f32x2 v = {lo, hi}; const bf16x2v b = __builtin_convertvector(v, bf16x2v); return __builtin_bit_cast(unsigned, b); }
__device__ __forceinline__ u32x2 pack4(f32x4 v) { u32x2 r; r.x = pack2(v[0], v[1]); r.y = pack2(v[2], v[3]); return r; }
__device__ __forceinline__ f32x4 unpack4(u32x2 u) { f32x4 r; r[0] = bf2f(u.x & 0xffffu); r[1] = bf2f(u.x >> 16); r[2] = bf2f(u.y & 0xffffu); r[3] = bf2f(u.y >> 16); return r; }
__device__ __forceinline__ float sigmoidf_(float x) { return __builtin_amdgcn_rcpf(1.0f + __expf(-x)); }
__device__ __forceinline__ float gelu_tanh(float x) { float z = 0.7978845608f * (x + 0.044715f * x * x * x); float e = __expf(2.0f * z); float th = 1.0f - 2.0f * __builtin_amdgcn_rcpf(e + 1.0f); return 0.5f * x * (1.0f + th); }
__device__ __forceinline__ int tidx() { int t = threadIdx.x; asm volatile("" : "+v"(t)); return t; }
#define LDS_BARRIER() do { asm volatile("s_waitcnt lgkmcnt(0)" ::: "memory"); __builtin_amdgcn_s_barrier(); asm volatile("" ::: "memory"); } while (0)
__device__ __forceinline__ float wave_sum(float v) { for (int o = 32; o > 0; o >>= 1) v += __shfl_xor(v, o); return v; }

namespace pg8 {
constexpr int BM = 256, BK = 64, HALF = 128, HTB = HALF * BK * 2, STAGE_BYTES = 8 * HTB, NXCD = 8, WGM = 8;
__host__ __device__ __forceinline__ int lds_byte(int r, int c) { const int st = (r >> 4) * 2 + (c >> 5), rr = r & 15, cc = c & 31, ob = rr * 64 + cc * 2; return st * 1024 + (ob ^ (((ob >> 9) & 1) << 5)); }
__host__ __device__ __forceinline__ void stage_rc(int b, int& R, int& C) { const int st = b / 1024, sb = b % 1024, swz = sb ^ (((sb >> 9) & 1) << 5); R = (st >> 1) * 16 + swz / 64; C = (st & 1) * 32 + (swz % 64) / 2; }
__host__ __device__ __forceinline__ int perm32(int rho) { const int n = rho >> 4, i = rho & 15; return 8 * (i >> 2) + 4 * n + (i & 3); }
struct Unit { int pm, pn; };
struct Gemm { const bf16_t* A; const bf16_t* Bt; int M, N, K; };
struct StaticOrder {
  int nM, nN, nwg, G, c;
  __device__ void init(int M, int N, int G_, int c_) { nM = M / BM; nN = N / BM; nwg = nM * nN; G = G_; c = c_; }
  __device__ bool next(int i, Unit& u) const {
    const long L = (long)i * G + c; if (L >= nwg) return false;
    int wgid = (int)L; { const int q = nwg / NXCD, r = nwg % NXCD, xcd = wgid % NXCD, off = wgid / NXCD; wgid = (xcd < r ? xcd * (q + 1) : r * (q + 1) + (xcd - r) * q) + off; }
    const int nig = WGM * nN, gid = wgid / nig, fm = gid * WGM, gsz = (nM - fm) < WGM ? (nM - fm) : WGM;
    u.pm = fm + ((wgid % nig) % gsz); u.pn = (wgid % nig) / gsz; return true;
  }
};

template <class Epi, class Sched>
__device__ __forceinline__ void gemm_phase(LAS unsigned char* lds, const Gemm g, const Sched& S, const Epi& E) {
  const int tid = tidx(), wid = __builtin_amdgcn_readfirstlane(tid >> 6), lane = tid & 63, wr = wid >> 2, wc = wid & 3, fr = lane & 15, fq = lane >> 4;
  const int K = g.K, nt = K / BK;
  unsigned voffA[2], voffB[2];
#pragma unroll
  for (int i = 0; i < 2; ++i) { int R, C; stage_rc(tid * 16 + i * 8192, R, C); voffA[i] = (unsigned)(R * K + C) * 2u; const int Rb = Epi::PERM ? ((R & ~31) + perm32(R & 31)) : R; voffB[i] = (unsigned)(Rb * K + C) * 2u; }
  const size_t kstep = (size_t)(BK * 2);
  const size_t hstep = (size_t)HALF * K * 2;
  const size_t tstep = 2 * hstep;
  const unsigned ldsw = (unsigned)wid * 1024u;
  const int aoff = lds_byte(wr * 64 + fr, fq * 8), boff = lds_byte(wc * 32 + fr, fq * 8);
#define PG8_SA(b, h) (((b) * 2 + (h)) * HTB)
#define PG8_SB(b, h) ((4 + (b) * 2 + (h)) * HTB)
#define PG8_STAGE(bufoff, gbase, voff) do { _Pragma("unroll") for (int _i = 0; _i < 2; ++_i) \
    __builtin_amdgcn_global_load_lds((const unsigned*)((const char*)(gbase) + (voff)[_i]), (LAS unsigned*)(lds + (bufoff) + ldsw + _i * 8192), 16, 0, 0); } while (0)
#define PG8_LDA(dst, b, h) do { _Pragma("unroll") for (int m = 0; m < 4; ++m) _Pragma("unroll") for (int k = 0; k < 2; ++k) dst[m][k] = *(const LAS bf16x8*)(lds + PG8_SA(b, h) + aoff + m * 2048 + k * 1024); } while (0)
#define PG8_LDB(dst, b, h) do { _Pragma("unroll") for (int n = 0; n < 2; ++n) _Pragma("unroll") for (int k = 0; k < 2; ++k) dst[n][k] = *(const LAS bf16x8*)(lds + PG8_SB(b, h) + boff + n * 2048 + k * 1024); } while (0)
#define PG8_MMA(ai, bj, At, Bt) do { __builtin_amdgcn_s_setprio(1); _Pragma("unroll") for (int m = 0; m < 4; ++m) _Pragma("unroll") for (int n = 0; n < 2; ++n) _Pragma("unroll") for (int k = 0; k < 2; ++k) \
    acc[ai][bj][m][n] = __builtin_amdgcn_mfma_f32_16x16x32_bf16(Bt[n][k], At[m][k], acc[ai][bj][m][n], 0, 0, 0); __builtin_amdgcn_s_setprio(0); } while (0)
#define PG8_WAIT_V(n) asm volatile("s_waitcnt vmcnt(" #n ")" ::: "memory")
#define PG8_WAIT_L(n) asm volatile("s_waitcnt lgkmcnt(" #n ")" ::: "memory")
#define PG8_BAR __builtin_amdgcn_s_barrier()
#define PG8_SCHED __builtin_amdgcn_sched_barrier(0)
  Unit cur, nxt; int ui = 0;
  if (!S.next(0, cur)) return;
  f32x4 acc[2][2][4][2];
#pragma unroll
  for (int a = 0; a < 2; ++a)
#pragma unroll
    for (int b = 0; b < 2; ++b)
#pragma unroll
      for (int m = 0; m < 4; ++m)
#pragma unroll
        for (int n = 0; n < 2; ++n) acc[a][b][m][n] = (f32x4){0.f, 0.f, 0.f, 0.f};
  bf16x8 At[4][2], B0[2][2], B1[2][2];
  const char* cA = (const char*)g.A + (size_t)cur.pm * tstep; const char* cB = (const char*)g.Bt + (size_t)cur.pn * tstep;
  PG8_STAGE(PG8_SB(0, 0), cB, voffB); PG8_STAGE(PG8_SA(0, 0), cA, voffA); PG8_STAGE(PG8_SB(0, 1), cB + hstep, voffB); PG8_STAGE(PG8_SA(0, 1), cA + hstep, voffA);
  if (wr == 1) PG8_BAR;
  PG8_WAIT_V(4); PG8_BAR;
  PG8_STAGE(PG8_SB(1, 0), cB + kstep, voffB); PG8_STAGE(PG8_SA(1, 0), cA + kstep, voffA); PG8_STAGE(PG8_SB(1, 1), cB + hstep + kstep, voffB);
  PG8_WAIT_V(6); PG8_BAR;
  for (;;) {
    const bool has_next = S.next(ui + 1, nxt);
    const char* nA = has_next ? (const char*)g.A + (size_t)nxt.pm * tstep : cA; const char* nB = has_next ? (const char*)g.Bt + (size_t)nxt.pn * tstep : cB;
    for (int t = 0; t < nt; t += 2) {
      const bool last = (t == nt - 2);
      const char* a1 = cA + (size_t)(t + 1) * kstep;
      const char* a2 = last ? nA : cA + (size_t)(t + 2) * kstep; const char* b2 = last ? nB : cB + (size_t)(t + 2) * kstep;
      const char* a3 = a2 + kstep; const char* b3 = b2 + kstep;
      PG8_LDB(B0, 0, 0); PG8_SCHED; PG8_LDA(At, 0, 0); PG8_STAGE(PG8_SA(1, 1), a1 + hstep, voffA);
      PG8_WAIT_L(8); PG8_BAR; PG8_WAIT_L(0); PG8_MMA(0, 0, At, B0); PG8_BAR; PG8_SCHED;
      PG8_LDB(B1, 0, 1); PG8_STAGE(PG8_SB(0, 0), b2, voffB);
      PG8_BAR; PG8_WAIT_L(0); PG8_MMA(0, 1, At, B1); PG8_BAR;
      PG8_LDA(At, 0, 1); PG8_STAGE(PG8_SA(0, 0), a2, voffA);
      PG8_BAR; PG8_WAIT_L(0); PG8_MMA(1, 0, At, B0); PG8_BAR; PG8_SCHED;
      PG8_STAGE(PG8_SB(0, 1), b2 + hstep, voffB);
      PG8_WAIT_V(6); PG8_BAR; PG8_MMA(1, 1, At, B1); PG8_BAR;
      PG8_LDB(B0, 1, 0); PG8_SCHED; PG8_LDA(At, 1, 0); PG8_STAGE(PG8_SA(0, 1), a2 + hstep, voffA);
      PG8_WAIT_L(8); PG8_BAR; PG8_WAIT_L(0); PG8_MMA(0, 0, At, B0); PG8_BAR; PG8_SCHED;
      PG8_LDB(B1, 1, 1); PG8_STAGE(PG8_SB(1, 0), b3, voffB);
      PG8_BAR; PG8_WAIT_L(0); PG8_MMA(0, 1, At, B1); PG8_BAR;
      PG8_LDA(At, 1, 1); PG8_STAGE(PG8_SA(1, 0), a3, voffA);
      PG8_BAR; PG8_WAIT_L(0); PG8_MMA(1, 0, At, B0); PG8_BAR; PG8_SCHED;
      PG8_STAGE(PG8_SB(1, 1), b3 + hstep, voffB);
      PG8_WAIT_V(6); PG8_BAR; PG8_MMA(1, 1, At, B1); PG8_BAR;
    }
    E(acc, cur, wr, wc, fr, fq);
    if (!has_next) break;
#pragma unroll
    for (int a = 0; a < 2; ++a)
#pragma unroll
      for (int b = 0; b < 2; ++b)
#pragma unroll
        for (int m = 0; m < 4; ++m)
#pragma unroll
          for (int n = 0; n < 2; ++n) acc[a][b][m][n] = (f32x4){0.f, 0.f, 0.f, 0.f};
    cur = nxt; cA = nA; cB = nB; ++ui;
  }
  PG8_WAIT_V(0);
  if (wr == 0) PG8_BAR;
  PG8_BAR;
#undef PG8_SA
#undef PG8_SB
#undef PG8_STAGE
#undef PG8_LDA
#undef PG8_LDB
#undef PG8_MMA
#undef PG8_WAIT_V
#undef PG8_WAIT_L
#undef PG8_BAR
#undef PG8_SCHED
}
}

typedef unsigned long long u64;
__device__ __forceinline__ u64 ss_fix(float ss) { return (u64)(ss * 16777216.0f); }
__device__ __forceinline__ float rs_of(u64 q) { const float f = (float)(unsigned)(q >> 32) * 4294967296.0f + (float)(unsigned)q; return rsqrtf(f * (1.0f / (16777216.0f * 1024.0f)) + 1e-6f); }
__device__ __forceinline__ void ss_add(u64* p, float ss) { __hip_atomic_fetch_add(p, ss_fix(ss), __ATOMIC_RELAXED, __HIP_MEMORY_SCOPE_AGENT); }
__device__ __forceinline__ int qcol(int cbase, int q) { return cbase + (q >> 1) * 128 + (q & 1) * 16; }
__device__ __forceinline__ f32x4 unlo(u32x4 u) { return unpack4((u32x2){u[0], u[1]}); }
__device__ __forceinline__ f32x4 unhi(u32x4 u) { return unpack4((u32x2){u[2], u[3]}); }
__device__ __forceinline__ u32x4 pack8(f32x4 a, f32x4 b) { const u32x2 p = pack4(a), q = pack4(b); return (u32x4){p.x, p.y, q.x, q.y}; }
struct F1 {
  static constexpr bool NEEDR = true, STAT = false, PERM = true; static constexpr int RB = 8;
  const float* bias; bf16_t* Pb; const u64* rs; u64* ss;
  struct ColData { f32x4 b[4]; }; struct RowData { u64 s; };
  __device__ __forceinline__ void load_cols(int cbase, ColData& cd) const {
#pragma unroll
    for (int q = 0; q < 4; ++q) { const int col = cbase + (q >> 1) * 128 + (q & 1) * 4; cd.b[q] = *(const f32x4*)(bias + (col < 4096 ? col : col + 8)); } }
  __device__ __forceinline__ void load_row(int row, int, RowData& rd) const { rd.s = rs[row]; }
  __device__ __forceinline__ float apply(int row, int cbase, const f32x4 (&v)[4], const ColData& cd, const RowData& rd) const {
    const float r = rs_of(rd.s);
    const int blk = cbase >> 8;
    const bool isk = blk >= 4 && blk < 8, issig = (blk >= 12 && blk < 16) || blk >= 18;
#pragma unroll
    for (int bj = 0; bj < 2; ++bj) {
      u32x4 pk;
#pragma unroll
      for (int n = 0; n < 2; ++n) {
        f32x4 o = v[bj * 2 + n] * r + cd.b[bj * 2 + n];
        if (isk) o = o * 0.0625f;
        else if (issig) { o[0] = sigmoidf_(o[0]); o[1] = sigmoidf_(o[1]); o[2] = sigmoidf_(o[2]); o[3] = sigmoidf_(o[3]); }
        const u32x2 p2 = pack4(o); pk[2 * n] = p2.x; pk[2 * n + 1] = p2.y;
      }
      *(u32x4*)(Pb + (size_t)row * NG1 + cbase + bj * 128) = pk;
    }
    return 0.f;
  }
  __device__ __forceinline__ float rowscale(int row) const { return rs_of(rs[row]); }
  __device__ __forceinline__ float operator()(int row, int col, f32x4 v, float r) const {
    const int bi = col < 4096 ? col : col + 8;
    const f32x4 b4 = *(const f32x4*)(bias + bi);
    f32x4 o = v * r + b4;
    if (col >= 1024 && col < 2048) o = o * 0.0625f;
    else if ((col >= 3072 && col < 4096) || col >= 4608) { o[0] = sigmoidf_(o[0]); o[1] = sigmoidf_(o[1]); o[2] = sigmoidf_(o[2]); o[3] = sigmoidf_(o[3]); }
    *(u32x2*)(Pb + (size_t)row * NG1 + col) = pack4(o);
    return 0.f;
  }
};
struct Fg {
  static constexpr bool NEEDR = true, STAT = false;
  const float* bias; float* gat; const u64* rs; u64* ss;
  __device__ __forceinline__ float rowscale(int row) const { return rs_of(rs[row]); }
  __device__ __forceinline__ float operator()(int row, int col, f32x4 v, float r) const {
    if (col < 8) {
      const f32x4 b4 = *(const f32x4*)(bias + col);
      f32x4 o = v * r + b4;
      if (col >= 4) {
#pragma unroll
        for (int i = 0; i < 4; ++i) { const float x = o[i]; o[i] = fminf(x, 0.f) - log1pf(__expf(-fabsf(x))); }
      }
      *(f32x4*)(gat + (size_t)row * 8 + col) = o;
    }
    return 0.f;
  }
};
struct Fglu {
  static constexpr bool NEEDR = false, STAT = false, PERM = true; static constexpr int RB = 8;
  const float* bias; const bf16_t* ysb; bf16_t* ys2; u64* ss;
  struct ColData { f32x4 b[4]; }; struct RowData { u32x4 y[2]; };
  __device__ __forceinline__ void load_cols(int cbase, ColData& cd) const {
#pragma unroll
    for (int q = 0; q < 4; ++q) cd.b[q] = *(const f32x4*)(bias + cbase + (q >> 1) * 128 + (q & 1) * 4); }
  __device__ __forceinline__ void load_row(int row, int cbase, RowData& rd) const {
#pragma unroll
    for (int bj = 0; bj < 2; ++bj) rd.y[bj] = *(const u32x4*)(ysb + (size_t)row * 512 + cbase + bj * 128); }
  __device__ __forceinline__ float apply(int row, int cbase, const f32x4 (&v)[4], const ColData& cd, const RowData& rd) const {
#pragma unroll
    for (int bj = 0; bj < 2; ++bj) {
      const f32x4 y0 = unlo(rd.y[bj]), y1 = unhi(rd.y[bj]); f32x4 o0, o1;
#pragma unroll
      for (int i = 0; i < 4; ++i) { o0[i] = y0[i] * sigmoidf_(v[bj * 2][i] + cd.b[bj * 2][i]); o1[i] = y1[i] * sigmoidf_(v[bj * 2 + 1][i] + cd.b[bj * 2 + 1][i]); }
      *(u32x4*)(ys2 + (size_t)row * 512 + cbase + bj * 128) = pack8(o0, o1);
    }
    return 0.f;
  }
  __device__ __forceinline__ float rowscale(int) const { return 1.f; }
  __device__ __forceinline__ float operator()(int row, int col, f32x4 v, float) const {
    const f32x4 b4 = *(const f32x4*)(bias + col);
    const f32x4 y = unpack4(*(const u32x2*)(ysb + (size_t)row * 512 + col));
    f32x4 o;
#pragma unroll
    for (int i = 0; i < 4; ++i) o[i] = y[i] * sigmoidf_(v[i] + b4[i]);
    *(u32x2*)(ys2 + (size_t)row * 512 + col) = pack4(o);
    return 0.f;
  }
};
struct Fa {
  static constexpr bool NEEDR = false, STAT = false, PERM = true; static constexpr int RB = 8;
  const bf16_t* Pb; bf16_t* t1; u64* ss;
  struct ColData { int dummy; }; struct RowData { u32x4 g[2]; };
  __device__ __forceinline__ void load_cols(int, ColData&) const {}
  __device__ __forceinline__ void load_row(int row, int cbase, RowData& rd) const {
#pragma unroll
    for (int bj = 0; bj < 2; ++bj) rd.g[bj] = *(const u32x4*)(Pb + (size_t)row * NG1 + 4608 + cbase + bj * 128); }
  __device__ __forceinline__ float apply(int row, int cbase, const f32x4 (&v)[4], const ColData&, const RowData& rd) const {
#pragma unroll
    for (int bj = 0; bj < 2; ++bj) *(u32x4*)(t1 + (size_t)row * DM + cbase + bj * 128) = pack8(unlo(rd.g[bj]) * v[bj * 2], unhi(rd.g[bj]) * v[bj * 2 + 1]);
    return 0.f;
  }
  __device__ __forceinline__ float rowscale(int) const { return 1.f; }
  __device__ __forceinline__ float operator()(int row, int col, f32x4 v, float) const {
    const f32x4 sg = unpack4(*(const u32x2*)(Pb + (size_t)row * NG1 + 4608 + col));
    *(u32x2*)(t1 + (size_t)row * DM + col) = pack4(sg * v);
    return 0.f;
  }
};
struct Fb {
  static constexpr bool NEEDR = false, STAT = false, PERM = true; static constexpr int RB = 4;
  const bf16_t* Pb; const bf16_t* t1; bf16_t* mg; u64* ss;
  struct ColData { int dummy; }; struct RowData { u32x4 g[2]; u32x4 t[2]; };
  __device__ __forceinline__ void load_cols(int, ColData&) const {}
  __device__ __forceinline__ void load_row(int row, int cbase, RowData& rd) const {
#pragma unroll
    for (int bj = 0; bj < 2; ++bj) { rd.g[bj] = *(const u32x4*)(Pb + (size_t)row * NG1 + 5632 + cbase + bj * 128); rd.t[bj] = *(const u32x4*)(t1 + (size_t)row * DM + cbase + bj * 128); } }
  __device__ __forceinline__ float apply(int row, int cbase, const f32x4 (&v)[4], const ColData&, const RowData& rd) const {
#pragma unroll
    for (int bj = 0; bj < 2; ++bj) *(u32x4*)(mg + (size_t)row * DM + cbase + bj * 128) = pack8(unlo(rd.t[bj]) + unlo(rd.g[bj]) * v[bj * 2], unhi(rd.t[bj]) + unhi(rd.g[bj]) * v[bj * 2 + 1]);
    return 0.f;
  }
  __device__ __forceinline__ float rowscale(int) const { return 1.f; }
  __device__ __forceinline__ float operator()(int row, int col, f32x4 v, float) const {
    const f32x4 sg = unpack4(*(const u32x2*)(Pb + (size_t)row * NG1 + 5632 + col));
    const f32x4 t = unpack4(*(const u32x2*)(t1 + (size_t)row * DM + col));
    *(u32x2*)(mg + (size_t)row * DM + col) = pack4(t + sg * v);
    return 0.f;
  }
};
struct Fres {
  static constexpr bool NEEDR = false, STAT = true, PERM = true; static constexpr int RB = 4;
  const float *xinP, *xinS; float* xo; bf16_t* xb; u64* ss;
  struct ColData { int dummy; }; struct RowData { f32x4 x[4]; };
  __device__ __forceinline__ void load_cols(int, ColData&) const {}
  __device__ __forceinline__ void load_row(int row, int cbase, RowData& rd) const {
#pragma unroll
    for (int q = 0; q < 4; ++q) rd.x[q] = *(const f32x4*)(xinP + (size_t)row * DM + cbase + (q >> 1) * 128 + (q & 1) * 4); }
  __device__ __forceinline__ float apply(int row, int cbase, const f32x4 (&v)[4], const ColData&, const RowData& rd) const {
    float s = 0.f;
#pragma unroll
    for (int bj = 0; bj < 2; ++bj) {
      const f32x4 o0 = rd.x[bj * 2] + v[bj * 2], o1 = rd.x[bj * 2 + 1] + v[bj * 2 + 1];
      float* xp = xo + (size_t)row * DM + cbase + bj * 128;
      *(f32x4*)xp = o0; *(f32x4*)(xp + 4) = o1;
      const u32x2 p0 = pack4(o0), p1 = pack4(o1);
      *(u32x4*)(xb + (size_t)row * DM + cbase + bj * 128) = (u32x4){p0.x, p0.y, p1.x, p1.y};
      s += (o0[0] * o0[0] + o0[1] * o0[1]) + (o0[2] * o0[2] + o0[3] * o0[3]) + (o1[0] * o1[0] + o1[1] * o1[1]) + (o1[2] * o1[2] + o1[3] * o1[3]);
    }
    return s;
  }
  __device__ __forceinline__ float rowscale(int) const { return 1.f; }
  __device__ __forceinline__ float operator()(int row, int col, f32x4 v, float) const {
    const float* xi = row < NP ? xinP + (size_t)row * DM : xinS + (size_t)(row - NP) * DM;
    const f32x4 o = *(const f32x4*)(xi + col) + v;
    *(f32x4*)(xo + (size_t)row * DM + col) = o;
    *(u32x2*)(xb + (size_t)row * DM + col) = pack4(o);
    return (o[0] * o[0] + o[1] * o[1]) + (o[2] * o[2] + o[3] * o[3]);
  }
};
struct F13 {
  const u64* rs; bf16_t* act;
  __device__ __forceinline__ float rowscale(int row) const { return rs_of(rs[row]); }
  __device__ __forceinline__ f32x4 glu(f32x4 a1, f32x4 a3, float r) const {
    f32x4 o;
#pragma unroll
    for (int i = 0; i < 4; ++i) { const float x1 = a1[i] * r, x3 = a3[i] * r; o[i] = x1 * sigmoidf_(x1) * x3; }
    return o;
  }
  __device__ __forceinline__ void pair(int row, int j, f32x4 a1, f32x4 a3, float r) const { *(u32x2*)(act + (size_t)row * DFF + j) = pack4(glu(a1, a3, r)); }
};

template <class F> struct EpiMain {
  static constexpr bool PERM = F::PERM;
  F f; int coff;
  __device__ __forceinline__ void operator()(const f32x4 (&acc)[2][2][4][2], const pg8::Unit& u, int wr, int wc, int fr, int fq) const {
    const int rbase = u.pm * 256 + wr * 64 + fr, cbase = coff + u.pn * 256 + wc * 32 + (F::PERM ? 8 : 4) * fq;
    typename F::ColData cd; f.load_cols(cbase, cd);
#pragma unroll
    for (int b0 = 0; b0 < 8; b0 += F::RB) {
      typename F::RowData rd[F::RB];
#pragma unroll
      for (int k = 0; k < F::RB; ++k) { const int i = b0 + k; f.load_row(rbase + (i >> 2) * 128 + (i & 3) * 16, cbase, rd[k]); }
      __builtin_amdgcn_sched_barrier(0);
#pragma unroll
      for (int k = 0; k < F::RB; ++k) {
        const int i = b0 + k, ai = i >> 2, m = i & 3, row = rbase + ai * 128 + m * 16;
        const f32x4 v[4] = {acc[ai][0][m][0], acc[ai][0][m][1], acc[ai][1][m][0], acc[ai][1][m][1]};
        float s = f.apply(row, cbase, v, cd, rd[k]);
        if (F::STAT) { s += __shfl_xor(s, 16); s += __shfl_xor(s, 32); if (fq == 0) ss_add(f.ss + row, s); }
      }
      __builtin_amdgcn_sched_barrier(0);
    }
  }
};
struct EpiMain13 {
  static constexpr bool PERM = true;
  F13 f;
  __device__ __forceinline__ void operator()(const f32x4 (&acc)[2][2][4][2], const pg8::Unit& u, int wr, int wc, int fr, int fq) const {
    const int rbase = u.pm * 256 + wr * 64 + fr, jbase = u.pn * 128 + wc * 32 + 8 * fq;
    u64 sq[8];
#pragma unroll
    for (int i = 0; i < 8; ++i) sq[i] = f.rs[rbase + (i >> 2) * 128 + (i & 3) * 16];
    __builtin_amdgcn_sched_barrier(0);
#pragma unroll
    for (int i = 0; i < 8; ++i) {
      const int ai = i >> 2, m = i & 3, row = rbase + ai * 128 + m * 16;
      const float r = rs_of(sq[i]);
      *(u32x4*)(f.act + (size_t)row * DFF + jbase) = pack8(f.glu(acc[ai][0][m][0], acc[ai][1][m][0], r), f.glu(acc[ai][0][m][1], acc[ai][1][m][1], r));
    }
  }
};

template <int NACC>
__device__ __forceinline__ void skinny_unit(const bf16_t* A, int K, const bf16_t* Bt, int row0, int brow0, int bstep, float* red, f32x4 (&out)[NACC]) {
  const int tid = tidx(), w = tid >> 6, lane = tid & 63, g4 = lane >> 4, l15 = lane & 15;
  const int nks = K >> 8, kbase = w * (K >> 3) + 8 * g4;
  f32x4 acc[8][NACC];
#pragma unroll
  for (int rt = 0; rt < 8; ++rt)
#pragma unroll
    for (int i = 0; i < NACC; ++i) acc[rt][i] = (f32x4){0.f, 0.f, 0.f, 0.f};
  const bf16_t* ap = A + (size_t)(row0 + l15) * K + kbase;
  const bf16_t* bp = Bt + (size_t)(brow0 + l15) * K + kbase;
  for (int ks = 0; ks < nks; ks += 2) {
    const bool two = ks + 1 < nks;
    bf16x8 a0[8], a1[8], b0[NACC], b1[NACC];
#pragma unroll
    for (int rt = 0; rt < 8; ++rt) a0[rt] = *(const bf16x8*)(ap + (size_t)16 * rt * K + 32 * ks);
#pragma unroll
    for (int i = 0; i < NACC; ++i) b0[i] = *(const bf16x8*)(bp + (size_t)bstep * i * K + 32 * ks);
    if (two) {
#pragma unroll
      for (int rt = 0; rt < 8; ++rt) a1[rt] = *(const bf16x8*)(ap + (size_t)16 * rt * K + 32 * ks + 32);
#pragma unroll
      for (int i = 0; i < NACC; ++i) b1[i] = *(const bf16x8*)(bp + (size_t)bstep * i * K + 32 * ks + 32);
    }
#pragma unroll
    for (int rt = 0; rt < 8; ++rt)
#pragma unroll
      for (int i = 0; i < NACC; ++i) acc[rt][i] = __builtin_amdgcn_mfma_f32_16x16x32_bf16(b0[i], a0[rt], acc[rt][i], 0, 0, 0);
    if (two) {
#pragma unroll
      for (int rt = 0; rt < 8; ++rt)
#pragma unroll
        for (int i = 0; i < NACC; ++i) acc[rt][i] = __builtin_amdgcn_mfma_f32_16x16x32_bf16(b1[i], a1[rt], acc[rt][i], 0, 0, 0);
    }
  }
#pragma unroll
  for (int rt = 0; rt < 8; ++rt)
#pragma unroll
    for (int i = 0; i < NACC; ++i) *(f32x4*)(red + (size_t)(((w * 8 + rt) * NACC + i) * 64 + lane) * 4) = acc[rt][i];
  __syncthreads();
#pragma unroll
  for (int i = 0; i < NACC; ++i) {
    f32x4 t = (f32x4){0.f, 0.f, 0.f, 0.f};
#pragma unroll
    for (int ww = 0; ww < 8; ++ww) t += *(const f32x4*)(red + (size_t)(((ww * 8 + w) * NACC + i) * 64 + lane) * 4);
    out[i] = t;
  }
}
template <class F>
__device__ __forceinline__ void skinny_run(const F& f, const bf16_t* A, int K, const bf16_t* Bt, int rowbase, int nrt, int ncu, int bid, int G, unsigned char* shm, int c0 = 0) {
  const int tid = tidx(), w = tid >> 6, lane = tid & 63, g = lane >> 4;
  const int total = nrt * ncu, nc = G - c0;
  if (bid < c0) return;
  for (int su = (G - 1 - bid); su < total; su += nc) {
    const int rt = su / ncu, cu = su - rt * ncu;
    const int row0 = rowbase + rt * 128, arow = row0 + 16 * w + (lane & 15);
    f32x4 acc[1];
    skinny_unit<1>(A, K, Bt, row0, 16 * cu, 16, (float*)shm, acc);
    const float rs = F::NEEDR ? f.rowscale(arow) : 1.f;
    float ss = f(arow, 16 * cu + 4 * g, acc[0], rs);
    if (F::STAT) { ss += __shfl_xor(ss, 16); ss += __shfl_xor(ss, 32); if (g == 0) ss_add(f.ss + arow, ss); }
    __syncthreads();
  }
}
__device__ __forceinline__ void skinny_run13(const F13& f, const bf16_t* A, const bf16_t* Bt, int bid, int G, unsigned char* shm) {
  const int tid = tidx(), w = tid >> 6, lane = tid & 63, g = lane >> 4;
  const int c0 = ((NP / 256) * (2 * DFF / 256)) % G, nc = G - c0;
  if (bid < c0) return;
  for (int su = (G - 1 - bid); su < DFF / 16; su += nc) {
    const int arow = NP + 16 * w + (lane & 15);
    f32x4 acc[2];
    skinny_unit<2>(A, 1024, Bt, NP, ((16 * su) >> 7) * 256 + ((16 * su) & 127), 128, (float*)shm, acc);
    f.pair(arow, 16 * su + 4 * g, acc[0], acc[1], f.rowscale(arow));
    __syncthreads();
  }
}
template <class F>
__device__ __forceinline__ void gemm_all(LAS unsigned char* lds, unsigned char* shm, const bf16_t* A, const bf16_t* Bt, int N, int K, const F& f, int bid, int G) {
  pg8::Gemm g; g.A = A; g.Bt = Bt; g.M = NP; g.N = N; g.K = K;
  pg8::StaticOrder S; S.init(NP, N, G, bid);
  EpiMain<F> E; E.f = f; E.coff = 0;
  REP(F::STAT ? 0 : 512) pg8::gemm_phase(lds, g, S, E);
  REP(F::STAT ? 0 : 256) skinny_run(f, A, K, Bt, NP, 1, N / 16, bid, G, shm, ((NP / 256) * (N / 256)) % G);
}

template <class F>
__device__ __forceinline__ void gemm_main_window(LAS unsigned char* lds, const bf16_t* A, const bf16_t* Bt, int N, int K, const F& f, int coff, int bid, int G) {
  pg8::Gemm g; g.A = A; g.Bt = Bt; g.M = NP; g.N = N; g.K = K;
  pg8::StaticOrder S; S.init(NP, N, G, bid);
  EpiMain<F> E; E.f = f; E.coff = coff;
  pg8::gemm_phase(lds, g, S, E);
}

__device__ __forceinline__ void prep_s5tables(const Params& P, int item, unsigned char* shm);
__device__ __forceinline__ void prep_phase(const Params& P, unsigned char* shm, int bid, int G) {
  const int tid = tidx(), w = tid >> 6, lane = tid & 63;
  bf16_t* T = (bf16_t*)shm;
  for (int t0 = 4 * bid; t0 < P.total_tiles; t0 += 4 * G) {
    f32x4 v0[4], v1[4]; float sc[4];
    const int kk = tid >> 3, jq = tid & 7, nn = jq * 8;
#pragma unroll
    for (int u = 0; u < 4; ++u) {
      const int tile = t0 + u;
      v0[u] = (f32x4){0.f, 0.f, 0.f, 0.f}; v1[u] = v0[u]; sc[u] = 1.f;
      if (tile < P.total_tiles) {
        int ji = 0;
        while (ji + 1 < P.njobs && P.jobs[ji + 1].tile0 <= tile) ++ji;
        const TJob& J = P.jobs[ji];
        const int lt = tile - J.tile0, tn = lt % J.ntn, tk = lt / J.ntn, k0 = tk * 64, n0 = tn * 64;
        if (n0 + nn < J.ncols) { const float* sp = J.src + (size_t)(k0 + kk) * J.ldn + J.c0 + n0 + nn; v0[u] = *(const f32x4*)sp; v1[u] = *(const f32x4*)(sp + 4); }
        if (J.scale) sc[u] = J.scale[k0 + kk];
      }
    }
#pragma unroll
    for (int u = 0; u < 4; ++u) {
      bf16_t* Tu = T + u * (64 * 72);
      const int kx = kk ^ (8 * jq);
#pragma unroll
      for (int i = 0; i < 4; ++i) { Tu[(nn + i) * 72 + kx] = f2bf(v0[u][i] * sc[u]); Tu[(nn + 4 + i) * 72 + kx] = f2bf(v1[u][i] * sc[u]); }
    }
    __syncthreads();
#pragma unroll
    for (int u = 0; u < 4; ++u) {
      const int tile = t0 + u;
      if (tile < P.total_tiles) {
        int ji = 0;
        while (ji + 1 < P.njobs && P.jobs[ji + 1].tile0 <= tile) ++ji;
        const TJob& J = P.jobs[ji];
        const int lt = tile - J.tile0, tn = lt % J.ntn, tk = lt / J.ntn, k0 = tk * 64, n0 = tn * 64;
        const int n = tid >> 3, k8 = (tid & 7) * 8, gn = n0 + n;
        if (gn < J.nwrite) {
          const int dr = J.mode == 0 ? J.r0 + gn : ((gn >> 7) * 256 + (J.mode == 2 ? 128 : 0) + (gn & 127));
          *(u32x4*)(J.dst + (size_t)dr * J.K + k0 + k8) = *(const u32x4*)(T + u * (64 * 72) + n * 72 + (k8 ^ (8 * ((n >> 3) & 7))));
        }
      }
    }
    __syncthreads();
  }
  for (int i = bid * 512 + tid; i < 2 * 2048; i += G * 512) {
    const int l = i >> 11, gp = i & 2047, g = gp >> 6, p = gp & 63;
    const float dt = expf(P.log_dt[l * 32 + g]);
    const float Ar = P.A_re[l * 2048 + gp], Ai = P.A_im[l * 2048 + gp];
    const float mag = expf(dt * Ar);
    float sn, cs; sincosf(dt * Ai, &sn, &cs);
    const float abr = mag * cs, abi = mag * sn;
    const float den = Ar * Ar + Ai * Ai, nr = abr - 1.0f, ni = abi;
    const float fre = (nr * Ar + ni * Ai) / den, fim = (ni * Ar - nr * Ai) / den;
    P.abar[l][gp] = abr; P.abar[l][2048 + gp] = abi;
    for (int c = 0; c < 16; ++c) {
      const float Br = P.B_re[(size_t)l * 32768 + gp * 16 + c], Bi = P.B_im[(size_t)l * 32768 + gp * 16 + c];
      P.bbar[l][(g * 16 + c) * 64 + p] = fre * Br - fim * Bi;
      P.bbar[l][32768 + (g * 16 + c) * 64 + p] = fre * Bi + fim * Br;
    }
  }
  for (int it = bid; it < 64; it += G) prep_s5tables(P, it, shm);
  for (int row = bid * 8 + w; row < NT; row += G * 8) {
    const float* xr = row < NP ? P.x_prompt + (size_t)row * DM : P.x_sample + (size_t)(row - NP) * DM;
    float ss = 0.f;
#pragma unroll
    for (int i = 0; i < 4; ++i) {
      const f32x4 v = *(const f32x4*)(xr + 256 * i + 4 * lane);
      ss += (v[0] * v[0] + v[1] * v[1]) + (v[2] * v[2] + v[3] * v[3]);
      *(u32x2*)(P.xb + (size_t)row * DM + 256 * i + 4 * lane) = pack4(v);
    }
    ss = wave_sum(ss);
    if (lane == 0) P.ssA[row] = ss_fix(ss);
  }
}

__device__ __forceinline__ void mlstm_scalars(const float* gat, int b, int h, float* sA, float* sM, float* sB, float* chain) {
  const int tid = tidx(), w = tid >> 6, lane = tid & 63;
  for (int cc = w; cc < 16; cc += 8) {
    const int t0 = cc * 128 + 2 * lane; const size_t r0 = (size_t)b * 2048 + t0;
    const float ig0 = gat[r0 * 8 + h], lf0 = gat[r0 * 8 + 4 + h], ig1 = gat[(r0 + 1) * 8 + h], lf1 = gat[(r0 + 1) * 8 + 4 + h];
    float x = lf0 + lf1;
    for (int off = 1; off < 64; off <<= 1) { const float y = __shfl_up(x, off); if (lane >= off) x += y; }
    const float b1 = x, b0 = x - lf1, a0 = ig0 - b0, a1 = ig1 - b1;
    float cm = fmaxf(a0, a1);
    for (int off = 1; off < 64; off <<= 1) { const float y = __shfl_up(cm, off); if (lane >= off) cm = fmaxf(cm, y); }
    const float prev = __shfl_up(cm, 1); const float cm0 = lane ? fmaxf(prev, a0) : a0;
    sB[t0] = b0; sB[t0 + 1] = b1; sA[t0] = a0; sA[t0 + 1] = a1; sM[t0] = cm0; sM[t0 + 1] = cm;
    if (lane == 63) { chain[33 + cc] = b1; chain[49 + cc] = cm; }
  }
  __syncthreads();
  if (tid == 0) { float m = 0.f; for (int cc = 0; cc < 16; ++cc) { chain[cc] = m; const float ml = fmaxf(m, chain[49 + cc]); chain[17 + cc] = ml; m = chain[33 + cc] + ml; } chain[16] = m; }
  __syncthreads();
  for (int t = tid; t < 2048; t += 512) sM[t] = fmaxf(chain[t >> 7], sM[t]);
  __syncthreads();
}

__device__ __forceinline__ void m1_item(const Params& P, int item, unsigned char* shm) {
  const int tid = tidx(), w = __builtin_amdgcn_readfirstlane(tid >> 6), lane = tid & 63, g = lane >> 4;
  const int b = item >> 6, h = (item >> 4) & 3, c = item & 15;
  float* sA = (float*)shm; float* sM = sA + 2048; float* sB = sM + 2048; float* chain = sB + 2048;
  mlstm_scalars(P.gat, b, h, sA, sM, sB, chain);
  const int row0 = b * 2048 + c * 128, t = 16 * w + (lane & 15);
  const bf16_t* qp = P.Pb + (size_t)(row0 + t) * NG1 + h * 256 + 8 * g;
  bf16x8 qf[8];
#pragma unroll
  for (int ks = 0; ks < 8; ++ks) qf[ks] = *(const bf16x8*)(qp + 32 * ks);
  const float Mt = sM[c * 128 + t];
  bf16_t* sp = P.St + (size_t)item * 16384 + t * 128;
#pragma unroll
  for (int sg = 0; sg < 8; sg += 4) {
    if (sg <= w) {
      bf16x8 kf[4][8];
#pragma unroll
      for (int u = 0; u < 4; ++u) {
        if (sg + u <= w) {
          const bf16_t* kp = P.Pb + (size_t)(row0 + 16 * (sg + u) + (lane & 15)) * NG1 + 1024 + h * 256 + 8 * g;
#pragma unroll
          for (int ks = 0; ks < 8; ++ks) kf[u][ks] = *(const bf16x8*)(kp + 32 * ks);
        }
      }
#pragma unroll
      for (int u = 0; u < 4; ++u) {
        const int st = sg + u;
        f32x4 acc = (f32x4){0.f, 0.f, 0.f, 0.f};
        if (st <= w) {
#pragma unroll
          for (int ks = 0; ks < 8; ++ks) acc = __builtin_amdgcn_mfma_f32_16x16x32_bf16(kf[u][ks], qf[ks], acc, 0, 0, 0);
#pragma unroll
          for (int r = 0; r < 4; ++r) { const int s2 = 16 * st + 4 * g + r; acc[r] = (s2 <= t) ? acc[r] * __expf(sA[c * 128 + s2] - Mt) : 0.f; }
        }
        *(u32x2*)(sp + 16 * st + 4 * g) = pack4(acc);
      }
    } else {
#pragma unroll
      for (int u = 0; u < 4; ++u) *(u32x2*)(sp + 16 * (sg + u) + 4 * g) = (u32x2){0u, 0u};
    }
  }
  __syncthreads();
}

__device__ __forceinline__ bf16x8 trread8(unsigned a0, unsigned a1) {
  bf16x4 lo, hi;
  asm volatile("ds_read_b64_tr_b16 %0, %2\n\tds_read_b64_tr_b16 %1, %3\n\ts_waitcnt lgkmcnt(0)" : "=&v"(lo), "=&v"(hi) : "v"(a0), "v"(a1) : "memory");
  return __builtin_shufflevector(lo, hi, 0, 1, 2, 3, 4, 5, 6, 7);
}
__device__ __forceinline__ void trread8x3(unsigned a0, unsigned a1, unsigned a2, unsigned dlt, bf16x8& r0, bf16x8& r1, bf16x8& r2) {
  bf16x4 l0, h0, l1, h1, l2, h2;
  asm volatile("ds_read_b64_tr_b16 %0, %6\n\tds_read_b64_tr_b16 %1, %7\n\tds_read_b64_tr_b16 %2, %8\n\tds_read_b64_tr_b16 %3, %9\n\tds_read_b64_tr_b16 %4, %10\n\tds_read_b64_tr_b16 %5, %11\n\ts_waitcnt lgkmcnt(0)"
               : "=&v"(l0), "=&v"(h0), "=&v"(l1), "=&v"(h1), "=&v"(l2), "=&v"(h2)
               : "v"(a0), "v"(a0 + dlt), "v"(a1), "v"(a1 + dlt), "v"(a2), "v"(a2 + dlt) : "memory");
  r0 = __builtin_shufflevector(l0, h0, 0, 1, 2, 3, 4, 5, 6, 7); r1 = __builtin_shufflevector(l1, h1, 0, 1, 2, 3, 4, 5, 6, 7); r2 = __builtin_shufflevector(l2, h2, 0, 1, 2, 3, 4, 5, 6, 7);
}
__device__ __forceinline__ void trread8x2(unsigned a0, unsigned a1, unsigned dlt, bf16x8& r0, bf16x8& r1) {
  bf16x4 l0, h0, l1, h1;
  asm volatile("ds_read_b64_tr_b16 %0, %4\n\tds_read_b64_tr_b16 %1, %5\n\tds_read_b64_tr_b16 %2, %6\n\tds_read_b64_tr_b16 %3, %7\n\ts_waitcnt lgkmcnt(0)"
               : "=&v"(l0), "=&v"(h0), "=&v"(l1), "=&v"(h1) : "v"(a0), "v"(a0 + dlt), "v"(a1), "v"(a1 + dlt) : "memory");
  r0 = __builtin_shufflevector(l0, h0, 0, 1, 2, 3, 4, 5, 6, 7); r1 = __builtin_shufflevector(l1, h1, 0, 1, 2, 3, 4, 5, 6, 7);
}

constexpr int KS_STRIDE = 272, VS_STRIDE = 56;
constexpr int M2_K = 0, M2_V = 69632, M2_CL = 83968, M2_SC = 110080;
__device__ __forceinline__ void m2_item(const Params& P, int l, int item, unsigned char* shm) {
  const int tid = tidx(), w = __builtin_amdgcn_readfirstlane(tid >> 6), lane = tid & 63, g = lane >> 4, l15 = lane & 15;
  const int bh = item >> 3, j = item & 7, b = bh >> 2, h = bh & 3;
  bf16_t* Ksh = (bf16_t*)(shm + M2_K); bf16_t* Vsh = (bf16_t*)(shm + M2_V); bf16_t* Cl = (bf16_t*)(shm + M2_CL);
  float* sA = (float*)(shm + M2_SC); float* sM = sA + 2048; float* sB = sM + 2048; float* chain = sB + 2048;
  const unsigned lbase = (unsigned)(size_t)shm;
  u32x4 kreg[8]; u32x4 vreg;
  const int vs = tid >> 2, vpc = tid & 3;
  {
    const int row0 = b * 2048;
#pragma unroll
    for (int i = 0; i < 8; ++i) { const int piece = tid + 512 * i, s = piece >> 5, pc = piece & 31; kreg[i] = *(const u32x4*)(P.Pb + (size_t)(row0 + s) * NG1 + 1024 + h * 256 + 8 * pc); }
    vreg = *(const u32x4*)(P.Pb + (size_t)(row0 + vs) * NG1 + 2048 + h * 256 + 32 * j + 8 * vpc);
  }
  bf16x8 qf[8], sf[4];
  {
    const int t = 16 * w + l15;
#pragma unroll
    for (int ks = 0; ks < 8; ++ks) qf[ks] = (bf16x8){0, 0, 0, 0, 0, 0, 0, 0};
    const bf16_t* sp0 = P.St + (size_t)(bh * 16) * 16384 + t * 128 + 8 * g;
#pragma unroll
    for (int ks = 0; ks < 4; ++ks) sf[ks] = *(const bf16x8*)(sp0 + 32 * ks);
  }
  mlstm_scalars(P.gat, b, h, sA, sM, sB, chain);
  f32x4 Cacc[2][3];
#pragma unroll
  for (int dt = 0; dt < 2; ++dt)
#pragma unroll
    for (int et = 0; et < 3; ++et) Cacc[dt][et] = (f32x4){0.f, 0.f, 0.f, 0.f};
  const int trq = l15 >> 2, trp = lane & 3;
#define M2_WRITE_KV(cc) do { \
    const float ml_ = chain[17 + (cc)]; \
    _Pragma("unroll") for (int i = 0; i < 8; ++i) { const int piece = tid + 512 * i, s = piece >> 5, pc = piece & 31; \
      const float wk = __expf(sA[(cc) * 128 + s] - ml_); u32x4 sc; \
      _Pragma("unroll") for (int e = 0; e < 4; ++e) { const unsigned u = kreg[i][e]; sc[e] = pack2(bf2f(u & 0xffffu) * wk, bf2f(u >> 16) * wk); } \
      *(u32x4*)(Ksh + s * KS_STRIDE + 8 * pc) = sc; } \
    *(u32x4*)(Vsh + vs * VS_STRIDE + 8 * vpc) = vreg; \
    if (vpc == 0) { unsigned zz = 0u; asm volatile("" : "+v"(zz)); const u32x4 z = (u32x4){zz, zz, zz, zz}; u32x4 o1 = z; o1[0] = 0x3F80u; \
      *(u32x4*)(Vsh + vs * VS_STRIDE + 32) = o1; *(u32x4*)(Vsh + vs * VS_STRIDE + 40) = z; } } while (0)
  M2_WRITE_KV(0);
  __syncthreads();
  for (int c = 0; c < 16; ++c) {
    const int row0 = b * 2048 + c * 128;
    const float mlast = chain[17 + c], mprev = chain[c];
    if (c < 15) {
      const int nrow0 = row0 + 128;
#pragma unroll
      for (int i = 0; i < 8; ++i) { const int piece = tid + 512 * i, s = piece >> 5, pc = piece & 31; kreg[i] = *(const u32x4*)(P.Pb + (size_t)(nrow0 + s) * NG1 + 1024 + h * 256 + 8 * pc); }
      vreg = *(const u32x4*)(P.Pb + (size_t)(nrow0 + vs) * NG1 + 2048 + h * 256 + 32 * j + 8 * vpc);
    }
    {
      const int t = 16 * w + l15, row = row0 + t;
      f32x4 acc[3]; acc[0] = (f32x4){0.f, 0.f, 0.f, 0.f}; acc[1] = acc[0]; acc[2] = acc[0];
      const float Mt = sM[c * 128 + t];
      if (c > 0) {
#pragma unroll
        for (int ks = 0; ks < 8; ++ks) {
          bf16x8 cf[3];
#pragma unroll
          for (int et = 0; et < 3; ++et) cf[et] = *(const bf16x8*)(Cl + (16 * et + l15) * KS_STRIDE + 32 * ks + 8 * g);
          __builtin_amdgcn_sched_barrier(0);
#pragma unroll
          for (int et = 0; et < 3; ++et) acc[et] = __builtin_amdgcn_mfma_f32_16x16x32_bf16(cf[et], qf[ks], acc[et], 0, 0, 0);
          __builtin_amdgcn_sched_barrier(0);
        }
        const float wi = __expf(mprev - Mt);
        acc[0] *= wi; acc[1] *= wi; acc[2] *= wi;
      }
      const float ac = __expf(mprev - mlast);
#pragma unroll
      for (int dt = 0; dt < 2; ++dt)
#pragma unroll
        for (int et = 0; et < 3; ++et) Cacc[dt][et] *= ac;
#pragma unroll
      for (int ks = 0; ks < 4; ++ks) {
        bf16x8 kf[2], vf[3];
        const unsigned va = lbase + M2_V + (unsigned)((32 * ks + 8 * g + trq) * VS_STRIDE + 4 * trp) * 2u;
        const unsigned ka = lbase + M2_K + (unsigned)((32 * ks + 8 * g + trq) * KS_STRIDE + 32 * w + 4 * trp) * 2u;
        trread8x3(va, va + 32u, va + 64u, 4u * VS_STRIDE * 2u, vf[0], vf[1], vf[2]);
        trread8x2(ka, ka + 32u, 4u * KS_STRIDE * 2u, kf[0], kf[1]);
#pragma unroll
        for (int et = 0; et < 3; ++et) acc[et] = __builtin_amdgcn_mfma_f32_16x16x32_bf16(vf[et], sf[ks], acc[et], 0, 0, 0);
#pragma unroll
        for (int dt = 0; dt < 2; ++dt)
#pragma unroll
          for (int et = 0; et < 3; ++et) Cacc[dt][et] = __builtin_amdgcn_mfma_f32_16x16x32_bf16(kf[dt], vf[et], Cacc[dt][et], 0, 0, 0);
      }
      if (c < 15) {
        const bf16_t* qp = P.Pb + (size_t)(row + 128) * NG1 + h * 256 + 8 * g;
#pragma unroll
        for (int ks = 0; ks < 8; ++ks) qf[ks] = *(const bf16x8*)(qp + 32 * ks);
        const bf16_t* sp = P.St + (size_t)(bh * 16 + c + 1) * 16384 + t * 128 + 8 * g;
#pragma unroll
        for (int ks = 0; ks < 4; ++ks) sf[ks] = *(const bf16x8*)(sp + 32 * ks);
      }
      const float den = __shfl(acc[2][0], l15);
      const float dd = fmaxf(fabsf(den), __expf(-(sB[c * 128 + t] + Mt)));
      const float inv = __builtin_amdgcn_rcpf(dd);
      const f32x4 o0 = acc[0] * inv, o1 = acc[1] * inv;
      bf16_t* hp = P.hA + (size_t)row * DM + h * 256 + 32 * j + 4 * g;
      *(u32x2*)hp = pack4(o0); *(u32x2*)(hp + 16) = pack4(o1);
      float ss = (o0[0] * o0[0] + o0[1] * o0[1]) + (o0[2] * o0[2] + o0[3] * o0[3]) + (o1[0] * o1[0] + o1[1] * o1[1]) + (o1[2] * o1[2] + o1[3] * o1[3]);
      ss += __shfl_xor(ss, 16); ss += __shfl_xor(ss, 32);
      if (g == 0) P.hss[(size_t)row * 32 + h * 8 + j] = ss;
    }
    LDS_BARRIER();
#pragma unroll
    for (int dt = 0; dt < 2; ++dt)
#pragma unroll
      for (int et = 0; et < 3; ++et) *(u32x2*)(Cl + (16 * et + l15) * KS_STRIDE + 32 * w + 16 * dt + 4 * g) = pack4(Cacc[dt][et]);
    if (c < 15) M2_WRITE_KV(c + 1);
    LDS_BARRIER();
  }
#undef M2_WRITE_KV
  const size_t sidx = (size_t)(l * 8 + b) * 4 + h;
#pragma unroll
  for (int dt = 0; dt < 2; ++dt)
#pragma unroll
    for (int r = 0; r < 4; ++r) {
      const int d = 32 * w + 16 * dt + 4 * g + r;
      P.out[O_CP + sidx * 65536 + (size_t)d * 256 + 32 * j + l15] = Cacc[dt][0][r];
      P.out[O_CP + sidx * 65536 + (size_t)d * 256 + 32 * j + 16 + l15] = Cacc[dt][1][r];
      if (j == 0 && l15 == 0) P.out[O_NP + sidx * 256 + d] = Cacc[dt][2][r];
    }
  if (j == 0 && tid == 0) P.out[O_MP + sidx] = chain[16];
  __syncthreads();
}

__device__ __forceinline__ void msample_item(const Params& P, int l, int item, unsigned char* shm) {
  const int tid = tidx(), w = tid >> 6, lane = tid & 63;
  const int b = item >> 2, h = item & 3, row = NP + b;
  float* q = (float*)shm; float* k = q + 256; float* v = k + 256; float* red = v + 256; float* red2 = red + 2048;
  if (tid < 256) {
    const bf16_t* pr = P.Pb + (size_t)row * NG1 + h * 256 + tid;
    q[tid] = bf2f(pr[0]); k[tid] = bf2f(pr[1024]); v[tid] = bf2f(pr[2048]);
  }
  const float ig = P.gat[(size_t)row * 8 + h], lf = P.gat[(size_t)row * 8 + 4 + h];
  const size_t sidx = (size_t)(l * 128 + b) * 4 + h;
  const float m0 = P.st_m[sidx];
  const float inter = lf + m0, mt = fmaxf(inter, ig), wi = __expf(inter - mt), wa = __expf(ig - mt);
  __syncthreads();
  const float* C0 = P.st_C + sidx * 65536; float* Co = P.out + O_CS + sidx * 65536;
  const float* n0 = P.st_n + sidx * 256;
  const f32x4 v4 = *(const f32x4*)(v + 4 * lane);
  f32x4 acc = (f32x4){0.f, 0.f, 0.f, 0.f};
#pragma unroll 8
  for (int dd = 0; dd < 32; ++dd) {
    const int d = 32 * w + dd;
    const f32x4 c4 = __builtin_nontemporal_load((const f32x4*)(C0 + (size_t)d * 256 + 4 * lane));
    const float kd = wa * k[d], qd = q[d];
    __builtin_nontemporal_store(c4 * wi + v4 * kd, (f32x4*)(Co + (size_t)d * 256 + 4 * lane));
    acc += c4 * qd;
  }
  *(f32x4*)(red + w * 256 + 4 * lane) = acc;
  float qk = 0.f, qn = 0.f;
#pragma unroll
  for (int i = 0; i < 4; ++i) { const int d = lane + 64 * i; qk += q[d] * k[d]; qn += q[d] * n0[d]; }
  qk = wave_sum(qk); qn = wave_sum(qn);
  __syncthreads();
  const float s = qk * wa, den = wi * qn + s, ddn = fmaxf(fabsf(den), __expf(-mt));
  float hval = 0.f;
  if (tid < 256) {
    float num = 0.f;
#pragma unroll
    for (int i = 0; i < 8; ++i) num += red[i * 256 + tid];
    hval = (wi * num + s * v[tid]) / ddn;
    P.hA[(size_t)row * DM + h * 256 + tid] = f2bf(hval);
    P.out[O_NS + sidx * 256 + tid] = wi * n0[tid] + wa * k[tid];
  }
  float ss = wave_sum(hval * hval);
  if (lane == 0) red2[w] = ss;
  __syncthreads();
  if (tid < 8) P.hss[(size_t)row * 32 + h * 8 + tid] = tid == 0 ? (red2[0] + red2[1] + red2[2] + red2[3]) : 0.f;
  if (tid == 0) P.out[O_MS + sidx] = mt;
  __syncthreads();
}

__device__ __forceinline__ void s5_load_C(const Params& P, int l, int g, float* Csh) {
  for (int i = tidx(); i < 2048; i += 512) { const int ri = i >> 10, c = (i >> 6) & 15, p = i & 63;
    Csh[ri * 1088 + c * 68 + p] = (ri ? P.C_im : P.C_re)[(size_t)l * 32768 + (g * 16 + c) * 64 + p]; }
}
__device__ __forceinline__ void s5_sample_item(const Params& P, int l, int item, unsigned char* shm) {
  const int tid = tidx(), w = tid >> 6, lane = tid & 63;
  const int g = item & 31, bs0 = (item >> 5) * 16 + 2 * w;
  float* Csh = (float*)shm; float* sbuf = Csh + 2176 + w * 2176;
  s5_load_C(P, l, g, Csh);
  const float are = P.abar[l][g * 64 + lane], aim = P.abar[l][2048 + g * 64 + lane];
  float bre[16], bim[16];
#pragma unroll
  for (int c = 0; c < 16; ++c) { bre[c] = P.bbar[l][(g * 16 + c) * 64 + lane]; bim[c] = P.bbar[l][32768 + (g * 16 + c) * 64 + lane]; }
  const int ch = lane >> 2, pq = lane & 3;
  const float Dc = P.D_skip[l * 512 + g * 16 + ch];
  __syncthreads();
#pragma unroll
  for (int rep = 0; rep < 2; ++rep) {
    const int bs = bs0 + rep, row = NP + bs;
    const size_t o = ((size_t)(l * 128 + bs) * 32 + g) * 64 + lane;
    const float s0r = P.st_sre[o], s0i = P.st_sim[o];
    const bf16_t* up = P.Pb + (size_t)row * NG1 + 4096 + g * 16;
    const u32x4 u0 = *(const u32x4*)up, u1 = *(const u32x4*)(up + 8);
    float br = 0.f, bi = 0.f;
#pragma unroll
    for (int i = 0; i < 4; ++i) {
      const float ua = bf2f(u0[i] & 0xffffu), ub = bf2f(u0[i] >> 16), uc = bf2f(u1[i] & 0xffffu), ud = bf2f(u1[i] >> 16);
      br += bre[2 * i] * ua + bre[2 * i + 1] * ub + bre[8 + 2 * i] * uc + bre[8 + 2 * i + 1] * ud;
      bi += bim[2 * i] * ua + bim[2 * i + 1] * ub + bim[8 + 2 * i] * uc + bim[8 + 2 * i + 1] * ud;
    }
    const float sr = are * s0r - aim * s0i + br, si = are * s0i + aim * s0r + bi;
    P.out[O_SRS + o] = sr; P.out[O_SIS + o] = si;
    sbuf[rep * 136 + lane] = sr; sbuf[rep * 136 + 68 + lane] = si;
    asm volatile("s_waitcnt lgkmcnt(0)" ::: "memory");
    float acc = 0.f;
#pragma unroll
    for (int p4 = 0; p4 < 4; ++p4) {
      const int p0 = 16 * pq + 4 * p4;
      const f32x4 vr = *(const f32x4*)(sbuf + rep * 136 + p0), vi = *(const f32x4*)(sbuf + rep * 136 + 68 + p0);
      const f32x4 cr = *(const f32x4*)(Csh + ch * 68 + p0), ci = *(const f32x4*)(Csh + 1088 + ch * 68 + p0);
      acc += (cr[0] * vr[0] + cr[1] * vr[1]) + (cr[2] * vr[2] + cr[3] * vr[3]) - (ci[0] * vi[0] + ci[1] * vi[1]) - (ci[2] * vi[2] + ci[3] * vi[3]);
    }
    acc += __shfl_xor(acc, 1); acc += __shfl_xor(acc, 2);
    if (pq == 0) {
      const float uc = bf2f(up[ch]);
      P.ysb[(size_t)row * 512 + g * 16 + ch] = f2bf(gelu_tanh(acc + Dc * uc));
    }
  }
  __syncthreads();
}

__device__ __forceinline__ void prep_s5tables(const Params& P, int item, unsigned char* shm) {
  const int tid = tidx(), l = item >> 5, g = item & 31;
  float* pwr = (float*)shm; float* pwi = pwr + 17 * 64; float* bbr = pwi + 17 * 64; float* bbi = bbr + 1024; float* Ccr = bbi + 1024; float* Cci = Ccr + 1024;
  if (tid < 64) {
    const int p = tid, gp = g * 64 + p;
    const float dt = expf(P.log_dt[l * 32 + g]);
    const float Ar = P.A_re[l * 2048 + gp], Ai = P.A_im[l * 2048 + gp];
    const float mag = expf(dt * Ar);
    float sn, cs; sincosf(dt * Ai, &sn, &cs);
    const float abr = mag * cs, abi = mag * sn;
    const float den = Ar * Ar + Ai * Ai, nr = abr - 1.0f, ni = abi;
    const float fre = (nr * Ar + ni * Ai) / den, fim = (ni * Ar - nr * Ai) / den;
    float pr = 1.f, pi = 0.f;
    for (int t = 0; t <= 16; ++t) { pwr[t * 64 + p] = pr; pwi[t * 64 + p] = pi; const float a = pr * abr - pi * abi, b = pr * abi + pi * abr; pr = a; pi = b; }
    for (int c = 0; c < 16; ++c) {
      const float Br = P.B_re[(size_t)l * 32768 + gp * 16 + c], Bi = P.B_im[(size_t)l * 32768 + gp * 16 + c];
      bbr[p * 16 + c] = fre * Br - fim * Bi; bbi[p * 16 + c] = fre * Bi + fim * Br;
    }
  }
  for (int i = tid; i < 1024; i += 512) { Ccr[i] = P.C_re[(size_t)l * 32768 + g * 1024 + i]; Cci[i] = P.C_im[(size_t)l * 32768 + g * 1024 + i]; }
  __syncthreads();
  bf16_t* Kt = P.Kt[l] + (size_t)g * 17 * 256; bf16_t* Gm = P.Gm[l] + (size_t)g * 32768; bf16_t* Hm = P.Hm[l] + (size_t)g * 32768;
  for (int o = tid; o < 17 * 256; o += 512) {
    const int tau = o >> 8, c = (o >> 4) & 15, c2 = o & 15;
    float acc = 0.f;
    if (tau < 16) for (int p = 0; p < 64; ++p) {
      const float pr = pwr[tau * 64 + p], pi = pwi[tau * 64 + p], br = bbr[p * 16 + c2], bi = bbi[p * 16 + c2];
      const float zr = pr * br - pi * bi, zi = pr * bi + pi * br;
      acc += Ccr[c * 64 + p] * zr - Cci[c * 64 + p] * zi;
    }
    Kt[o] = f2bf(acc);
  }
  for (int o = tid; o < 32768; o += 512) {
    { const int tc = o >> 7, q = o & 127, t = tc >> 4, c = tc & 15, p = q & 63;
      const float cr = Ccr[c * 64 + p], ci = Cci[c * 64 + p], pr = pwr[(t + 1) * 64 + p], pi = pwi[(t + 1) * 64 + p];
      Gm[o] = f2bf(q < 64 ? (cr * pr - ci * pi) : -(cr * pi + ci * pr)); }
    { const int q = o >> 8, jc = o & 255, j = jc >> 4, c2 = jc & 15, p = q & 63;
      const float pr = pwr[(15 - j) * 64 + p], pi = pwi[(15 - j) * 64 + p], br = bbr[p * 16 + c2], bi = bbi[p * 16 + c2];
      Hm[o] = f2bf(q < 64 ? (pr * br - pi * bi) : (pr * bi + pi * br)); }
  }
  if (tid < 64) { P.a16[l][g * 64 + tid] = pwr[16 * 64 + tid]; P.a16[l][2048 + g * 64 + tid] = pwi[16 * 64 + tid]; }
  __syncthreads();
}
constexpr int S3_R0 = 0, S3_SIN = 69632, S3_KT = 69632 + 34816;
__device__ __forceinline__ void s5_stage3_item(const Params& P, int l, int item, unsigned char* shm) {
  const int tid = tidx(), w = tid >> 6, lane = tid & 63, g4 = lane >> 4, l15 = lane & 15;
  const int b = item >> 5, g = item & 31;
  float* Ebuf = (float*)(shm + S3_R0); bf16_t* Gsh = (bf16_t*)(shm + S3_R0); bf16_t* Sin = (bf16_t*)(shm + S3_SIN); bf16_t* Ksh = (bf16_t*)(shm + S3_KT);
  { bf16_t* Hsh = (bf16_t*)(shm + S3_R0); const bf16_t* Hm = P.Hm[l] + (size_t)g * 32768;
#pragma unroll
    for (int i = 0; i < 8; ++i) { const int piece = tid + 512 * i, r = piece >> 5, pc = piece & 31; *(u32x4*)(Hsh + r * 264 + 8 * pc) = *(const u32x4*)(Hm + r * 256 + 8 * pc); } }
  { const bf16_t* Kt = P.Kt[l] + (size_t)g * 17 * 256; for (int i = tid; i < 544; i += 512) *(u32x4*)(Ksh + 8 * i) = *(const u32x4*)(Kt + 8 * i); }
  const int n = 16 * w + l15, r0 = b * 2048 + n * 16;
  bf16x8 uf[8];
#pragma unroll
  for (int ks = 0; ks < 8; ++ks) uf[ks] = *(const bf16x8*)(P.Pb + (size_t)(r0 + 2 * ks + (g4 >> 1)) * NG1 + 4096 + g * 16 + 8 * (g4 & 1));
  __syncthreads();
  {
    const bf16_t* Hsh = (const bf16_t*)(shm + S3_R0);
    f32x4 eacc[8];
#pragma unroll
    for (int qt = 0; qt < 8; ++qt) {
      eacc[qt] = (f32x4){0.f, 0.f, 0.f, 0.f};
#pragma unroll
      for (int ks = 0; ks < 8; ++ks) { const bf16x8 x = *(const bf16x8*)(Hsh + (16 * qt + l15) * 264 + 32 * ks + 8 * g4); eacc[qt] = __builtin_amdgcn_mfma_f32_16x16x32_bf16(x, uf[ks], eacc[qt], 0, 0, 0); }
    }
    __syncthreads();
#pragma unroll
    for (int qt = 0; qt < 8; ++qt) *(f32x4*)(Ebuf + n * 128 + 16 * qt + 4 * g4) = eacc[qt];
  }
  __syncthreads();
  {
    const float ar = P.a16[l][g * 64 + lane], ai = P.a16[l][2048 + g * 64 + lane];
    float lr[16], li[16], sr = 0.f, si = 0.f;
#pragma unroll
    for (int k = 0; k < 16; ++k) {
      lr[k] = sr; li[k] = si;
      const float er = Ebuf[(16 * w + k) * 128 + lane], ei = Ebuf[(16 * w + k) * 128 + 64 + lane];
      const float nr = ar * sr - ai * si + er, ni = ar * si + ai * sr + ei; sr = nr; si = ni;
    }
    float* wend = (float*)(shm + S3_KT + 8704);
    wend[w * 128 + lane] = sr; wend[w * 128 + 64 + lane] = si;
    float br = ar, bi = ai;
#pragma unroll
    for (int i = 0; i < 4; ++i) { const float nr = br * br - bi * bi, ni = 2.f * br * bi; br = nr; bi = ni; }
    __syncthreads();
    float cr = 0.f, ci = 0.f;
    for (int w2 = 0; w2 < w; ++w2) { const float er = wend[w2 * 128 + lane], ei = wend[w2 * 128 + 64 + lane]; const float nr = br * cr - bi * ci + er, ni = br * ci + bi * cr + ei; cr = nr; ci = ni; }
    float pr = 1.f, pi = 0.f;
#pragma unroll
    for (int k = 0; k < 16; ++k) {
      Sin[(16 * w + k) * 136 + lane] = f2bf(lr[k] + pr * cr - pi * ci); Sin[(16 * w + k) * 136 + 64 + lane] = f2bf(li[k] + pr * ci + pi * cr);
      const float nr = pr * ar - pi * ai, ni = pr * ai + pi * ar; pr = nr; pi = ni;
    }
    if (w == 7) { const size_t o = ((size_t)(l * 8 + b) * 32 + g) * 64 + lane; P.out[O_SRP + o] = sr + pr * cr - pi * ci; P.out[O_SIP + o] = si + pr * ci + pi * cr; }
  }
  __syncthreads();
  { const bf16_t* Gm = P.Gm[l] + (size_t)g * 32768;
#pragma unroll
    for (int i = 0; i < 8; ++i) { const int piece = tid + 512 * i, r = piece >> 4, pc = piece & 15; *(u32x4*)(Gsh + r * 136 + 8 * pc) = *(const u32x4*)(Gm + r * 128 + 8 * pc); } }
  __syncthreads();
  bf16x8 sf[4];
#pragma unroll
  for (int k2 = 0; k2 < 4; ++k2) sf[k2] = *(const bf16x8*)(Sin + n * 136 + 32 * k2 + 8 * g4);
  const f32x4 D4 = *(const f32x4*)(P.D_skip + l * 512 + g * 16 + 4 * g4);
#pragma unroll
  for (int t = 0; t < 16; ++t) {
    f32x4 acc = (f32x4){0.f, 0.f, 0.f, 0.f};
    const int row = r0 + t;
    const f32x4 u4 = unpack4(*(const u32x2*)(P.Pb + (size_t)row * NG1 + 4096 + g * 16 + 4 * g4));
#pragma unroll
    for (int ks = 0; ks <= (t >> 1); ++ks) {
      const int tau = t - (2 * ks + (g4 >> 1)), idx = tau >= 0 ? tau : 16;
      const bf16x8 x = *(const bf16x8*)(Ksh + (idx * 16 + l15) * 16 + 8 * (g4 & 1));
      acc = __builtin_amdgcn_mfma_f32_16x16x32_bf16(x, uf[ks], acc, 0, 0, 0);
    }
#pragma unroll
    for (int k2 = 0; k2 < 4; ++k2) { const bf16x8 x = *(const bf16x8*)(Gsh + (t * 16 + l15) * 136 + 32 * k2 + 8 * g4); acc = __builtin_amdgcn_mfma_f32_16x16x32_bf16(x, sf[k2], acc, 0, 0, 0); }
    f32x4 y;
#pragma unroll
    for (int r = 0; r < 4; ++r) y[r] = gelu_tanh(acc[r] + D4[r] * u4[r]);
    *(u32x2*)(P.ysb + (size_t)row * 512 + g * 16 + 4 * g4) = pack4(y);
  }
  __syncthreads();
}

__device__ __forceinline__ void headnorm_rows(const Params& P, int l, int bid, int G) {
  const int w = tidx() >> 6, lane = tidx() & 63;
  constexpr int R1 = 6400;
  const bool split = (G == 256);
  const int rbeg = split ? (bid < 128 ? bid * 8 + w : R1 + (bid - 128) * 8 + w) : bid * 8 + w;
  const int rend = split ? (bid < 128 ? R1 : NT) : NT, rstep = split ? 128 * 8 : G * 8;
  for (int row = rbeg; row < rend; row += rstep) {
    if (lane == 0) { P.ssA[row] = 0ull; P.ssB[row] = 0ull; }
#pragma unroll
    for (int h = 0; h < 4; ++h) {
      const f32x4 s0 = *(const f32x4*)(P.hss + (size_t)row * 32 + h * 8), s1 = *(const f32x4*)(P.hss + (size_t)row * 32 + h * 8 + 4);
      const float ss = (s0[0] + s0[1]) + (s0[2] + s0[3]) + (s1[0] + s1[1]) + (s1[2] + s1[3]);
      const float rh = rsqrtf(ss * (1.0f / 256.0f) + 1e-6f);
      const int col = h * 256 + 4 * lane;
      const f32x4 hv = unpack4(*(const u32x2*)(P.hA + (size_t)row * DM + col));
      const f32x4 so = unpack4(*(const u32x2*)(P.Pb + (size_t)row * NG1 + 3072 + col));
      const f32x4 gh = *(const f32x4*)(P.g_hn + l * 1024 + col);
      *(u32x2*)(P.xa + (size_t)row * DM + col) = pack4(so * hv * gh * rh);
    }
  }
}
__device__ __forceinline__ void final_rows(const Params& P, int bid, int G) {
  const int w = tidx() >> 6, lane = tidx() & 63;
  for (int row = bid * 8 + w; row < NT; row += G * 8) {
    const float rs = rs_of(P.ssA[row]);
    float* o = row < NP ? P.out + O_YP + (size_t)row * DM : P.out + O_YS + (size_t)(row - NP) * DM;
#pragma unroll
    for (int i = 0; i < 4; ++i) {
      const int col = 256 * i + 4 * lane;
      const f32x4 v = *(const f32x4*)(P.X2 + (size_t)row * DM + col);
      const f32x4 gf = *(const f32x4*)(P.g_final + col);
      *(f32x4*)(o + col) = v * gf * rs;
    }
  }
}


#define XB_TMO      128
#define XB_XCNT(j)  (256  + 64 * (j))
#define XB_XSUB(j)  (1280 + 64 * (j))
#define XB_XGEN(j)  (2304 + 64 * (j))
#define XB_TOP      3328
#define XB_TOPGEN   3392
#define XCD_BAR_WORDS 3456
#define XB_SPIN_CAP (1u << 22)
__device__ __forceinline__ unsigned xb_ld(unsigned* p)              { return __hip_atomic_load(p, __ATOMIC_RELAXED, __HIP_MEMORY_SCOPE_AGENT); }
__device__ __forceinline__ unsigned xb_add(unsigned* p, unsigned v) { return __hip_atomic_fetch_add(p, v, __ATOMIC_RELAXED, __HIP_MEMORY_SCOPE_AGENT); }
__device__ __forceinline__ unsigned xb_xcc_id() { return (unsigned)__builtin_amdgcn_s_getreg((3 << 11) | 20) & 0xFu; }
#define XB_SPIN(cond, bar) do { unsigned _sp = 0; while (cond) { __builtin_amdgcn_s_sleep(1); \
    if ((++_sp & 255u) == 0u) { if (xb_ld(&(bar)[XB_TMO])) break; if (_sp > XB_SPIN_CAP) { atomicAdd(&(bar)[XB_TMO], 1u); break; } } } } while (0)
struct XcdBarrier { unsigned* bar; unsigned x; volatile LAS unsigned* st; };
__device__ __forceinline__ XcdBarrier xcd_barrier_post(unsigned* bar, volatile LAS unsigned* st) {
  XcdBarrier b; b.bar = bar; b.x = xb_xcc_id(); b.st = st;
  if (threadIdx.x == 0) (void)xb_add(&bar[XB_XCNT(b.x)], 1u);
  return b;
}
__device__ __forceinline__ void xcd_barrier_complete(unsigned* bar, unsigned x, unsigned& nloc, unsigned& nx) {
  const unsigned G = gridDim.x * gridDim.y * gridDim.z;
  unsigned sum, cnt, mine, sp = 0u;
  for (;;) {
    sum = 0u; cnt = 0u; mine = 0u;
#pragma unroll
    for (unsigned j = 0; j < 16; ++j) { const unsigned c = xb_ld(&bar[XB_XCNT(j)]); sum += c; cnt += (c > 0u) ? 1u : 0u; mine = (j == x) ? c : mine; }
    if (sum == G) break;
    __builtin_amdgcn_s_sleep(1);
    if ((++sp & 255u) == 0u) { if (xb_ld(&bar[XB_TMO])) break; if (sp > XB_SPIN_CAP) { atomicAdd(&bar[XB_TMO], 1u); break; } }
  }
  nloc = mine > 0u ? mine : 1u; nx = cnt > 0u ? cnt : 1u;
}
__device__ __forceinline__ void xcd_barrier(const XcdBarrier& b) {
  asm volatile("s_waitcnt vmcnt(0)" ::: "memory");
  __syncthreads();
  if (threadIdx.x == 0) {
    unsigned* bar = b.bar;
    __builtin_amdgcn_s_waitcnt(0);
    unsigned nloc = b.st[0], nx = b.st[1];
    if (nloc == 0u) { xcd_barrier_complete(bar, b.x, nloc, nx); b.st[0] = nloc; b.st[1] = nx; }
    const unsigned old = xb_add(&bar[XB_XSUB(b.x)], 1u);
    const unsigned gen = old / nloc;
    if (old + 1u == (gen + 1u) * nloc) {
      __builtin_amdgcn_fence(__ATOMIC_RELEASE, "agent");
      asm volatile("s_waitcnt vmcnt(0)" ::: "memory");
      const unsigned og = xb_add(&bar[XB_TOP], 1u);
      const unsigned tg = og / nx;
      if (og + 1u == (tg + 1u) * nx) xb_add(&bar[XB_TOPGEN], 1u);
      else XB_SPIN(xb_ld(&bar[XB_TOPGEN]) == tg, bar);
      __builtin_amdgcn_fence(__ATOMIC_ACQUIRE, "agent");
      xb_add(&bar[XB_XGEN(b.x)], 1u);
      asm volatile("s_waitcnt vmcnt(0)" ::: "memory");
    } else {
      XB_SPIN(xb_ld(&bar[XB_XGEN(b.x)]) == gen, bar);
      __builtin_amdgcn_fence(__ATOMIC_ACQUIRE, "agent");
      asm volatile("s_waitcnt vmcnt(0)" ::: "memory");
    }
  }
  __syncthreads();
}

__global__ void __launch_bounds__(512) mega(const Params P) {
  extern __shared__ __attribute__((aligned(16))) unsigned char shm[];
  cg::grid_group grid = cg::this_grid();
  LAS unsigned char* lds = (LAS unsigned char*)shm;
  const int bid = blockIdx.x, G = gridDim.x;

  volatile LAS unsigned* xst = (volatile LAS unsigned*)(lds + LDS_BYTES - 16);
  if (threadIdx.x == 0) { xst[0] = 0u; xst[1] = 0u; }
  if (bid == 0) for (int i = threadIdx.x; i < XCD_BAR_WORDS; i += 512) P.bar[i] = 0u;
  REP(1) prep_phase(P, shm, bid, G);
  grid.sync();
  const XcdBarrier xb = xcd_barrier_post(P.bar, xst);

  for (int l = 0; l < 2; ++l) {
    REP(2) {
      F1 f; f.bias = P.b_in + l * PTOT; f.Pb = P.Pb; f.rs = P.ssA; f.ss = nullptr;
      gemm_main_window(lds, P.xb, P.WinT[l], 4096, 1024, f, 0, bid, G);
      gemm_main_window(lds, P.xb, P.WinT[l] + (size_t)4608 * 1024, 2048, 1024, f, 4608, bid, G);
      skinny_run(f, P.xb, 1024, P.WinT[l], NP, 1, NG1 / 16, bid, G, shm, 0);
      Fg fg; fg.bias = P.b_in + l * PTOT + 4096; fg.gat = P.gat; fg.rs = P.ssA; fg.ss = nullptr;
      REP(256) skinny_run(fg, P.xb, 1024, P.WgT[l], 0, 129, 1, bid, G, shm, 0);
    }
    xcd_barrier(xb);
    { F1 f; f.bias = P.b_in + l * PTOT; f.Pb = P.Pb; f.rs = P.ssA; f.ss = nullptr;
      gemm_main_window(lds, P.xb, P.WinT[l] + (size_t)4096 * 1024, 512, 1024, f, 4096, bid, G); }
    {
      const int n1 = G == 256 ? (bid < 128 ? 1 : 3) : (512 - bid + G - 1) / G;
      for (int j = 0; j < n1; ++j) m1_item(P, G == 256 ? (bid < 128 ? bid : 128 + (bid - 128) * 3 + j) : bid + j * G, shm);
      for (int it = bid; it < 512; it += G) msample_item(P, l, it, shm);
      for (int it = bid; it < 256; it += G) s5_sample_item(P, l, it, shm);
    }
    xcd_barrier(xb);
    REP(8) for (int it = bid; it < 256; it += G) m2_item(P, l, G == 256 ? (((it & 7) * 4 + (it >> 6)) * 8 + ((it >> 3) & 7)) : it, shm);
    REP(16) for (int it = bid; it < 256; it += G) s5_stage3_item(P, l, G == 256 ? ((it & 7) * 32 + (it >> 3)) : it, shm);
    xcd_barrier(xb);
    REP(32) {
      Fglu f; f.bias = P.b_glu + l * 512; f.ysb = P.ysb; f.ys2 = P.ys2; f.ss = nullptr;
      gemm_all(lds, shm, P.ysb, P.WgluT[l], 512, 512, f, bid, G);
      headnorm_rows(P, l, bid, G);
    }
    xcd_barrier(xb);
    REP(32) {
      Fa fa; fa.Pb = P.Pb; fa.t1 = P.t1; fa.ss = nullptr;
      gemm_all(lds, shm, P.xa, P.WaT[l], 1024, 1024, fa, bid, G);
      Fb fb; fb.Pb = P.Pb; fb.t1 = P.t1; fb.mg = P.mg; fb.ss = nullptr;
      gemm_all(lds, shm, P.ys2, P.WbT[l], 1024, 512, fb, bid, G);
    }
    xcd_barrier(xb);
    REP(32) {
      Fres f; f.xinP = l == 0 ? P.x_prompt : P.X2; f.xinS = l == 0 ? P.x_sample : P.X2 + (size_t)NP * DM; f.xo = P.X1; f.xb = P.xb; f.ss = P.ssB;
      gemm_all(lds, shm, P.mg, P.WoT[l], 1024, 1024, f, bid, G);
    }
    xcd_barrier(xb);
    REP(64) {
      F13 f; f.rs = P.ssB; f.act = P.act;
      pg8::Gemm g; g.A = P.xb; g.Bt = P.W13T[l]; g.M = NP; g.N = 2 * DFF; g.K = 1024;
      pg8::StaticOrder S; S.init(NP, 2 * DFF, G, bid);
      EpiMain13 E; E.f = f;
      REP(512) pg8::gemm_phase(lds, g, S, E);
      REP(256) skinny_run13(f, P.xb, P.W13T[l], bid, G, shm);
    }
    xcd_barrier(xb);
    REP(64) {
      Fres f; f.xinP = P.X1; f.xinS = P.X1 + (size_t)NP * DM; f.xo = P.X2; f.xb = P.xb; f.ss = P.ssA;
      gemm_all(lds, shm, P.act, P.W2T[l], 1024, DFF, f, bid, G);
    }
    xcd_barrier(xb);
  }
  final_rows(P, bid, G);
}

extern "C" void kernel_launch(void* const* d_in, const int* in_sizes, int n_in, void* d_out, int out_size, void* d_ws, size_t ws_size, hipStream_t stream) {
  constexpr size_t kDynLds = LDS_BYTES;
  static int grid_blocks = 0;
  if (!grid_blocks) {
    int dev = 0, cus = 0, per_cu = 0;
    (void)hipGetDevice(&dev);
    (void)hipDeviceGetAttribute(&cus, hipDeviceAttributeMultiprocessorCount, dev);
    (void)hipFuncSetAttribute((const void*)mega, hipFuncAttributeMaxDynamicSharedMemorySize, (int)kDynLds);
    (void)hipOccupancyMaxActiveBlocksPerMultiprocessor(&per_cu, mega, 512, kDynLds);
    if (per_cu > 1) per_cu = 1;
    grid_blocks = cus * per_cu;
    if (grid_blocks > 256) grid_blocks = 256;
  }
  Params p;
  memset(&p, 0, sizeof(p));
  const float* const* in = (const float* const*)d_in;
  p.x_prompt = in[0]; p.x_sample = in[1]; p.st_C = in[2]; p.st_n = in[3]; p.st_m = in[4]; p.st_sre = in[5]; p.st_sim = in[6];
  p.g_mix = in[7]; p.w_in = in[8]; p.b_in = in[9]; p.g_hn = in[10]; p.w_a = in[11]; p.A_re = in[12]; p.A_im = in[13]; p.log_dt = in[14];
  p.B_re = in[15]; p.B_im = in[16]; p.C_re = in[17]; p.C_im = in[18]; p.D_skip = in[19]; p.w_glu = in[20]; p.b_glu = in[21]; p.w_b = in[22]; p.w_out = in[23];
  p.g_ffn = in[24]; p.w_ff1 = in[25]; p.w_ff3 = in[26]; p.w_ff2 = in[27]; p.g_final = in[28];
  p.out = (float*)d_out;
  char* base = (char*)d_ws; size_t off = 0;
  auto alloc = [&](size_t bytes) { char* r = base + off; off += (bytes + 255) & ~(size_t)255; return r; };
  for (int l = 0; l < 2; ++l) {
    p.WinT[l] = (bf16_t*)alloc((size_t)NG1 * 1024 * 2); p.WgT[l] = (bf16_t*)alloc(16 * 1024 * 2); p.WgluT[l] = (bf16_t*)alloc(512 * 512 * 2);
    p.WaT[l] = (bf16_t*)alloc(1024 * 1024 * 2); p.WbT[l] = (bf16_t*)alloc(1024 * 512 * 2); p.WoT[l] = (bf16_t*)alloc(1024 * 1024 * 2);
    p.W13T[l] = (bf16_t*)alloc((size_t)2 * DFF * 1024 * 2); p.W2T[l] = (bf16_t*)alloc((size_t)1024 * DFF * 2);
    p.abar[l] = (float*)alloc(4096 * 4); p.bbar[l] = (float*)alloc(65536 * 4);
  }
  p.xb = (bf16_t*)alloc((size_t)NT * DM * 2); p.Pb = (bf16_t*)alloc((size_t)NT * NG1 * 2); p.St = (bf16_t*)alloc((size_t)512 * 16384 * 2);
  p.ysb = (bf16_t*)alloc((size_t)NT * 512 * 2); p.ys2 = (bf16_t*)alloc((size_t)NT * 512 * 2); p.xa = (bf16_t*)alloc((size_t)NT * DM * 2);
  p.mg = (bf16_t*)alloc((size_t)NT * DM * 2); p.act = (bf16_t*)alloc((size_t)NT * DFF * 2);
  p.X1 = (float*)alloc((size_t)NT * DM * 4); p.X2 = (float*)alloc((size_t)NT * DM * 4);
  p.ssA = (unsigned long long*)alloc((size_t)NT * 8); p.ssB = (unsigned long long*)alloc((size_t)NT * 8); p.bar = (unsigned*)alloc(XCD_BAR_WORDS * 4);
  for (int l = 0; l < 2; ++l) { p.Kt[l] = (bf16_t*)alloc(32 * 17 * 256 * 2); p.Gm[l] = (bf16_t*)alloc(32 * 32768 * 2); p.Hm[l] = (bf16_t*)alloc(32 * 32768 * 2); p.a16[l] = (float*)alloc(4096 * 4); }
  p.E2 = (float*)alloc((size_t)8 * 128 * 32 * 128 * 4);
  p.gat = (float*)alloc((size_t)NT * 8 * 4); p.hA = (bf16_t*)alloc((size_t)NT * DM * 2); p.hss = (float*)alloc((size_t)NT * 32 * 4);
  p.t1 = (bf16_t*)alloc((size_t)NT * DM * 2); p.Eend = (float*)alloc((size_t)2 * 524288 * 4);
  int nj = 0, tile0 = 0;
  auto job = [&](const float* src, const float* scale, bf16_t* dst, int ldn, int c0, int ncols, int K, int mode, int r0, int nwrite) {
    TJob& J = p.jobs[nj++]; J.src = src; J.scale = scale; J.dst = dst; J.ldn = ldn; J.c0 = c0; J.ncols = ncols; J.K = K; J.mode = mode; J.r0 = r0;
    J.tile0 = tile0; J.ntn = (ncols + 63) / 64; J.nwrite = nwrite; J.pad = 0; tile0 += J.ntn * (K / 64);
  };
  for (int l = 0; l < 2; ++l) {
    const float* win = p.w_in + (size_t)l * 1024 * PTOT; const float* gm = p.g_mix + l * 1024; const float* gf = p.g_ffn + l * 1024;
    job(win, gm, p.WinT[l], PTOT, 0, 4096, 1024, 0, 0, 4096);
    job(win, gm, p.WinT[l], PTOT, 4104, 512, 1024, 0, 4096, 512);
    job(win, gm, p.WinT[l], PTOT, 4616, 2048, 1024, 0, 4608, 2048);
    job(win, gm, p.WgT[l], PTOT, 4096, 8, 1024, 0, 0, 16);
    job(p.w_glu + (size_t)l * 512 * 512, nullptr, p.WgluT[l], 512, 0, 512, 512, 0, 0, 512);
    job(p.w_a + (size_t)l * 1024 * 1024, nullptr, p.WaT[l], 1024, 0, 1024, 1024, 0, 0, 1024);
    job(p.w_b + (size_t)l * 512 * 1024, nullptr, p.WbT[l], 1024, 0, 1024, 512, 0, 0, 1024);
    job(p.w_out + (size_t)l * 1024 * 1024, nullptr, p.WoT[l], 1024, 0, 1024, 1024, 0, 0, 1024);
    job(p.w_ff1 + (size_t)l * 1024 * DFF, gf, p.W13T[l], DFF, 0, DFF, 1024, 1, 0, DFF);
    job(p.w_ff3 + (size_t)l * 1024 * DFF, gf, p.W13T[l], DFF, 0, DFF, 1024, 2, 0, DFF);
    job(p.w_ff2 + (size_t)l * DFF * 1024, nullptr, p.W2T[l], 1024, 0, 1024, DFF, 0, 0, 1024);
  }
  p.njobs = nj; p.total_tiles = tile0;
  void* args[] = {&p};
  hipError_t e = hipLaunchCooperativeKernel((void*)mega, dim3(grid_blocks), dim3(512), args, kDynLds, stream);
  if (e != hipSuccess) fprintf(stderr, "cooperative launch failed: %s (grid %d)\n", hipGetErrorString(e), grid_blocks);
}
```

```cpp
#include <hip/hip_runtime.h>
#include <hip/hip_cooperative_groups.h>
#include <cstdio>
#include <cstring>
namespace cg = cooperative_groups;

#define LAS __attribute__((address_space(3)))
typedef unsigned short bf16_t;
typedef short bf16x8 __attribute__((ext_vector_type(8)));
typedef short bf16x4 __attribute__((ext_vector_type(4)));
typedef float f32x4 __attribute__((ext_vector_type(4)));
typedef unsigned u32x4 __attribute__((ext_vector_type(4)));
typedef unsigned u32x2 __attribute__((ext_vector_type(2)));

constexpr int NP = 16384, NS = 128, NT = 16512, DM = 1024, NG1 = 6656, DFF = 2816, PTOT = 6664;
constexpr int LDS_BYTES = 150 * 1024;
#ifndef DUPMASK
#define DUPMASK 0
#endif
#define REP(bit) for (int rep_ = 0; rep_ < ((DUPMASK & (bit)) ? 2 : 1); ++rep_)
constexpr size_t O_YP = 0, O_YS = 16777216, O_CP = 16908288, O_NP = 21102592, O_MP = 21118976, O_SRP = 21119040, O_SIP = 21151808,
                 O_CS = 21184576, O_NS = 88293440, O_MS = 88555584, O_SRS = 88556608, O_SIS = 89080896;

struct TJob { const float* src; const float* scale; bf16_t* dst; int ldn, c0, ncols, K, mode, r0, tile0, ntn, nwrite, pad; };

struct Params {
  const float *x_prompt, *x_sample, *st_C, *st_n, *st_m, *st_sre, *st_sim;
  const float *g_mix, *w_in, *b_in, *g_hn, *w_a, *A_re, *A_im, *log_dt, *B_re, *B_im, *C_re, *C_im, *D_skip, *w_glu, *b_glu, *w_b, *w_out,
      *g_ffn, *w_ff1, *w_ff3, *w_ff2, *g_final;
  float* out;
  bf16_t *WinT[2], *WgT[2], *WgluT[2], *WaT[2], *WbT[2], *WoT[2], *W13T[2], *W2T[2];
  float *abar[2], *bbar[2];
  bf16_t *xb, *Pb, *St, *ysb, *ys2, *xa, *mg, *act;
  float *X1, *X2, *gat, *hss, *Eend; bf16_t *hA, *t1;
  unsigned long long *ssA, *ssB;
  unsigned* bar;
  bf16_t *Kt[2], *Gm[2], *Hm[2]; float *a16[2], *E2;
  TJob jobs[22];
  int njobs, total_tiles;
};

__device__ __forceinline__ bf16_t f2bf(float f) { return __builtin_bit_cast(bf16_t, (__bf16)f); }
__device__ __forceinline__ float bf2f(unsigned b) { return __uint_as_float(b << 16); }
typedef float f32x2 __attribute__((ext_vector_type(2)));
typedef __bf16 bf16x2v __attribute__((ext_vector_type(2)));
__device__ __forceinline__ unsigned pack2(float lo, float hi) { const f32x2 v = {lo, hi}; const bf16x2v b = __builtin_convertvector(v, bf16x2v); return __builtin_bit_cast(unsigned, b); }
__device__ __forceinline__ u32x2 pack4(f32x4 v) { u32x2 r; r.x = pack2(v[0], v[1]); r.y = pack2(v[2], v[3]); return r; }
__device__ __forceinline__ f32x4 unpack4(u32x2 u) { f32x4 r; r[0] = bf2f(u.x & 0xffffu); r[1] = bf2f(u.x >> 16); r[2] = bf2f(u.y & 0xffffu); r[3] = bf2f(u.y >> 16); return r; }
__device__ __forceinline__ float sigmoidf_(float x) { return __builtin_amdgcn_rcpf(1.0f + __expf(-x)); }
__device__ __forceinline__ float gelu_tanh(float x) { float z = 0.7978845608f * (x + 0.044715f * x * x * x); float e = __expf(2.0f * z); float th = 1.0f - 2.0f * __builtin_amdgcn_rcpf(e + 1.0f); return 0.5f * x * (1.0f + th); }
__device__ __forceinline__ int tidx() { int t = threadIdx.x; asm volatile("" : "+v"(t)); return t; }
#define LDS_BARRIER() do { asm volatile("s_waitcnt lgkmcnt(0)" ::: "memory"); __builtin_amdgcn_s_barrier(); asm volatile("" ::: "memory"); } while (0)
__device__ __forceinline__ float wave_sum(float v) { for (int o = 32; o > 0; o >>= 1) v += __shfl_xor(v, o); return v; }

namespace pg8 {
constexpr int BM = 256, BK = 64, HALF = 128, HTB = HALF * BK * 2, STAGE_BYTES = 8 * HTB, NXCD = 8, WGM = 8;
__host__ __device__ __forceinline__ int lds_byte(int r, int c) { const int st = (r >> 4) * 2 + (c >> 5), rr = r & 15, cc = c & 31, ob = rr * 64 + cc * 2; return st * 1024 + (ob ^ (((ob >> 9) & 1) << 5)); }
__host__ __device__ __forceinline__ void stage_rc(int b, int& R, int& C) { const int st = b / 1024, sb = b % 1024, swz = sb ^ (((sb >> 9) & 1) << 5); R = (st >> 1) * 16 + swz / 64; C = (st & 1) * 32 + (swz % 64) / 2; }
__host__ __device__ __forceinline__ int perm32(int rho) { const int n = rho >> 4, i = rho & 15; return 8 * (i >> 2) + 4 * n + (i & 3); }
struct Unit { int pm, pn; };
struct Gemm { const bf16_t* A; const bf16_t* Bt; int M, N, K; };
struct StaticOrder {
  int nM, nN, nwg, G, c;
  __device__ void init(int M, int N, int G_, int c_) { nM = M / BM; nN = N / BM; nwg = nM * nN; G = G_; c = c_; }
  __device__ bool next(int i, Unit& u) const {
    const long L = (long)i * G + c; if (L >= nwg) return false;
    int wgid = (int)L; { const int q = nwg / NXCD, r = nwg % NXCD, xcd = wgid % NXCD, off = wgid / NXCD; wgid = (xcd < r ? xcd * (q + 1) : r * (q + 1) + (xcd - r) * q) + off; }
    const int nig = WGM * nN, gid = wgid / nig, fm = gid * WGM, gsz = (nM - fm) < WGM ? (nM - fm) : WGM;
    u.pm = fm + ((wgid % nig) % gsz); u.pn = (wgid % nig) / gsz; return true;
  }
};

template <class Epi, class Sched>
__device__ __forceinline__ void gemm_phase(LAS unsigned char* lds, const Gemm g, const Sched& S, const Epi& E) {
  const int tid = tidx(), wid = __builtin_amdgcn_readfirstlane(tid >> 6), lane = tid & 63, wr = wid >> 2, wc = wid & 3, fr = lane & 15, fq = lane >> 4;
  const int K = g.K, nt = K / BK;
  unsigned voffA[2], voffB[2];
#pragma unroll
  for (int i = 0; i < 2; ++i) { int R, C; stage_rc(tid * 16 + i * 8192, R, C); voffA[i] = (unsigned)(R * K + C) * 2u; const int Rb = Epi::PERM ? ((R & ~31) + perm32(R & 31)) : R; voffB[i] = (unsigned)(Rb * K + C) * 2u; }
  const size_t kstep = (size_t)(BK * 2);
  const size_t hstep = (size_t)HALF * K * 2;
  const size_t tstep = 2 * hstep;
  const unsigned ldsw = (unsigned)wid * 1024u;
  const int aoff = lds_byte(wr * 64 + fr, fq * 8), boff = lds_byte(wc * 32 + fr, fq * 8);
#define PG8_SA(b, h) (((b) * 2 + (h)) * HTB)
#define PG8_SB(b, h) ((4 + (b) * 2 + (h)) * HTB)
#define PG8_STAGE(bufoff, gbase, voff) do { _Pragma("unroll") for (int _i = 0; _i < 2; ++_i) \
    __builtin_amdgcn_global_load_lds((const unsigned*)((const char*)(gbase) + (voff)[_i]), (LAS unsigned*)(lds + (bufoff) + ldsw + _i * 8192), 16, 0, 0); } while (0)
#define PG8_LDA(dst, b, h) do { _Pragma("unroll") for (int m = 0; m < 4; ++m) _Pragma("unroll") for (int k = 0; k < 2; ++k) dst[m][k] = *(const LAS bf16x8*)(lds + PG8_SA(b, h) + aoff + m * 2048 + k * 1024); } while (0)
#define PG8_LDB(dst, b, h) do { _Pragma("unroll") for (int n = 0; n < 2; ++n) _Pragma("unroll") for (int k = 0; k < 2; ++k) dst[n][k] = *(const LAS bf16x8*)(lds + PG8_SB(b, h) + boff + n * 2048 + k * 1024); } while (0)
#define PG8_MMA(ai, bj, At, Bt) do { __builtin_amdgcn_s_setprio(1); _Pragma("unroll") for (int m = 0; m < 4; ++m) _Pragma("unroll") for (int n = 0; n < 2; ++n) _Pragma("unroll") for (int k = 0; k < 2; ++k) \
    acc[ai][bj][m][n] = __builtin_amdgcn_mfma_f32_16x16x32_bf16(Bt[n][k], At[m][k], acc[ai][bj][m][n], 0, 0, 0); __builtin_amdgcn_s_setprio(0); } while (0)
#define PG8_WAIT_V(n) asm volatile("s_waitcnt vmcnt(" #n ")" ::: "memory")
#define PG8_WAIT_L(n) asm volatile("s_waitcnt lgkmcnt(" #n ")" ::: "memory")
#define PG8_BAR __builtin_amdgcn_s_barrier()
#define PG8_SCHED __builtin_amdgcn_sched_barrier(0)
  Unit cur, nxt; int ui = 0;
  if (!S.next(0, cur)) return;
  f32x4 acc[2][2][4][2];
#pragma unroll
  for (int a = 0; a < 2; ++a)
#pragma unroll
    for (int b = 0; b < 2; ++b)
#pragma unroll
      for (int m = 0; m < 4; ++m)
#pragma unroll
        for (int n = 0; n < 2; ++n) acc[a][b][m][n] = (f32x4){0.f, 0.f, 0.f, 0.f};
  bf16x8 At[4][2], B0[2][2], B1[2][2];
  const char* cA = (const char*)g.A + (size_t)cur.pm * tstep; const char* cB = (const char*)g.Bt + (size_t)cur.pn * tstep;
  PG8_STAGE(PG8_SB(0, 0), cB, voffB); PG8_STAGE(PG8_SA(0, 0), cA, voffA); PG8_STAGE(PG8_SB(0, 1), cB + hstep, voffB); PG8_STAGE(PG8_SA(0, 1), cA + hstep, voffA);
  if (wr == 1) PG8_BAR;
  PG8_WAIT_V(4); PG8_BAR;
  PG8_STAGE(PG8_SB(1, 0), cB + kstep, voffB); PG8_STAGE(PG8_SA(1, 0), cA + kstep, voffA); PG8_STAGE(PG8_SB(1, 1), cB + hstep + kstep, voffB);
  PG8_WAIT_V(6); PG8_BAR;
  for (;;) {
    const bool has_next = S.next(ui + 1, nxt);
    const char* nA = has_next ? (const char*)g.A + (size_t)nxt.pm * tstep : cA; const char* nB = has_next ? (const char*)g.Bt + (size_t)nxt.pn * tstep : cB;
    for (int t = 0; t < nt; t += 2) {
      const bool last = (t == nt - 2);
      const char* a1 = cA + (size_t)(t + 1) * kstep;
      const char* a2 = last ? nA : cA + (size_t)(t + 2) * kstep; const char* b2 = last ? nB : cB + (size_t)(t + 2) * kstep;
      const char* a3 = a2 + kstep; const char* b3 = b2 + kstep;
      PG8_LDB(B0, 0, 0); PG8_SCHED; PG8_LDA(At, 0, 0); PG8_STAGE(PG8_SA(1, 1), a1 + hstep, voffA);
      PG8_WAIT_L(8); PG8_BAR; PG8_WAIT_L(0); PG8_MMA(0, 0, At, B0); PG8_BAR; PG8_SCHED;
      PG8_LDB(B1, 0, 1); PG8_STAGE(PG8_SB(0, 0), b2, voffB);
      PG8_BAR; PG8_WAIT_L(0); PG8_MMA(0, 1, At, B1); PG8_BAR;
      PG8_LDA(At, 0, 1); PG8_STAGE(PG8_SA(0, 0), a2, voffA);
      PG8_BAR; PG8_WAIT_L(0); PG8_MMA(1, 0, At, B0); PG8_BAR; PG8_SCHED;
      PG8_STAGE(PG8_SB(0, 1), b2 + hstep, voffB);
      PG8_WAIT_V(6); PG8_BAR; PG8_MMA(1, 1, At, B1); PG8_BAR;
      PG8_LDB(B0, 1, 0); PG8_SCHED; PG8_LDA(At, 1, 0); PG8_STAGE(PG8_SA(0, 1), a2 + hstep, voffA);
      PG8_WAIT_L(8); PG8_BAR; PG8_WAIT_L(0); PG8_MMA(0, 0, At, B0); PG8_BAR; PG8_SCHED;
      PG8_LDB(B1, 1, 1); PG8_STAGE(PG8_SB(1, 0), b3, voffB);
      PG8_BAR; PG8_WAIT_L(0); PG8_MMA(0, 1, At, B1); PG8_BAR;
      PG8_LDA(At, 1, 1); PG8_STAGE(PG8_SA(1, 0), a3, voffA);
      PG8_BAR; PG8_WAIT_L(0); PG8_MMA(1, 0, At, B0); PG8_BAR; PG8_SCHED;
      PG8_STAGE(PG8_SB(1, 1), b3 + hstep, voffB);
      PG8_WAIT_V(6); PG8_BAR; PG8_MMA(1, 1, At, B1); PG8_BAR;
    }
    E(acc, cur, wr, wc, fr, fq);
    if (!has_next) break;
#pragma unroll
    for (int a = 0; a < 2; ++a)
#pragma unroll
      for (int b = 0; b < 2; ++b)
#pragma unroll
        for (int m = 0; m < 4; ++m)
#pragma unroll
          for (int n = 0; n < 2; ++n) acc[a][b][m][n] = (f32x4){0.f, 0.f, 0.f, 0.f};
    cur = nxt; cA = nA; cB = nB; ++ui;
  }
  PG8_WAIT_V(0);
  if (wr == 0) PG8_BAR;
  PG8_BAR;
#undef PG8_SA
#undef PG8_SB
#undef PG8_STAGE
#undef PG8_LDA
#undef PG8_LDB
#undef PG8_MMA
#undef PG8_WAIT_V
#undef PG8_WAIT_L
#undef PG8_BAR
#undef PG8_SCHED
}
}

typedef unsigned long long u64;
__device__ __forceinline__ u64 ss_fix(float ss) { return (u64)(ss * 16777216.0f); }
__device__ __forceinline__ float rs_of(u64 q) { const float f = (float)(unsigned)(q >> 32) * 4294967296.0f + (float)(unsigned)q; return rsqrtf(f * (1.0f / (16777216.0f * 1024.0f)) + 1e-6f); }
__device__ __forceinline__ void ss_add(u64* p, float ss) { __hip_atomic_fetch_add(p, ss_fix(ss), __ATOMIC_RELAXED, __HIP_MEMORY_SCOPE_AGENT); }
__device__ __forceinline__ int qcol(int cbase, int q) { return cbase + (q >> 1) * 128 + (q & 1) * 16; }
__device__ __forceinline__ f32x4 unlo(u32x4 u) { return unpack4((u32x2){u[0], u[1]}); }
__device__ __forceinline__ f32x4 unhi(u32x4 u) { return unpack4((u32x2){u[2], u[3]}); }
__device__ __forceinline__ u32x4 pack8(f32x4 a, f32x4 b) { const u32x2 p = pack4(a), q = pack4(b); return (u32x4){p.x, p.y, q.x, q.y}; }
struct F1 {
  static constexpr bool NEEDR = true, STAT = false, PERM = true; static constexpr int RB = 8;
  const float* bias; bf16_t* Pb; const u64* rs; u64* ss;
  struct ColData { f32x4 b[4]; }; struct RowData { u64 s; };
  __device__ __forceinline__ void load_cols(int cbase, ColData& cd) const {
#pragma unroll
    for (int q = 0; q < 4; ++q) { const int col = cbase + (q >> 1) * 128 + (q & 1) * 4; cd.b[q] = *(const f32x4*)(bias + (col < 4096 ? col : col + 8)); } }
  __device__ __forceinline__ void load_row(int row, int, RowData& rd) const { rd.s = rs[row]; }
  __device__ __forceinline__ float apply(int row, int cbase, const f32x4 (&v)[4], const ColData& cd, const RowData& rd) const {
    const float r = rs_of(rd.s);
    const int blk = cbase >> 8;
    const bool isk = blk >= 4 && blk < 8, issig = (blk >= 12 && blk < 16) || blk >= 18;
#pragma unroll
    for (int bj = 0; bj < 2; ++bj) {
      u32x4 pk;
#pragma unroll
      for (int n = 0; n < 2; ++n) {
        f32x4 o = v[bj * 2 + n] * r + cd.b[bj * 2 + n];
        if (isk) o = o * 0.0625f;
        else if (issig) { o[0] = sigmoidf_(o[0]); o[1] = sigmoidf_(o[1]); o[2] = sigmoidf_(o[2]); o[3] = sigmoidf_(o[3]); }
        const u32x2 p2 = pack4(o); pk[2 * n] = p2.x; pk[2 * n + 1] = p2.y;
      }
      *(u32x4*)(Pb + (size_t)row * NG1 + cbase + bj * 128) = pk;
    }
    return 0.f;
  }
  __device__ __forceinline__ float rowscale(int row) const { return rs_of(rs[row]); }
  __device__ __forceinline__ float operator()(int row, int col, f32x4 v, float r) const {
    const int bi = col < 4096 ? col : col + 8;
    const f32x4 b4 = *(const f32x4*)(bias + bi);
    f32x4 o = v * r + b4;
    if (col >= 1024 && col < 2048) o = o * 0.0625f;
    else if ((col >= 3072 && col < 4096) || col >= 4608) { o[0] = sigmoidf_(o[0]); o[1] = sigmoidf_(o[1]); o[2] = sigmoidf_(o[2]); o[3] = sigmoidf_(o[3]); }
    *(u32x2*)(Pb + (size_t)row * NG1 + col) = pack4(o);
    return 0.f;
  }
};
struct Fg {
  static constexpr bool NEEDR = true, STAT = false;
  const float* bias; float* gat; const u64* rs; u64* ss;
  __device__ __forceinline__ float rowscale(int row) const { return rs_of(rs[row]); }
  __device__ __forceinline__ float operator()(int row, int col, f32x4 v, float r) const {
    if (col < 8) {
      const f32x4 b4 = *(const f32x4*)(bias + col);
      f32x4 o = v * r + b4;
      if (col >= 4) {
#pragma unroll
        for (int i = 0; i < 4; ++i) { const float x = o[i]; o[i] = fminf(x, 0.f) - log1pf(__expf(-fabsf(x))); }
      }
      *(f32x4*)(gat + (size_t)row * 8 + col) = o;
    }
    return 0.f;
  }
};
struct Fglu {
  static constexpr bool NEEDR = false, STAT = false, PERM = true; static constexpr int RB = 8;
  const float* bias; const bf16_t* ysb; bf16_t* ys2; u64* ss;
  struct ColData { f32x4 b[4]; }; struct RowData { u32x4 y[2]; };
  __device__ __forceinline__ void load_cols(int cbase, ColData& cd) const {
#pragma unroll
    for (int q = 0; q < 4; ++q) cd.b[q] = *(const f32x4*)(bias + cbase + (q >> 1) * 128 + (q & 1) * 4); }
  __device__ __forceinline__ void load_row(int row, int cbase, RowData& rd) const {
#pragma unroll
    for (int bj = 0; bj < 2; ++bj) rd.y[bj] = *(const u32x4*)(ysb + (size_t)row * 512 + cbase + bj * 128); }
  __device__ __forceinline__ float apply(int row, int cbase, const f32x4 (&v)[4], const ColData& cd, const RowData& rd) const {
#pragma unroll
    for (int bj = 0; bj < 2; ++bj) {
      const f32x4 y0 = unlo(rd.y[bj]), y1 = unhi(rd.y[bj]); f32x4 o0, o1;
#pragma unroll
      for (int i = 0; i < 4; ++i) { o0[i] = y0[i] * sigmoidf_(v[bj * 2][i] + cd.b[bj * 2][i]); o1[i] = y1[i] * sigmoidf_(v[bj * 2 + 1][i] + cd.b[bj * 2 + 1][i]); }
      *(u32x4*)(ys2 + (size_t)row * 512 + cbase + bj * 128) = pack8(o0, o1);
    }
    return 0.f;
  }
  __device__ __forceinline__ float rowscale(int) const { return 1.f; }
  __device__ __forceinline__ float operator()(int row, int col, f32x4 v, float) const {
    const f32x4 b4 = *(const f32x4*)(bias + col);
    const f32x4 y = unpack4(*(const u32x2*)(ysb + (size_t)row * 512 + col));
    f32x4 o;
#pragma unroll
    for (int i = 0; i < 4; ++i) o[i] = y[i] * sigmoidf_(v[i] + b4[i]);
    *(u32x2*)(ys2 + (size_t)row * 512 + col) = pack4(o);
    return 0.f;
  }
};
struct Fa {
  static constexpr bool NEEDR = false, STAT = false, PERM = true; static constexpr int RB = 8;
  const bf16_t* Pb; bf16_t* t1; u64* ss;
  struct ColData { int dummy; }; struct RowData { u32x4 g[2]; };
  __device__ __forceinline__ void load_cols(int, ColData&) const {}
  __device__ __forceinline__ void load_row(int row, int cbase, RowData& rd) const {
#pragma unroll
    for (int bj = 0; bj < 2; ++bj) rd.g[bj] = *(const u32x4*)(Pb + (size_t)row * NG1 + 4608 + cbase + bj * 128); }
  __device__ __forceinline__ float apply(int row, int cbase, const f32x4 (&v)[4], const ColData&, const RowData& rd) const {
#pragma unroll
    for (int bj = 0; bj < 2; ++bj) *(u32x4*)(t1 + (size_t)row * DM + cbase + bj * 128) = pack8(unlo(rd.g[bj]) * v[bj * 2], unhi(rd.g[bj]) * v[bj * 2 + 1]);
    return 0.f;
  }
  __device__ __forceinline__ float rowscale(int) const { return 1.f; }
  __device__ __forceinline__ float operator()(int row, int col, f32x4 v, float) const {
    const f32x4 sg = unpack4(*(const u32x2*)(Pb + (size_t)row * NG1 + 4608 + col));
    *(u32x2*)(t1 + (size_t)row * DM + col) = pack4(sg * v);
    return 0.f;
  }
};
struct Fb {
  static constexpr bool NEEDR = false, STAT = false, PERM = true; static constexpr int RB = 4;
  const bf16_t* Pb; const bf16_t* t1; bf16_t* mg; u64* ss;
  struct ColData { int dummy; }; struct RowData { u32x4 g[2]; u32x4 t[2]; };
  __device__ __forceinline__ void load_cols(int, ColData&) const {}
  __device__ __forceinline__ void load_row(int row, int cbase, RowData& rd) const {
#pragma unroll
    for (int bj = 0; bj < 2; ++bj) { rd.g[bj] = *(const u32x4*)(Pb + (size_t)row * NG1 + 5632 + cbase + bj * 128); rd.t[bj] = *(const u32x4*)(t1 + (size_t)row * DM + cbase + bj * 128); } }
  __device__ __forceinline__ float apply(int row, int cbase, const f32x4 (&v)[4], const ColData&, const RowData& rd) const {
#pragma unroll
    for (int bj = 0; bj < 2; ++bj) *(u32x4*)(mg + (size_t)row * DM + cbase + bj * 128) = pack8(unlo(rd.t[bj]) + unlo(rd.g[bj]) * v[bj * 2], unhi(rd.t[bj]) + unhi(rd.g[bj]) * v[bj * 2 + 1]);
    return 0.f;
  }
  __device__ __forceinline__ float rowscale(int) const { return 1.f; }
  __device__ __forceinline__ float operator()(int row, int col, f32x4 v, float) const {
    const f32x4 sg = unpack4(*(const u32x2*)(Pb + (size_t)row * NG1 + 5632 + col));
    const f32x4 t = unpack4(*(const u32x2*)(t1 + (size_t)row * DM + col));
    *(u32x2*)(mg + (size_t)row * DM + col) = pack4(t + sg * v);
    return 0.f;
  }
};
struct Fres {
  static constexpr bool NEEDR = false, STAT = true, PERM = true; static constexpr int RB = 4;
  const float *xinP, *xinS; float* xo; bf16_t* xb; u64* ss;
  struct ColData { int dummy; }; struct RowData { f32x4 x[4]; };
  __device__ __forceinline__ void load_cols(int, ColData&) const {}
  __device__ __forceinline__ void load_row(int row, int cbase, RowData& rd) const {
#pragma unroll
    for (int q = 0; q < 4; ++q) rd.x[q] = *(const f32x4*)(xinP + (size_t)row * DM + cbase + (q >> 1) * 128 + (q & 1) * 4); }
  __device__ __forceinline__ float apply(int row, int cbase, const f32x4 (&v)[4], const ColData&, const RowData& rd) const {
    float s = 0.f;
#pragma unroll
    for (int bj = 0; bj < 2; ++bj) {
      const f32x4 o0 = rd.x[bj * 2] + v[bj * 2], o1 = rd.x[bj * 2 + 1] + v[bj * 2 + 1];
      float* xp = xo + (size_t)row * DM + cbase + bj * 128;
      *(f32x4*)xp = o0; *(f32x4*)(xp + 4) = o1;
      const u32x2 p0 = pack4(o0), p1 = pack4(o1);
      *(u32x4*)(xb + (size_t)row * DM + cbase + bj * 128) = (u32x4){p0.x, p0.y, p1.x, p1.y};
      s += (o0[0] * o0[0] + o0[1] * o0[1]) + (o0[2] * o0[2] + o0[3] * o0[3]) + (o1[0] * o1[0] + o1[1] * o1[1]) + (o1[2] * o1[2] + o1[3] * o1[3]);
    }
    return s;
  }
  __device__ __forceinline__ float rowscale(int) const { return 1.f; }
  __device__ __forceinline__ float operator()(int row, int col, f32x4 v, float) const {
    const float* xi = row < NP ? xinP + (size_t)row * DM : xinS + (size_t)(row - NP) * DM;
    const f32x4 o = *(const f32x4*)(xi + col) + v;
    *(f32x4*)(xo + (size_t)row * DM + col) = o;
    *(u32x2*)(xb + (size_t)row * DM + col) = pack4(o);
    return (o[0] * o[0] + o[1] * o[1]) + (o[2] * o[2] + o[3] * o[3]);
  }
};
struct F13 {
  const u64* rs; bf16_t* act;
  __device__ __forceinline__ float rowscale(int row) const { return rs_of(rs[row]); }
  __device__ __forceinline__ f32x4 glu(f32x4 a1, f32x4 a3, float r) const {
    f32x4 o;
#pragma unroll
    for (int i = 0; i < 4; ++i) { const float x1 = a1[i] * r, x3 = a3[i] * r; o[i] = x1 * sigmoidf_(x1) * x3; }
    return o;
  }
  __device__ __forceinline__ void pair(int row, int j, f32x4 a1, f32x4 a3, float r) const { *(u32x2*)(act + (size_t)row * DFF + j) = pack4(glu(a1, a3, r)); }
};

template <class F> struct EpiMain {
  static constexpr bool PERM = F::PERM;
  F f; int coff;
  __device__ __forceinline__ void operator()(const f32x4 (&acc)[2][2][4][2], const pg8::Unit& u, int wr, int wc, int fr, int fq) const {
    const int rbase = u.pm * 256 + wr * 64 + fr, cbase = coff + u.pn * 256 + wc * 32 + (F::PERM ? 8 : 4) * fq;
    typename F::ColData cd; f.load_cols(cbase, cd);
#pragma unroll
    for (int b0 = 0; b0 < 8; b0 += F::RB) {
      typename F::RowData rd[F::RB];
#pragma unroll
      for (int k = 0; k < F::RB; ++k) { const int i = b0 + k; f.load_row(rbase + (i >> 2) * 128 + (i & 3) * 16, cbase, rd[k]); }
      __builtin_amdgcn_sched_barrier(0);
#pragma unroll
      for (int k = 0; k < F::RB; ++k) {
        const int i = b0 + k, ai = i >> 2, m = i & 3, row = rbase + ai * 128 + m * 16;
        const f32x4 v[4] = {acc[ai][0][m][0], acc[ai][0][m][1], acc[ai][1][m][0], acc[ai][1][m][1]};
        float s = f.apply(row, cbase, v, cd, rd[k]);
        if (F::STAT) { s += __shfl_xor(s, 16); s += __shfl_xor(s, 32); if (fq == 0) ss_add(f.ss + row, s); }
      }
      __builtin_amdgcn_sched_barrier(0);
    }
  }
};
struct EpiMain13 {
  static constexpr bool PERM = true;
  F13 f;
  __device__ __forceinline__ void operator()(const f32x4 (&acc)[2][2][4][2], const pg8::Unit& u, int wr, int wc, int fr, int fq) const {
    const int rbase = u.pm * 256 + wr * 64 + fr, jbase = u.pn * 128 + wc * 32 + 8 * fq;
    u64 sq[8];
#pragma unroll
    for (int i = 0; i < 8; ++i) sq[i] = f.rs[rbase + (i >> 2) * 128 + (i & 3) * 16];
    __builtin_amdgcn_sched_barrier(0);
#pragma unroll
    for (int i = 0; i < 8; ++i) {
      const int ai = i >> 2, m = i & 3, row = rbase + ai * 128 + m * 16;
      const float r = rs_of(sq[i]);
      *(u32x4*)(f.act + (size_t)row * DFF + jbase) = pack8(f.glu(acc[ai][0][m][0], acc[ai][1][m][0], r), f.glu(acc[ai][0][m][1], acc[ai][1][m][1], r));
    }
  }
};

template <int NACC>
__device__ __forceinline__ void skinny_unit(const bf16_t* A, int K, const bf16_t* Bt, int row0, int brow0, int bstep, float* red, f32x4 (&out)[NACC]) {
  const int tid = tidx(), w = tid >> 6, lane = tid & 63, g4 = lane >> 4, l15 = lane & 15;
  const int nks = K >> 8, kbase = w * (K >> 3) + 8 * g4;
  f32x4 acc[8][NACC];
#pragma unroll
  for (int rt = 0; rt < 8; ++rt)
#pragma unroll
    for (int i = 0; i < NACC; ++i) acc[rt][i] = (f32x4){0.f, 0.f, 0.f, 0.f};
  const bf16_t* ap = A + (size_t)(row0 + l15) * K + kbase;
  const bf16_t* bp = Bt + (size_t)(brow0 + l15) * K + kbase;
  for (int ks = 0; ks < nks; ks += 2) {
    const bool two = ks + 1 < nks;
    bf16x8 a0[8], a1[8], b0[NACC], b1[NACC];
#pragma unroll
    for (int rt = 0; rt < 8; ++rt) a0[rt] = *(const bf16x8*)(ap + (size_t)16 * rt * K + 32 * ks);
#pragma unroll
    for (int i = 0; i < NACC; ++i) b0[i] = *(const bf16x8*)(bp + (size_t)bstep * i * K + 32 * ks);
    if (two) {
#pragma unroll
      for (int rt = 0; rt < 8; ++rt) a1[rt] = *(const bf16x8*)(ap + (size_t)16 * rt * K + 32 * ks + 32);
#pragma unroll
      for (int i = 0; i < NACC; ++i) b1[i] = *(const bf16x8*)(bp + (size_t)bstep * i * K + 32 * ks + 32);
    }
#pragma unroll
    for (int rt = 0; rt < 8; ++rt)
#pragma unroll
      for (int i = 0; i < NACC; ++i) acc[rt][i] = __builtin_amdgcn_mfma_f32_16x16x32_bf16(b0[i], a0[rt], acc[rt][i], 0, 0, 0);
    if (two) {
#pragma unroll
      for (int rt = 0; rt < 8; ++rt)
#pragma unroll
        for (int i = 0; i < NACC; ++i) acc[rt][i] = __builtin_amdgcn_mfma_f32_16x16x32_bf16(b1[i], a1[rt], acc[rt][i], 0, 0, 0);
    }
  }
#pragma unroll
  for (int rt = 0; rt < 8; ++rt)
#pragma unroll
    for (int i = 0; i < NACC; ++i) *(f32x4*)(red + (size_t)(((w * 8 + rt) * NACC + i) * 64 + lane) * 4) = acc[rt][i];
  __syncthreads();
#pragma unroll
  for (int i = 0; i < NACC; ++i) {
    f32x4 t = (f32x4){0.f, 0.f, 0.f, 0.f};
#pragma unroll
    for (int ww = 0; ww < 8; ++ww) t += *(const f32x4*)(red + (size_t)(((ww * 8 + w) * NACC + i) * 64 + lane) * 4);
    out[i] = t;
  }
}
template <class F>
__device__ __forceinline__ void skinny_run(const F& f, const bf16_t* A, int K, const bf16_t* Bt, int rowbase, int nrt, int ncu, int bid, int G, unsigned char* shm, int c0 = 0) {
  const int tid = tidx(), w = tid >> 6, lane = tid & 63, g = lane >> 4;
  const int total = nrt * ncu, nc = G - c0;
  if (bid < c0) return;
  for (int su = (G - 1 - bid); su < total; su += nc) {
    const int rt = su / ncu, cu = su - rt * ncu;
    const int row0 = rowbase + rt * 128, arow = row0 + 16 * w + (lane & 15);
    f32x4 acc[1];
    skinny_unit<1>(A, K, Bt, row0, 16 * cu, 16, (float*)shm, acc);
    const float rs = F::NEEDR ? f.rowscale(arow) : 1.f;
    float ss = f(arow, 16 * cu + 4 * g, acc[0], rs);
    if (F::STAT) { ss += __shfl_xor(ss, 16); ss += __shfl_xor(ss, 32); if (g == 0) ss_add(f.ss + arow, ss); }
    __syncthreads();
  }
}
template <class F>
__device__ __forceinline__ void skinny_run_quarter(const F& f, const bf16_t* A, int K, const bf16_t* Bt, int ncu, int bid, int G, unsigned char* shm, int c0) {
  const int tid = tidx(), w = tid >> 6, lane = tid & 63, g4 = lane >> 4, l15 = lane & 15;
  const int total = 4 * ncu, nc = G - c0;
  if (bid < c0) return;
  float* red = (float*)shm;
  for (int su = (G - 1 - bid); su < total; su += nc) {
    const int cu = su >> 2, rq = su & 3, rt = w >> 2, kq = w & 3;
    const int arow = NP + 32 * rq + 16 * rt + l15;
    const int kspan = K >> 2, kbase = kq * kspan + 8 * g4;
    const bf16_t* ap = A + (size_t)arow * K + kbase;
    const bf16_t* bp = Bt + (size_t)(16 * cu + l15) * K + kbase;
    f32x4 acc = (f32x4){0.f, 0.f, 0.f, 0.f};
    for (int k0 = 0; k0 < kspan; k0 += 256) {
      bf16x8 a[8], b[8];
#pragma unroll
      for (int s8 = 0; s8 < 8; ++s8) { if (k0 + 32 * s8 < kspan) { a[s8] = *(const bf16x8*)(ap + k0 + 32 * s8); b[s8] = *(const bf16x8*)(bp + k0 + 32 * s8); } }
#pragma unroll
      for (int s8 = 0; s8 < 8; ++s8) { if (k0 + 32 * s8 < kspan) acc = __builtin_amdgcn_mfma_f32_16x16x32_bf16(b[s8], a[s8], acc, 0, 0, 0); }
    }
    *(f32x4*)(red + (size_t)(w * 64 + lane) * 4) = acc;
    __syncthreads();
    if (kq == 0) {
      f32x4 t = acc;
#pragma unroll
      for (int q = 1; q < 4; ++q) t += *(const f32x4*)(red + (size_t)((w + q) * 64 + lane) * 4);
      const float rs = F::NEEDR ? f.rowscale(arow) : 1.f;
      float ss = f(arow, 16 * cu + 4 * g4, t, rs);
      if (F::STAT) { ss += __shfl_xor(ss, 16); ss += __shfl_xor(ss, 32); if (g4 == 0) ss_add(f.ss + arow, ss); }
    }
    __syncthreads();
  }
}
__device__ __forceinline__ void skinny_run13(const F13& f, const bf16_t* A, const bf16_t* Bt, int bid, int G, unsigned char* shm) {
  const int tid = tidx(), w = tid >> 6, lane = tid & 63, g = lane >> 4;
  const int c0 = ((NP / 256) * (2 * DFF / 256)) % G, nc = G - c0;
  if (bid < c0) return;
  for (int su = (G - 1 - bid); su < DFF / 16; su += nc) {
    const int arow = NP + 16 * w + (lane & 15);
    f32x4 acc[2];
    skinny_unit<2>(A, 1024, Bt, NP, ((16 * su) >> 7) * 256 + ((16 * su) & 127), 128, (float*)shm, acc);
    f.pair(arow, 16 * su + 4 * g, acc[0], acc[1], f.rowscale(arow));
    __syncthreads();
  }
}
template <class F>
__device__ __forceinline__ void gemm_all(LAS unsigned char* lds, unsigned char* shm, const bf16_t* A, const bf16_t* Bt, int N, int K, const F& f, int bid, int G) {
  pg8::Gemm g; g.A = A; g.Bt = Bt; g.M = NP; g.N = N; g.K = K;
  pg8::StaticOrder S; S.init(NP, N, G, bid);
  EpiMain<F> E; E.f = f; E.coff = 0;
  REP(F::STAT ? 0 : 512) pg8::gemm_phase(lds, g, S, E);
  const int c0 = ((NP / 256) * (N / 256)) % G;
  if ((N / 16) * 2 <= G - c0) skinny_run_quarter(f, A, K, Bt, N / 16, bid, G, shm, c0);
  else skinny_run(f, A, K, Bt, NP, 1, N / 16, bid, G, shm, c0);
}

template <class F>
__device__ __forceinline__ void gemm_main_window(LAS unsigned char* lds, const bf16_t* A, const bf16_t* Bt, int N, int K, const F& f, int coff, int bid, int G) {
  pg8::Gemm g; g.A = A; g.Bt = Bt; g.M = NP; g.N = N; g.K = K;
  pg8::StaticOrder S; S.init(NP, N, G, bid);
  EpiMain<F> E; E.f = f; E.coff = coff;
  pg8::gemm_phase(lds, g, S, E);
}

__device__ __forceinline__ void prep_s5tables(const Params& P, int item, unsigned char* shm);
__device__ __forceinline__ void prep_phase(const Params& P, unsigned char* shm, int bid, int G) {
  const int tid = tidx(), w = tid >> 6, lane = tid & 63;
  bf16_t* T = (bf16_t*)shm;
  for (int t0 = 4 * bid; t0 < P.total_tiles; t0 += 4 * G) {
    f32x4 v0[4], v1[4]; float sc[4];
    const int kk = tid >> 3, jq = tid & 7, nn = jq * 8;
#pragma unroll
    for (int u = 0; u < 4; ++u) {
      const int tile = t0 + u;
      v0[u] = (f32x4){0.f, 0.f, 0.f, 0.f}; v1[u] = v0[u]; sc[u] = 1.f;
      if (tile < P.total_tiles) {
        int ji = 0;
        while (ji + 1 < P.njobs && P.jobs[ji + 1].tile0 <= tile) ++ji;
        const TJob& J = P.jobs[ji];
        const int lt = tile - J.tile0, tn = lt % J.ntn, tk = lt / J.ntn, k0 = tk * 64, n0 = tn * 64;
        if (n0 + nn < J.ncols) { const float* sp = J.src + (size_t)(k0 + kk) * J.ldn + J.c0 + n0 + nn; v0[u] = *(const f32x4*)sp; v1[u] = *(const f32x4*)(sp + 4); }
        if (J.scale) sc[u] = J.scale[k0 + kk];
      }
    }
#pragma unroll
    for (int u = 0; u < 4; ++u) {
      bf16_t* Tu = T + u * (64 * 72);
      const int kx = kk ^ (8 * jq);
#pragma unroll
      for (int i = 0; i < 4; ++i) { Tu[(nn + i) * 72 + kx] = f2bf(v0[u][i] * sc[u]); Tu[(nn + 4 + i) * 72 + kx] = f2bf(v1[u][i] * sc[u]); }
    }
    __syncthreads();
#pragma unroll
    for (int u = 0; u < 4; ++u) {
      const int tile = t0 + u;
      if (tile < P.total_tiles) {
        int ji = 0;
        while (ji + 1 < P.njobs && P.jobs[ji + 1].tile0 <= tile) ++ji;
        const TJob& J = P.jobs[ji];
        const int lt = tile - J.tile0, tn = lt % J.ntn, tk = lt / J.ntn, k0 = tk * 64, n0 = tn * 64;
        const int n = tid >> 3, k8 = (tid & 7) * 8, gn = n0 + n;
        if (gn < J.nwrite) {
          const int dr = J.mode == 0 ? J.r0 + gn : ((gn >> 7) * 256 + (J.mode == 2 ? 128 : 0) + (gn & 127));
          *(u32x4*)(J.dst + (size_t)dr * J.K + k0 + k8) = *(const u32x4*)(T + u * (64 * 72) + n * 72 + (k8 ^ (8 * ((n >> 3) & 7))));
        }
      }
    }
    __syncthreads();
  }
  for (int i = bid * 512 + tid; i < 2 * 2048; i += G * 512) {
    const int l = i >> 11, gp = i & 2047, g = gp >> 6, p = gp & 63;
    const float dt = expf(P.log_dt[l * 32 + g]);
    const float Ar = P.A_re[l * 2048 + gp], Ai = P.A_im[l * 2048 + gp];
    const float mag = expf(dt * Ar);
    float sn, cs; sincosf(dt * Ai, &sn, &cs);
    const float abr = mag * cs, abi = mag * sn;
    const float den = Ar * Ar + Ai * Ai, nr = abr - 1.0f, ni = abi;
    const float fre = (nr * Ar + ni * Ai) / den, fim = (ni * Ar - nr * Ai) / den;
    P.abar[l][gp] = abr; P.abar[l][2048 + gp] = abi;
    for (int c = 0; c < 16; ++c) {
      const float Br = P.B_re[(size_t)l * 32768 + gp * 16 + c], Bi = P.B_im[(size_t)l * 32768 + gp * 16 + c];
      P.bbar[l][(g * 16 + c) * 64 + p] = fre * Br - fim * Bi;
      P.bbar[l][32768 + (g * 16 + c) * 64 + p] = fre * Bi + fim * Br;
    }
  }
  for (int it = bid; it < 64; it += G) prep_s5tables(P, it, shm);
  for (int row = bid * 8 + w; row < NT; row += G * 8) {
    const float* xr = row < NP ? P.x_prompt + (size_t)row * DM : P.x_sample + (size_t)(row - NP) * DM;
    float ss = 0.f;
#pragma unroll
    for (int i = 0; i < 4; ++i) {
      const f32x4 v = *(const f32x4*)(xr + 256 * i + 4 * lane);
      ss += (v[0] * v[0] + v[1] * v[1]) + (v[2] * v[2] + v[3] * v[3]);
      *(u32x2*)(P.xb + (size_t)row * DM + 256 * i + 4 * lane) = pack4(v);
    }
    ss = wave_sum(ss);
    if (lane == 0) P.ssA[row] = ss_fix(ss);
  }
}

__device__ __forceinline__ void mlstm_scalars(const float* gat, int b, int h, float* sA, float* sM, float* sB, float* chain) {
  const int tid = tidx(), w = tid >> 6, lane = tid & 63;
  for (int cc = w; cc < 16; cc += 8) {
    const int t0 = cc * 128 + 2 * lane; const size_t r0 = (size_t)b * 2048 + t0;
    const float ig0 = gat[r0 * 8 + h], lf0 = gat[r0 * 8 + 4 + h], ig1 = gat[(r0 + 1) * 8 + h], lf1 = gat[(r0 + 1) * 8 + 4 + h];
    float x = lf0 + lf1;
    for (int off = 1; off < 64; off <<= 1) { const float y = __shfl_up(x, off); if (lane >= off) x += y; }
    const float b1 = x, b0 = x - lf1, a0 = ig0 - b0, a1 = ig1 - b1;
    float cm = fmaxf(a0, a1);
    for (int off = 1; off < 64; off <<= 1) { const float y = __shfl_up(cm, off); if (lane >= off) cm = fmaxf(cm, y); }
    const float prev = __shfl_up(cm, 1); const float cm0 = lane ? fmaxf(prev, a0) : a0;
    sB[t0] = b0; sB[t0 + 1] = b1; sA[t0] = a0; sA[t0 + 1] = a1; sM[t0] = cm0; sM[t0 + 1] = cm;
    if (lane == 63) { chain[33 + cc] = b1; chain[49 + cc] = cm; }
  }
  __syncthreads();
  if (tid == 0) { float m = 0.f; for (int cc = 0; cc < 16; ++cc) { chain[cc] = m; const float ml = fmaxf(m, chain[49 + cc]); chain[17 + cc] = ml; m = chain[33 + cc] + ml; } chain[16] = m; }
  __syncthreads();
  for (int t = tid; t < 2048; t += 512) sM[t] = fmaxf(chain[t >> 7], sM[t]);
  __syncthreads();
}

__device__ __forceinline__ void m1_item(const Params& P, int item, unsigned char* shm) {
  const int tid = tidx(), w = __builtin_amdgcn_readfirstlane(tid >> 6), lane = tid & 63, g = lane >> 4;
  const int b = item >> 6, h = (item >> 4) & 3, c = item & 15;
  float* sA = (float*)shm; float* sM = sA + 2048; float* sB = sM + 2048; float* chain = sB + 2048;
  mlstm_scalars(P.gat, b, h, sA, sM, sB, chain);
  const int row0 = b * 2048 + c * 128, t = 16 * w + (lane & 15);
  const bf16_t* qp = P.Pb + (size_t)(row0 + t) * NG1 + h * 256 + 8 * g;
  bf16x8 qf[8];
#pragma unroll
  for (int ks = 0; ks < 8; ++ks) qf[ks] = *(const bf16x8*)(qp + 32 * ks);
  const float Mt = sM[c * 128 + t];
  bf16_t* sp = P.St + (size_t)item * 16384 + t * 128;
#pragma unroll
  for (int sg = 0; sg < 8; sg += 4) {
    if (sg <= w) {
      bf16x8 kf[4][8];
#pragma unroll
      for (int u = 0; u < 4; ++u) {
        if (sg + u <= w) {
          const bf16_t* kp = P.Pb + (size_t)(row0 + 16 * (sg + u) + (lane & 15)) * NG1 + 1024 + h * 256 + 8 * g;
#pragma unroll
          for (int ks = 0; ks < 8; ++ks) kf[u][ks] = *(const bf16x8*)(kp + 32 * ks);
        }
      }
#pragma unroll
      for (int u = 0; u < 4; ++u) {
        const int st = sg + u;
        f32x4 acc = (f32x4){0.f, 0.f, 0.f, 0.f};
        if (st <= w) {
#pragma unroll
          for (int ks = 0; ks < 8; ++ks) acc = __builtin_amdgcn_mfma_f32_16x16x32_bf16(kf[u][ks], qf[ks], acc, 0, 0, 0);
#pragma unroll
          for (int r = 0; r < 4; ++r) { const int s2 = 16 * st + 4 * g + r; acc[r] = (s2 <= t) ? acc[r] * __expf(sA[c * 128 + s2] - Mt) : 0.f; }
        }
        *(u32x2*)(sp + 16 * st + 4 * g) = pack4(acc);
      }
    } else {
#pragma unroll
      for (int u = 0; u < 4; ++u) *(u32x2*)(sp + 16 * (sg + u) + 4 * g) = (u32x2){0u, 0u};
    }
  }
  __syncthreads();
}

__device__ __forceinline__ bf16x8 trread8(unsigned a0, unsigned a1) {
  bf16x4 lo, hi;
  asm volatile("ds_read_b64_tr_b16 %0, %2\n\tds_read_b64_tr_b16 %1, %3\n\ts_waitcnt lgkmcnt(0)" : "=&v"(lo), "=&v"(hi) : "v"(a0), "v"(a1) : "memory");
  return __builtin_shufflevector(lo, hi, 0, 1, 2, 3, 4, 5, 6, 7);
}
__device__ __forceinline__ void trread8x3(unsigned a0, unsigned a1, unsigned a2, unsigned dlt, bf16x8& r0, bf16x8& r1, bf16x8& r2) {
  bf16x4 l0, h0, l1, h1, l2, h2;
  asm volatile("ds_read_b64_tr_b16 %0, %6\n\tds_read_b64_tr_b16 %1, %7\n\tds_read_b64_tr_b16 %2, %8\n\tds_read_b64_tr_b16 %3, %9\n\tds_read_b64_tr_b16 %4, %10\n\tds_read_b64_tr_b16 %5, %11\n\ts_waitcnt lgkmcnt(0)"
               : "=&v"(l0), "=&v"(h0), "=&v"(l1), "=&v"(h1), "=&v"(l2), "=&v"(h2)
               : "v"(a0), "v"(a0 + dlt), "v"(a1), "v"(a1 + dlt), "v"(a2), "v"(a2 + dlt) : "memory");
  r0 = __builtin_shufflevector(l0, h0, 0, 1, 2, 3, 4, 5, 6, 7); r1 = __builtin_shufflevector(l1, h1, 0, 1, 2, 3, 4, 5, 6, 7); r2 = __builtin_shufflevector(l2, h2, 0, 1, 2, 3, 4, 5, 6, 7);
}
__device__ __forceinline__ void trread8x2(unsigned a0, unsigned a1, unsigned dlt, bf16x8& r0, bf16x8& r1) {
  bf16x4 l0, h0, l1, h1;
  asm volatile("ds_read_b64_tr_b16 %0, %4\n\tds_read_b64_tr_b16 %1, %5\n\tds_read_b64_tr_b16 %2, %6\n\tds_read_b64_tr_b16 %3, %7\n\ts_waitcnt lgkmcnt(0)"
               : "=&v"(l0), "=&v"(h0), "=&v"(l1), "=&v"(h1) : "v"(a0), "v"(a0 + dlt), "v"(a1), "v"(a1 + dlt) : "memory");
  r0 = __builtin_shufflevector(l0, h0, 0, 1, 2, 3, 4, 5, 6, 7); r1 = __builtin_shufflevector(l1, h1, 0, 1, 2, 3, 4, 5, 6, 7);
}

constexpr int KS_STRIDE = 272, VS_STRIDE = 56;
constexpr int M2_K = 0, M2_V = 69632, M2_CL = 83968, M2_SC = 110080;
__device__ __forceinline__ void m2_item(const Params& P, int l, int item, unsigned char* shm) {
  const int tid = tidx(), w = __builtin_amdgcn_readfirstlane(tid >> 6), lane = tid & 63, g = lane >> 4, l15 = lane & 15;
  const int bh = item >> 3, j = item & 7, b = bh >> 2, h = bh & 3;
  bf16_t* Ksh = (bf16_t*)(shm + M2_K); bf16_t* Vsh = (bf16_t*)(shm + M2_V); bf16_t* Cl = (bf16_t*)(shm + M2_CL);
  float* sA = (float*)(shm + M2_SC); float* sM = sA + 2048; float* sB = sM + 2048; float* chain = sB + 2048;
  const unsigned lbase = (unsigned)(size_t)shm;
  u32x4 kreg[8]; u32x4 vreg;
  const int vs = tid >> 2, vpc = tid & 3;
  {
    const int row0 = b * 2048;
#pragma unroll
    for (int i = 0; i < 8; ++i) { const int piece = tid + 512 * i, s = piece >> 5, pc = piece & 31; kreg[i] = *(const u32x4*)(P.Pb + (size_t)(row0 + s) * NG1 + 1024 + h * 256 + 8 * pc); }
    vreg = *(const u32x4*)(P.Pb + (size_t)(row0 + vs) * NG1 + 2048 + h * 256 + 32 * j + 8 * vpc);
  }
  bf16x8 qf[8], sf[4];
  {
    const int t = 16 * w + l15;
#pragma unroll
    for (int ks = 0; ks < 8; ++ks) qf[ks] = (bf16x8){0, 0, 0, 0, 0, 0, 0, 0};
    const bf16_t* sp0 = P.St + (size_t)(bh * 16) * 16384 + t * 128 + 8 * g;
#pragma unroll
    for (int ks = 0; ks < 4; ++ks) sf[ks] = *(const bf16x8*)(sp0 + 32 * ks);
  }
  mlstm_scalars(P.gat, b, h, sA, sM, sB, chain);
  f32x4 Cacc[2][3];
#pragma unroll
  for (int dt = 0; dt < 2; ++dt)
#pragma unroll
    for (int et = 0; et < 3; ++et) Cacc[dt][et] = (f32x4){0.f, 0.f, 0.f, 0.f};
  const int trq = l15 >> 2, trp = lane & 3;
#define M2_WRITE_KV(cc) do { \
    const float ml_ = chain[17 + (cc)]; \
    _Pragma("unroll") for (int i = 0; i < 8; ++i) { const int piece = tid + 512 * i, s = piece >> 5, pc = piece & 31; \
      const float wk = __expf(sA[(cc) * 128 + s] - ml_); u32x4 sc; \
      _Pragma("unroll") for (int e = 0; e < 4; ++e) { const unsigned u = kreg[i][e]; sc[e] = pack2(bf2f(u & 0xffffu) * wk, bf2f(u >> 16) * wk); } \
      *(u32x4*)(Ksh + s * KS_STRIDE + 8 * pc) = sc; } \
    *(u32x4*)(Vsh + vs * VS_STRIDE + 8 * vpc) = vreg; \
    if (vpc == 0) { unsigned zz = 0u; asm volatile("" : "+v"(zz)); const u32x4 z = (u32x4){zz, zz, zz, zz}; u32x4 o1 = z; o1[0] = 0x3F80u; \
      *(u32x4*)(Vsh + vs * VS_STRIDE + 32) = o1; *(u32x4*)(Vsh + vs * VS_STRIDE + 40) = z; } } while (0)
  M2_WRITE_KV(0);
  __syncthreads();
  for (int c = 0; c < 16; ++c) {
    const int row0 = b * 2048 + c * 128;
    const float mlast = chain[17 + c], mprev = chain[c];
    if (c < 15) {
      const int nrow0 = row0 + 128;
#pragma unroll
      for (int i = 0; i < 8; ++i) { const int piece = tid + 512 * i, s = piece >> 5, pc = piece & 31; kreg[i] = *(const u32x4*)(P.Pb + (size_t)(nrow0 + s) * NG1 + 1024 + h * 256 + 8 * pc); }
      vreg = *(const u32x4*)(P.Pb + (size_t)(nrow0 + vs) * NG1 + 2048 + h * 256 + 32 * j + 8 * vpc);
    }
    {
      const int t = 16 * w + l15, row = row0 + t;
      f32x4 acc[3]; acc[0] = (f32x4){0.f, 0.f, 0.f, 0.f}; acc[1] = acc[0]; acc[2] = acc[0];
      const float Mt = sM[c * 128 + t];
      if (c > 0) {
#pragma unroll
        for (int ks = 0; ks < 8; ++ks) {
          bf16x8 cf[3];
#pragma unroll
          for (int et = 0; et < 3; ++et) cf[et] = *(const bf16x8*)(Cl + (16 * et + l15) * KS_STRIDE + 32 * ks + 8 * g);
          __builtin_amdgcn_sched_barrier(0);
#pragma unroll
          for (int et = 0; et < 3; ++et) acc[et] = __builtin_amdgcn_mfma_f32_16x16x32_bf16(cf[et], qf[ks], acc[et], 0, 0, 0);
          __builtin_amdgcn_sched_barrier(0);
        }
        const float wi = __expf(mprev - Mt);
        acc[0] *= wi; acc[1] *= wi; acc[2] *= wi;
      }
      const float ac = __expf(mprev - mlast);
#pragma unroll
      for (int dt = 0; dt < 2; ++dt)
#pragma unroll
        for (int et = 0; et < 3; ++et) Cacc[dt][et] *= ac;
#pragma unroll
      for (int ks = 0; ks < 4; ++ks) {
        bf16x8 kf[2], vf[3];
        const unsigned va = lbase + M2_V + (unsigned)((32 * ks + 8 * g + trq) * VS_STRIDE + 4 * trp) * 2u;
        const unsigned ka = lbase + M2_K + (unsigned)((32 * ks + 8 * g + trq) * KS_STRIDE + 32 * w + 4 * trp) * 2u;
        trread8x3(va, va + 32u, va + 64u, 4u * VS_STRIDE * 2u, vf[0], vf[1], vf[2]);
        trread8x2(ka, ka + 32u, 4u * KS_STRIDE * 2u, kf[0], kf[1]);
#pragma unroll
        for (int et = 0; et < 3; ++et) acc[et] = __builtin_amdgcn_mfma_f32_16x16x32_bf16(vf[et], sf[ks], acc[et], 0, 0, 0);
#pragma unroll
        for (int dt = 0; dt < 2; ++dt)
#pragma unroll
          for (int et = 0; et < 3; ++et) Cacc[dt][et] = __builtin_amdgcn_mfma_f32_16x16x32_bf16(kf[dt], vf[et], Cacc[dt][et], 0, 0, 0);
      }
      if (c < 15) {
        const bf16_t* qp = P.Pb + (size_t)(row + 128) * NG1 + h * 256 + 8 * g;
#pragma unroll
        for (int ks = 0; ks < 8; ++ks) qf[ks] = *(const bf16x8*)(qp + 32 * ks);
        const bf16_t* sp = P.St + (size_t)(bh * 16 + c + 1) * 16384 + t * 128 + 8 * g;
#pragma unroll
        for (int ks = 0; ks < 4; ++ks) sf[ks] = *(const bf16x8*)(sp + 32 * ks);
      }
      const float den = __shfl(acc[2][0], l15);
      const float dd = fmaxf(fabsf(den), __expf(-(sB[c * 128 + t] + Mt)));
      const float inv = __builtin_amdgcn_rcpf(dd);
      const f32x4 o0 = acc[0] * inv, o1 = acc[1] * inv;
      bf16_t* hp = P.hA + (size_t)row * DM + h * 256 + 32 * j + 4 * g;
      *(u32x2*)hp = pack4(o0); *(u32x2*)(hp + 16) = pack4(o1);
      float ss = (o0[0] * o0[0] + o0[1] * o0[1]) + (o0[2] * o0[2] + o0[3] * o0[3]) + (o1[0] * o1[0] + o1[1] * o1[1]) + (o1[2] * o1[2] + o1[3] * o1[3]);
      ss += __shfl_xor(ss, 16); ss += __shfl_xor(ss, 32);
      if (g == 0) P.hss[(size_t)row * 32 + h * 8 + j] = ss;
    }
    LDS_BARRIER();
#pragma unroll
    for (int dt = 0; dt < 2; ++dt)
#pragma unroll
      for (int et = 0; et < 3; ++et) *(u32x2*)(Cl + (16 * et + l15) * KS_STRIDE + 32 * w + 16 * dt + 4 * g) = pack4(Cacc[dt][et]);
    if (c < 15) M2_WRITE_KV(c + 1);
    LDS_BARRIER();
  }
#undef M2_WRITE_KV
  const size_t sidx = (size_t)(l * 8 + b) * 4 + h;
#pragma unroll
  for (int dt = 0; dt < 2; ++dt)
#pragma unroll
    for (int r = 0; r < 4; ++r) {
      const int d = 32 * w + 16 * dt + 4 * g + r;
      P.out[O_CP + sidx * 65536 + (size_t)d * 256 + 32 * j + l15] = Cacc[dt][0][r];
      P.out[O_CP + sidx * 65536 + (size_t)d * 256 + 32 * j + 16 + l15] = Cacc[dt][1][r];
      if (j == 0 && l15 == 0) P.out[O_NP + sidx * 256 + d] = Cacc[dt][2][r];
    }
  if (j == 0 && tid == 0) P.out[O_MP + sidx] = chain[16];
  __syncthreads();
}

__device__ __forceinline__ void msample_item(const Params& P, int l, int item, unsigned char* shm) {
  const int tid = tidx(), w = tid >> 6, lane = tid & 63;
  const int b = item >> 2, h = item & 3, row = NP + b;
  float* q = (float*)shm; float* k = q + 256; float* v = k + 256; float* red = v + 256; float* red2 = red + 2048;
  if (tid < 256) {
    const bf16_t* pr = P.Pb + (size_t)row * NG1 + h * 256 + tid;
    q[tid] = bf2f(pr[0]); k[tid] = bf2f(pr[1024]); v[tid] = bf2f(pr[2048]);
  }
  const float ig = P.gat[(size_t)row * 8 + h], lf = P.gat[(size_t)row * 8 + 4 + h];
  const size_t sidx = (size_t)(l * 128 + b) * 4 + h;
  const float m0 = P.st_m[sidx];
  const float inter = lf + m0, mt = fmaxf(inter, ig), wi = __expf(inter - mt), wa = __expf(ig - mt);
  __syncthreads();
  const float* C0 = P.st_C + sidx * 65536; float* Co = P.out + O_CS + sidx * 65536;
  const float* n0 = P.st_n + sidx * 256;
  const f32x4 v4 = *(const f32x4*)(v + 4 * lane);
  f32x4 acc = (f32x4){0.f, 0.f, 0.f, 0.f};
#pragma unroll 8
  for (int dd = 0; dd < 32; ++dd) {
    const int d = 32 * w + dd;
    const f32x4 c4 = __builtin_nontemporal_load((const f32x4*)(C0 + (size_t)d * 256 + 4 * lane));
    const float kd = wa * k[d], qd = q[d];
    __builtin_nontemporal_store(c4 * wi + v4 * kd, (f32x4*)(Co + (size_t)d * 256 + 4 * lane));
    acc += c4 * qd;
  }
  *(f32x4*)(red + w * 256 + 4 * lane) = acc;
  float qk = 0.f, qn = 0.f;
#pragma unroll
  for (int i = 0; i < 4; ++i) { const int d = lane + 64 * i; qk += q[d] * k[d]; qn += q[d] * n0[d]; }
  qk = wave_sum(qk); qn = wave_sum(qn);
  __syncthreads();
  const float s = qk * wa, den = wi * qn + s, ddn = fmaxf(fabsf(den), __expf(-mt));
  float hval = 0.f;
  if (tid < 256) {
    float num = 0.f;
#pragma unroll
    for (int i = 0; i < 8; ++i) num += red[i * 256 + tid];
    hval = (wi * num + s * v[tid]) / ddn;
    P.hA[(size_t)row * DM + h * 256 + tid] = f2bf(hval);
    P.out[O_NS + sidx * 256 + tid] = wi * n0[tid] + wa * k[tid];
  }
  float ss = wave_sum(hval * hval);
  if (lane == 0) red2[w] = ss;
  __syncthreads();
  if (tid < 8) P.hss[(size_t)row * 32 + h * 8 + tid] = tid == 0 ? (red2[0] + red2[1] + red2[2] + red2[3]) : 0.f;
  if (tid == 0) P.out[O_MS + sidx] = mt;
  __syncthreads();
}

__device__ __forceinline__ void s5_load_C(const Params& P, int l, int g, float* Csh) {
  for (int i = tidx(); i < 2048; i += 512) { const int ri = i >> 10, c = (i >> 6) & 15, p = i & 63;
    Csh[ri * 1088 + c * 68 + p] = (ri ? P.C_im : P.C_re)[(size_t)l * 32768 + (g * 16 + c) * 64 + p]; }
}
__device__ __forceinline__ void s5_sample_item(const Params& P, int l, int item, unsigned char* shm) {
  const int tid = tidx(), w = tid >> 6, lane = tid & 63;
  const int g = item & 31, bs0 = (item >> 5) * 16 + 2 * w;
  float* Csh = (float*)shm; float* sbuf = Csh + 2176 + w * 2176;
  s5_load_C(P, l, g, Csh);
  const float are = P.abar[l][g * 64 + lane], aim = P.abar[l][2048 + g * 64 + lane];
  float bre[16], bim[16];
#pragma unroll
  for (int c = 0; c < 16; ++c) { bre[c] = P.bbar[l][(g * 16 + c) * 64 + lane]; bim[c] = P.bbar[l][32768 + (g * 16 + c) * 64 + lane]; }
  const int ch = lane >> 2, pq = lane & 3;
  const float Dc = P.D_skip[l * 512 + g * 16 + ch];
  __syncthreads();
#pragma unroll
  for (int rep = 0; rep < 2; ++rep) {
    const int bs = bs0 + rep, row = NP + bs;
    const size_t o = ((size_t)(l * 128 + bs) * 32 + g) * 64 + lane;
    const float s0r = P.st_sre[o], s0i = P.st_sim[o];
    const bf16_t* up = P.Pb + (size_t)row * NG1 + 4096 + g * 16;
    const u32x4 u0 = *(const u32x4*)up, u1 = *(const u32x4*)(up + 8);
    float br = 0.f, bi = 0.f;
#pragma unroll
    for (int i = 0; i < 4; ++i) {
      const float ua = bf2f(u0[i] & 0xffffu), ub = bf2f(u0[i] >> 16), uc = bf2f(u1[i] & 0xffffu), ud = bf2f(u1[i] >> 16);
      br += bre[2 * i] * ua + bre[2 * i + 1] * ub + bre[8 + 2 * i] * uc + bre[8 + 2 * i + 1] * ud;
      bi += bim[2 * i] * ua + bim[2 * i + 1] * ub + bim[8 + 2 * i] * uc + bim[8 + 2 * i + 1] * ud;
    }
    const float sr = are * s0r - aim * s0i + br, si = are * s0i + aim * s0r + bi;
    P.out[O_SRS + o] = sr; P.out[O_SIS + o] = si;
    sbuf[rep * 136 + lane] = sr; sbuf[rep * 136 + 68 + lane] = si;
    asm volatile("s_waitcnt lgkmcnt(0)" ::: "memory");
    float acc = 0.f;
#pragma unroll
    for (int p4 = 0; p4 < 4; ++p4) {
      const int p0 = 16 * pq + 4 * p4;
      const f32x4 vr = *(const f32x4*)(sbuf + rep * 136 + p0), vi = *(const f32x4*)(sbuf + rep * 136 + 68 + p0);
      const f32x4 cr = *(const f32x4*)(Csh + ch * 68 + p0), ci = *(const f32x4*)(Csh + 1088 + ch * 68 + p0);
      acc += (cr[0] * vr[0] + cr[1] * vr[1]) + (cr[2] * vr[2] + cr[3] * vr[3]) - (ci[0] * vi[0] + ci[1] * vi[1]) - (ci[2] * vi[2] + ci[3] * vi[3]);
    }
    acc += __shfl_xor(acc, 1); acc += __shfl_xor(acc, 2);
    if (pq == 0) {
      const float uc = bf2f(up[ch]);
      P.ysb[(size_t)row * 512 + g * 16 + ch] = f2bf(gelu_tanh(acc + Dc * uc));
    }
  }
  __syncthreads();
}

__device__ __forceinline__ void prep_s5tables(const Params& P, int item, unsigned char* shm) {
  const int tid = tidx(), l = item >> 5, g = item & 31;
  float* pwr = (float*)shm; float* pwi = pwr + 17 * 64; float* bbr = pwi + 17 * 64; float* bbi = bbr + 1024; float* Ccr = bbi + 1024; float* Cci = Ccr + 1024;
  if (tid < 64) {
    const int p = tid, gp = g * 64 + p;
    const float dt = expf(P.log_dt[l * 32 + g]);
    const float Ar = P.A_re[l * 2048 + gp], Ai = P.A_im[l * 2048 + gp];
    const float mag = expf(dt * Ar);
    float sn, cs; sincosf(dt * Ai, &sn, &cs);
    const float abr = mag * cs, abi = mag * sn;
    const float den = Ar * Ar + Ai * Ai, nr = abr - 1.0f, ni = abi;
    const float fre = (nr * Ar + ni * Ai) / den, fim = (ni * Ar - nr * Ai) / den;
    float pr = 1.f, pi = 0.f;
    for (int t = 0; t <= 16; ++t) { pwr[t * 64 + p] = pr; pwi[t * 64 + p] = pi; const float a = pr * abr - pi * abi, b = pr * abi + pi * abr; pr = a; pi = b; }
    for (int c = 0; c < 16; ++c) {
      const float Br = P.B_re[(size_t)l * 32768 + gp * 16 + c], Bi = P.B_im[(size_t)l * 32768 + gp * 16 + c];
      bbr[p * 16 + c] = fre * Br - fim * Bi; bbi[p * 16 + c] = fre * Bi + fim * Br;
    }
  }
  for (int i = tid; i < 1024; i += 512) { Ccr[i] = P.C_re[(size_t)l * 32768 + g * 1024 + i]; Cci[i] = P.C_im[(size_t)l * 32768 + g * 1024 + i]; }
  __syncthreads();
  bf16_t* Kt = P.Kt[l] + (size_t)g * 17 * 256; bf16_t* Gm = P.Gm[l] + (size_t)g * 32768; bf16_t* Hm = P.Hm[l] + (size_t)g * 32768;
  for (int o = tid; o < 17 * 256; o += 512) {
    const int tau = o >> 8, c = (o >> 4) & 15, c2 = o & 15;
    float acc = 0.f;
    if (tau < 16) for (int p = 0; p < 64; ++p) {
      const float pr = pwr[tau * 64 + p], pi = pwi[tau * 64 + p], br = bbr[p * 16 + c2], bi = bbi[p * 16 + c2];
      const float zr = pr * br - pi * bi, zi = pr * bi + pi * br;
      acc += Ccr[c * 64 + p] * zr - Cci[c * 64 + p] * zi;
    }
    Kt[o] = f2bf(acc);
  }
  for (int o = tid; o < 32768; o += 512) {
    { const int tc = o >> 7, q = o & 127, t = tc >> 4, c = tc & 15, p = q & 63;
      const float cr = Ccr[c * 64 + p], ci = Cci[c * 64 + p], pr = pwr[(t + 1) * 64 + p], pi = pwi[(t + 1) * 64 + p];
      Gm[o] = f2bf(q < 64 ? (cr * pr - ci * pi) : -(cr * pi + ci * pr)); }
    { const int q = o >> 8, jc = o & 255, j = jc >> 4, c2 = jc & 15, p = q & 63;
      const float pr = pwr[(15 - j) * 64 + p], pi = pwi[(15 - j) * 64 + p], br = bbr[p * 16 + c2], bi = bbi[p * 16 + c2];
      Hm[o] = f2bf(q < 64 ? (pr * br - pi * bi) : (pr * bi + pi * br)); }
  }
  if (tid < 64) { P.a16[l][g * 64 + tid] = pwr[16 * 64 + tid]; P.a16[l][2048 + g * 64 + tid] = pwi[16 * 64 + tid]; }
  __syncthreads();
}
constexpr int S3_R0 = 0, S3_SIN = 69632, S3_KT = 69632 + 34816;
__device__ __forceinline__ void s5_stage3_item(const Params& P, int l, int item, unsigned char* shm) {
  const int tid = tidx(), w = tid >> 6, lane = tid & 63, g4 = lane >> 4, l15 = lane & 15;
  const int b = item >> 5, g = item & 31;
  float* Ebuf = (float*)(shm + S3_R0); bf16_t* Gsh = (bf16_t*)(shm + S3_R0); bf16_t* Sin = (bf16_t*)(shm + S3_SIN); bf16_t* Ksh = (bf16_t*)(shm + S3_KT);
  { bf16_t* Hsh = (bf16_t*)(shm + S3_R0); const bf16_t* Hm = P.Hm[l] + (size_t)g * 32768;
#pragma unroll
    for (int i = 0; i < 8; ++i) { const int piece = tid + 512 * i, r = piece >> 5, pc = piece & 31; *(u32x4*)(Hsh + r * 264 + 8 * pc) = *(const u32x4*)(Hm + r * 256 + 8 * pc); } }
  { const bf16_t* Kt = P.Kt[l] + (size_t)g * 17 * 256; for (int i = tid; i < 544; i += 512) *(u32x4*)(Ksh + 8 * i) = *(const u32x4*)(Kt + 8 * i); }
  const int n = 16 * w + l15, r0 = b * 2048 + n * 16;
  bf16x8 uf[8];
#pragma unroll
  for (int ks = 0; ks < 8; ++ks) uf[ks] = *(const bf16x8*)(P.Pb + (size_t)(r0 + 2 * ks + (g4 >> 1)) * NG1 + 4096 + g * 16 + 8 * (g4 & 1));
  __syncthreads();
  {
    const bf16_t* Hsh = (const bf16_t*)(shm + S3_R0);
    f32x4 eacc[8];
#pragma unroll
    for (int qt = 0; qt < 8; ++qt) {
      eacc[qt] = (f32x4){0.f, 0.f, 0.f, 0.f};
#pragma unroll
      for (int ks = 0; ks < 8; ++ks) { const bf16x8 x = *(const bf16x8*)(Hsh + (16 * qt + l15) * 264 + 32 * ks + 8 * g4); eacc[qt] = __builtin_amdgcn_mfma_f32_16x16x32_bf16(x, uf[ks], eacc[qt], 0, 0, 0); }
    }
    __syncthreads();
#pragma unroll
    for (int qt = 0; qt < 8; ++qt) *(f32x4*)(Ebuf + n * 128 + 16 * qt + 4 * g4) = eacc[qt];
  }
  __syncthreads();
  {
    const float ar = P.a16[l][g * 64 + lane], ai = P.a16[l][2048 + g * 64 + lane];
    float lr[16], li[16], sr = 0.f, si = 0.f;
#pragma unroll
    for (int k = 0; k < 16; ++k) {
      lr[k] = sr; li[k] = si;
      const float er = Ebuf[(16 * w + k) * 128 + lane], ei = Ebuf[(16 * w + k) * 128 + 64 + lane];
      const float nr = ar * sr - ai * si + er, ni = ar * si + ai * sr + ei; sr = nr; si = ni;
    }
    float* wend = (float*)(shm + S3_KT + 8704);
    wend[w * 128 + lane] = sr; wend[w * 128 + 64 + lane] = si;
    float br = ar, bi = ai;
#pragma unroll
    for (int i = 0; i < 4; ++i) { const float nr = br * br - bi * bi, ni = 2.f * br * bi; br = nr; bi = ni; }
    __syncthreads();
    float cr = 0.f, ci = 0.f;
    for (int w2 = 0; w2 < w; ++w2) { const float er = wend[w2 * 128 + lane], ei = wend[w2 * 128 + 64 + lane]; const float nr = br * cr - bi * ci + er, ni = br * ci + bi * cr + ei; cr = nr; ci = ni; }
    float pr = 1.f, pi = 0.f;
#pragma unroll
    for (int k = 0; k < 16; ++k) {
      Sin[(16 * w + k) * 136 + lane] = f2bf(lr[k] + pr * cr - pi * ci); Sin[(16 * w + k) * 136 + 64 + lane] = f2bf(li[k] + pr * ci + pi * cr);
      const float nr = pr * ar - pi * ai, ni = pr * ai + pi * ar; pr = nr; pi = ni;
    }
    if (w == 7) { const size_t o = ((size_t)(l * 8 + b) * 32 + g) * 64 + lane; P.out[O_SRP + o] = sr + pr * cr - pi * ci; P.out[O_SIP + o] = si + pr * ci + pi * cr; }
  }
  __syncthreads();
  { const bf16_t* Gm = P.Gm[l] + (size_t)g * 32768;
#pragma unroll
    for (int i = 0; i < 8; ++i) { const int piece = tid + 512 * i, r = piece >> 4, pc = piece & 15; *(u32x4*)(Gsh + r * 136 + 8 * pc) = *(const u32x4*)(Gm + r * 128 + 8 * pc); } }
  __syncthreads();
  bf16x8 sf[4];
#pragma unroll
  for (int k2 = 0; k2 < 4; ++k2) sf[k2] = *(const bf16x8*)(Sin + n * 136 + 32 * k2 + 8 * g4);
  const f32x4 D4 = *(const f32x4*)(P.D_skip + l * 512 + g * 16 + 4 * g4);
#pragma unroll
  for (int t = 0; t < 16; ++t) {
    f32x4 acc = (f32x4){0.f, 0.f, 0.f, 0.f};
    const int row = r0 + t;
    const f32x4 u4 = unpack4(*(const u32x2*)(P.Pb + (size_t)row * NG1 + 4096 + g * 16 + 4 * g4));
#pragma unroll
    for (int ks = 0; ks <= (t >> 1); ++ks) {
      const int tau = t - (2 * ks + (g4 >> 1)), idx = tau >= 0 ? tau : 16;
      const bf16x8 x = *(const bf16x8*)(Ksh + (idx * 16 + l15) * 16 + 8 * (g4 & 1));
      acc = __builtin_amdgcn_mfma_f32_16x16x32_bf16(x, uf[ks], acc, 0, 0, 0);
    }
#pragma unroll
    for (int k2 = 0; k2 < 4; ++k2) { const bf16x8 x = *(const bf16x8*)(Gsh + (t * 16 + l15) * 136 + 32 * k2 + 8 * g4); acc = __builtin_amdgcn_mfma_f32_16x16x32_bf16(x, sf[k2], acc, 0, 0, 0); }
    f32x4 y;
#pragma unroll
    for (int r = 0; r < 4; ++r) y[r] = gelu_tanh(acc[r] + D4[r] * u4[r]);
    *(u32x2*)(P.ysb + (size_t)row * 512 + g * 16 + 4 * g4) = pack4(y);
  }
  __syncthreads();
}

__device__ __forceinline__ void headnorm_rows(const Params& P, int l, int bid, int G) {
  const int w = tidx() >> 6, lane = tidx() & 63;
  constexpr int R1 = 6400;
  const bool split = (G == 256);
  const int rbeg = split ? (bid < 128 ? bid * 8 + w : R1 + (bid - 128) * 8 + w) : bid * 8 + w;
  const int rend = split ? (bid < 128 ? R1 : NT) : NT, rstep = split ? 128 * 8 : G * 8;
  for (int row = rbeg; row < rend; row += rstep) {
    if (lane == 0) { P.ssA[row] = 0ull; P.ssB[row] = 0ull; }
#pragma unroll
    for (int h = 0; h < 4; ++h) {
      const f32x4 s0 = *(const f32x4*)(P.hss + (size_t)row * 32 + h * 8), s1 = *(const f32x4*)(P.hss + (size_t)row * 32 + h * 8 + 4);
      const float ss = (s0[0] + s0[1]) + (s0[2] + s0[3]) + (s1[0] + s1[1]) + (s1[2] + s1[3]);
      const float rh = rsqrtf(ss * (1.0f / 256.0f) + 1e-6f);
      const int col = h * 256 + 4 * lane;
      const f32x4 hv = unpack4(*(const u32x2*)(P.hA + (size_t)row * DM + col));
      const f32x4 so = unpack4(*(const u32x2*)(P.Pb + (size_t)row * NG1 + 3072 + col));
      const f32x4 gh = *(const f32x4*)(P.g_hn + l * 1024 + col);
      *(u32x2*)(P.xa + (size_t)row * DM + col) = pack4(so * hv * gh * rh);
    }
  }
}
__device__ __forceinline__ void final_rows(const Params& P, int bid, int G) {
  const int w = tidx() >> 6, lane = tidx() & 63;
  for (int row = bid * 8 + w; row < NT; row += G * 8) {
    const float rs = rs_of(P.ssA[row]);
    float* o = row < NP ? P.out + O_YP + (size_t)row * DM : P.out + O_YS + (size_t)(row - NP) * DM;
#pragma unroll
    for (int i = 0; i < 4; ++i) {
      const int col = 256 * i + 4 * lane;
      const f32x4 v = *(const f32x4*)(P.X2 + (size_t)row * DM + col);
      const f32x4 gf = *(const f32x4*)(P.g_final + col);
      *(f32x4*)(o + col) = v * gf * rs;
    }
  }
}


#define XB_TMO      128
#define XB_XCNT(j)  (256  + 64 * (j))
#define XB_XSUB(j)  (1280 + 64 * (j))
#define XB_XGEN(j)  (2304 + 64 * (j))
#define XB_TOP      3328
#define XB_TOPGEN   3392
#define XCD_BAR_WORDS 3456
#define XB_SPIN_CAP (1u << 22)
__device__ __forceinline__ unsigned xb_ld(unsigned* p)              { return __hip_atomic_load(p, __ATOMIC_RELAXED, __HIP_MEMORY_SCOPE_AGENT); }
__device__ __forceinline__ unsigned xb_add(unsigned* p, unsigned v) { return __hip_atomic_fetch_add(p, v, __ATOMIC_RELAXED, __HIP_MEMORY_SCOPE_AGENT); }
__device__ __forceinline__ unsigned xb_xcc_id() { return (unsigned)__builtin_amdgcn_s_getreg((3 << 11) | 20) & 0xFu; }
#define XB_SPIN(cond, bar) do { unsigned _sp = 0; while (cond) { __builtin_amdgcn_s_sleep(1); \
    if ((++_sp & 255u) == 0u) { if (xb_ld(&(bar)[XB_TMO])) break; if (_sp > XB_SPIN_CAP) { atomicAdd(&(bar)[XB_TMO], 1u); break; } } } } while (0)
struct XcdBarrier { unsigned* bar; unsigned x; volatile LAS unsigned* st; };
__device__ __forceinline__ XcdBarrier xcd_barrier_post(unsigned* bar, volatile LAS unsigned* st) {
  XcdBarrier b; b.bar = bar; b.x = xb_xcc_id(); b.st = st;
  if (threadIdx.x == 0) (void)xb_add(&bar[XB_XCNT(b.x)], 1u);
  return b;
}
__device__ __forceinline__ void xcd_barrier_complete(unsigned* bar, unsigned x, unsigned& nloc, unsigned& nx) {
  const unsigned G = gridDim.x * gridDim.y * gridDim.z;
  unsigned sum, cnt, mine, sp = 0u;
  for (;;) {
    sum = 0u; cnt = 0u; mine = 0u;
#pragma unroll
    for (unsigned j = 0; j < 16; ++j) { const unsigned c = xb_ld(&bar[XB_XCNT(j)]); sum += c; cnt += (c > 0u) ? 1u : 0u; mine = (j == x) ? c : mine; }
    if (sum == G) break;
    __builtin_amdgcn_s_sleep(1);
    if ((++sp & 255u) == 0u) { if (xb_ld(&bar[XB_TMO])) break; if (sp > XB_SPIN_CAP) { atomicAdd(&bar[XB_TMO], 1u); break; } }
  }
  nloc = mine > 0u ? mine : 1u; nx = cnt > 0u ? cnt : 1u;
}
__device__ __forceinline__ void xcd_barrier(const XcdBarrier& b) {
  asm volatile("s_waitcnt vmcnt(0)" ::: "memory");
  __syncthreads();
  if (threadIdx.x == 0) {
    unsigned* bar = b.bar;
    __builtin_amdgcn_s_waitcnt(0);
    unsigned nloc = b.st[0], nx = b.st[1];
    if (nloc == 0u) { xcd_barrier_complete(bar, b.x, nloc, nx); b.st[0] = nloc; b.st[1] = nx; }
    const unsigned old = xb_add(&bar[XB_XSUB(b.x)], 1u);
    const unsigned gen = old / nloc;
    if (old + 1u == (gen + 1u) * nloc) {
      __builtin_amdgcn_fence(__ATOMIC_RELEASE, "agent");
      asm volatile("s_waitcnt vmcnt(0)" ::: "memory");
      const unsigned og = xb_add(&bar[XB_TOP], 1u);
      const unsigned tg = og / nx;
      if (og + 1u == (tg + 1u) * nx) xb_add(&bar[XB_TOPGEN], 1u);
      else XB_SPIN(xb_ld(&bar[XB_TOPGEN]) == tg, bar);
      __builtin_amdgcn_fence(__ATOMIC_ACQUIRE, "agent");
      xb_add(&bar[XB_XGEN(b.x)], 1u);
      asm volatile("s_waitcnt vmcnt(0)" ::: "memory");
    } else {
      XB_SPIN(xb_ld(&bar[XB_XGEN(b.x)]) == gen, bar);
      __builtin_amdgcn_fence(__ATOMIC_ACQUIRE, "agent");
      asm volatile("s_waitcnt vmcnt(0)" ::: "memory");
    }
  }
  __syncthreads();
}

__global__ void __launch_bounds__(512) mega(const Params P) {
  extern __shared__ __attribute__((aligned(16))) unsigned char shm[];
  cg::grid_group grid = cg::this_grid();
  LAS unsigned char* lds = (LAS unsigned char*)shm;
  const int bid = blockIdx.x, G = gridDim.x;

  volatile LAS unsigned* xst = (volatile LAS unsigned*)(lds + LDS_BYTES - 16);
  if (threadIdx.x == 0) { xst[0] = 0u; xst[1] = 0u; }
  if (bid == 0) for (int i = threadIdx.x; i < XCD_BAR_WORDS; i += 512) P.bar[i] = 0u;
  REP(1) prep_phase(P, shm, bid, G);
  grid.sync();
  const XcdBarrier xb = xcd_barrier_post(P.bar, xst);

  for (int l = 0; l < 2; ++l) {
    REP(2) {
      F1 f; f.bias = P.b_in + l * PTOT; f.Pb = P.Pb; f.rs = P.ssA; f.ss = nullptr;
      gemm_main_window(lds, P.xb, P.WinT[l], 4096, 1024, f, 0, bid, G);
      gemm_main_window(lds, P.xb, P.WinT[l] + (size_t)4608 * 1024, 2048, 1024, f, 4608, bid, G);
      skinny_run(f, P.xb, 1024, P.WinT[l], NP, 1, NG1 / 16, bid, G, shm, 0);
      Fg fg; fg.bias = P.b_in + l * PTOT + 4096; fg.gat = P.gat; fg.rs = P.ssA; fg.ss = nullptr;
      REP(256) skinny_run(fg, P.xb, 1024, P.WgT[l], 0, 129, 1, bid, G, shm, 0);
    }
    xcd_barrier(xb);
    { F1 f; f.bias = P.b_in + l * PTOT; f.Pb = P.Pb; f.rs = P.ssA; f.ss = nullptr;
      gemm_main_window(lds, P.xb, P.WinT[l] + (size_t)4096 * 1024, 512, 1024, f, 4096, bid, G); }
    {
      const int n1 = G == 256 ? (bid < 128 ? 1 : 3) : (512 - bid + G - 1) / G;
      for (int j = 0; j < n1; ++j) m1_item(P, G == 256 ? (bid < 128 ? bid : 128 + (bid - 128) * 3 + j) : bid + j * G, shm);
      for (int it = bid; it < 512; it += G) msample_item(P, l, it, shm);
      for (int it = bid; it < 256; it += G) s5_sample_item(P, l, it, shm);
    }
    xcd_barrier(xb);
    REP(8) for (int it = bid; it < 256; it += G) m2_item(P, l, G == 256 ? (((it & 7) * 4 + (it >> 6)) * 8 + ((it >> 3) & 7)) : it, shm);
    REP(16) for (int it = bid; it < 256; it += G) s5_stage3_item(P, l, G == 256 ? ((it & 7) * 32 + (it >> 3)) : it, shm);
    xcd_barrier(xb);
    REP(32) {
      Fglu f; f.bias = P.b_glu + l * 512; f.ysb = P.ysb; f.ys2 = P.ys2; f.ss = nullptr;
      gemm_all(lds, shm, P.ysb, P.WgluT[l], 512, 512, f, bid, G);
      headnorm_rows(P, l, bid, G);
    }
    xcd_barrier(xb);
    REP(32) {
      Fa fa; fa.Pb = P.Pb; fa.t1 = P.t1; fa.ss = nullptr;
      gemm_all(lds, shm, P.xa, P.WaT[l], 1024, 1024, fa, bid, G);
      Fb fb; fb.Pb = P.Pb; fb.t1 = P.t1; fb.mg = P.mg; fb.ss = nullptr;
      gemm_all(lds, shm, P.ys2, P.WbT[l], 1024, 512, fb, bid, G);
    }
    xcd_barrier(xb);
    REP(32) {
      Fres f; f.xinP = l == 0 ? P.x_prompt : P.X2; f.xinS = l == 0 ? P.x_sample : P.X2 + (size_t)NP * DM; f.xo = P.X1; f.xb = P.xb; f.ss = P.ssB;
      gemm_all(lds, shm, P.mg, P.WoT[l], 1024, 1024, f, bid, G);
    }
    xcd_barrier(xb);
    REP(64) {
      F13 f; f.rs = P.ssB; f.act = P.act;
      pg8::Gemm g; g.A = P.xb; g.Bt = P.W13T[l]; g.M = NP; g.N = 2 * DFF; g.K = 1024;
      pg8::StaticOrder S; S.init(NP, 2 * DFF, G, bid);
      EpiMain13 E; E.f = f;
      REP(512) pg8::gemm_phase(lds, g, S, E);
      REP(256) skinny_run13(f, P.xb, P.W13T[l], bid, G, shm);
    }
    xcd_barrier(xb);
    REP(64) {
      Fres f; f.xinP = P.X1; f.xinS = P.X1 + (size_t)NP * DM; f.xo = P.X2; f.xb = P.xb; f.ss = P.ssA;
      gemm_all(lds, shm, P.act, P.W2T[l], 1024, DFF, f, bid, G);
    }
    xcd_barrier(xb);
  }
  final_rows(P, bid, G);
}

extern "C" void kernel_launch(void* const* d_in, const int* in_sizes, int n_in, void* d_out, int out_size, void* d_ws, size_t ws_size, hipStream_t stream) {
  constexpr size_t kDynLds = LDS_BYTES;
  static int grid_blocks = 0;
  if (!grid_blocks) {
    int dev = 0, cus = 0, per_cu = 0;
    (void)hipGetDevice(&dev);
    (void)hipDeviceGetAttribute(&cus, hipDeviceAttributeMultiprocessorCount, dev);
    (void)hipFuncSetAttribute((const void*)mega, hipFuncAttributeMaxDynamicSharedMemorySize, (int)kDynLds);
    (void)hipOccupancyMaxActiveBlocksPerMultiprocessor(&per_cu, mega, 512, kDynLds);
    if (per_cu > 1) per_cu = 1;
    grid_blocks = cus * per_cu;
    if (grid_blocks > 256) grid_blocks = 256;
  }
  Params p;
  memset(&p, 0, sizeof(p));
  const float* const* in = (const float* const*)d_in;
  p.x_prompt = in[0]; p.x_sample = in[1]; p.st_C = in[2]; p.st_n = in[3]; p.st_m = in[4]; p.st_sre = in[5]; p.st_sim = in[6];
  p.g_mix = in[7]; p.w_in = in[8]; p.b_in = in[9]; p.g_hn = in[10]; p.w_a = in[11]; p.A_re = in[12]; p.A_im = in[13]; p.log_dt = in[14];
  p.B_re = in[15]; p.B_im = in[16]; p.C_re = in[17]; p.C_im = in[18]; p.D_skip = in[19]; p.w_glu = in[20]; p.b_glu = in[21]; p.w_b = in[22]; p.w_out = in[23];
  p.g_ffn = in[24]; p.w_ff1 = in[25]; p.w_ff3 = in[26]; p.w_ff2 = in[27]; p.g_final = in[28];
  p.out = (float*)d_out;
  char* base = (char*)d_ws; size_t off = 0;
  auto alloc = [&](size_t bytes) { char* r = base + off; off += (bytes + 255) & ~(size_t)255; return r; };
  for (int l = 0; l < 2; ++l) {
    p.WinT[l] = (bf16_t*)alloc((size_t)NG1 * 1024 * 2); p.WgT[l] = (bf16_t*)alloc(16 * 1024 * 2); p.WgluT[l] = (bf16_t*)alloc(512 * 512 * 2);
    p.WaT[l] = (bf16_t*)alloc(1024 * 1024 * 2); p.WbT[l] = (bf16_t*)alloc(1024 * 512 * 2); p.WoT[l] = (bf16_t*)alloc(1024 * 1024 * 2);
    p.W13T[l] = (bf16_t*)alloc((size_t)2 * DFF * 1024 * 2); p.W2T[l] = (bf16_t*)alloc((size_t)1024 * DFF * 2);
    p.abar[l] = (float*)alloc(4096 * 4); p.bbar[l] = (float*)alloc(65536 * 4);
  }
  p.xb = (bf16_t*)alloc((size_t)NT * DM * 2); p.Pb = (bf16_t*)alloc((size_t)NT * NG1 * 2); p.St = (bf16_t*)alloc((size_t)512 * 16384 * 2);
  p.ysb = (bf16_t*)alloc((size_t)NT * 512 * 2); p.ys2 = (bf16_t*)alloc((size_t)NT * 512 * 2); p.xa = (bf16_t*)alloc((size_t)NT * DM * 2);
  p.mg = (bf16_t*)alloc((size_t)NT * DM * 2); p.act = (bf16_t*)alloc((size_t)NT * DFF * 2);
  p.X1 = (float*)alloc((size_t)NT * DM * 4); p.X2 = (float*)alloc((size_t)NT * DM * 4);
  p.ssA = (unsigned long long*)alloc((size_t)NT * 8); p.ssB = (unsigned long long*)alloc((size_t)NT * 8); p.bar = (unsigned*)alloc(XCD_BAR_WORDS * 4);
  for (int l = 0; l < 2; ++l) { p.Kt[l] = (bf16_t*)alloc(32 * 17 * 256 * 2); p.Gm[l] = (bf16_t*)alloc(32 * 32768 * 2); p.Hm[l] = (bf16_t*)alloc(32 * 32768 * 2); p.a16[l] = (float*)alloc(4096 * 4); }
  p.E2 = (float*)alloc((size_t)8 * 128 * 32 * 128 * 4);
  p.gat = (float*)alloc((size_t)NT * 8 * 4); p.hA = (bf16_t*)alloc((size_t)NT * DM * 2); p.hss = (float*)alloc((size_t)NT * 32 * 4);
  p.t1 = (bf16_t*)alloc((size_t)NT * DM * 2); p.Eend = (float*)alloc((size_t)2 * 524288 * 4);
  int nj = 0, tile0 = 0;
  auto job = [&](const float* src, const float* scale, bf16_t* dst, int ldn, int c0, int ncols, int K, int mode, int r0, int nwrite) {
    TJob& J = p.jobs[nj++]; J.src = src; J.scale = scale; J.dst = dst; J.ldn = ldn; J.c0 = c0; J.ncols = ncols; J.K = K; J.mode = mode; J.r0 = r0;
    J.tile0 = tile0; J.ntn = (ncols + 63) / 64; J.nwrite = nwrite; J.pad = 0; tile0 += J.ntn * (K / 64);
  };
  for (int l = 0; l < 2; ++l) {
    const float* win = p.w_in + (size_t)l * 1024 * PTOT; const float* gm = p.g_mix + l * 1024; const float* gf = p.g_ffn + l * 1024;
    job(win, gm, p.WinT[l], PTOT, 0, 4096, 1024, 0, 0, 4096);
    job(win, gm, p.WinT[l], PTOT, 4104, 512, 1024, 0, 4096, 512);
    job(win, gm, p.WinT[l], PTOT, 4616, 2048, 1024, 0, 4608, 2048);
    job(win, gm, p.WgT[l], PTOT, 4096, 8, 1024, 0, 0, 16);
    job(p.w_glu + (size_t)l * 512 * 512, nullptr, p.WgluT[l], 512, 0, 512, 512, 0, 0, 512);
    job(p.w_a + (size_t)l * 1024 * 1024, nullptr, p.WaT[l], 1024, 0, 1024, 1024, 0, 0, 1024);
    job(p.w_b + (size_t)l * 512 * 1024, nullptr, p.WbT[l], 1024, 0, 1024, 512, 0, 0, 1024);
    job(p.w_out + (size_t)l * 1024 * 1024, nullptr, p.WoT[l], 1024, 0, 1024, 1024, 0, 0, 1024);
    job(p.w_ff1 + (size_t)l * 1024 * DFF, gf, p.W13T[l], DFF, 0, DFF, 1024, 1, 0, DFF);
    job(p.w_ff3 + (size_t)l * 1024 * DFF, gf, p.W13T[l], DFF, 0, DFF, 1024, 2, 0, DFF);
    job(p.w_ff2 + (size_t)l * DFF * 1024, nullptr, p.W2T[l], 1024, 0, 1024, DFF, 0, 0, 1024);
  }
  p.njobs = nj; p.total_tiles = tile0;
  void* args[] = {&p};
  hipError_t e = hipLaunchCooperativeKernel((void*)mega, dim3(grid_blocks), dim3(512), args, kDynLds, stream);
  if (e != hipSuccess) fprintf(stderr, "cooperative launch failed: %s (grid %d)\n", hipGetErrorString(e), grid_blocks);
}
```

```cpp
#include <hip/hip_runtime.h>
#include <hip/hip_cooperative_groups.h>
#include <cstdio>
#include <cstring>
namespace cg = cooperative_groups;

#define LAS __attribute__((address_space(3)))
typedef unsigned short bf16_t;
typedef short bf16x8 __attribute__((ext_vector_type(8)));
typedef short bf16x4 __attribute__((ext_vector_type(4)));
typedef float f32x4 __attribute__((ext_vector_type(4)));
typedef unsigned u32x4 __attribute__((ext_vector_type(4)));
typedef unsigned u32x2 __attribute__((ext_vector_type(2)));

constexpr int NP = 16384, NS = 128, NT = 16512, DM = 1024, NG1 = 6656, DFF = 2816, PTOT = 6664;
constexpr int LDS_BYTES = 150 * 1024;
#ifndef DUPMASK
#define DUPMASK 0
#endif
#define REP(bit) for (int rep_ = 0; rep_ < ((DUPMASK & (bit)) ? 2 : 1); ++rep_)
constexpr size_t O_YP = 0, O_YS = 16777216, O_CP = 16908288, O_NP = 21102592, O_MP = 21118976, O_SRP = 21119040, O_SIP = 21151808,
                 O_CS = 21184576, O_NS = 88293440, O_MS = 88555584, O_SRS = 88556608, O_SIS = 89080896;

struct TJob { const float* src; const float* scale; bf16_t* dst; int ldn, c0, ncols, K, mode, r0, tile0, ntn, nwrite, pad; };

struct Params {
  const float *x_prompt, *x_sample, *st_C, *st_n, *st_m, *st_sre, *st_sim;
  const float *g_mix, *w_in, *b_in, *g_hn, *w_a, *A_re, *A_im, *log_dt, *B_re, *B_im, *C_re, *C_im, *D_skip, *w_glu, *b_glu, *w_b, *w_out,
      *g_ffn, *w_ff1, *w_ff3, *w_ff2, *g_final;
  float* out;
  bf16_t *WinT[2], *WgT[2], *WgluT[2], *WaT[2], *WbT[2], *WoT[2], *W13T[2], *W2T[2];
  float *abar[2], *bbar[2];
  bf16_t *xb, *Pb, *St, *ysb, *ys2, *xa, *mg, *act;
  float *X1, *X2, *gat, *hss, *Eend; bf16_t *hA, *t1;
  unsigned long long *ssA, *ssB;
  unsigned* bar;
  bf16_t *Kt[2], *Gm[2], *Hm[2]; float *a16[2], *E2;
  TJob jobs[22];
  int njobs, total_tiles;
};

__device__ __forceinline__ bf16_t f2bf(float f) { return __builtin_bit_cast(bf16_t, (__bf16)f); }
__device__ __forceinline__ float bf2f(unsigned b) { return __uint_as_float(b << 16); }
typedef float f32x2 __attribute__((ext_vector_type(2)));
typedef __bf16 bf16x2v __attribute__((ext_vector_type(2)));
__device__ __forceinline__ unsigned pack2(float lo, float hi) { const f32x2 v = {lo, hi}; const bf16x2v b = __builtin_convertvector(v, bf16x2v); return __builtin_bit_cast(unsigned, b); }
__device__ __forceinline__ u32x2 pack4(f32x4 v) { u32x2 r; r.x = pack2(v[0], v[1]); r.y = pack2(v[2], v[3]); return r; }
__device__ __forceinline__ f32x4 unpack4(u32x2 u) { f32x4 r; r[0] = bf2f(u.x & 0xffffu); r[1] = bf2f(u.x >> 16); r[2] = bf2f(u.y & 0xffffu); r[3] = bf2f(u.y >> 16); return r; }
__device__ __forceinline__ float sigmoidf_(float x) { return __builtin_amdgcn_rcpf(1.0f + __expf(-x)); }
__device__ __forceinline__ float gelu_tanh(float x) { float z = 0.7978845608f * (x + 0.044715f * x * x * x); float e = __expf(2.0f * z); float th = 1.0f - 2.0f * __builtin_amdgcn_rcpf(e + 1.0f); return 0.5f * x * (1.0f + th); }
__device__ __forceinline__ int tidx() { int t = threadIdx.x; asm volatile("" : "+v"(t)); return t; }
#define LDS_BARRIER() do { asm volatile("s_waitcnt lgkmcnt(0)" ::: "memory"); __builtin_amdgcn_s_barrier(); asm volatile("" ::: "memory"); } while (0)
__device__ __forceinline__ float wave_sum(float v) { for (int o = 32; o > 0; o >>= 1) v += __shfl_xor(v, o); return v; }

namespace pg8 {
constexpr int BM = 256, BK = 64, HALF = 128, HTB = HALF * BK * 2, STAGE_BYTES = 8 * HTB, NXCD = 8, WGM = 8;
__host__ __device__ __forceinline__ int lds_byte(int r, int c) { const int st = (r >> 4) * 2 + (c >> 5), rr = r & 15, cc = c & 31, ob = rr * 64 + cc * 2; return st * 1024 + (ob ^ (((ob >> 9) & 1) << 5)); }
__host__ __device__ __forceinline__ void stage_rc(int b, int& R, int& C) { const int st = b / 1024, sb = b % 1024, swz = sb ^ (((sb >> 9) & 1) << 5); R = (st >> 1) * 16 + swz / 64; C = (st & 1) * 32 + (swz % 64) / 2; }
__host__ __device__ __forceinline__ int perm32(int rho) { const int n = rho >> 4, i = rho & 15; return 8 * (i >> 2) + 4 * n + (i & 3); }
struct Unit { int pm, pn; };
struct Gemm { const bf16_t* A; const bf16_t* Bt; int M, N, K; };
struct StaticOrder {
  int nM, nN, nwg, G, c;
  __device__ void init(int M, int N, int G_, int c_) { nM = M / BM; nN = N / BM; nwg = nM * nN; G = G_; c = c_; }
  __device__ bool next(int i, Unit& u) const {
    const long L = (long)i * G + c; if (L >= nwg) return false;
    int wgid = (int)L; { const int q = nwg / NXCD, r = nwg % NXCD, xcd = wgid % NXCD, off = wgid / NXCD; wgid = (xcd < r ? xcd * (q + 1) : r * (q + 1) + (xcd - r) * q) + off; }
    const int nig = WGM * nN, gid = wgid / nig, fm = gid * WGM, gsz = (nM - fm) < WGM ? (nM - fm) : WGM;
    u.pm = fm + ((wgid % nig) % gsz); u.pn = (wgid % nig) / gsz; return true;
  }
};

template <class Epi, class Sched>
__device__ __forceinline__ void gemm_phase(LAS unsigned char* lds, const Gemm g, const Sched& S, const Epi& E) {
  const int tid = tidx(), wid = __builtin_amdgcn_readfirstlane(tid >> 6), lane = tid & 63, wr = wid >> 2, wc = wid & 3, fr = lane & 15, fq = lane >> 4;
  const int K = g.K, nt = K / BK;
  unsigned voffA[2], voffB[2];
#pragma unroll
  for (int i = 0; i < 2; ++i) { int R, C; stage_rc(tid * 16 + i * 8192, R, C); voffA[i] = (unsigned)(R * K + C) * 2u; const int Rb = Epi::PERM ? ((R & ~31) + perm32(R & 31)) : R; voffB[i] = (unsigned)(Rb * K + C) * 2u; }
  const size_t kstep = (size_t)(BK * 2);
  const size_t hstep = (size_t)HALF * K * 2;
  const size_t tstep = 2 * hstep;
  const unsigned ldsw = (unsigned)wid * 1024u;
  const int aoff = lds_byte(wr * 64 + fr, fq * 8), boff = lds_byte(wc * 32 + fr, fq * 8);
#define PG8_SA(b, h) (((b) * 2 + (h)) * HTB)
#define PG8_SB(b, h) ((4 + (b) * 2 + (h)) * HTB)
#define PG8_STAGE(bufoff, gbase, voff) do { _Pragma("unroll") for (int _i = 0; _i < 2; ++_i) \
    __builtin_amdgcn_global_load_lds((const unsigned*)((const char*)(gbase) + (voff)[_i]), (LAS unsigned*)(lds + (bufoff) + ldsw + _i * 8192), 16, 0, 0); } while (0)
#define PG8_LDA(dst, b, h) do { _Pragma("unroll") for (int m = 0; m < 4; ++m) _Pragma("unroll") for (int k = 0; k < 2; ++k) dst[m][k] = *(const LAS bf16x8*)(lds + PG8_SA(b, h) + aoff + m * 2048 + k * 1024); } while (0)
#define PG8_LDB(dst, b, h) do { _Pragma("unroll") for (int n = 0; n < 2; ++n) _Pragma("unroll") for (int k = 0; k < 2; ++k) dst[n][k] = *(const LAS bf16x8*)(lds + PG8_SB(b, h) + boff + n * 2048 + k * 1024); } while (0)
#define PG8_MMA(ai, bj, At, Bt) do { __builtin_amdgcn_s_setprio(1); _Pragma("unroll") for (int m = 0; m < 4; ++m) _Pragma("unroll") for (int n = 0; n < 2; ++n) _Pragma("unroll") for (int k = 0; k < 2; ++k) \
    acc[ai][bj][m][n] = __builtin_amdgcn_mfma_f32_16x16x32_bf16(Bt[n][k], At[m][k], acc[ai][bj][m][n], 0, 0, 0); __builtin_amdgcn_s_setprio(0); } while (0)
#define PG8_WAIT_V(n) asm volatile("s_waitcnt vmcnt(" #n ")" ::: "memory")
#define PG8_WAIT_L(n) asm volatile("s_waitcnt lgkmcnt(" #n ")" ::: "memory")
#define PG8_BAR __builtin_amdgcn_s_barrier()
#define PG8_SCHED __builtin_amdgcn_sched_barrier(0)
  Unit cur, nxt; int ui = 0;
  if (!S.next(0, cur)) return;
  f32x4 acc[2][2][4][2];
#pragma unroll
  for (int a = 0; a < 2; ++a)
#pragma unroll
    for (int b = 0; b < 2; ++b)
#pragma unroll
      for (int m = 0; m < 4; ++m)
#pragma unroll
        for (int n = 0; n < 2; ++n) acc[a][b][m][n] = (f32x4){0.f, 0.f, 0.f, 0.f};
  bf16x8 At[4][2], B0[2][2], B1[2][2];
  const char* cA = (const char*)g.A + (size_t)cur.pm * tstep; const char* cB = (const char*)g.Bt + (size_t)cur.pn * tstep;
  PG8_STAGE(PG8_SB(0, 0), cB, voffB); PG8_STAGE(PG8_SA(0, 0), cA, voffA); PG8_STAGE(PG8_SB(0, 1), cB + hstep, voffB); PG8_STAGE(PG8_SA(0, 1), cA + hstep, voffA);
  if (wr == 1) PG8_BAR;
  PG8_WAIT_V(4); PG8_BAR;
  PG8_STAGE(PG8_SB(1, 0), cB + kstep, voffB); PG8_STAGE(PG8_SA(1, 0), cA + kstep, voffA); PG8_STAGE(PG8_SB(1, 1), cB + hstep + kstep, voffB);
  PG8_WAIT_V(6); PG8_BAR;
  for (;;) {
    const bool has_next = S.next(ui + 1, nxt);
    const char* nA = has_next ? (const char*)g.A + (size_t)nxt.pm * tstep : cA; const char* nB = has_next ? (const char*)g.Bt + (size_t)nxt.pn * tstep : cB;
    for (int t = 0; t < nt; t += 2) {
      const bool last = (t == nt - 2);
      const char* a1 = cA + (size_t)(t + 1) * kstep;
      const char* a2 = last ? nA : cA + (size_t)(t + 2) * kstep; const char* b2 = last ? nB : cB + (size_t)(t + 2) * kstep;
      const char* a3 = a2 + kstep; const char* b3 = b2 + kstep;
      PG8_LDB(B0, 0, 0); PG8_SCHED; PG8_LDA(At, 0, 0); PG8_STAGE(PG8_SA(1, 1), a1 + hstep, voffA);
      PG8_WAIT_L(8); PG8_BAR; PG8_WAIT_L(0); PG8_MMA(0, 0, At, B0); PG8_BAR; PG8_SCHED;
      PG8_LDB(B1, 0, 1); PG8_STAGE(PG8_SB(0, 0), b2, voffB);
      PG8_BAR; PG8_WAIT_L(0); PG8_MMA(0, 1, At, B1); PG8_BAR;
      PG8_LDA(At, 0, 1); PG8_STAGE(PG8_SA(0, 0), a2, voffA);
      PG8_BAR; PG8_WAIT_L(0); PG8_MMA(1, 0, At, B0); PG8_BAR; PG8_SCHED;
      PG8_STAGE(PG8_SB(0, 1), b2 + hstep, voffB);
      PG8_WAIT_V(6); PG8_BAR; PG8_MMA(1, 1, At, B1); PG8_BAR;
      PG8_LDB(B0, 1, 0); PG8_SCHED; PG8_LDA(At, 1, 0); PG8_STAGE(PG8_SA(0, 1), a2 + hstep, voffA);
      PG8_WAIT_L(8); PG8_BAR; PG8_WAIT_L(0); PG8_MMA(0, 0, At, B0); PG8_BAR; PG8_SCHED;
      PG8_LDB(B1, 1, 1); PG8_STAGE(PG8_SB(1, 0), b3, voffB);
      PG8_BAR; PG8_WAIT_L(0); PG8_MMA(0, 1, At, B1); PG8_BAR;
      PG8_LDA(At, 1, 1); PG8_STAGE(PG8_SA(1, 0), a3, voffA);
      PG8_BAR; PG8_WAIT_L(0); PG8_MMA(1, 0, At, B0); PG8_BAR; PG8_SCHED;
      PG8_STAGE(PG8_SB(1, 1), b3 + hstep, voffB);
      PG8_WAIT_V(6); PG8_BAR; PG8_MMA(1, 1, At, B1); PG8_BAR;
    }
    E(acc, cur, wr, wc, fr, fq);
    if (!has_next) break;
#pragma unroll
    for (int a = 0; a < 2; ++a)
#pragma unroll
      for (int b = 0; b < 2; ++b)
#pragma unroll
        for (int m = 0; m < 4; ++m)
#pragma unroll
          for (int n = 0; n < 2; ++n) acc[a][b][m][n] = (f32x4){0.f, 0.f, 0.f, 0.f};
    cur = nxt; cA = nA; cB = nB; ++ui;
  }
  PG8_WAIT_V(0);
  if (wr == 0) PG8_BAR;
  PG8_BAR;
#undef PG8_SA
#undef PG8_SB
#undef PG8_STAGE
#undef PG8_LDA
#undef PG8_LDB
#undef PG8_MMA
#undef PG8_WAIT_V
#undef PG8_WAIT_L
#undef PG8_BAR
#undef PG8_SCHED
}
}

typedef unsigned long long u64;
__device__ __forceinline__ u64 ss_fix(float ss) { return (u64)(ss * 16777216.0f); }
__device__ __forceinline__ float rs_of(u64 q) { const float f = (float)(unsigned)(q >> 32) * 4294967296.0f + (float)(unsigned)q; return rsqrtf(f * (1.0f / (16777216.0f * 1024.0f)) + 1e-6f); }
__device__ __forceinline__ void ss_add(u64* p, float ss) { __hip_atomic_fetch_add(p, ss_fix(ss), __ATOMIC_RELAXED, __HIP_MEMORY_SCOPE_AGENT); }
__device__ __forceinline__ int qcol(int cbase, int q) { return cbase + (q >> 1) * 128 + (q & 1) * 16; }
__device__ __forceinline__ f32x4 unlo(u32x4 u) { return unpack4((u32x2){u[0], u[1]}); }
__device__ __forceinline__ f32x4 unhi(u32x4 u) { return unpack4((u32x2){u[2], u[3]}); }
__device__ __forceinline__ u32x4 pack8(f32x4 a, f32x4 b) { const u32x2 p = pack4(a), q = pack4(b); return (u32x4){p.x, p.y, q.x, q.y}; }
struct F1 {
  static constexpr bool NEEDR = true, STAT = false, PERM = true; static constexpr int RB = 8;
  const float* bias; bf16_t* Pb; const u64* rs; u64* ss;
  struct ColData { f32x4 b[4]; }; struct RowData { u64 s; };
  __device__ __forceinline__ void load_cols(int cbase, ColData& cd) const {
#pragma unroll
    for (int q = 0; q < 4; ++q) { const int col = cbase + (q >> 1) * 128 + (q & 1) * 4; cd.b[q] = *(const f32x4*)(bias + (col < 4096 ? col : col + 8)); } }
  __device__ __forceinline__ void load_row(int row, int, RowData& rd) const { rd.s = rs[row]; }
  __device__ __forceinline__ float apply(int row, int cbase, const f32x4 (&v)[4], const ColData& cd, const RowData& rd) const {
    const float r = rs_of(rd.s);
    const int blk = cbase >> 8;
    const bool isk = blk >= 4 && blk < 8, issig = (blk >= 12 && blk < 16) || blk >= 18;
#pragma unroll
    for (int bj = 0; bj < 2; ++bj) {
      u32x4 pk;
#pragma unroll
      for (int n = 0; n < 2; ++n) {
        f32x4 o = v[bj * 2 + n] * r + cd.b[bj * 2 + n];
        if (isk) o = o * 0.0625f;
        else if (issig) { o[0] = sigmoidf_(o[0]); o[1] = sigmoidf_(o[1]); o[2] = sigmoidf_(o[2]); o[3] = sigmoidf_(o[3]); }
        const u32x2 p2 = pack4(o); pk[2 * n] = p2.x; pk[2 * n + 1] = p2.y;
      }
      *(u32x4*)(Pb + (size_t)row * NG1 + cbase + bj * 128) = pk;
    }
    return 0.f;
  }
  __device__ __forceinline__ float rowscale(int row) const { return rs_of(rs[row]); }
  __device__ __forceinline__ float operator()(int row, int col, f32x4 v, float r) const {
    const int bi = col < 4096 ? col : col + 8;
    const f32x4 b4 = *(const f32x4*)(bias + bi);
    f32x4 o = v * r + b4;
    if (col >= 1024 && col < 2048) o = o * 0.0625f;
    else if ((col >= 3072 && col < 4096) || col >= 4608) { o[0] = sigmoidf_(o[0]); o[1] = sigmoidf_(o[1]); o[2] = sigmoidf_(o[2]); o[3] = sigmoidf_(o[3]); }
    *(u32x2*)(Pb + (size_t)row * NG1 + col) = pack4(o);
    return 0.f;
  }
};
struct Fg {
  static constexpr bool NEEDR = true, STAT = false;
  const float* bias; float* gat; const u64* rs; u64* ss;
  __device__ __forceinline__ float rowscale(int row) const { return rs_of(rs[row]); }
  __device__ __forceinline__ float operator()(int row, int col, f32x4 v, float r) const {
    if (col < 8) {
      const f32x4 b4 = *(const f32x4*)(bias + col);
      f32x4 o = v * r + b4;
      if (col >= 4) {
#pragma unroll
        for (int i = 0; i < 4; ++i) { const float x = o[i]; o[i] = fminf(x, 0.f) - log1pf(__expf(-fabsf(x))); }
      }
      *(f32x4*)(gat + (size_t)row * 8 + col) = o;
    }
    return 0.f;
  }
};
struct Fglu {
  static constexpr bool NEEDR = false, STAT = false, PERM = true; static constexpr int RB = 8;
  const float* bias; const bf16_t* ysb; bf16_t* ys2; u64* ss;
  struct ColData { f32x4 b[4]; }; struct RowData { u32x4 y[2]; };
  __device__ __forceinline__ void load_cols(int cbase, ColData& cd) const {
#pragma unroll
    for (int q = 0; q < 4; ++q) cd.b[q] = *(const f32x4*)(bias + cbase + (q >> 1) * 128 + (q & 1) * 4); }
  __device__ __forceinline__ void load_row(int row, int cbase, RowData& rd) const {
#pragma unroll
    for (int bj = 0; bj < 2; ++bj) rd.y[bj] = *(const u32x4*)(ysb + (size_t)row * 512 + cbase + bj * 128); }
  __device__ __forceinline__ float apply(int row, int cbase, const f32x4 (&v)[4], const ColData& cd, const RowData& rd) const {
#pragma unroll
    for (int bj = 0; bj < 2; ++bj) {
      const f32x4 y0 = unlo(rd.y[bj]), y1 = unhi(rd.y[bj]); f32x4 o0, o1;
#pragma unroll
      for (int i = 0; i < 4; ++i) { o0[i] = y0[i] * sigmoidf_(v[bj * 2][i] + cd.b[bj * 2][i]); o1[i] = y1[i] * sigmoidf_(v[bj * 2 + 1][i] + cd.b[bj * 2 + 1][i]); }
      *(u32x4*)(ys2 + (size_t)row * 512 + cbase + bj * 128) = pack8(o0, o1);
    }
    return 0.f;
  }
  struct Pre { f32x4 b; u32x2 y; };
  __device__ __forceinline__ Pre pre(int row, int col) const { Pre p; p.b = *(const f32x4*)(bias + col); p.y = *(const u32x2*)(ysb + (size_t)row * 512 + col); return p; }
  __device__ __forceinline__ float post(int row, int col, f32x4 v, const Pre& p) const {
    const f32x4 y = unpack4(p.y); f32x4 o;
#pragma unroll
    for (int i = 0; i < 4; ++i) o[i] = y[i] * sigmoidf_(v[i] + p.b[i]);
    *(u32x2*)(ys2 + (size_t)row * 512 + col) = pack4(o); return 0.f; }
  __device__ __forceinline__ float rowscale(int) const { return 1.f; }
  __device__ __forceinline__ float operator()(int row, int col, f32x4 v, float) const {
    const f32x4 b4 = *(const f32x4*)(bias + col);
    const f32x4 y = unpack4(*(const u32x2*)(ysb + (size_t)row * 512 + col));
    f32x4 o;
#pragma unroll
    for (int i = 0; i < 4; ++i) o[i] = y[i] * sigmoidf_(v[i] + b4[i]);
    *(u32x2*)(ys2 + (size_t)row * 512 + col) = pack4(o);
    return 0.f;
  }
};
struct Fa {
  static constexpr bool NEEDR = false, STAT = false, PERM = true; static constexpr int RB = 8;
  const bf16_t* Pb; bf16_t* t1; u64* ss;
  struct ColData { int dummy; }; struct RowData { u32x4 g[2]; };
  __device__ __forceinline__ void load_cols(int, ColData&) const {}
  __device__ __forceinline__ void load_row(int row, int cbase, RowData& rd) const {
#pragma unroll
    for (int bj = 0; bj < 2; ++bj) rd.g[bj] = *(const u32x4*)(Pb + (size_t)row * NG1 + 4608 + cbase + bj * 128); }
  __device__ __forceinline__ float apply(int row, int cbase, const f32x4 (&v)[4], const ColData&, const RowData& rd) const {
#pragma unroll
    for (int bj = 0; bj < 2; ++bj) *(u32x4*)(t1 + (size_t)row * DM + cbase + bj * 128) = pack8(unlo(rd.g[bj]) * v[bj * 2], unhi(rd.g[bj]) * v[bj * 2 + 1]);
    return 0.f;
  }
  struct Pre { u32x2 g; };
  __device__ __forceinline__ Pre pre(int row, int col) const { Pre p; p.g = *(const u32x2*)(Pb + (size_t)row * NG1 + 4608 + col); return p; }
  __device__ __forceinline__ float post(int row, int col, f32x4 v, const Pre& p) const { *(u32x2*)(t1 + (size_t)row * DM + col) = pack4(unpack4(p.g) * v); return 0.f; }
  __device__ __forceinline__ float rowscale(int) const { return 1.f; }
  __device__ __forceinline__ float operator()(int row, int col, f32x4 v, float) const {
    const f32x4 sg = unpack4(*(const u32x2*)(Pb + (size_t)row * NG1 + 4608 + col));
    *(u32x2*)(t1 + (size_t)row * DM + col) = pack4(sg * v);
    return 0.f;
  }
};
struct Fb {
  static constexpr bool NEEDR = false, STAT = false, PERM = true; static constexpr int RB = 4;
  const bf16_t* Pb; const bf16_t* t1; bf16_t* mg; u64* ss;
  struct ColData { int dummy; }; struct RowData { u32x4 g[2]; u32x4 t[2]; };
  __device__ __forceinline__ void load_cols(int, ColData&) const {}
  __device__ __forceinline__ void load_row(int row, int cbase, RowData& rd) const {
#pragma unroll
    for (int bj = 0; bj < 2; ++bj) { rd.g[bj] = *(const u32x4*)(Pb + (size_t)row * NG1 + 5632 + cbase + bj * 128); rd.t[bj] = *(const u32x4*)(t1 + (size_t)row * DM + cbase + bj * 128); } }
  __device__ __forceinline__ float apply(int row, int cbase, const f32x4 (&v)[4], const ColData&, const RowData& rd) const {
#pragma unroll
    for (int bj = 0; bj < 2; ++bj) *(u32x4*)(mg + (size_t)row * DM + cbase + bj * 128) = pack8(unlo(rd.t[bj]) + unlo(rd.g[bj]) * v[bj * 2], unhi(rd.t[bj]) + unhi(rd.g[bj]) * v[bj * 2 + 1]);
    return 0.f;
  }
  struct Pre { u32x2 g; u32x2 t; };
  __device__ __forceinline__ Pre pre(int row, int col) const { Pre p; p.g = *(const u32x2*)(Pb + (size_t)row * NG1 + 5632 + col); p.t = *(const u32x2*)(t1 + (size_t)row * DM + col); return p; }
  __device__ __forceinline__ float post(int row, int col, f32x4 v, const Pre& p) const { *(u32x2*)(mg + (size_t)row * DM + col) = pack4(unpack4(p.t) + unpack4(p.g) * v); return 0.f; }
  __device__ __forceinline__ float rowscale(int) const { return 1.f; }
  __device__ __forceinline__ float operator()(int row, int col, f32x4 v, float) const {
    const f32x4 sg = unpack4(*(const u32x2*)(Pb + (size_t)row * NG1 + 5632 + col));
    const f32x4 t = unpack4(*(const u32x2*)(t1 + (size_t)row * DM + col));
    *(u32x2*)(mg + (size_t)row * DM + col) = pack4(t + sg * v);
    return 0.f;
  }
};
struct Fres {
  static constexpr bool NEEDR = false, STAT = true, PERM = true; static constexpr int RB = 4;
  const float *xinP, *xinS; float* xo; bf16_t* xb; u64* ss;
  struct ColData { int dummy; }; struct RowData { f32x4 x[4]; };
  __device__ __forceinline__ void load_cols(int, ColData&) const {}
  __device__ __forceinline__ void load_row(int row, int cbase, RowData& rd) const {
#pragma unroll
    for (int q = 0; q < 4; ++q) rd.x[q] = *(const f32x4*)(xinP + (size_t)row * DM + cbase + (q >> 1) * 128 + (q & 1) * 4); }
  __device__ __forceinline__ float apply(int row, int cbase, const f32x4 (&v)[4], const ColData&, const RowData& rd) const {
    float s = 0.f;
#pragma unroll
    for (int bj = 0; bj < 2; ++bj) {
      const f32x4 o0 = rd.x[bj * 2] + v[bj * 2], o1 = rd.x[bj * 2 + 1] + v[bj * 2 + 1];
      float* xp = xo + (size_t)row * DM + cbase + bj * 128;
      *(f32x4*)xp = o0; *(f32x4*)(xp + 4) = o1;
      const u32x2 p0 = pack4(o0), p1 = pack4(o1);
      *(u32x4*)(xb + (size_t)row * DM + cbase + bj * 128) = (u32x4){p0.x, p0.y, p1.x, p1.y};
      s += (o0[0] * o0[0] + o0[1] * o0[1]) + (o0[2] * o0[2] + o0[3] * o0[3]) + (o1[0] * o1[0] + o1[1] * o1[1]) + (o1[2] * o1[2] + o1[3] * o1[3]);
    }
    return s;
  }
  struct Pre { f32x4 x; };
  __device__ __forceinline__ Pre pre(int row, int col) const { Pre p; const float* xi = row < NP ? xinP + (size_t)row * DM : xinS + (size_t)(row - NP) * DM; p.x = *(const f32x4*)(xi + col); return p; }
  __device__ __forceinline__ float post(int row, int col, f32x4 v, const Pre& p) const {
    const f32x4 o = p.x + v;
    *(f32x4*)(xo + (size_t)row * DM + col) = o; *(u32x2*)(xb + (size_t)row * DM + col) = pack4(o);
    return (o[0] * o[0] + o[1] * o[1]) + (o[2] * o[2] + o[3] * o[3]); }
  __device__ __forceinline__ float rowscale(int) const { return 1.f; }
  __device__ __forceinline__ float operator()(int row, int col, f32x4 v, float) const {
    const float* xi = row < NP ? xinP + (size_t)row * DM : xinS + (size_t)(row - NP) * DM;
    const f32x4 o = *(const f32x4*)(xi + col) + v;
    *(f32x4*)(xo + (size_t)row * DM + col) = o;
    *(u32x2*)(xb + (size_t)row * DM + col) = pack4(o);
    return (o[0] * o[0] + o[1] * o[1]) + (o[2] * o[2] + o[3] * o[3]);
  }
};
struct F13 {
  const u64* rs; bf16_t* act;
  __device__ __forceinline__ float rowscale(int row) const { return rs_of(rs[row]); }
  __device__ __forceinline__ f32x4 glu(f32x4 a1, f32x4 a3, float r) const {
    f32x4 o;
#pragma unroll
    for (int i = 0; i < 4; ++i) { const float x1 = a1[i] * r, x3 = a3[i] * r; o[i] = x1 * sigmoidf_(x1) * x3; }
    return o;
  }
  __device__ __forceinline__ void pair(int row, int j, f32x4 a1, f32x4 a3, float r) const { *(u32x2*)(act + (size_t)row * DFF + j) = pack4(glu(a1, a3, r)); }
};

template <class F> struct EpiMain {
  static constexpr bool PERM = F::PERM;
  F f; int coff;
  __device__ __forceinline__ void operator()(const f32x4 (&acc)[2][2][4][2], const pg8::Unit& u, int wr, int wc, int fr, int fq) const {
    const int rbase = u.pm * 256 + wr * 64 + fr, cbase = coff + u.pn * 256 + wc * 32 + (F::PERM ? 8 : 4) * fq;
    typename F::ColData cd; f.load_cols(cbase, cd);
#pragma unroll
    for (int b0 = 0; b0 < 8; b0 += F::RB) {
      typename F::RowData rd[F::RB];
#pragma unroll
      for (int k = 0; k < F::RB; ++k) { const int i = b0 + k; f.load_row(rbase + (i >> 2) * 128 + (i & 3) * 16, cbase, rd[k]); }
      __builtin_amdgcn_sched_barrier(0);
#pragma unroll
      for (int k = 0; k < F::RB; ++k) {
        const int i = b0 + k, ai = i >> 2, m = i & 3, row = rbase + ai * 128 + m * 16;
        const f32x4 v[4] = {acc[ai][0][m][0], acc[ai][0][m][1], acc[ai][1][m][0], acc[ai][1][m][1]};
        float s = f.apply(row, cbase, v, cd, rd[k]);
        if (F::STAT) { s += __shfl_xor(s, 16); s += __shfl_xor(s, 32); if (fq == 0) ss_add(f.ss + row, s); }
      }
      __builtin_amdgcn_sched_barrier(0);
    }
  }
};
struct EpiMain13 {
  static constexpr bool PERM = true;
  F13 f;
  __device__ __forceinline__ void operator()(const f32x4 (&acc)[2][2][4][2], const pg8::Unit& u, int wr, int wc, int fr, int fq) const {
    const int rbase = u.pm * 256 + wr * 64 + fr, jbase = u.pn * 128 + wc * 32 + 8 * fq;
    u64 sq[8];
#pragma unroll
    for (int i = 0; i < 8; ++i) sq[i] = f.rs[rbase + (i >> 2) * 128 + (i & 3) * 16];
    __builtin_amdgcn_sched_barrier(0);
#pragma unroll
    for (int i = 0; i < 8; ++i) {
      const int ai = i >> 2, m = i & 3, row = rbase + ai * 128 + m * 16;
      const float r = rs_of(sq[i]);
      *(u32x4*)(f.act + (size_t)row * DFF + jbase) = pack8(f.glu(acc[ai][0][m][0], acc[ai][1][m][0], r), f.glu(acc[ai][0][m][1], acc[ai][1][m][1], r));
    }
  }
};

template <int NACC>
__device__ __forceinline__ void skinny_unit(const bf16_t* A, int K, const bf16_t* Bt, int row0, int brow0, int bstep, float* red, f32x4 (&out)[NACC]) {
  const int tid = tidx(), w = tid >> 6, lane = tid & 63, g4 = lane >> 4, l15 = lane & 15;
  const int nks = K >> 8, kbase = w * (K >> 3) + 8 * g4;
  f32x4 acc[8][NACC];
#pragma unroll
  for (int rt = 0; rt < 8; ++rt)
#pragma unroll
    for (int i = 0; i < NACC; ++i) acc[rt][i] = (f32x4){0.f, 0.f, 0.f, 0.f};
  const bf16_t* ap = A + (size_t)(row0 + l15) * K + kbase;
  const bf16_t* bp = Bt + (size_t)(brow0 + l15) * K + kbase;
  for (int ks = 0; ks < nks; ks += 2) {
    const bool two = ks + 1 < nks;
    bf16x8 a0[8], a1[8], b0[NACC], b1[NACC];
#pragma unroll
    for (int rt = 0; rt < 8; ++rt) a0[rt] = *(const bf16x8*)(ap + (size_t)16 * rt * K + 32 * ks);
#pragma unroll
    for (int i = 0; i < NACC; ++i) b0[i] = *(const bf16x8*)(bp + (size_t)bstep * i * K + 32 * ks);
    if (two) {
#pragma unroll
      for (int rt = 0; rt < 8; ++rt) a1[rt] = *(const bf16x8*)(ap + (size_t)16 * rt * K + 32 * ks + 32);
#pragma unroll
      for (int i = 0; i < NACC; ++i) b1[i] = *(const bf16x8*)(bp + (size_t)bstep * i * K + 32 * ks + 32);
    }
#pragma unroll
    for (int rt = 0; rt < 8; ++rt)
#pragma unroll
      for (int i = 0; i < NACC; ++i) acc[rt][i] = __builtin_amdgcn_mfma_f32_16x16x32_bf16(b0[i], a0[rt], acc[rt][i], 0, 0, 0);
    if (two) {
#pragma unroll
      for (int rt = 0; rt < 8; ++rt)
#pragma unroll
        for (int i = 0; i < NACC; ++i) acc[rt][i] = __builtin_amdgcn_mfma_f32_16x16x32_bf16(b1[i], a1[rt], acc[rt][i], 0, 0, 0);
    }
  }
#pragma unroll
  for (int rt = 0; rt < 8; ++rt)
#pragma unroll
    for (int i = 0; i < NACC; ++i) *(f32x4*)(red + (size_t)(((w * 8 + rt) * NACC + i) * 64 + lane) * 4) = acc[rt][i];
  __syncthreads();
#pragma unroll
  for (int i = 0; i < NACC; ++i) {
    f32x4 t = (f32x4){0.f, 0.f, 0.f, 0.f};
#pragma unroll
    for (int ww = 0; ww < 8; ++ww) t += *(const f32x4*)(red + (size_t)(((ww * 8 + w) * NACC + i) * 64 + lane) * 4);
    out[i] = t;
  }
}
template <class F, int NA = 1>
__device__ __forceinline__ void skinny_run(const F& f, const bf16_t* A, int K, const bf16_t* Bt, int rowbase, int nrt, int ncu, int bid, int G, unsigned char* shm, int c0 = 0) {
  const int tid = tidx(), w = tid >> 6, lane = tid & 63, g = lane >> 4;
  const int ncu2 = ncu / NA, total = nrt * ncu2, nc = G - c0;
  if (bid < c0) return;
  for (int su = (G - 1 - bid); su < total; su += nc) {
    const int rt = su / ncu2, cu = su - rt * ncu2;
    const int row0 = rowbase + rt * 128, arow = row0 + 16 * w + (lane & 15);
    f32x4 acc[NA];
    const float rs = F::NEEDR ? f.rowscale(arow) : 1.f;
    skinny_unit<NA>(A, K, Bt, row0, 16 * NA * cu, 16, (float*)shm, acc);
#pragma unroll
    for (int i = 0; i < NA; ++i) {
      float ss = f(arow, 16 * (NA * cu + i) + 4 * g, acc[i], rs);
      if (F::STAT) { ss += __shfl_xor(ss, 16); ss += __shfl_xor(ss, 32); if (g == 0) ss_add(f.ss + arow, ss); }
    }
    __syncthreads();
  }
}
template <class F>
__device__ __forceinline__ void skinny_run_quarter(const F& f, const bf16_t* A, int K, const bf16_t* Bt, int ncu, int bid, int G, unsigned char* shm, int c0) {
  const int tid = tidx(), w = tid >> 6, lane = tid & 63, g4 = lane >> 4, l15 = lane & 15;
  const int total = 4 * ncu, nc = G - c0;
  if (bid < c0) return;
  float* red = (float*)shm;
  for (int su = (G - 1 - bid); su < total; su += nc) {
    const int cu = su >> 2, rq = su & 3, rt = w >> 2, kq = w & 3;
    const int arow = NP + 32 * rq + 16 * rt + l15;
    const int kspan = K >> 2, kbase = kq * kspan + 8 * g4;
    const bf16_t* ap = A + (size_t)arow * K + kbase;
    const bf16_t* bp = Bt + (size_t)(16 * cu + l15) * K + kbase;
    f32x4 acc = (f32x4){0.f, 0.f, 0.f, 0.f};
    typename F::Pre pre;
    if (kq == 0) pre = f.pre(arow, 16 * cu + 4 * g4);
    for (int k0 = 0; k0 < kspan; k0 += 256) {
      bf16x8 a[8], b[8];
#pragma unroll
      for (int s8 = 0; s8 < 8; ++s8) { if (k0 + 32 * s8 < kspan) { a[s8] = *(const bf16x8*)(ap + k0 + 32 * s8); b[s8] = *(const bf16x8*)(bp + k0 + 32 * s8); } }
#pragma unroll
      for (int s8 = 0; s8 < 8; ++s8) { if (k0 + 32 * s8 < kspan) acc = __builtin_amdgcn_mfma_f32_16x16x32_bf16(b[s8], a[s8], acc, 0, 0, 0); }
    }
    *(f32x4*)(red + (size_t)(w * 64 + lane) * 4) = acc;
    __syncthreads();
    if (kq == 0) {
      f32x4 t = acc;
#pragma unroll
      for (int q = 1; q < 4; ++q) t += *(const f32x4*)(red + (size_t)((w + q) * 64 + lane) * 4);
      float ss = f.post(arow, 16 * cu + 4 * g4, t, pre);
      if (F::STAT) { ss += __shfl_xor(ss, 16); ss += __shfl_xor(ss, 32); if (g4 == 0) ss_add(f.ss + arow, ss); }
    }
    __syncthreads();
  }
}
__device__ __forceinline__ void skinny_run13(const F13& f, const bf16_t* A, const bf16_t* Bt, int bid, int G, unsigned char* shm) {
  const int tid = tidx(), w = tid >> 6, lane = tid & 63, g = lane >> 4;
  const int c0 = ((NP / 256) * (2 * DFF / 256)) % G, nc = G - c0;
  if (bid < c0) return;
  for (int su = (G - 1 - bid); su < DFF / 16; su += nc) {
    const int arow = NP + 16 * w + (lane & 15);
    f32x4 acc[2];
    const float rs13 = f.rowscale(arow);
    skinny_unit<2>(A, 1024, Bt, NP, ((16 * su) >> 7) * 256 + ((16 * su) & 127), 128, (float*)shm, acc);
    f.pair(arow, 16 * su + 4 * g, acc[0], acc[1], rs13);
    __syncthreads();
  }
}
template <class F>
__device__ __forceinline__ void gemm_all(LAS unsigned char* lds, unsigned char* shm, const bf16_t* A, const bf16_t* Bt, int N, int K, const F& f, int bid, int G) {
  pg8::Gemm g; g.A = A; g.Bt = Bt; g.M = NP; g.N = N; g.K = K;
  pg8::StaticOrder S; S.init(NP, N, G, bid);
  EpiMain<F> E; E.f = f; E.coff = 0;
  REP(F::STAT ? 0 : 512) pg8::gemm_phase(lds, g, S, E);
  const int c0 = ((NP / 256) * (N / 256)) % G;
  if ((N / 16) * 2 <= G - c0) skinny_run_quarter(f, A, K, Bt, N / 16, bid, G, shm, c0);
  else skinny_run(f, A, K, Bt, NP, 1, N / 16, bid, G, shm, c0);
}

template <class F>
__device__ __forceinline__ void gemm_main_window(LAS unsigned char* lds, const bf16_t* A, const bf16_t* Bt, int N, int K, const F& f, int coff, int bid, int G) {
  pg8::Gemm g; g.A = A; g.Bt = Bt; g.M = NP; g.N = N; g.K = K;
  pg8::StaticOrder S; S.init(NP, N, G, bid);
  EpiMain<F> E; E.f = f; E.coff = coff;
  pg8::gemm_phase(lds, g, S, E);
}

__device__ __forceinline__ void prep_s5tables(const Params& P, int item, unsigned char* shm);
__device__ __forceinline__ void prep_phase(const Params& P, unsigned char* shm, int bid, int G) {
  const int tid = tidx(), w = tid >> 6, lane = tid & 63;
  bf16_t* T = (bf16_t*)shm;
  for (int t0 = 4 * bid; t0 < P.total_tiles; t0 += 4 * G) {
    f32x4 v0[4], v1[4]; float sc[4];
    const int kk = tid >> 3, jq = tid & 7, nn = jq * 8;
#pragma unroll
    for (int u = 0; u < 4; ++u) {
      const int tile = t0 + u;
      v0[u] = (f32x4){0.f, 0.f, 0.f, 0.f}; v1[u] = v0[u]; sc[u] = 1.f;
      if (tile < P.total_tiles) {
        int ji = 0;
        while (ji + 1 < P.njobs && P.jobs[ji + 1].tile0 <= tile) ++ji;
        const TJob& J = P.jobs[ji];
        const int lt = tile - J.tile0, tn = lt % J.ntn, tk = lt / J.ntn, k0 = tk * 64, n0 = tn * 64;
        if (n0 + nn < J.ncols) { const float* sp = J.src + (size_t)(k0 + kk) * J.ldn + J.c0 + n0 + nn; v0[u] = *(const f32x4*)sp; v1[u] = *(const f32x4*)(sp + 4); }
        if (J.scale) sc[u] = J.scale[k0 + kk];
      }
    }
#pragma unroll
    for (int u = 0; u < 4; ++u) {
      bf16_t* Tu = T + u * (64 * 72);
      const int kx = kk ^ (8 * jq);
#pragma unroll
      for (int i = 0; i < 4; ++i) { Tu[(nn + i) * 72 + kx] = f2bf(v0[u][i] * sc[u]); Tu[(nn + 4 + i) * 72 + kx] = f2bf(v1[u][i] * sc[u]); }
    }
    __syncthreads();
#pragma unroll
    for (int u = 0; u < 4; ++u) {
      const int tile = t0 + u;
      if (tile < P.total_tiles) {
        int ji = 0;
        while (ji + 1 < P.njobs && P.jobs[ji + 1].tile0 <= tile) ++ji;
        const TJob& J = P.jobs[ji];
        const int lt = tile - J.tile0, tn = lt % J.ntn, tk = lt / J.ntn, k0 = tk * 64, n0 = tn * 64;
        const int n = tid >> 3, k8 = (tid & 7) * 8, gn = n0 + n;
        if (gn < J.nwrite) {
          const int dr = J.mode == 0 ? J.r0 + gn : ((gn >> 7) * 256 + (J.mode == 2 ? 128 : 0) + (gn & 127));
          *(u32x4*)(J.dst + (size_t)dr * J.K + k0 + k8) = *(const u32x4*)(T + u * (64 * 72) + n * 72 + (k8 ^ (8 * ((n >> 3) & 7))));
        }
      }
    }
    __syncthreads();
  }
  for (int i = bid * 512 + tid; i < 2 * 2048; i += G * 512) {
    const int l = i >> 11, gp = i & 2047, g = gp >> 6, p = gp & 63;
    const float dt = expf(P.log_dt[l * 32 + g]);
    const float Ar = P.A_re[l * 2048 + gp], Ai = P.A_im[l * 2048 + gp];
    const float mag = expf(dt * Ar);
    float sn, cs; sincosf(dt * Ai, &sn, &cs);
    const float abr = mag * cs, abi = mag * sn;
    const float den = Ar * Ar + Ai * Ai, nr = abr - 1.0f, ni = abi;
    const float fre = (nr * Ar + ni * Ai) / den, fim = (ni * Ar - nr * Ai) / den;
    P.abar[l][gp] = abr; P.abar[l][2048 + gp] = abi;
    for (int c = 0; c < 16; ++c) {
      const float Br = P.B_re[(size_t)l * 32768 + gp * 16 + c], Bi = P.B_im[(size_t)l * 32768 + gp * 16 + c];
      P.bbar[l][(g * 16 + c) * 64 + p] = fre * Br - fim * Bi;
      P.bbar[l][32768 + (g * 16 + c) * 64 + p] = fre * Bi + fim * Br;
    }
  }
  for (int it = bid; it < 64; it += G) prep_s5tables(P, it, shm);
  for (int row = bid * 8 + w; row < NT; row += G * 8) {
    const float* xr = row < NP ? P.x_prompt + (size_t)row * DM : P.x_sample + (size_t)(row - NP) * DM;
    float ss = 0.f;
#pragma unroll
    for (int i = 0; i < 4; ++i) {
      const f32x4 v = *(const f32x4*)(xr + 256 * i + 4 * lane);
      ss += (v[0] * v[0] + v[1] * v[1]) + (v[2] * v[2] + v[3] * v[3]);
      *(u32x2*)(P.xb + (size_t)row * DM + 256 * i + 4 * lane) = pack4(v);
    }
    ss = wave_sum(ss);
    if (lane == 0) P.ssA[row] = ss_fix(ss);
  }
}

__device__ __forceinline__ void mlstm_scalars(const float* gat, int b, int h, float* sA, float* sM, float* sB, float* chain) {
  const int tid = tidx(), w = tid >> 6, lane = tid & 63;
  for (int cc = w; cc < 16; cc += 8) {
    const int t0 = cc * 128 + 2 * lane; const size_t r0 = (size_t)b * 2048 + t0;
    const float ig0 = gat[r0 * 8 + h], lf0 = gat[r0 * 8 + 4 + h], ig1 = gat[(r0 + 1) * 8 + h], lf1 = gat[(r0 + 1) * 8 + 4 + h];
    float x = lf0 + lf1;
    for (int off = 1; off < 64; off <<= 1) { const float y = __shfl_up(x, off); if (lane >= off) x += y; }
    const float b1 = x, b0 = x - lf1, a0 = ig0 - b0, a1 = ig1 - b1;
    float cm = fmaxf(a0, a1);
    for (int off = 1; off < 64; off <<= 1) { const float y = __shfl_up(cm, off); if (lane >= off) cm = fmaxf(cm, y); }
    const float prev = __shfl_up(cm, 1); const float cm0 = lane ? fmaxf(prev, a0) : a0;
    sB[t0] = b0; sB[t0 + 1] = b1; sA[t0] = a0; sA[t0 + 1] = a1; sM[t0] = cm0; sM[t0 + 1] = cm;
    if (lane == 63) { chain[33 + cc] = b1; chain[49 + cc] = cm; }
  }
  __syncthreads();
  if (tid == 0) { float m = 0.f; for (int cc = 0; cc < 16; ++cc) { chain[cc] = m; const float ml = fmaxf(m, chain[49 + cc]); chain[17 + cc] = ml; m = chain[33 + cc] + ml; } chain[16] = m; }
  __syncthreads();
  for (int t = tid; t < 2048; t += 512) sM[t] = fmaxf(chain[t >> 7], sM[t]);
  __syncthreads();
}

__device__ __forceinline__ void m1_item(const Params& P, int item, unsigned char* shm) {
  const int tid = tidx(), w = __builtin_amdgcn_readfirstlane(tid >> 6), lane = tid & 63, g = lane >> 4;
  const int b = item >> 6, h = (item >> 4) & 3, c = item & 15;
  float* sA = (float*)shm; float* sM = sA + 2048; float* sB = sM + 2048; float* chain = sB + 2048;
  mlstm_scalars(P.gat, b, h, sA, sM, sB, chain);
  const int row0 = b * 2048 + c * 128, t = 16 * w + (lane & 15);
  const bf16_t* qp = P.Pb + (size_t)(row0 + t) * NG1 + h * 256 + 8 * g;
  bf16x8 qf[8];
#pragma unroll
  for (int ks = 0; ks < 8; ++ks) qf[ks] = *(const bf16x8*)(qp + 32 * ks);
  const float Mt = sM[c * 128 + t];
  bf16_t* sp = P.St + (size_t)item * 16384 + t * 128;
#pragma unroll
  for (int sg = 0; sg < 8; sg += 4) {
    if (sg <= w) {
      bf16x8 kf[4][8];
#pragma unroll
      for (int u = 0; u < 4; ++u) {
        if (sg + u <= w) {
          const bf16_t* kp = P.Pb + (size_t)(row0 + 16 * (sg + u) + (lane & 15)) * NG1 + 1024 + h * 256 + 8 * g;
#pragma unroll
          for (int ks = 0; ks < 8; ++ks) kf[u][ks] = *(const bf16x8*)(kp + 32 * ks);
        }
      }
#pragma unroll
      for (int u = 0; u < 4; ++u) {
        const int st = sg + u;
        f32x4 acc = (f32x4){0.f, 0.f, 0.f, 0.f};
        if (st <= w) {
#pragma unroll
          for (int ks = 0; ks < 8; ++ks) acc = __builtin_amdgcn_mfma_f32_16x16x32_bf16(kf[u][ks], qf[ks], acc, 0, 0, 0);
#pragma unroll
          for (int r = 0; r < 4; ++r) { const int s2 = 16 * st + 4 * g + r; acc[r] = (s2 <= t) ? acc[r] * __expf(sA[c * 128 + s2] - Mt) : 0.f; }
        }
        *(u32x2*)(sp + 16 * st + 4 * g) = pack4(acc);
      }
    } else {
#pragma unroll
      for (int u = 0; u < 4; ++u) *(u32x2*)(sp + 16 * (sg + u) + 4 * g) = (u32x2){0u, 0u};
    }
  }
  __syncthreads();
}

__device__ __forceinline__ bf16x8 trread8(unsigned a0, unsigned a1) {
  bf16x4 lo, hi;
  asm volatile("ds_read_b64_tr_b16 %0, %2\n\tds_read_b64_tr_b16 %1, %3\n\ts_waitcnt lgkmcnt(0)" : "=&v"(lo), "=&v"(hi) : "v"(a0), "v"(a1) : "memory");
  return __builtin_shufflevector(lo, hi, 0, 1, 2, 3, 4, 5, 6, 7);
}
__device__ __forceinline__ void trread8x3(unsigned a0, unsigned a1, unsigned a2, unsigned dlt, bf16x8& r0, bf16x8& r1, bf16x8& r2) {
  bf16x4 l0, h0, l1, h1, l2, h2;
  asm volatile("ds_read_b64_tr_b16 %0, %6\n\tds_read_b64_tr_b16 %1, %7\n\tds_read_b64_tr_b16 %2, %8\n\tds_read_b64_tr_b16 %3, %9\n\tds_read_b64_tr_b16 %4, %10\n\tds_read_b64_tr_b16 %5, %11\n\ts_waitcnt lgkmcnt(0)"
               : "=&v"(l0), "=&v"(h0), "=&v"(l1), "=&v"(h1), "=&v"(l2), "=&v"(h2)
               : "v"(a0), "v"(a0 + dlt), "v"(a1), "v"(a1 + dlt), "v"(a2), "v"(a2 + dlt) : "memory");
  r0 = __builtin_shufflevector(l0, h0, 0, 1, 2, 3, 4, 5, 6, 7); r1 = __builtin_shufflevector(l1, h1, 0, 1, 2, 3, 4, 5, 6, 7); r2 = __builtin_shufflevector(l2, h2, 0, 1, 2, 3, 4, 5, 6, 7);
}
__device__ __forceinline__ void trread8x2(unsigned a0, unsigned a1, unsigned dlt, bf16x8& r0, bf16x8& r1) {
  bf16x4 l0, h0, l1, h1;
  asm volatile("ds_read_b64_tr_b16 %0, %4\n\tds_read_b64_tr_b16 %1, %5\n\tds_read_b64_tr_b16 %2, %6\n\tds_read_b64_tr_b16 %3, %7\n\ts_waitcnt lgkmcnt(0)"
               : "=&v"(l0), "=&v"(h0), "=&v"(l1), "=&v"(h1) : "v"(a0), "v"(a0 + dlt), "v"(a1), "v"(a1 + dlt) : "memory");
  r0 = __builtin_shufflevector(l0, h0, 0, 1, 2, 3, 4, 5, 6, 7); r1 = __builtin_shufflevector(l1, h1, 0, 1, 2, 3, 4, 5, 6, 7);
}

constexpr int KS_STRIDE = 272, VS_STRIDE = 56;
constexpr int M2_K = 0, M2_V = 69632, M2_CL = 83968, M2_SC = 110080;
__device__ __forceinline__ void m2_item(const Params& P, int l, int item, unsigned char* shm) {
  const int tid = tidx(), w = __builtin_amdgcn_readfirstlane(tid >> 6), lane = tid & 63, g = lane >> 4, l15 = lane & 15;
  const int bh = item >> 3, j = item & 7, b = bh >> 2, h = bh & 3;
  bf16_t* Ksh = (bf16_t*)(shm + M2_K); bf16_t* Vsh = (bf16_t*)(shm + M2_V); bf16_t* Cl = (bf16_t*)(shm + M2_CL);
  float* sA = (float*)(shm + M2_SC); float* sM = sA + 2048; float* sB = sM + 2048; float* chain = sB + 2048;
  const unsigned lbase = (unsigned)(size_t)shm;
  u32x4 kreg[8]; u32x4 vreg;
  const int vs = tid >> 2, vpc = tid & 3;
  {
    const int row0 = b * 2048;
#pragma unroll
    for (int i = 0; i < 8; ++i) { const int piece = tid + 512 * i, s = piece >> 5, pc = piece & 31; kreg[i] = *(const u32x4*)(P.Pb + (size_t)(row0 + s) * NG1 + 1024 + h * 256 + 8 * pc); }
    vreg = *(const u32x4*)(P.Pb + (size_t)(row0 + vs) * NG1 + 2048 + h * 256 + 32 * j + 8 * vpc);
  }
  bf16x8 qf[8], sf[4];
  {
    const int t = 16 * w + l15;
#pragma unroll
    for (int ks = 0; ks < 8; ++ks) qf[ks] = (bf16x8){0, 0, 0, 0, 0, 0, 0, 0};
    const bf16_t* sp0 = P.St + (size_t)(bh * 16) * 16384 + t * 128 + 8 * g;
#pragma unroll
    for (int ks = 0; ks < 4; ++ks) sf[ks] = *(const bf16x8*)(sp0 + 32 * ks);
  }
  mlstm_scalars(P.gat, b, h, sA, sM, sB, chain);
  f32x4 Cacc[2][3];
#pragma unroll
  for (int dt = 0; dt < 2; ++dt)
#pragma unroll
    for (int et = 0; et < 3; ++et) Cacc[dt][et] = (f32x4){0.f, 0.f, 0.f, 0.f};
  const int trq = l15 >> 2, trp = lane & 3;
#define M2_WRITE_KV(cc) do { \
    const float ml_ = chain[17 + (cc)]; \
    _Pragma("unroll") for (int i = 0; i < 8; ++i) { const int piece = tid + 512 * i, s = piece >> 5, pc = piece & 31; \
      const float wk = __expf(sA[(cc) * 128 + s] - ml_); u32x4 sc; \
      _Pragma("unroll") for (int e = 0; e < 4; ++e) { const unsigned u = kreg[i][e]; sc[e] = pack2(bf2f(u & 0xffffu) * wk, bf2f(u >> 16) * wk); } \
      *(u32x4*)(Ksh + s * KS_STRIDE + 8 * pc) = sc; } \
    *(u32x4*)(Vsh + vs * VS_STRIDE + 8 * vpc) = vreg; \
    if (vpc == 0) { unsigned zz = 0u; asm volatile("" : "+v"(zz)); const u32x4 z = (u32x4){zz, zz, zz, zz}; u32x4 o1 = z; o1[0] = 0x3F80u; \
      *(u32x4*)(Vsh + vs * VS_STRIDE + 32) = o1; *(u32x4*)(Vsh + vs * VS_STRIDE + 40) = z; } } while (0)
  M2_WRITE_KV(0);
  __syncthreads();
  for (int c = 0; c < 16; ++c) {
    const int row0 = b * 2048 + c * 128;
    const float mlast = chain[17 + c], mprev = chain[c];
    if (c < 15) {
      const int nrow0 = row0 + 128;
#pragma unroll
      for (int i = 0; i < 8; ++i) { const int piece = tid + 512 * i, s = piece >> 5, pc = piece & 31; kreg[i] = *(const u32x4*)(P.Pb + (size_t)(nrow0 + s) * NG1 + 1024 + h * 256 + 8 * pc); }
      vreg = *(const u32x4*)(P.Pb + (size_t)(nrow0 + vs) * NG1 + 2048 + h * 256 + 32 * j + 8 * vpc);
    }
    {
      const int t = 16 * w + l15, row = row0 + t;
      f32x4 acc[3]; acc[0] = (f32x4){0.f, 0.f, 0.f, 0.f}; acc[1] = acc[0]; acc[2] = acc[0];
      const float Mt = sM[c * 128 + t];
      if (c > 0) {
#pragma unroll
        for (int ks = 0; ks < 8; ++ks) {
          bf16x8 cf[3];
#pragma unroll
          for (int et = 0; et < 3; ++et) cf[et] = *(const bf16x8*)(Cl + (16 * et + l15) * KS_STRIDE + 32 * ks + 8 * g);
          __builtin_amdgcn_sched_barrier(0);
#pragma unroll
          for (int et = 0; et < 3; ++et) acc[et] = __builtin_amdgcn_mfma_f32_16x16x32_bf16(cf[et], qf[ks], acc[et], 0, 0, 0);
          __builtin_amdgcn_sched_barrier(0);
        }
        const float wi = __expf(mprev - Mt);
        acc[0] *= wi; acc[1] *= wi; acc[2] *= wi;
      }
      const float ac = __expf(mprev - mlast);
#pragma unroll
      for (int dt = 0; dt < 2; ++dt)
#pragma unroll
        for (int et = 0; et < 3; ++et) Cacc[dt][et] *= ac;
#pragma unroll
      for (int ks = 0; ks < 4; ++ks) {
        bf16x8 kf[2], vf[3];
        const unsigned va = lbase + M2_V + (unsigned)((32 * ks + 8 * g + trq) * VS_STRIDE + 4 * trp) * 2u;
        const unsigned ka = lbase + M2_K + (unsigned)((32 * ks + 8 * g + trq) * KS_STRIDE + 32 * w + 4 * trp) * 2u;
        trread8x3(va, va + 32u, va + 64u, 4u * VS_STRIDE * 2u, vf[0], vf[1], vf[2]);
        trread8x2(ka, ka + 32u, 4u * KS_STRIDE * 2u, kf[0], kf[1]);
#pragma unroll
        for (int et = 0; et < 3; ++et) acc[et] = __builtin_amdgcn_mfma_f32_16x16x32_bf16(vf[et], sf[ks], acc[et], 0, 0, 0);
#pragma unroll
        for (int dt = 0; dt < 2; ++dt)
#pragma unroll
          for (int et = 0; et < 3; ++et) Cacc[dt][et] = __builtin_amdgcn_mfma_f32_16x16x32_bf16(kf[dt], vf[et], Cacc[dt][et], 0, 0, 0);
      }
      if (c < 15) {
        const bf16_t* qp = P.Pb + (size_t)(row + 128) * NG1 + h * 256 + 8 * g;
#pragma unroll
        for (int ks = 0; ks < 8; ++ks) qf[ks] = *(const bf16x8*)(qp + 32 * ks);
        const bf16_t* sp = P.St + (size_t)(bh * 16 + c + 1) * 16384 + t * 128 + 8 * g;
#pragma unroll
        for (int ks = 0; ks < 4; ++ks) sf[ks] = *(const bf16x8*)(sp + 32 * ks);
      }
      const float den = __shfl(acc[2][0], l15);
      const float dd = fmaxf(fabsf(den), __expf(-(sB[c * 128 + t] + Mt)));
      const float inv = __builtin_amdgcn_rcpf(dd);
      const f32x4 o0 = acc[0] * inv, o1 = acc[1] * inv;
      bf16_t* hp = P.hA + (size_t)row * DM + h * 256 + 32 * j + 4 * g;
      *(u32x2*)hp = pack4(o0); *(u32x2*)(hp + 16) = pack4(o1);
      float ss = (o0[0] * o0[0] + o0[1] * o0[1]) + (o0[2] * o0[2] + o0[3] * o0[3]) + (o1[0] * o1[0] + o1[1] * o1[1]) + (o1[2] * o1[2] + o1[3] * o1[3]);
      ss += __shfl_xor(ss, 16); ss += __shfl_xor(ss, 32);
      if (g == 0) P.hss[(size_t)row * 32 + h * 8 + j] = ss;
    }
    LDS_BARRIER();
#pragma unroll
    for (int dt = 0; dt < 2; ++dt)
#pragma unroll
      for (int et = 0; et < 3; ++et) *(u32x2*)(Cl + (16 * et + l15) * KS_STRIDE + 32 * w + 16 * dt + 4 * g) = pack4(Cacc[dt][et]);
    if (c < 15) M2_WRITE_KV(c + 1);
    LDS_BARRIER();
  }
#undef M2_WRITE_KV
  const size_t sidx = (size_t)(l * 8 + b) * 4 + h;
#pragma unroll
  for (int dt = 0; dt < 2; ++dt)
#pragma unroll
    for (int r = 0; r < 4; ++r) {
      const int d = 32 * w + 16 * dt + 4 * g + r;
      P.out[O_CP + sidx * 65536 + (size_t)d * 256 + 32 * j + l15] = Cacc[dt][0][r];
      P.out[O_CP + sidx * 65536 + (size_t)d * 256 + 32 * j + 16 + l15] = Cacc[dt][1][r];
      if (j == 0 && l15 == 0) P.out[O_NP + sidx * 256 + d] = Cacc[dt][2][r];
    }
  if (j == 0 && tid == 0) P.out[O_MP + sidx] = chain[16];
  __syncthreads();
}

__device__ __forceinline__ void msample_item(const Params& P, int l, int item, unsigned char* shm) {
  const int tid = tidx(), w = tid >> 6, lane = tid & 63;
  const int b = item >> 2, h = item & 3, row = NP + b;
  float* q = (float*)shm; float* k = q + 256; float* v = k + 256; float* red = v + 256; float* red2 = red + 2048;
  if (tid < 256) {
    const bf16_t* pr = P.Pb + (size_t)row * NG1 + h * 256 + tid;
    q[tid] = bf2f(pr[0]); k[tid] = bf2f(pr[1024]); v[tid] = bf2f(pr[2048]);
  }
  const float ig = P.gat[(size_t)row * 8 + h], lf = P.gat[(size_t)row * 8 + 4 + h];
  const size_t sidx = (size_t)(l * 128 + b) * 4 + h;
  const float m0 = P.st_m[sidx];
  const float inter = lf + m0, mt = fmaxf(inter, ig), wi = __expf(inter - mt), wa = __expf(ig - mt);
  __syncthreads();
  const float* C0 = P.st_C + sidx * 65536; float* Co = P.out + O_CS + sidx * 65536;
  const float* n0 = P.st_n + sidx * 256;
  const f32x4 v4 = *(const f32x4*)(v + 4 * lane);
  f32x4 acc = (f32x4){0.f, 0.f, 0.f, 0.f};
#pragma unroll 8
  for (int dd = 0; dd < 32; ++dd) {
    const int d = 32 * w + dd;
    const f32x4 c4 = __builtin_nontemporal_load((const f32x4*)(C0 + (size_t)d * 256 + 4 * lane));
    const float kd = wa * k[d], qd = q[d];
    __builtin_nontemporal_store(c4 * wi + v4 * kd, (f32x4*)(Co + (size_t)d * 256 + 4 * lane));
    acc += c4 * qd;
  }
  *(f32x4*)(red + w * 256 + 4 * lane) = acc;
  float qk = 0.f, qn = 0.f;
#pragma unroll
  for (int i = 0; i < 4; ++i) { const int d = lane + 64 * i; qk += q[d] * k[d]; qn += q[d] * n0[d]; }
  qk = wave_sum(qk); qn = wave_sum(qn);
  __syncthreads();
  const float s = qk * wa, den = wi * qn + s, ddn = fmaxf(fabsf(den), __expf(-mt));
  float hval = 0.f;
  if (tid < 256) {
    float num = 0.f;
#pragma unroll
    for (int i = 0; i < 8; ++i) num += red[i * 256 + tid];
    hval = (wi * num + s * v[tid]) / ddn;
    P.hA[(size_t)row * DM + h * 256 + tid] = f2bf(hval);
    P.out[O_NS + sidx * 256 + tid] = wi * n0[tid] + wa * k[tid];
  }
  float ss = wave_sum(hval * hval);
  if (lane == 0) red2[w] = ss;
  __syncthreads();
  if (tid < 8) P.hss[(size_t)row * 32 + h * 8 + tid] = tid == 0 ? (red2[0] + red2[1] + red2[2] + red2[3]) : 0.f;
  if (tid == 0) P.out[O_MS + sidx] = mt;
  __syncthreads();
}

__device__ __forceinline__ void s5_load_C(const Params& P, int l, int g, float* Csh) {
  for (int i = tidx(); i < 2048; i += 512) { const int ri = i >> 10, c = (i >> 6) & 15, p = i & 63;
    Csh[ri * 1088 + c * 68 + p] = (ri ? P.C_im : P.C_re)[(size_t)l * 32768 + (g * 16 + c) * 64 + p]; }
}
__device__ __forceinline__ void s5_sample_item(const Params& P, int l, int item, unsigned char* shm) {
  const int tid = tidx(), w = tid >> 6, lane = tid & 63;
  const int g = item & 31, bs0 = (item >> 5) * 16 + 2 * w;
  float* Csh = (float*)shm; float* sbuf = Csh + 2176 + w * 2176;
  s5_load_C(P, l, g, Csh);
  const float are = P.abar[l][g * 64 + lane], aim = P.abar[l][2048 + g * 64 + lane];
  float bre[16], bim[16];
#pragma unroll
  for (int c = 0; c < 16; ++c) { bre[c] = P.bbar[l][(g * 16 + c) * 64 + lane]; bim[c] = P.bbar[l][32768 + (g * 16 + c) * 64 + lane]; }
  const int ch = lane >> 2, pq = lane & 3;
  const float Dc = P.D_skip[l * 512 + g * 16 + ch];
  __syncthreads();
#pragma unroll
  for (int rep = 0; rep < 2; ++rep) {
    const int bs = bs0 + rep, row = NP + bs;
    const size_t o = ((size_t)(l * 128 + bs) * 32 + g) * 64 + lane;
    const float s0r = P.st_sre[o], s0i = P.st_sim[o];
    const bf16_t* up = P.Pb + (size_t)row * NG1 + 4096 + g * 16;
    const u32x4 u0 = *(const u32x4*)up, u1 = *(const u32x4*)(up + 8);
    float br = 0.f, bi = 0.f;
#pragma unroll
    for (int i = 0; i < 4; ++i) {
      const float ua = bf2f(u0[i] & 0xffffu), ub = bf2f(u0[i] >> 16), uc = bf2f(u1[i] & 0xffffu), ud = bf2f(u1[i] >> 16);
      br += bre[2 * i] * ua + bre[2 * i + 1] * ub + bre[8 + 2 * i] * uc + bre[8 + 2 * i + 1] * ud;
      bi += bim[2 * i] * ua + bim[2 * i + 1] * ub + bim[8 + 2 * i] * uc + bim[8 + 2 * i + 1] * ud;
    }
    const float sr = are * s0r - aim * s0i + br, si = are * s0i + aim * s0r + bi;
    P.out[O_SRS + o] = sr; P.out[O_SIS + o] = si;
    sbuf[rep * 136 + lane] = sr; sbuf[rep * 136 + 68 + lane] = si;
    asm volatile("s_waitcnt lgkmcnt(0)" ::: "memory");
    float acc = 0.f;
#pragma unroll
    for (int p4 = 0; p4 < 4; ++p4) {
      const int p0 = 16 * pq + 4 * p4;
      const f32x4 vr = *(const f32x4*)(sbuf + rep * 136 + p0), vi = *(const f32x4*)(sbuf + rep * 136 + 68 + p0);
      const f32x4 cr = *(const f32x4*)(Csh + ch * 68 + p0), ci = *(const f32x4*)(Csh + 1088 + ch * 68 + p0);
      acc += (cr[0] * vr[0] + cr[1] * vr[1]) + (cr[2] * vr[2] + cr[3] * vr[3]) - (ci[0] * vi[0] + ci[1] * vi[1]) - (ci[2] * vi[2] + ci[3] * vi[3]);
    }
    acc += __shfl_xor(acc, 1); acc += __shfl_xor(acc, 2);
    if (pq == 0) {
      const float uc = bf2f(up[ch]);
      P.ysb[(size_t)row * 512 + g * 16 + ch] = f2bf(gelu_tanh(acc + Dc * uc));
    }
  }
  __syncthreads();
}

__device__ __forceinline__ void prep_s5tables(const Params& P, int item, unsigned char* shm) {
  const int tid = tidx(), l = item >> 5, g = item & 31;
  float* pwr = (float*)shm; float* pwi = pwr + 17 * 64; float* bbr = pwi + 17 * 64; float* bbi = bbr + 1024; float* Ccr = bbi + 1024; float* Cci = Ccr + 1024;
  if (tid < 64) {
    const int p = tid, gp = g * 64 + p;
    const float dt = expf(P.log_dt[l * 32 + g]);
    const float Ar = P.A_re[l * 2048 + gp], Ai = P.A_im[l * 2048 + gp];
    const float mag = expf(dt * Ar);
    float sn, cs; sincosf(dt * Ai, &sn, &cs);
    const float abr = mag * cs, abi = mag * sn;
    const float den = Ar * Ar + Ai * Ai, nr = abr - 1.0f, ni = abi;
    const float fre = (nr * Ar + ni * Ai) / den, fim = (ni * Ar - nr * Ai) / den;
    float pr = 1.f, pi = 0.f;
    for (int t = 0; t <= 16; ++t) { pwr[t * 64 + p] = pr; pwi[t * 64 + p] = pi; const float a = pr * abr - pi * abi, b = pr * abi + pi * abr; pr = a; pi = b; }
    for (int c = 0; c < 16; ++c) {
      const float Br = P.B_re[(size_t)l * 32768 + gp * 16 + c], Bi = P.B_im[(size_t)l * 32768 + gp * 16 + c];
      bbr[p * 16 + c] = fre * Br - fim * Bi; bbi[p * 16 + c] = fre * Bi + fim * Br;
    }
  }
  for (int i = tid; i < 1024; i += 512) { Ccr[i] = P.C_re[(size_t)l * 32768 + g * 1024 + i]; Cci[i] = P.C_im[(size_t)l * 32768 + g * 1024 + i]; }
  __syncthreads();
  bf16_t* Kt = P.Kt[l] + (size_t)g * 17 * 256; bf16_t* Gm = P.Gm[l] + (size_t)g * 32768; bf16_t* Hm = P.Hm[l] + (size_t)g * 32768;
  for (int o = tid; o < 17 * 256; o += 512) {
    const int tau = o >> 8, c = (o >> 4) & 15, c2 = o & 15;
    float acc = 0.f;
    if (tau < 16) for (int p = 0; p < 64; ++p) {
      const float pr = pwr[tau * 64 + p], pi = pwi[tau * 64 + p], br = bbr[p * 16 + c2], bi = bbi[p * 16 + c2];
      const float zr = pr * br - pi * bi, zi = pr * bi + pi * br;
      acc += Ccr[c * 64 + p] * zr - Cci[c * 64 + p] * zi;
    }
    Kt[o] = f2bf(acc);
  }
  for (int o = tid; o < 32768; o += 512) {
    { const int tc = o >> 7, q = o & 127, t = tc >> 4, c = tc & 15, p = q & 63;
      const float cr = Ccr[c * 64 + p], ci = Cci[c * 64 + p], pr = pwr[(t + 1) * 64 + p], pi = pwi[(t + 1) * 64 + p];
      Gm[o] = f2bf(q < 64 ? (cr * pr - ci * pi) : -(cr * pi + ci * pr)); }
    { const int q = o >> 8, jc = o & 255, j = jc >> 4, c2 = jc & 15, p = q & 63;
      const float pr = pwr[(15 - j) * 64 + p], pi = pwi[(15 - j) * 64 + p], br = bbr[p * 16 + c2], bi = bbi[p * 16 + c2];
      Hm[o] = f2bf(q < 64 ? (pr * br - pi * bi) : (pr * bi + pi * br)); }
  }
  if (tid < 64) { P.a16[l][g * 64 + tid] = pwr[16 * 64 + tid]; P.a16[l][2048 + g * 64 + tid] = pwi[16 * 64 + tid]; }
  __syncthreads();
}
constexpr int S3_R0 = 0, S3_SIN = 69632, S3_KT = 69632 + 34816;
__device__ __forceinline__ void s5_stage3_item(const Params& P, int l, int item, unsigned char* shm) {
  const int tid = tidx(), w = tid >> 6, lane = tid & 63, g4 = lane >> 4, l15 = lane & 15;
  const int b = item >> 5, g = item & 31;
  float* Ebuf = (float*)(shm + S3_R0); bf16_t* Gsh = (bf16_t*)(shm + S3_R0); bf16_t* Sin = (bf16_t*)(shm + S3_SIN); bf16_t* Ksh = (bf16_t*)(shm + S3_KT);
  { bf16_t* Hsh = (bf16_t*)(shm + S3_R0); const bf16_t* Hm = P.Hm[l] + (size_t)g * 32768;
#pragma unroll
    for (int i = 0; i < 8; ++i) { const int piece = tid + 512 * i, r = piece >> 5, pc = piece & 31; *(u32x4*)(Hsh + r * 264 + 8 * pc) = *(const u32x4*)(Hm + r * 256 + 8 * pc); } }
  { const bf16_t* Kt = P.Kt[l] + (size_t)g * 17 * 256; for (int i = tid; i < 544; i += 512) *(u32x4*)(Ksh + 8 * i) = *(const u32x4*)(Kt + 8 * i); }
  const int n = 16 * w + l15, r0 = b * 2048 + n * 16;
  bf16x8 uf[8];
#pragma unroll
  for (int ks = 0; ks < 8; ++ks) uf[ks] = *(const bf16x8*)(P.Pb + (size_t)(r0 + 2 * ks + (g4 >> 1)) * NG1 + 4096 + g * 16 + 8 * (g4 & 1));
  __syncthreads();
  {
    const bf16_t* Hsh = (const bf16_t*)(shm + S3_R0);
    f32x4 eacc[8];
#pragma unroll
    for (int qt = 0; qt < 8; ++qt) {
      eacc[qt] = (f32x4){0.f, 0.f, 0.f, 0.f};
#pragma unroll
      for (int ks = 0; ks < 8; ++ks) { const bf16x8 x = *(const bf16x8*)(Hsh + (16 * qt + l15) * 264 + 32 * ks + 8 * g4); eacc[qt] = __builtin_amdgcn_mfma_f32_16x16x32_bf16(x, uf[ks], eacc[qt], 0, 0, 0); }
    }
    __syncthreads();
#pragma unroll
    for (int qt = 0; qt < 8; ++qt) *(f32x4*)(Ebuf + n * 128 + 16 * qt + 4 * g4) = eacc[qt];
  }
  __syncthreads();
  {
    const float ar = P.a16[l][g * 64 + lane], ai = P.a16[l][2048 + g * 64 + lane];
    float lr[16], li[16], sr = 0.f, si = 0.f;
#pragma unroll
    for (int k = 0; k < 16; ++k) {
      lr[k] = sr; li[k] = si;
      const float er = Ebuf[(16 * w + k) * 128 + lane], ei = Ebuf[(16 * w + k) * 128 + 64 + lane];
      const float nr = ar * sr - ai * si + er, ni = ar * si + ai * sr + ei; sr = nr; si = ni;
    }
    float* wend = (float*)(shm + S3_KT + 8704);
    wend[w * 128 + lane] = sr; wend[w * 128 + 64 + lane] = si;
    float br = ar, bi = ai;
#pragma unroll
    for (int i = 0; i < 4; ++i) { const float nr = br * br - bi * bi, ni = 2.f * br * bi; br = nr; bi = ni; }
    __syncthreads();
    float cr = 0.f, ci = 0.f;
    for (int w2 = 0; w2 < w; ++w2) { const float er = wend[w2 * 128 + lane], ei = wend[w2 * 128 + 64 + lane]; const float nr = br * cr - bi * ci + er, ni = br * ci + bi * cr + ei; cr = nr; ci = ni; }
    float pr = 1.f, pi = 0.f;
#pragma unroll
    for (int k = 0; k < 16; ++k) {
      Sin[(16 * w + k) * 136 + lane] = f2bf(lr[k] + pr * cr - pi * ci); Sin[(16 * w + k) * 136 + 64 + lane] = f2bf(li[k] + pr * ci + pi * cr);
      const float nr = pr * ar - pi * ai, ni = pr * ai + pi * ar; pr = nr; pi = ni;
    }
    if (w == 7) { const size_t o = ((size_t)(l * 8 + b) * 32 + g) * 64 + lane; P.out[O_SRP + o] = sr + pr * cr - pi * ci; P.out[O_SIP + o] = si + pr * ci + pi * cr; }
  }
  __syncthreads();
  { const bf16_t* Gm = P.Gm[l] + (size_t)g * 32768;
#pragma unroll
    for (int i = 0; i < 8; ++i) { const int piece = tid + 512 * i, r = piece >> 4, pc = piece & 15; *(u32x4*)(Gsh + r * 136 + 8 * pc) = *(const u32x4*)(Gm + r * 128 + 8 * pc); } }
  __syncthreads();
  bf16x8 sf[4];
#pragma unroll
  for (int k2 = 0; k2 < 4; ++k2) sf[k2] = *(const bf16x8*)(Sin + n * 136 + 32 * k2 + 8 * g4);
  const f32x4 D4 = *(const f32x4*)(P.D_skip + l * 512 + g * 16 + 4 * g4);
#pragma unroll
  for (int t = 0; t < 16; ++t) {
    f32x4 acc = (f32x4){0.f, 0.f, 0.f, 0.f};
    const int row = r0 + t;
    const f32x4 u4 = unpack4(*(const u32x2*)(P.Pb + (size_t)row * NG1 + 4096 + g * 16 + 4 * g4));
#pragma unroll
    for (int ks = 0; ks <= (t >> 1); ++ks) {
      const int tau = t - (2 * ks + (g4 >> 1)), idx = tau >= 0 ? tau : 16;
      const bf16x8 x = *(const bf16x8*)(Ksh + (idx * 16 + l15) * 16 + 8 * (g4 & 1));
      acc = __builtin_amdgcn_mfma_f32_16x16x32_bf16(x, uf[ks], acc, 0, 0, 0);
    }
#pragma unroll
    for (int k2 = 0; k2 < 4; ++k2) { const bf16x8 x = *(const bf16x8*)(Gsh + (t * 16 + l15) * 136 + 32 * k2 + 8 * g4); acc = __builtin_amdgcn_mfma_f32_16x16x32_bf16(x, sf[k2], acc, 0, 0, 0); }
    f32x4 y;
#pragma unroll
    for (int r = 0; r < 4; ++r) y[r] = gelu_tanh(acc[r] + D4[r] * u4[r]);
    *(u32x2*)(P.ysb + (size_t)row * 512 + g * 16 + 4 * g4) = pack4(y);
  }
  __syncthreads();
}

__device__ __forceinline__ void headnorm_rows(const Params& P, int l, int bid, int G) {
  const int w = tidx() >> 6, lane = tidx() & 63;
  constexpr int R1 = 6400;
  const bool split = (G == 256);
  const int rbeg = split ? (bid < 128 ? bid * 8 + w : R1 + (bid - 128) * 8 + w) : bid * 8 + w;
  const int rend = split ? (bid < 128 ? R1 : NT) : NT, rstep = split ? 128 * 8 : G * 8;
  for (int row = rbeg; row < rend; row += rstep) {
    if (lane == 0) { P.ssA[row] = 0ull; P.ssB[row] = 0ull; }
#pragma unroll
    for (int h = 0; h < 4; ++h) {
      const f32x4 s0 = *(const f32x4*)(P.hss + (size_t)row * 32 + h * 8), s1 = *(const f32x4*)(P.hss + (size_t)row * 32 + h * 8 + 4);
      const float ss = (s0[0] + s0[1]) + (s0[2] + s0[3]) + (s1[0] + s1[1]) + (s1[2] + s1[3]);
      const float rh = rsqrtf(ss * (1.0f / 256.0f) + 1e-6f);
      const int col = h * 256 + 4 * lane;
      const f32x4 hv = unpack4(*(const u32x2*)(P.hA + (size_t)row * DM + col));
      const f32x4 so = unpack4(*(const u32x2*)(P.Pb + (size_t)row * NG1 + 3072 + col));
      const f32x4 gh = *(const f32x4*)(P.g_hn + l * 1024 + col);
      *(u32x2*)(P.xa + (size_t)row * DM + col) = pack4(so * hv * gh * rh);
    }
  }
}
__device__ __forceinline__ void final_rows(const Params& P, int bid, int G) {
  const int w = tidx() >> 6, lane = tidx() & 63;
  for (int row = bid * 8 + w; row < NT; row += G * 8) {
    const float rs = rs_of(P.ssA[row]);
    float* o = row < NP ? P.out + O_YP + (size_t)row * DM : P.out + O_YS + (size_t)(row - NP) * DM;
#pragma unroll
    for (int i = 0; i < 4; ++i) {
      const int col = 256 * i + 4 * lane;
      const f32x4 v = *(const f32x4*)(P.X2 + (size_t)row * DM + col);
      const f32x4 gf = *(const f32x4*)(P.g_final + col);
      *(f32x4*)(o + col) = v * gf * rs;
    }
  }
}


#define XB_TMO      128
#define XB_XCNT(j)  (256  + 64 * (j))
#define XB_XSUB(j)  (1280 + 64 * (j))
#define XB_XGEN(j)  (2304 + 64 * (j))
#define XB_TOP      3328
#define XB_TOPGEN   3392
#define XCD_BAR_WORDS 3456
#define XB_SPIN_CAP (1u << 22)
__device__ __forceinline__ unsigned xb_ld(unsigned* p)              { return __hip_atomic_load(p, __ATOMIC_RELAXED, __HIP_MEMORY_SCOPE_AGENT); }
__device__ __forceinline__ unsigned xb_add(unsigned* p, unsigned v) { return __hip_atomic_fetch_add(p, v, __ATOMIC_RELAXED, __HIP_MEMORY_SCOPE_AGENT); }
__device__ __forceinline__ unsigned xb_xcc_id() { return (unsigned)__builtin_amdgcn_s_getreg((3 << 11) | 20) & 0xFu; }
#define XB_SPIN(cond, bar) do { unsigned _sp = 0; while (cond) { __builtin_amdgcn_s_sleep(1); \
    if ((++_sp & 255u) == 0u) { if (xb_ld(&(bar)[XB_TMO])) break; if (_sp > XB_SPIN_CAP) { atomicAdd(&(bar)[XB_TMO], 1u); break; } } } } while (0)
struct XcdBarrier { unsigned* bar; unsigned x; volatile LAS unsigned* st; };
__device__ __forceinline__ XcdBarrier xcd_barrier_post(unsigned* bar, volatile LAS unsigned* st) {
  XcdBarrier b; b.bar = bar; b.x = xb_xcc_id(); b.st = st;
  if (threadIdx.x == 0) (void)xb_add(&bar[XB_XCNT(b.x)], 1u);
  return b;
}
__device__ __forceinline__ void xcd_barrier_complete(unsigned* bar, unsigned x, unsigned& nloc, unsigned& nx) {
  const unsigned G = gridDim.x * gridDim.y * gridDim.z;
  unsigned sum, cnt, mine, sp = 0u;
  for (;;) {
    sum = 0u; cnt = 0u; mine = 0u;
#pragma unroll
    for (unsigned j = 0; j < 16; ++j) { const unsigned c = xb_ld(&bar[XB_XCNT(j)]); sum += c; cnt += (c > 0u) ? 1u : 0u; mine = (j == x) ? c : mine; }
    if (sum == G) break;
    __builtin_amdgcn_s_sleep(1);
    if ((++sp & 255u) == 0u) { if (xb_ld(&bar[XB_TMO])) break; if (sp > XB_SPIN_CAP) { atomicAdd(&bar[XB_TMO], 1u); break; } }
  }
  nloc = mine > 0u ? mine : 1u; nx = cnt > 0u ? cnt : 1u;
}
__device__ __forceinline__ void xcd_barrier(const XcdBarrier& b) {
  asm volatile("s_waitcnt vmcnt(0)" ::: "memory");
  __syncthreads();
  if (threadIdx.x == 0) {
    unsigned* bar = b.bar;
    __builtin_amdgcn_s_waitcnt(0);
    unsigned nloc = b.st[0], nx = b.st[1];
    if (nloc == 0u) { xcd_barrier_complete(bar, b.x, nloc, nx); b.st[0] = nloc; b.st[1] = nx; }
    const unsigned old = xb_add(&bar[XB_XSUB(b.x)], 1u);
    const unsigned gen = old / nloc;
    if (old + 1u == (gen + 1u) * nloc) {
      __builtin_amdgcn_fence(__ATOMIC_RELEASE, "agent");
      asm volatile("s_waitcnt vmcnt(0)" ::: "memory");
      const unsigned og = xb_add(&bar[XB_TOP], 1u);
      const unsigned tg = og / nx;
      if (og + 1u == (tg + 1u) * nx) xb_add(&bar[XB_TOPGEN], 1u);
      else XB_SPIN(xb_ld(&bar[XB_TOPGEN]) == tg, bar);
      __builtin_amdgcn_fence(__ATOMIC_ACQUIRE, "agent");
      xb_add(&bar[XB_XGEN(b.x)], 1u);
      asm volatile("s_waitcnt vmcnt(0)" ::: "memory");
    } else {
      XB_SPIN(xb_ld(&bar[XB_XGEN(b.x)]) == gen, bar);
      __builtin_amdgcn_fence(__ATOMIC_ACQUIRE, "agent");
      asm volatile("s_waitcnt vmcnt(0)" ::: "memory");
    }
  }
  __syncthreads();
}

__global__ void __launch_bounds__(512) mega(const Params P) {
  extern __shared__ __attribute__((aligned(16))) unsigned char shm[];
  cg::grid_group grid = cg::this_grid();
  LAS unsigned char* lds = (LAS unsigned char*)shm;
  const int bid = blockIdx.x, G = gridDim.x;

  volatile LAS unsigned* xst = (volatile LAS unsigned*)(lds + LDS_BYTES - 16);
  if (threadIdx.x == 0) { xst[0] = 0u; xst[1] = 0u; }
  if (bid == 0) for (int i = threadIdx.x; i < XCD_BAR_WORDS; i += 512) P.bar[i] = 0u;
  REP(1) prep_phase(P, shm, bid, G);
  grid.sync();
  const XcdBarrier xb = xcd_barrier_post(P.bar, xst);

  for (int l = 0; l < 2; ++l) {
    REP(2) {
      F1 f; f.bias = P.b_in + l * PTOT; f.Pb = P.Pb; f.rs = P.ssA; f.ss = nullptr;
      gemm_main_window(lds, P.xb, P.WinT[l], 4096, 1024, f, 0, bid, G);
      gemm_main_window(lds, P.xb, P.WinT[l] + (size_t)4608 * 1024, 2048, 1024, f, 4608, bid, G);
      skinny_run<F1, 2>(f, P.xb, 1024, P.WinT[l], NP, 1, NG1 / 16, bid, G, shm, 0);
      Fg fg; fg.bias = P.b_in + l * PTOT + 4096; fg.gat = P.gat; fg.rs = P.ssA; fg.ss = nullptr;
      REP(256) skinny_run(fg, P.xb, 1024, P.WgT[l], 0, 129, 1, bid, G, shm, 0);
    }
    xcd_barrier(xb);
    { F1 f; f.bias = P.b_in + l * PTOT; f.Pb = P.Pb; f.rs = P.ssA; f.ss = nullptr;
      gemm_main_window(lds, P.xb, P.WinT[l] + (size_t)4096 * 1024, 512, 1024, f, 4096, bid, G); }
    {
      const int n1 = G == 256 ? (bid < 128 ? 1 : 3) : (512 - bid + G - 1) / G;
      for (int j = 0; j < n1; ++j) m1_item(P, G == 256 ? (bid < 128 ? bid : 128 + (bid - 128) * 3 + j) : bid + j * G, shm);
      for (int it = bid; it < 512; it += G) msample_item(P, l, it, shm);
      for (int it = bid; it < 256; it += G) s5_sample_item(P, l, it, shm);
    }
    xcd_barrier(xb);
    REP(8) for (int it = bid; it < 256; it += G) m2_item(P, l, G == 256 ? (((it & 7) * 4 + (it >> 6)) * 8 + ((it >> 3) & 7)) : it, shm);
    REP(16) for (int it = bid; it < 256; it += G) s5_stage3_item(P, l, G == 256 ? ((it & 7) * 32 + (it >> 3)) : it, shm);
    xcd_barrier(xb);
    REP(32) {
      Fglu f; f.bias = P.b_glu + l * 512; f.ysb = P.ysb; f.ys2 = P.ys2; f.ss = nullptr;
      gemm_all(lds, shm, P.ysb, P.WgluT[l], 512, 512, f, bid, G);
      headnorm_rows(P, l, bid, G);
    }
    xcd_barrier(xb);
    REP(32) {
      Fa fa; fa.Pb = P.Pb; fa.t1 = P.t1; fa.ss = nullptr;
      gemm_all(lds, shm, P.xa, P.WaT[l], 1024, 1024, fa, bid, G);
      Fb fb; fb.Pb = P.Pb; fb.t1 = P.t1; fb.mg = P.mg; fb.ss = nullptr;
      gemm_all(lds, shm, P.ys2, P.WbT[l], 1024, 512, fb, bid, G);
    }
    xcd_barrier(xb);
    REP(32) {
      Fres f; f.xinP = l == 0 ? P.x_prompt : P.X2; f.xinS = l == 0 ? P.x_sample : P.X2 + (size_t)NP * DM; f.xo = P.X1; f.xb = P.xb; f.ss = P.ssB;
      gemm_all(lds, shm, P.mg, P.WoT[l], 1024, 1024, f, bid, G);
    }
    xcd_barrier(xb);
    REP(64) {
      F13 f; f.rs = P.ssB; f.act = P.act;
      pg8::Gemm g; g.A = P.xb; g.Bt = P.W13T[l]; g.M = NP; g.N = 2 * DFF; g.K = 1024;
      pg8::StaticOrder S; S.init(NP, 2 * DFF, G, bid);
      EpiMain13 E; E.f = f;
      REP(512) pg8::gemm_phase(lds, g, S, E);
      REP(256) skinny_run13(f, P.xb, P.W13T[l], bid, G, shm);
    }
    xcd_barrier(xb);
    REP(64) {
      Fres f; f.xinP = P.X1; f.xinS = P.X1 + (size_t)NP * DM; f.xo = P.X2; f.xb = P.xb; f.ss = P.ssA;
      gemm_all(lds, shm, P.act, P.W2T[l], 1024, DFF, f, bid, G);
    }
    xcd_barrier(xb);
  }
  final_rows(P, bid, G);
}

extern "C" void kernel_launch(void* const* d_in, const int* in_sizes, int n_in, void* d_out, int out_size, void* d_ws, size_t ws_size, hipStream_t stream) {
  constexpr size_t kDynLds = LDS_BYTES;
  static int grid_blocks = 0;
  if (!grid_blocks) {
    int dev = 0, cus = 0, per_cu = 0;
    (void)hipGetDevice(&dev);
    (void)hipDeviceGetAttribute(&cus, hipDeviceAttributeMultiprocessorCount, dev);
    (void)hipFuncSetAttribute((const void*)mega, hipFuncAttributeMaxDynamicSharedMemorySize, (int)kDynLds);
    (void)hipOccupancyMaxActiveBlocksPerMultiprocessor(&per_cu, mega, 512, kDynLds);
    if (per_cu > 1) per_cu = 1;
    grid_blocks = cus * per_cu;
    if (grid_blocks > 256) grid_blocks = 256;
  }
  Params p;
  memset(&p, 0, sizeof(p));
  const float* const* in = (const float* const*)d_in;
  p.x_prompt = in[0]; p.x_sample = in[1]; p.st_C = in[2]; p.st_n = in[3]; p.st_m = in[4]; p.st_sre = in[5]; p.st_sim = in[6];
  p.g_mix = in[7]; p.w_in = in[8]; p.b_in = in[9]; p.g_hn = in[10]; p.w_a = in[11]; p.A_re = in[12]; p.A_im = in[13]; p.log_dt = in[14];
  p.B_re = in[15]; p.B_im = in[16]; p.C_re = in[17]; p.C_im = in[18]; p.D_skip = in[19]; p.w_glu = in[20]; p.b_glu = in[21]; p.w_b = in[22]; p.w_out = in[23];
  p.g_ffn = in[24]; p.w_ff1 = in[25]; p.w_ff3 = in[26]; p.w_ff2 = in[27]; p.g_final = in[28];
  p.out = (float*)d_out;
  char* base = (char*)d_ws; size_t off = 0;
  auto alloc = [&](size_t bytes) { char* r = base + off; off += (bytes + 255) & ~(size_t)255; return r; };
  for (int l = 0; l < 2; ++l) {
    p.WinT[l] = (bf16_t*)alloc((size_t)NG1 * 1024 * 2); p.WgT[l] = (bf16_t*)alloc(16 * 1024 * 2); p.WgluT[l] = (bf16_t*)alloc(512 * 512 * 2);
    p.WaT[l] = (bf16_t*)alloc(1024 * 1024 * 2); p.WbT[l] = (bf16_t*)alloc(1024 * 512 * 2); p.WoT[l] = (bf16_t*)alloc(1024 * 1024 * 2);
    p.W13T[l] = (bf16_t*)alloc((size_t)2 * DFF * 1024 * 2); p.W2T[l] = (bf16_t*)alloc((size_t)1024 * DFF * 2);
    p.abar[l] = (float*)alloc(4096 * 4); p.bbar[l] = (float*)alloc(65536 * 4);
  }
  p.xb = (bf16_t*)alloc((size_t)NT * DM * 2); p.Pb = (bf16_t*)alloc((size_t)NT * NG1 * 2); p.St = (bf16_t*)alloc((size_t)512 * 16384 * 2);
  p.ysb = (bf16_t*)alloc((size_t)NT * 512 * 2); p.ys2 = (bf16_t*)alloc((size_t)NT * 512 * 2); p.xa = (bf16_t*)alloc((size_t)NT * DM * 2);
  p.mg = (bf16_t*)alloc((size_t)NT * DM * 2); p.act = (bf16_t*)alloc((size_t)NT * DFF * 2);
  p.X1 = (float*)alloc((size_t)NT * DM * 4); p.X2 = (float*)alloc((size_t)NT * DM * 4);
  p.ssA = (unsigned long long*)alloc((size_t)NT * 8); p.ssB = (unsigned long long*)alloc((size_t)NT * 8); p.bar = (unsigned*)alloc(XCD_BAR_WORDS * 4);
  for (int l = 0; l < 2; ++l) { p.Kt[l] = (bf16_t*)alloc(32 * 17 * 256 * 2); p.Gm[l] = (bf16_t*)alloc(32 * 32768 * 2); p.Hm[l] = (bf16_t*)alloc(32 * 32768 * 2); p.a16[l] = (float*)alloc(4096 * 4); }
  p.E2 = (float*)alloc((size_t)8 * 128 * 32 * 128 * 4);
  p.gat = (float*)alloc((size_t)NT * 8 * 4); p.hA = (bf16_t*)alloc((size_t)NT * DM * 2); p.hss = (float*)alloc((size_t)NT * 32 * 4);
  p.t1 = (bf16_t*)alloc((size_t)NT * DM * 2); p.Eend = (float*)alloc((size_t)2 * 524288 * 4);
  int nj = 0, tile0 = 0;
  auto job = [&](const float* src, const float* scale, bf16_t* dst, int ldn, int c0, int ncols, int K, int mode, int r0, int nwrite) {
    TJob& J = p.jobs[nj++]; J.src = src; J.scale = scale; J.dst = dst; J.ldn = ldn; J.c0 = c0; J.ncols = ncols; J.K = K; J.mode = mode; J.r0 = r0;
    J.tile0 = tile0; J.ntn = (ncols + 63) / 64; J.nwrite = nwrite; J.pad = 0; tile0 += J.ntn * (K / 64);
  };
  for (int l = 0; l < 2; ++l) {
    const float* win = p.w_in + (size_t)l * 1024 * PTOT; const float* gm = p.g_mix + l * 1024; const float* gf = p.g_ffn + l * 1024;
    job(win, gm, p.WinT[l], PTOT, 0, 4096, 1024, 0, 0, 4096);
    job(win, gm, p.WinT[l], PTOT, 4104, 512, 1024, 0, 4096, 512);
    job(win, gm, p.WinT[l], PTOT, 4616, 2048, 1024, 0, 4608, 2048);
    job(win, gm, p.WgT[l], PTOT, 4096, 8, 1024, 0, 0, 16);
    job(p.w_glu + (size_t)l * 512 * 512, nullptr, p.WgluT[l], 512, 0, 512, 512, 0, 0, 512);
    job(p.w_a + (size_t)l * 1024 * 1024, nullptr, p.WaT[l], 1024, 0, 1024, 1024, 0, 0, 1024);
    job(p.w_b + (size_t)l * 512 * 1024, nullptr, p.WbT[l], 1024, 0, 1024, 512, 0, 0, 1024);
    job(p.w_out + (size_t)l * 1024 * 1024, nullptr, p.WoT[l], 1024, 0, 1024, 1024, 0, 0, 1024);
    job(p.w_ff1 + (size_t)l * 1024 * DFF, gf, p.W13T[l], DFF, 0, DFF, 1024, 1, 0, DFF);
    job(p.w_ff3 + (size_t)l * 1024 * DFF, gf, p.W13T[l], DFF, 0, DFF, 1024, 2, 0, DFF);
    job(p.w_ff2 + (size_t)l * DFF * 1024, nullptr, p.W2T[l], 1024, 0, 1024, DFF, 0, 0, 1024);
  }
  p.njobs = nj; p.total_tiles = tile0;
  void* args[] = {&p};
  hipError_t e = hipLaunchCooperativeKernel((void*)mega, dim3(grid_blocks), dim3(512), args, kDynLds, stream);
  if (e != hipSuccess) fprintf(stderr, "cooperative launch failed: %s (grid %d)\n", hipGetErrorString(e), grid_blocks);
}
```

```cpp
#include <hip/hip_runtime.h>
#include <hip/hip_cooperative_groups.h>
#include <cstdio>
#include <cstring>
namespace cg = cooperative_groups;

#define LAS __attribute__((address_space(3)))
typedef unsigned short bf16_t;
typedef short bf16x8 __attribute__((ext_vector_type(8)));
typedef short bf16x4 __attribute__((ext_vector_type(4)));
typedef float f32x4 __attribute__((ext_vector_type(4)));
typedef unsigned u32x4 __attribute__((ext_vector_type(4)));
typedef unsigned u32x2 __attribute__((ext_vector_type(2)));

constexpr int NP = 16384, NS = 128, NT = 16512, DM = 1024, NG1 = 6656, DFF = 2816, PTOT = 6664;
constexpr int LDS_BYTES = 150 * 1024;
#ifndef DUPMASK
#define DUPMASK 0
#endif
#define REP(bit) for (int rep_ = 0; rep_ < ((DUPMASK & (bit)) ? 2 : 1); ++rep_)
constexpr size_t O_YP = 0, O_YS = 16777216, O_CP = 16908288, O_NP = 21102592, O_MP = 21118976, O_SRP = 21119040, O_SIP = 21151808,
                 O_CS = 21184576, O_NS = 88293440, O_MS = 88555584, O_SRS = 88556608, O_SIS = 89080896;

struct TJob { const float* src; const float* scale; bf16_t* dst; int ldn, c0, ncols, K, mode, r0, tile0, ntn, nwrite, pad; };

struct Params {
  const float *x_prompt, *x_sample, *st_C, *st_n, *st_m, *st_sre, *st_sim;
  const float *g_mix, *w_in, *b_in, *g_hn, *w_a, *A_re, *A_im, *log_dt, *B_re, *B_im, *C_re, *C_im, *D_skip, *w_glu, *b_glu, *w_b, *w_out,
      *g_ffn, *w_ff1, *w_ff3, *w_ff2, *g_final;
  float* out;
  bf16_t *WinT[2], *WgT[2], *WgluT[2], *WaT[2], *WbT[2], *WoT[2], *W13T[2], *W2T[2];
  float *abar[2], *bbar[2];
  bf16_t *xb, *Pb, *St, *ysb, *ys2, *xa, *mg, *act;
  float *X1, *X2, *gat, *hss, *Eend; bf16_t *hA, *t1;
  unsigned long long *ssA, *ssB;
  unsigned* bar;
  bf16_t *Kt[2], *Gm[2], *Hm[2]; float *a16[2], *E2;
  TJob jobs[22];
  int njobs, total_tiles;
};

__device__ __forceinline__ bf16_t f2bf(float f) { return __builtin_bit_cast(bf16_t, (__bf16)f); }
__device__ __forceinline__ float bf2f(unsigned b) { return __uint_as_float(b << 16); }
typedef float f32x2 __attribute__((ext_vector_type(2)));
typedef __bf16 bf16x2v __attribute__((ext_vector_type(2)));
__device__ __forceinline__ unsigned pack2(float lo, float hi) { const f32x2 v = {lo, hi}; const bf16x2v b = __builtin_convertvector(v, bf16x2v); return __builtin_bit_cast(unsigned, b); }
__device__ __forceinline__ u32x2 pack4(f32x4 v) { u32x2 r; r.x = pack2(v[0], v[1]); r.y = pack2(v[2], v[3]); return r; }
__device__ __forceinline__ f32x4 unpack4(u32x2 u) { f32x4 r; r[0] = bf2f(u.x & 0xffffu); r[1] = bf2f(u.x >> 16); r[2] = bf2f(u.y & 0xffffu); r[3] = bf2f(u.y >> 16); return r; }
__device__ __forceinline__ float sigmoidf_(float x) { return __builtin_amdgcn_rcpf(1.0f + __expf(-x)); }
__device__ __forceinline__ float gelu_tanh(float x) { float z = 0.7978845608f * (x + 0.044715f * x * x * x); float e = __expf(2.0f * z); float th = 1.0f - 2.0f * __builtin_amdgcn_rcpf(e + 1.0f); return 0.5f * x * (1.0f + th); }
__device__ __forceinline__ int tidx() { int t = threadIdx.x; asm volatile("" : "+v"(t)); return t; }
#define LDS_BARRIER() do { asm volatile("s_waitcnt lgkmcnt(0)" ::: "memory"); __builtin_amdgcn_s_barrier(); asm volatile("" ::: "memory"); } while (0)
__device__ __forceinline__ float wave_sum(float v) { for (int o = 32; o > 0; o >>= 1) v += __shfl_xor(v, o); return v; }

namespace pg8 {
constexpr int BM = 256, BK = 64, HALF = 128, HTB = HALF * BK * 2, STAGE_BYTES = 8 * HTB, NXCD = 8, WGM = 8;
__host__ __device__ __forceinline__ int lds_byte(int r, int c) { const int st = (r >> 4) * 2 + (c >> 5), rr = r & 15, cc = c & 31, ob = rr * 64 + cc * 2; return st * 1024 + (ob ^ (((ob >> 9) & 1) << 5)); }
__host__ __device__ __forceinline__ void stage_rc(int b, int& R, int& C) { const int st = b / 1024, sb = b % 1024, swz = sb ^ (((sb >> 9) & 1) << 5); R = (st >> 1) * 16 + swz / 64; C = (st & 1) * 32 + (swz % 64) / 2; }
__host__ __device__ __forceinline__ int perm32(int rho) { const int n = rho >> 4, i = rho & 15; return 8 * (i >> 2) + 4 * n + (i & 3); }
struct Unit { int pm, pn; };
struct Gemm { const bf16_t* A; const bf16_t* Bt; int M, N, K; };
struct StaticOrder {
  int nM, nN, nwg, G, c;
  __device__ void init(int M, int N, int G_, int c_) { nM = M / BM; nN = N / BM; nwg = nM * nN; G = G_; c = c_; }
  __device__ bool next(int i, Unit& u) const {
    const long L = (long)i * G + c; if (L >= nwg) return false;
    int wgid = (int)L; { const int q = nwg / NXCD, r = nwg % NXCD, xcd = wgid % NXCD, off = wgid / NXCD; wgid = (xcd < r ? xcd * (q + 1) : r * (q + 1) + (xcd - r) * q) + off; }
    const int nig = WGM * nN, gid = wgid / nig, fm = gid * WGM, gsz = (nM - fm) < WGM ? (nM - fm) : WGM;
    u.pm = fm + ((wgid % nig) % gsz); u.pn = (wgid % nig) / gsz; return true;
  }
};

template <class Epi, class Sched>
__device__ __forceinline__ void gemm_phase(LAS unsigned char* lds, const Gemm g, const Sched& S, const Epi& E) {
  const int tid = tidx(), wid = __builtin_amdgcn_readfirstlane(tid >> 6), lane = tid & 63, wr = wid >> 2, wc = wid & 3, fr = lane & 15, fq = lane >> 4;
  const int K = g.K, nt = K / BK;
  unsigned voffA[2], voffB[2];
#pragma unroll
  for (int i = 0; i < 2; ++i) { int R, C; stage_rc(tid * 16 + i * 8192, R, C); voffA[i] = (unsigned)(R * K + C) * 2u; const int Rb = Epi::PERM ? ((R & ~31) + perm32(R & 31)) : R; voffB[i] = (unsigned)(Rb * K + C) * 2u; }
  const size_t kstep = (size_t)(BK * 2);
  const size_t hstep = (size_t)HALF * K * 2;
  const size_t tstep = 2 * hstep;
  const unsigned ldsw = (unsigned)wid * 1024u;
  const int aoff = lds_byte(wr * 64 + fr, fq * 8), boff = lds_byte(wc * 32 + fr, fq * 8);
#define PG8_SA(b, h) (((b) * 2 + (h)) * HTB)
#define PG8_SB(b, h) ((4 + (b) * 2 + (h)) * HTB)
#define PG8_STAGE(bufoff, gbase, voff) do { _Pragma("unroll") for (int _i = 0; _i < 2; ++_i) \
    __builtin_amdgcn_global_load_lds((const unsigned*)((const char*)(gbase) + (voff)[_i]), (LAS unsigned*)(lds + (bufoff) + ldsw + _i * 8192), 16, 0, 0); } while (0)
#define PG8_LDA(dst, b, h) do { _Pragma("unroll") for (int m = 0; m < 4; ++m) _Pragma("unroll") for (int k = 0; k < 2; ++k) dst[m][k] = *(const LAS bf16x8*)(lds + PG8_SA(b, h) + aoff + m * 2048 + k * 1024); } while (0)
#define PG8_LDB(dst, b, h) do { _Pragma("unroll") for (int n = 0; n < 2; ++n) _Pragma("unroll") for (int k = 0; k < 2; ++k) dst[n][k] = *(const LAS bf16x8*)(lds + PG8_SB(b, h) + boff + n * 2048 + k * 1024); } while (0)
#define PG8_MMA(ai, bj, At, Bt) do { __builtin_amdgcn_s_setprio(1); _Pragma("unroll") for (int m = 0; m < 4; ++m) _Pragma("unroll") for (int n = 0; n < 2; ++n) _Pragma("unroll") for (int k = 0; k < 2; ++k) \
    acc[ai][bj][m][n] = __builtin_amdgcn_mfma_f32_16x16x32_bf16(Bt[n][k], At[m][k], acc[ai][bj][m][n], 0, 0, 0); __builtin_amdgcn_s_setprio(0); } while (0)
#define PG8_WAIT_V(n) asm volatile("s_waitcnt vmcnt(" #n ")" ::: "memory")
#define PG8_WAIT_L(n) asm volatile("s_waitcnt lgkmcnt(" #n ")" ::: "memory")
#define PG8_BAR __builtin_amdgcn_s_barrier()
#define PG8_SCHED __builtin_amdgcn_sched_barrier(0)
  Unit cur, nxt; int ui = 0;
  if (!S.next(0, cur)) return;
  f32x4 acc[2][2][4][2];
#pragma unroll
  for (int a = 0; a < 2; ++a)
#pragma unroll
    for (int b = 0; b < 2; ++b)
#pragma unroll
      for (int m = 0; m < 4; ++m)
#pragma unroll
        for (int n = 0; n < 2; ++n) acc[a][b][m][n] = (f32x4){0.f, 0.f, 0.f, 0.f};
  bf16x8 At[4][2], B0[2][2], B1[2][2];
  const char* cA = (const char*)g.A + (size_t)cur.pm * tstep; const char* cB = (const char*)g.Bt + (size_t)cur.pn * tstep;
  PG8_STAGE(PG8_SB(0, 0), cB, voffB); PG8_STAGE(PG8_SA(0, 0), cA, voffA); PG8_STAGE(PG8_SB(0, 1), cB + hstep, voffB); PG8_STAGE(PG8_SA(0, 1), cA + hstep, voffA);
  if (wr == 1) PG8_BAR;
  PG8_WAIT_V(4); PG8_BAR;
  PG8_STAGE(PG8_SB(1, 0), cB + kstep, voffB); PG8_STAGE(PG8_SA(1, 0), cA + kstep, voffA); PG8_STAGE(PG8_SB(1, 1), cB + hstep + kstep, voffB);
  PG8_WAIT_V(6); PG8_BAR;
  for (;;) {
    const bool has_next = S.next(ui + 1, nxt);
    const char* nA = has_next ? (const char*)g.A + (size_t)nxt.pm * tstep : cA; const char* nB = has_next ? (const char*)g.Bt + (size_t)nxt.pn * tstep : cB;
    for (int t = 0; t < nt; t += 2) {
      const bool last = (t == nt - 2);
      const char* a1 = cA + (size_t)(t + 1) * kstep;
      const char* a2 = last ? nA : cA + (size_t)(t + 2) * kstep; const char* b2 = last ? nB : cB + (size_t)(t + 2) * kstep;
      const char* a3 = a2 + kstep; const char* b3 = b2 + kstep;
      PG8_LDB(B0, 0, 0); PG8_SCHED; PG8_LDA(At, 0, 0); PG8_STAGE(PG8_SA(1, 1), a1 + hstep, voffA);
      PG8_WAIT_L(8); PG8_BAR; PG8_WAIT_L(0); PG8_MMA(0, 0, At, B0); PG8_BAR; PG8_SCHED;
      PG8_LDB(B1, 0, 1); PG8_STAGE(PG8_SB(0, 0), b2, voffB);
      PG8_BAR; PG8_WAIT_L(0); PG8_MMA(0, 1, At, B1); PG8_BAR;
      PG8_LDA(At, 0, 1); PG8_STAGE(PG8_SA(0, 0), a2, voffA);
      PG8_BAR; PG8_WAIT_L(0); PG8_MMA(1, 0, At, B0); PG8_BAR; PG8_SCHED;
      PG8_STAGE(PG8_SB(0, 1), b2 + hstep, voffB);
      PG8_WAIT_V(6); PG8_BAR; PG8_MMA(1, 1, At, B1); PG8_BAR;
      PG8_LDB(B0, 1, 0); PG8_SCHED; PG8_LDA(At, 1, 0); PG8_STAGE(PG8_SA(0, 1), a2 + hstep, voffA);
      PG8_WAIT_L(8); PG8_BAR; PG8_WAIT_L(0); PG8_MMA(0, 0, At, B0); PG8_BAR; PG8_SCHED;
      PG8_LDB(B1, 1, 1); PG8_STAGE(PG8_SB(1, 0), b3, voffB);
      PG8_BAR; PG8_WAIT_L(0); PG8_MMA(0, 1, At, B1); PG8_BAR;
      PG8_LDA(At, 1, 1); PG8_STAGE(PG8_SA(1, 0), a3, voffA);
      PG8_BAR; PG8_WAIT_L(0); PG8_MMA(1, 0, At, B0); PG8_BAR; PG8_SCHED;
      PG8_STAGE(PG8_SB(1, 1), b3 + hstep, voffB);
      PG8_WAIT_V(6); PG8_BAR; PG8_MMA(1, 1, At, B1); PG8_BAR;
    }
    E(acc, cur, wr, wc, fr, fq);
    if (!has_next) break;
#pragma unroll
    for (int a = 0; a < 2; ++a)
#pragma unroll
      for (int b = 0; b < 2; ++b)
#pragma unroll
        for (int m = 0; m < 4; ++m)
#pragma unroll
          for (int n = 0; n < 2; ++n) acc[a][b][m][n] = (f32x4){0.f, 0.f, 0.f, 0.f};
    cur = nxt; cA = nA; cB = nB; ++ui;
  }
  PG8_WAIT_V(0);
  if (wr == 0) PG8_BAR;
  PG8_BAR;
#undef PG8_SA
#undef PG8_SB
#undef PG8_STAGE
#undef PG8_LDA
#undef PG8_LDB
#undef PG8_MMA
#undef PG8_WAIT_V
#undef PG8_WAIT_L
#undef PG8_BAR
#undef PG8_SCHED
}
}

typedef unsigned long long u64;
__device__ __forceinline__ u64 ss_fix(float ss) { return (u64)(ss * 16777216.0f); }
__device__ __forceinline__ float rs_of(u64 q) { const float f = (float)(unsigned)(q >> 32) * 4294967296.0f + (float)(unsigned)q; return rsqrtf(f * (1.0f / (16777216.0f * 1024.0f)) + 1e-6f); }
__device__ __forceinline__ void ss_add(u64* p, float ss) { __hip_atomic_fetch_add(p, ss_fix(ss), __ATOMIC_RELAXED, __HIP_MEMORY_SCOPE_AGENT); }
__device__ __forceinline__ int qcol(int cbase, int q) { return cbase + (q >> 1) * 128 + (q & 1) * 16; }
__device__ __forceinline__ f32x4 unlo(u32x4 u) { return unpack4((u32x2){u[0], u[1]}); }
__device__ __forceinline__ f32x4 unhi(u32x4 u) { return unpack4((u32x2){u[2], u[3]}); }
__device__ __forceinline__ u32x4 pack8(f32x4 a, f32x4 b) { const u32x2 p = pack4(a), q = pack4(b); return (u32x4){p.x, p.y, q.x, q.y}; }
struct F1 {
  static constexpr bool NEEDR = true, STAT = false, PERM = true; static constexpr int RB = 8;
  const float* bias; bf16_t* Pb; const u64* rs; u64* ss;
  struct ColData { f32x4 b[4]; }; struct RowData { u64 s; };
  __device__ __forceinline__ void load_cols(int cbase, ColData& cd) const {
#pragma unroll
    for (int q = 0; q < 4; ++q) { const int col = cbase + (q >> 1) * 128 + (q & 1) * 4; cd.b[q] = *(const f32x4*)(bias + (col < 4096 ? col : col + 8)); } }
  __device__ __forceinline__ void load_row(int row, int, RowData& rd) const { rd.s = rs[row]; }
  __device__ __forceinline__ float apply(int row, int cbase, const f32x4 (&v)[4], const ColData& cd, const RowData& rd) const {
    const float r = rs_of(rd.s);
    const int blk = cbase >> 8;
    const bool isk = blk >= 4 && blk < 8, issig = (blk >= 12 && blk < 16) || blk >= 18;
#pragma unroll
    for (int bj = 0; bj < 2; ++bj) {
      u32x4 pk;
#pragma unroll
      for (int n = 0; n < 2; ++n) {
        f32x4 o = v[bj * 2 + n] * r + cd.b[bj * 2 + n];
        if (isk) o = o * 0.0625f;
        else if (issig) { o[0] = sigmoidf_(o[0]); o[1] = sigmoidf_(o[1]); o[2] = sigmoidf_(o[2]); o[3] = sigmoidf_(o[3]); }
        const u32x2 p2 = pack4(o); pk[2 * n] = p2.x; pk[2 * n + 1] = p2.y;
      }
      *(u32x4*)(Pb + (size_t)row * NG1 + cbase + bj * 128) = pk;
    }
    return 0.f;
  }
  __device__ __forceinline__ float rowscale(int row) const { return rs_of(rs[row]); }
  __device__ __forceinline__ float operator()(int row, int col, f32x4 v, float r) const {
    const int bi = col < 4096 ? col : col + 8;
    const f32x4 b4 = *(const f32x4*)(bias + bi);
    f32x4 o = v * r + b4;
    if (col >= 1024 && col < 2048) o = o * 0.0625f;
    else if ((col >= 3072 && col < 4096) || col >= 4608) { o[0] = sigmoidf_(o[0]); o[1] = sigmoidf_(o[1]); o[2] = sigmoidf_(o[2]); o[3] = sigmoidf_(o[3]); }
    *(u32x2*)(Pb + (size_t)row * NG1 + col) = pack4(o);
    return 0.f;
  }
};
struct Fg {
  static constexpr bool NEEDR = true, STAT = false;
  const float* bias; float* gat; const u64* rs; u64* ss;
  __device__ __forceinline__ float rowscale(int row) const { return rs_of(rs[row]); }
  __device__ __forceinline__ float operator()(int row, int col, f32x4 v, float r) const {
    if (col < 8) {
      const f32x4 b4 = *(const f32x4*)(bias + col);
      f32x4 o = v * r + b4;
      if (col >= 4) {
#pragma unroll
        for (int i = 0; i < 4; ++i) { const float x = o[i]; o[i] = fminf(x, 0.f) - log1pf(__expf(-fabsf(x))); }
      }
      *(f32x4*)(gat + (size_t)row * 8 + col) = o;
    }
    return 0.f;
  }
};
struct Fglu {
  static constexpr bool NEEDR = false, STAT = false, PERM = true; static constexpr int RB = 8;
  const float* bias; const bf16_t* ysb; bf16_t* ys2; u64* ss;
  struct ColData { f32x4 b[4]; }; struct RowData { u32x4 y[2]; };
  __device__ __forceinline__ void load_cols(int cbase, ColData& cd) const {
#pragma unroll
    for (int q = 0; q < 4; ++q) cd.b[q] = *(const f32x4*)(bias + cbase + (q >> 1) * 128 + (q & 1) * 4); }
  __device__ __forceinline__ void load_row(int row, int cbase, RowData& rd) const {
#pragma unroll
    for (int bj = 0; bj < 2; ++bj) rd.y[bj] = *(const u32x4*)(ysb + (size_t)row * 512 + cbase + bj * 128); }
  __device__ __forceinline__ float apply(int row, int cbase, const f32x4 (&v)[4], const ColData& cd, const RowData& rd) const {
#pragma unroll
    for (int bj = 0; bj < 2; ++bj) {
      const f32x4 y0 = unlo(rd.y[bj]), y1 = unhi(rd.y[bj]); f32x4 o0, o1;
#pragma unroll
      for (int i = 0; i < 4; ++i) { o0[i] = y0[i] * sigmoidf_(v[bj * 2][i] + cd.b[bj * 2][i]); o1[i] = y1[i] * sigmoidf_(v[bj * 2 + 1][i] + cd.b[bj * 2 + 1][i]); }
      *(u32x4*)(ys2 + (size_t)row * 512 + cbase + bj * 128) = pack8(o0, o1);
    }
    return 0.f;
  }
  struct Pre { f32x4 b; u32x2 y; };
  __device__ __forceinline__ Pre pre(int row, int col) const { Pre p; p.b = *(const f32x4*)(bias + col); p.y = *(const u32x2*)(ysb + (size_t)row * 512 + col); return p; }
  __device__ __forceinline__ float post(int row, int col, f32x4 v, const Pre& p) const {
    const f32x4 y = unpack4(p.y); f32x4 o;
#pragma unroll
    for (int i = 0; i < 4; ++i) o[i] = y[i] * sigmoidf_(v[i] + p.b[i]);
    *(u32x2*)(ys2 + (size_t)row * 512 + col) = pack4(o); return 0.f; }
  __device__ __forceinline__ float rowscale(int) const { return 1.f; }
  __device__ __forceinline__ float operator()(int row, int col, f32x4 v, float) const {
    const f32x4 b4 = *(const f32x4*)(bias + col);
    const f32x4 y = unpack4(*(const u32x2*)(ysb + (size_t)row * 512 + col));
    f32x4 o;
#pragma unroll
    for (int i = 0; i < 4; ++i) o[i] = y[i] * sigmoidf_(v[i] + b4[i]);
    *(u32x2*)(ys2 + (size_t)row * 512 + col) = pack4(o);
    return 0.f;
  }
};
struct Fa {
  static constexpr bool NEEDR = false, STAT = false, PERM = true; static constexpr int RB = 8;
  const bf16_t* Pb; bf16_t* t1; u64* ss;
  struct ColData { int dummy; }; struct RowData { u32x4 g[2]; };
  __device__ __forceinline__ void load_cols(int, ColData&) const {}
  __device__ __forceinline__ void load_row(int row, int cbase, RowData& rd) const {
#pragma unroll
    for (int bj = 0; bj < 2; ++bj) rd.g[bj] = *(const u32x4*)(Pb + (size_t)row * NG1 + 4608 + cbase + bj * 128); }
  __device__ __forceinline__ float apply(int row, int cbase, const f32x4 (&v)[4], const ColData&, const RowData& rd) const {
#pragma unroll
    for (int bj = 0; bj < 2; ++bj) *(u32x4*)(t1 + (size_t)row * DM + cbase + bj * 128) = pack8(unlo(rd.g[bj]) * v[bj * 2], unhi(rd.g[bj]) * v[bj * 2 + 1]);
    return 0.f;
  }
  struct Pre { u32x2 g; };
  __device__ __forceinline__ Pre pre(int row, int col) const { Pre p; p.g = *(const u32x2*)(Pb + (size_t)row * NG1 + 4608 + col); return p; }
  __device__ __forceinline__ float post(int row, int col, f32x4 v, const Pre& p) const { *(u32x2*)(t1 + (size_t)row * DM + col) = pack4(unpack4(p.g) * v); return 0.f; }
  __device__ __forceinline__ float rowscale(int) const { return 1.f; }
  __device__ __forceinline__ float operator()(int row, int col, f32x4 v, float) const {
    const f32x4 sg = unpack4(*(const u32x2*)(Pb + (size_t)row * NG1 + 4608 + col));
    *(u32x2*)(t1 + (size_t)row * DM + col) = pack4(sg * v);
    return 0.f;
  }
};
struct Fb {
  static constexpr bool NEEDR = false, STAT = false, PERM = true; static constexpr int RB = 4;
  const bf16_t* Pb; const bf16_t* t1; bf16_t* mg; u64* ss;
  struct ColData { int dummy; }; struct RowData { u32x4 g[2]; u32x4 t[2]; };
  __device__ __forceinline__ void load_cols(int, ColData&) const {}
  __device__ __forceinline__ void load_row(int row, int cbase, RowData& rd) const {
#pragma unroll
    for (int bj = 0; bj < 2; ++bj) { rd.g[bj] = *(const u32x4*)(Pb + (size_t)row * NG1 + 5632 + cbase + bj * 128); rd.t[bj] = *(const u32x4*)(t1 + (size_t)row * DM + cbase + bj * 128); } }
  __device__ __forceinline__ float apply(int row, int cbase, const f32x4 (&v)[4], const ColData&, const RowData& rd) const {
#pragma unroll
    for (int bj = 0; bj < 2; ++bj) *(u32x4*)(mg + (size_t)row * DM + cbase + bj * 128) = pack8(unlo(rd.t[bj]) + unlo(rd.g[bj]) * v[bj * 2], unhi(rd.t[bj]) + unhi(rd.g[bj]) * v[bj * 2 + 1]);
    return 0.f;
  }
  struct Pre { u32x2 g; u32x2 t; };
  __device__ __forceinline__ Pre pre(int row, int col) const { Pre p; p.g = *(const u32x2*)(Pb + (size_t)row * NG1 + 5632 + col); p.t = *(const u32x2*)(t1 + (size_t)row * DM + col); return p; }
  __device__ __forceinline__ float post(int row, int col, f32x4 v, const Pre& p) const { *(u32x2*)(mg + (size_t)row * DM + col) = pack4(unpack4(p.t) + unpack4(p.g) * v); return 0.f; }
  __device__ __forceinline__ float rowscale(int) const { return 1.f; }
  __device__ __forceinline__ float operator()(int row, int col, f32x4 v, float) const {
    const f32x4 sg = unpack4(*(const u32x2*)(Pb + (size_t)row * NG1 + 5632 + col));
    const f32x4 t = unpack4(*(const u32x2*)(t1 + (size_t)row * DM + col));
    *(u32x2*)(mg + (size_t)row * DM + col) = pack4(t + sg * v);
    return 0.f;
  }
};
struct Fres {
  static constexpr bool NEEDR = false, STAT = true, PERM = true; static constexpr int RB = 4;
  const float *xinP, *xinS; float* xo; bf16_t* xb; u64* ss;
  struct ColData { int dummy; }; struct RowData { f32x4 x[4]; };
  __device__ __forceinline__ void load_cols(int, ColData&) const {}
  __device__ __forceinline__ void load_row(int row, int cbase, RowData& rd) const {
#pragma unroll
    for (int q = 0; q < 4; ++q) rd.x[q] = *(const f32x4*)(xinP + (size_t)row * DM + cbase + (q >> 1) * 128 + (q & 1) * 4); }
  __device__ __forceinline__ float apply(int row, int cbase, const f32x4 (&v)[4], const ColData&, const RowData& rd) const {
    float s = 0.f;
#pragma unroll
    for (int bj = 0; bj < 2; ++bj) {
      const f32x4 o0 = rd.x[bj * 2] + v[bj * 2], o1 = rd.x[bj * 2 + 1] + v[bj * 2 + 1];
      float* xp = xo + (size_t)row * DM + cbase + bj * 128;
      *(f32x4*)xp = o0; *(f32x4*)(xp + 4) = o1;
      const u32x2 p0 = pack4(o0), p1 = pack4(o1);
      *(u32x4*)(xb + (size_t)row * DM + cbase + bj * 128) = (u32x4){p0.x, p0.y, p1.x, p1.y};
      s += (o0[0] * o0[0] + o0[1] * o0[1]) + (o0[2] * o0[2] + o0[3] * o0[3]) + (o1[0] * o1[0] + o1[1] * o1[1]) + (o1[2] * o1[2] + o1[3] * o1[3]);
    }
    return s;
  }
  struct Pre { f32x4 x; };
  __device__ __forceinline__ Pre pre(int row, int col) const { Pre p; const float* xi = row < NP ? xinP + (size_t)row * DM : xinS + (size_t)(row - NP) * DM; p.x = *(const f32x4*)(xi + col); return p; }
  __device__ __forceinline__ float post(int row, int col, f32x4 v, const Pre& p) const {
    const f32x4 o = p.x + v;
    *(f32x4*)(xo + (size_t)row * DM + col) = o; *(u32x2*)(xb + (size_t)row * DM + col) = pack4(o);
    return (o[0] * o[0] + o[1] * o[1]) + (o[2] * o[2] + o[3] * o[3]); }
  __device__ __forceinline__ float rowscale(int) const { return 1.f; }
  __device__ __forceinline__ float operator()(int row, int col, f32x4 v, float) const {
    const float* xi = row < NP ? xinP + (size_t)row * DM : xinS + (size_t)(row - NP) * DM;
    const f32x4 o = *(const f32x4*)(xi + col) + v;
    *(f32x4*)(xo + (size_t)row * DM + col) = o;
    *(u32x2*)(xb + (size_t)row * DM + col) = pack4(o);
    return (o[0] * o[0] + o[1] * o[1]) + (o[2] * o[2] + o[3] * o[3]);
  }
};
struct F13 {
  const u64* rs; bf16_t* act;
  __device__ __forceinline__ float rowscale(int row) const { return rs_of(rs[row]); }
  __device__ __forceinline__ f32x4 glu(f32x4 a1, f32x4 a3, float r) const {
    f32x4 o;
#pragma unroll
    for (int i = 0; i < 4; ++i) { const float x1 = a1[i] * r, x3 = a3[i] * r; o[i] = x1 * sigmoidf_(x1) * x3; }
    return o;
  }
  __device__ __forceinline__ void pair(int row, int j, f32x4 a1, f32x4 a3, float r) const { *(u32x2*)(act + (size_t)row * DFF + j) = pack4(glu(a1, a3, r)); }
};

template <class F> struct EpiMain {
  static constexpr bool PERM = F::PERM;
  F f; int coff;
  __device__ __forceinline__ void operator()(const f32x4 (&acc)[2][2][4][2], const pg8::Unit& u, int wr, int wc, int fr, int fq) const {
    const int rbase = u.pm * 256 + wr * 64 + fr, cbase = coff + u.pn * 256 + wc * 32 + (F::PERM ? 8 : 4) * fq;
    typename F::ColData cd; f.load_cols(cbase, cd);
#pragma unroll
    for (int b0 = 0; b0 < 8; b0 += F::RB) {
      typename F::RowData rd[F::RB];
#pragma unroll
      for (int k = 0; k < F::RB; ++k) { const int i = b0 + k; f.load_row(rbase + (i >> 2) * 128 + (i & 3) * 16, cbase, rd[k]); }
      __builtin_amdgcn_sched_barrier(0);
#pragma unroll
      for (int k = 0; k < F::RB; ++k) {
        const int i = b0 + k, ai = i >> 2, m = i & 3, row = rbase + ai * 128 + m * 16;
        const f32x4 v[4] = {acc[ai][0][m][0], acc[ai][0][m][1], acc[ai][1][m][0], acc[ai][1][m][1]};
        float s = f.apply(row, cbase, v, cd, rd[k]);
        if (F::STAT) { s += __shfl_xor(s, 16); s += __shfl_xor(s, 32); if (fq == 0) ss_add(f.ss + row, s); }
      }
      __builtin_amdgcn_sched_barrier(0);
    }
  }
};
struct EpiMain13 {
  static constexpr bool PERM = true;
  F13 f;
  __device__ __forceinline__ void operator()(const f32x4 (&acc)[2][2][4][2], const pg8::Unit& u, int wr, int wc, int fr, int fq) const {
    const int rbase = u.pm * 256 + wr * 64 + fr, jbase = u.pn * 128 + wc * 32 + 8 * fq;
    u64 sq[8];
#pragma unroll
    for (int i = 0; i < 8; ++i) sq[i] = f.rs[rbase + (i >> 2) * 128 + (i & 3) * 16];
    __builtin_amdgcn_sched_barrier(0);
#pragma unroll
    for (int i = 0; i < 8; ++i) {
      const int ai = i >> 2, m = i & 3, row = rbase + ai * 128 + m * 16;
      const float r = rs_of(sq[i]);
      *(u32x4*)(f.act + (size_t)row * DFF + jbase) = pack8(f.glu(acc[ai][0][m][0], acc[ai][1][m][0], r), f.glu(acc[ai][0][m][1], acc[ai][1][m][1], r));
    }
  }
};

template <int NACC>
__device__ __forceinline__ void skinny_unit(const bf16_t* A, int K, const bf16_t* Bt, int row0, int brow0, int bstep, float* red, f32x4 (&out)[NACC]) {
  const int tid = tidx(), w = tid >> 6, lane = tid & 63, g4 = lane >> 4, l15 = lane & 15;
  const int nks = K >> 8, kbase = w * (K >> 3) + 8 * g4;
  f32x4 acc[8][NACC];
#pragma unroll
  for (int rt = 0; rt < 8; ++rt)
#pragma unroll
    for (int i = 0; i < NACC; ++i) acc[rt][i] = (f32x4){0.f, 0.f, 0.f, 0.f};
  const bf16_t* ap = A + (size_t)(row0 + l15) * K + kbase;
  const bf16_t* bp = Bt + (size_t)(brow0 + l15) * K + kbase;
  for (int ks = 0; ks < nks; ks += 2) {
    const bool two = ks + 1 < nks;
    bf16x8 a0[8], a1[8], b0[NACC], b1[NACC];
#pragma unroll
    for (int rt = 0; rt < 8; ++rt) a0[rt] = *(const bf16x8*)(ap + (size_t)16 * rt * K + 32 * ks);
#pragma unroll
    for (int i = 0; i < NACC; ++i) b0[i] = *(const bf16x8*)(bp + (size_t)bstep * i * K + 32 * ks);
    if (two) {
#pragma unroll
      for (int rt = 0; rt < 8; ++rt) a1[rt] = *(const bf16x8*)(ap + (size_t)16 * rt * K + 32 * ks + 32);
#pragma unroll
      for (int i = 0; i < NACC; ++i) b1[i] = *(const bf16x8*)(bp + (size_t)bstep * i * K + 32 * ks + 32);
    }
#pragma unroll
    for (int rt = 0; rt < 8; ++rt)
#pragma unroll
      for (int i = 0; i < NACC; ++i) acc[rt][i] = __builtin_amdgcn_mfma_f32_16x16x32_bf16(b0[i], a0[rt], acc[rt][i], 0, 0, 0);
    if (two) {
#pragma unroll
      for (int rt = 0; rt < 8; ++rt)
#pragma unroll
        for (int i = 0; i < NACC; ++i) acc[rt][i] = __builtin_amdgcn_mfma_f32_16x16x32_bf16(b1[i], a1[rt], acc[rt][i], 0, 0, 0);
    }
  }
#pragma unroll
  for (int rt = 0; rt < 8; ++rt)
#pragma unroll
    for (int i = 0; i < NACC; ++i) *(f32x4*)(red + (size_t)(((w * 8 + rt) * NACC + i) * 64 + lane) * 4) = acc[rt][i];
  __syncthreads();
#pragma unroll
  for (int i = 0; i < NACC; ++i) {
    f32x4 t = (f32x4){0.f, 0.f, 0.f, 0.f};
#pragma unroll
    for (int ww = 0; ww < 8; ++ww) t += *(const f32x4*)(red + (size_t)(((ww * 8 + w) * NACC + i) * 64 + lane) * 4);
    out[i] = t;
  }
}
template <class F, int NA = 1>
__device__ __forceinline__ void skinny_run(const F& f, const bf16_t* A, int K, const bf16_t* Bt, int rowbase, int nrt, int ncu, int bid, int G, unsigned char* shm, int c0 = 0) {
  const int tid = tidx(), w = tid >> 6, lane = tid & 63, g = lane >> 4;
  const int ncu2 = ncu / NA, total = nrt * ncu2, nc = G - c0;
  if (bid < c0) return;
  for (int su = (G - 1 - bid); su < total; su += nc) {
    const int rt = su / ncu2, cu = su - rt * ncu2;
    const int row0 = rowbase + rt * 128, arow = row0 + 16 * w + (lane & 15);
    f32x4 acc[NA];
    const float rs = F::NEEDR ? f.rowscale(arow) : 1.f;
    skinny_unit<NA>(A, K, Bt, row0, 16 * NA * cu, 16, (float*)shm, acc);
#pragma unroll
    for (int i = 0; i < NA; ++i) {
      float ss = f(arow, 16 * (NA * cu + i) + 4 * g, acc[i], rs);
      if (F::STAT) { ss += __shfl_xor(ss, 16); ss += __shfl_xor(ss, 32); if (g == 0) ss_add(f.ss + arow, ss); }
    }
    __syncthreads();
  }
}
template <class F>
__device__ __forceinline__ void skinny_run_quarter(const F& f, const bf16_t* A, int K, const bf16_t* Bt, int ncu, int bid, int G, unsigned char* shm, int c0) {
  const int tid = tidx(), w = tid >> 6, lane = tid & 63, g4 = lane >> 4, l15 = lane & 15;
  const int total = 4 * ncu, nc = G - c0;
  if (bid < c0) return;
  float* red = (float*)shm;
  for (int su = (G - 1 - bid); su < total; su += nc) {
    const int cu = su >> 2, rq = su & 3, rt = w >> 2, kq = w & 3;
    const int arow = NP + 32 * rq + 16 * rt + l15;
    const int kspan = K >> 2, kbase = kq * kspan + 8 * g4;
    const bf16_t* ap = A + (size_t)arow * K + kbase;
    const bf16_t* bp = Bt + (size_t)(16 * cu + l15) * K + kbase;
    f32x4 acc = (f32x4){0.f, 0.f, 0.f, 0.f};
    typename F::Pre pre;
    if (kq == 0) pre = f.pre(arow, 16 * cu + 4 * g4);
    for (int k0 = 0; k0 < kspan; k0 += 256) {
      bf16x8 a[8], b[8];
#pragma unroll
      for (int s8 = 0; s8 < 8; ++s8) { if (k0 + 32 * s8 < kspan) { a[s8] = *(const bf16x8*)(ap + k0 + 32 * s8); b[s8] = *(const bf16x8*)(bp + k0 + 32 * s8); } }
#pragma unroll
      for (int s8 = 0; s8 < 8; ++s8) { if (k0 + 32 * s8 < kspan) acc = __builtin_amdgcn_mfma_f32_16x16x32_bf16(b[s8], a[s8], acc, 0, 0, 0); }
    }
    *(f32x4*)(red + (size_t)(w * 64 + lane) * 4) = acc;
    __syncthreads();
    if (kq == 0) {
      f32x4 t = acc;
#pragma unroll
      for (int q = 1; q < 4; ++q) t += *(const f32x4*)(red + (size_t)((w + q) * 64 + lane) * 4);
      float ss = f.post(arow, 16 * cu + 4 * g4, t, pre);
      if (F::STAT) { ss += __shfl_xor(ss, 16); ss += __shfl_xor(ss, 32); if (g4 == 0) ss_add(f.ss + arow, ss); }
    }
    __syncthreads();
  }
}
__device__ __forceinline__ void skinny_run13(const F13& f, const bf16_t* A, const bf16_t* Bt, int bid, int G, unsigned char* shm) {
  const int tid = tidx(), w = tid >> 6, lane = tid & 63, g = lane >> 4;
  const int c0 = ((NP / 256) * (2 * DFF / 256)) % G, nc = G - c0;
  if (bid < c0) return;
  for (int su = (G - 1 - bid); su < DFF / 16; su += nc) {
    const int arow = NP + 16 * w + (lane & 15);
    f32x4 acc[2];
    const float rs13 = f.rowscale(arow);
    skinny_unit<2>(A, 1024, Bt, NP, ((16 * su) >> 7) * 256 + ((16 * su) & 127), 128, (float*)shm, acc);
    f.pair(arow, 16 * su + 4 * g, acc[0], acc[1], rs13);
    __syncthreads();
  }
}
template <class F>
__device__ __forceinline__ void gemm_all(LAS unsigned char* lds, unsigned char* shm, const bf16_t* A, const bf16_t* Bt, int N, int K, const F& f, int bid, int G) {
  pg8::Gemm g; g.A = A; g.Bt = Bt; g.M = NP; g.N = N; g.K = K;
  pg8::StaticOrder S; S.init(NP, N, G, bid);
  EpiMain<F> E; E.f = f; E.coff = 0;
  REP(F::STAT ? 0 : 512) pg8::gemm_phase(lds, g, S, E);
  const int c0 = ((NP / 256) * (N / 256)) % G;
  if ((N / 16) * 2 <= G - c0) skinny_run_quarter(f, A, K, Bt, N / 16, bid, G, shm, c0);
  else skinny_run(f, A, K, Bt, NP, 1, N / 16, bid, G, shm, c0);
}

template <class F>
__device__ __forceinline__ void gemm_main_window(LAS unsigned char* lds, const bf16_t* A, const bf16_t* Bt, int N, int K, const F& f, int coff, int bid, int G) {
  pg8::Gemm g; g.A = A; g.Bt = Bt; g.M = NP; g.N = N; g.K = K;
  pg8::StaticOrder S; S.init(NP, N, G, bid);
  EpiMain<F> E; E.f = f; E.coff = coff;
  pg8::gemm_phase(lds, g, S, E);
}

__device__ __forceinline__ void prep_s5tables(const Params& P, int item, unsigned char* shm);
__device__ __forceinline__ void prep_phase(const Params& P, unsigned char* shm, int bid, int G) {
  const int tid = tidx(), w = tid >> 6, lane = tid & 63;
  bf16_t* T = (bf16_t*)shm;
  int jcur = 0;
  for (int t0 = 4 * bid; t0 < P.total_tiles; t0 += 4 * G) {
    f32x4 v0[4], v1[4]; float sc[4]; int jix[4];
    const int kk = tid >> 3, jq = tid & 7, nn = jq * 8;
#pragma unroll
    for (int u = 0; u < 4; ++u) {
      const int tile = t0 + u;
      v0[u] = (f32x4){0.f, 0.f, 0.f, 0.f}; v1[u] = v0[u]; sc[u] = 1.f;
      if (tile < P.total_tiles) {
        while (jcur + 1 < P.njobs && P.jobs[jcur + 1].tile0 <= tile) ++jcur;
        jix[u] = jcur;
        const TJob& J = P.jobs[jcur];
        const int lt = tile - J.tile0, tn = lt % J.ntn, tk = lt / J.ntn, k0 = tk * 64, n0 = tn * 64;
        if (n0 + nn < J.ncols) { const float* sp = J.src + (size_t)(k0 + kk) * J.ldn + J.c0 + n0 + nn; v0[u] = *(const f32x4*)sp; v1[u] = *(const f32x4*)(sp + 4); }
        if (J.scale) sc[u] = J.scale[k0 + kk];
      }
    }
#pragma unroll
    for (int u = 0; u < 4; ++u) {
      bf16_t* Tu = T + u * (64 * 72);
      const int kx = kk ^ (8 * jq);
#pragma unroll
      for (int i = 0; i < 4; ++i) { Tu[(nn + i) * 72 + kx] = f2bf(v0[u][i] * sc[u]); Tu[(nn + 4 + i) * 72 + kx] = f2bf(v1[u][i] * sc[u]); }
    }
    __syncthreads();
#pragma unroll
    for (int u = 0; u < 4; ++u) {
      const int tile = t0 + u;
      if (tile < P.total_tiles) {
        const TJob& J = P.jobs[jix[u]];
        const int lt = tile - J.tile0, tn = lt % J.ntn, tk = lt / J.ntn, k0 = tk * 64, n0 = tn * 64;
        const int n = tid >> 3, k8 = (tid & 7) * 8, gn = n0 + n;
        if (gn < J.nwrite) {
          const int dr = J.mode == 0 ? J.r0 + gn : ((gn >> 7) * 256 + (J.mode == 2 ? 128 : 0) + (gn & 127));
          *(u32x4*)(J.dst + (size_t)dr * J.K + k0 + k8) = *(const u32x4*)(T + u * (64 * 72) + n * 72 + (k8 ^ (8 * ((n >> 3) & 7))));
        }
      }
    }
    __syncthreads();
  }
  for (int i = bid * 512 + tid; i < 2 * 2048; i += G * 512) {
    const int l = i >> 11, gp = i & 2047, g = gp >> 6, p = gp & 63;
    const float dt = expf(P.log_dt[l * 32 + g]);
    const float Ar = P.A_re[l * 2048 + gp], Ai = P.A_im[l * 2048 + gp];
    const float mag = expf(dt * Ar);
    float sn, cs; sincosf(dt * Ai, &sn, &cs);
    const float abr = mag * cs, abi = mag * sn;
    const float den = Ar * Ar + Ai * Ai, nr = abr - 1.0f, ni = abi;
    const float fre = (nr * Ar + ni * Ai) / den, fim = (ni * Ar - nr * Ai) / den;
    P.abar[l][gp] = abr; P.abar[l][2048 + gp] = abi;
    for (int c = 0; c < 16; ++c) {
      const float Br = P.B_re[(size_t)l * 32768 + gp * 16 + c], Bi = P.B_im[(size_t)l * 32768 + gp * 16 + c];
      P.bbar[l][(g * 16 + c) * 64 + p] = fre * Br - fim * Bi;
      P.bbar[l][32768 + (g * 16 + c) * 64 + p] = fre * Bi + fim * Br;
    }
  }
  for (int it = bid; it < 256; it += G) prep_s5tables(P, it, shm);
  for (int row = bid * 8 + w; row < NT; row += G * 8) {
    const float* xr = row < NP ? P.x_prompt + (size_t)row * DM : P.x_sample + (size_t)(row - NP) * DM;
    float ss = 0.f;
#pragma unroll
    for (int i = 0; i < 4; ++i) {
      const f32x4 v = *(const f32x4*)(xr + 256 * i + 4 * lane);
      ss += (v[0] * v[0] + v[1] * v[1]) + (v[2] * v[2] + v[3] * v[3]);
      *(u32x2*)(P.xb + (size_t)row * DM + 256 * i + 4 * lane) = pack4(v);
    }
    ss = wave_sum(ss);
    if (lane == 0) P.ssA[row] = ss_fix(ss);
  }
}

__device__ __forceinline__ void mlstm_scalars(const float* gat, int b, int h, float* sA, float* sM, float* sB, float* chain) {
  const int tid = tidx(), w = tid >> 6, lane = tid & 63;
  for (int cc = w; cc < 16; cc += 8) {
    const int t0 = cc * 128 + 2 * lane; const size_t r0 = (size_t)b * 2048 + t0;
    const float ig0 = gat[r0 * 8 + h], lf0 = gat[r0 * 8 + 4 + h], ig1 = gat[(r0 + 1) * 8 + h], lf1 = gat[(r0 + 1) * 8 + 4 + h];
    float x = lf0 + lf1;
    for (int off = 1; off < 64; off <<= 1) { const float y = __shfl_up(x, off); if (lane >= off) x += y; }
    const float b1 = x, b0 = x - lf1, a0 = ig0 - b0, a1 = ig1 - b1;
    float cm = fmaxf(a0, a1);
    for (int off = 1; off < 64; off <<= 1) { const float y = __shfl_up(cm, off); if (lane >= off) cm = fmaxf(cm, y); }
    const float prev = __shfl_up(cm, 1); const float cm0 = lane ? fmaxf(prev, a0) : a0;
    sB[t0] = b0; sB[t0 + 1] = b1; sA[t0] = a0; sA[t0 + 1] = a1; sM[t0] = cm0; sM[t0 + 1] = cm;
    if (lane == 63) { chain[33 + cc] = b1; chain[49 + cc] = cm; }
  }
  __syncthreads();
  if (tid == 0) { float m = 0.f; for (int cc = 0; cc < 16; ++cc) { chain[cc] = m; const float ml = fmaxf(m, chain[49 + cc]); chain[17 + cc] = ml; m = chain[33 + cc] + ml; } chain[16] = m; }
  __syncthreads();
  for (int t = tid; t < 2048; t += 512) sM[t] = fmaxf(chain[t >> 7], sM[t]);
  __syncthreads();
}

__device__ __forceinline__ void m1_item(const Params& P, int item, unsigned char* shm) {
  const int tid = tidx(), w = __builtin_amdgcn_readfirstlane(tid >> 6), lane = tid & 63, g = lane >> 4;
  const int b = item >> 6, h = (item >> 4) & 3, c = item & 15;
  float* sA = (float*)shm; float* sM = sA + 2048; float* sB = sM + 2048; float* chain = sB + 2048;
  mlstm_scalars(P.gat, b, h, sA, sM, sB, chain);
  const int row0 = b * 2048 + c * 128, t = 16 * w + (lane & 15);
  const bf16_t* qp = P.Pb + (size_t)(row0 + t) * NG1 + h * 256 + 8 * g;
  bf16x8 qf[8];
#pragma unroll
  for (int ks = 0; ks < 8; ++ks) qf[ks] = *(const bf16x8*)(qp + 32 * ks);
  const float Mt = sM[c * 128 + t];
  bf16_t* sp = P.St + (size_t)item * 16384 + t * 128;
#pragma unroll
  for (int sg = 0; sg < 8; sg += 4) {
    if (sg <= w) {
      bf16x8 kf[4][8];
#pragma unroll
      for (int u = 0; u < 4; ++u) {
        if (sg + u <= w) {
          const bf16_t* kp = P.Pb + (size_t)(row0 + 16 * (sg + u) + (lane & 15)) * NG1 + 1024 + h * 256 + 8 * g;
#pragma unroll
          for (int ks = 0; ks < 8; ++ks) kf[u][ks] = *(const bf16x8*)(kp + 32 * ks);
        }
      }
#pragma unroll
      for (int u = 0; u < 4; ++u) {
        const int st = sg + u;
        f32x4 acc = (f32x4){0.f, 0.f, 0.f, 0.f};
        if (st <= w) {
#pragma unroll
          for (int ks = 0; ks < 8; ++ks) acc = __builtin_amdgcn_mfma_f32_16x16x32_bf16(kf[u][ks], qf[ks], acc, 0, 0, 0);
#pragma unroll
          for (int r = 0; r < 4; ++r) { const int s2 = 16 * st + 4 * g + r; acc[r] = (s2 <= t) ? acc[r] * __expf(sA[c * 128 + s2] - Mt) : 0.f; }
        }
        *(u32x2*)(sp + 16 * st + 4 * g) = pack4(acc);
      }
    } else {
#pragma unroll
      for (int u = 0; u < 4; ++u) *(u32x2*)(sp + 16 * (sg + u) + 4 * g) = (u32x2){0u, 0u};
    }
  }
  __syncthreads();
}

__device__ __forceinline__ bf16x8 trread8(unsigned a0, unsigned a1) {
  bf16x4 lo, hi;
  asm volatile("ds_read_b64_tr_b16 %0, %2\n\tds_read_b64_tr_b16 %1, %3\n\ts_waitcnt lgkmcnt(0)" : "=&v"(lo), "=&v"(hi) : "v"(a0), "v"(a1) : "memory");
  return __builtin_shufflevector(lo, hi, 0, 1, 2, 3, 4, 5, 6, 7);
}
__device__ __forceinline__ void trread8x3(unsigned a0, unsigned a1, unsigned a2, unsigned dlt, bf16x8& r0, bf16x8& r1, bf16x8& r2) {
  bf16x4 l0, h0, l1, h1, l2, h2;
  asm volatile("ds_read_b64_tr_b16 %0, %6\n\tds_read_b64_tr_b16 %1, %7\n\tds_read_b64_tr_b16 %2, %8\n\tds_read_b64_tr_b16 %3, %9\n\tds_read_b64_tr_b16 %4, %10\n\tds_read_b64_tr_b16 %5, %11\n\ts_waitcnt lgkmcnt(0)"
               : "=&v"(l0), "=&v"(h0), "=&v"(l1), "=&v"(h1), "=&v"(l2), "=&v"(h2)
               : "v"(a0), "v"(a0 + dlt), "v"(a1), "v"(a1 + dlt), "v"(a2), "v"(a2 + dlt) : "memory");
  r0 = __builtin_shufflevector(l0, h0, 0, 1, 2, 3, 4, 5, 6, 7); r1 = __builtin_shufflevector(l1, h1, 0, 1, 2, 3, 4, 5, 6, 7); r2 = __builtin_shufflevector(l2, h2, 0, 1, 2, 3, 4, 5, 6, 7);
}
__device__ __forceinline__ void trread8x2(unsigned a0, unsigned a1, unsigned dlt, bf16x8& r0, bf16x8& r1) {
  bf16x4 l0, h0, l1, h1;
  asm volatile("ds_read_b64_tr_b16 %0, %4\n\tds_read_b64_tr_b16 %1, %5\n\tds_read_b64_tr_b16 %2, %6\n\tds_read_b64_tr_b16 %3, %7\n\ts_waitcnt lgkmcnt(0)"
               : "=&v"(l0), "=&v"(h0), "=&v"(l1), "=&v"(h1) : "v"(a0), "v"(a0 + dlt), "v"(a1), "v"(a1 + dlt) : "memory");
  r0 = __builtin_shufflevector(l0, h0, 0, 1, 2, 3, 4, 5, 6, 7); r1 = __builtin_shufflevector(l1, h1, 0, 1, 2, 3, 4, 5, 6, 7);
}

constexpr int KS_STRIDE = 272, VS_STRIDE = 56;
constexpr int M2_K = 0, M2_V = 69632, M2_CL = 83968, M2_SC = 110080;
__device__ __forceinline__ void m2_item(const Params& P, int l, int item, unsigned char* shm) {
  const int tid = tidx(), w = __builtin_amdgcn_readfirstlane(tid >> 6), lane = tid & 63, g = lane >> 4, l15 = lane & 15;
  const int bh = item >> 3, j = item & 7, b = bh >> 2, h = bh & 3;
  bf16_t* Ksh = (bf16_t*)(shm + M2_K); bf16_t* Vsh = (bf16_t*)(shm + M2_V); bf16_t* Cl = (bf16_t*)(shm + M2_CL);
  float* sA = (float*)(shm + M2_SC); float* sM = sA + 2048; float* sB = sM + 2048; float* chain = sB + 2048;
  const unsigned lbase = (unsigned)(size_t)shm;
  u32x4 kreg[8]; u32x4 vreg;
  const int vs = tid >> 2, vpc = tid & 3;
  {
    const int row0 = b * 2048;
#pragma unroll
    for (int i = 0; i < 8; ++i) { const int piece = tid + 512 * i, s = piece >> 5, pc = piece & 31; kreg[i] = *(const u32x4*)(P.Pb + (size_t)(row0 + s) * NG1 + 1024 + h * 256 + 8 * pc); }
    vreg = *(const u32x4*)(P.Pb + (size_t)(row0 + vs) * NG1 + 2048 + h * 256 + 32 * j + 8 * vpc);
  }
  bf16x8 qf[8], sf[4];
  {
    const int t = 16 * w + l15;
#pragma unroll
    for (int ks = 0; ks < 8; ++ks) qf[ks] = (bf16x8){0, 0, 0, 0, 0, 0, 0, 0};
    const bf16_t* sp0 = P.St + (size_t)(bh * 16) * 16384 + t * 128 + 8 * g;
#pragma unroll
    for (int ks = 0; ks < 4; ++ks) sf[ks] = *(const bf16x8*)(sp0 + 32 * ks);
  }
  mlstm_scalars(P.gat, b, h, sA, sM, sB, chain);
  f32x4 Cacc[2][3];
#pragma unroll
  for (int dt = 0; dt < 2; ++dt)
#pragma unroll
    for (int et = 0; et < 3; ++et) Cacc[dt][et] = (f32x4){0.f, 0.f, 0.f, 0.f};
  const int trq = l15 >> 2, trp = lane & 3;
#define M2_WRITE_KV(cc) do { \
    const float ml_ = chain[17 + (cc)]; \
    _Pragma("unroll") for (int i = 0; i < 8; ++i) { const int piece = tid + 512 * i, s = piece >> 5, pc = piece & 31; \
      const float wk = __expf(sA[(cc) * 128 + s] - ml_); u32x4 sc; \
      _Pragma("unroll") for (int e = 0; e < 4; ++e) { const unsigned u = kreg[i][e]; sc[e] = pack2(bf2f(u & 0xffffu) * wk, bf2f(u >> 16) * wk); } \
      *(u32x4*)(Ksh + s * KS_STRIDE + 8 * pc) = sc; } \
    *(u32x4*)(Vsh + vs * VS_STRIDE + 8 * vpc) = vreg; \
    if (vpc == 0) { unsigned zz = 0u; asm volatile("" : "+v"(zz)); const u32x4 z = (u32x4){zz, zz, zz, zz}; u32x4 o1 = z; o1[0] = 0x3F80u; \
      *(u32x4*)(Vsh + vs * VS_STRIDE + 32) = o1; *(u32x4*)(Vsh + vs * VS_STRIDE + 40) = z; } } while (0)
  M2_WRITE_KV(0);
  __syncthreads();
  for (int c = 0; c < 16; ++c) {
    const int row0 = b * 2048 + c * 128;
    const float mlast = chain[17 + c], mprev = chain[c];
    if (c < 15) {
      const int nrow0 = row0 + 128;
#pragma unroll
      for (int i = 0; i < 8; ++i) { const int piece = tid + 512 * i, s = piece >> 5, pc = piece & 31; kreg[i] = *(const u32x4*)(P.Pb + (size_t)(nrow0 + s) * NG1 + 1024 + h * 256 + 8 * pc); }
      vreg = *(const u32x4*)(P.Pb + (size_t)(nrow0 + vs) * NG1 + 2048 + h * 256 + 32 * j + 8 * vpc);
    }
    {
      const int t = 16 * w + l15, row = row0 + t;
      f32x4 acc[3]; acc[0] = (f32x4){0.f, 0.f, 0.f, 0.f}; acc[1] = acc[0]; acc[2] = acc[0];
      const float Mt = sM[c * 128 + t];
      if (c > 0) {
#pragma unroll
        for (int ks = 0; ks < 8; ++ks) {
          bf16x8 cf[3];
#pragma unroll
          for (int et = 0; et < 3; ++et) cf[et] = *(const bf16x8*)(Cl + (16 * et + l15) * KS_STRIDE + 32 * ks + 8 * g);
          __builtin_amdgcn_sched_barrier(0);
#pragma unroll
          for (int et = 0; et < 3; ++et) acc[et] = __builtin_amdgcn_mfma_f32_16x16x32_bf16(cf[et], qf[ks], acc[et], 0, 0, 0);
          __builtin_amdgcn_sched_barrier(0);
        }
        const float wi = __expf(mprev - Mt);
        acc[0] *= wi; acc[1] *= wi; acc[2] *= wi;
      }
      const float ac = __expf(mprev - mlast);
#pragma unroll
      for (int dt = 0; dt < 2; ++dt)
#pragma unroll
        for (int et = 0; et < 3; ++et) Cacc[dt][et] *= ac;
#pragma unroll
      for (int ks = 0; ks < 4; ++ks) {
        bf16x8 kf[2], vf[3];
        const unsigned va = lbase + M2_V + (unsigned)((32 * ks + 8 * g + trq) * VS_STRIDE + 4 * trp) * 2u;
        const unsigned ka = lbase + M2_K + (unsigned)((32 * ks + 8 * g + trq) * KS_STRIDE + 32 * w + 4 * trp) * 2u;
        trread8x3(va, va + 32u, va + 64u, 4u * VS_STRIDE * 2u, vf[0], vf[1], vf[2]);
        trread8x2(ka, ka + 32u, 4u * KS_STRIDE * 2u, kf[0], kf[1]);
#pragma unroll
        for (int et = 0; et < 3; ++et) acc[et] = __builtin_amdgcn_mfma_f32_16x16x32_bf16(vf[et], sf[ks], acc[et], 0, 0, 0);
#pragma unroll
        for (int dt = 0; dt < 2; ++dt)
#pragma unroll
          for (int et = 0; et < 3; ++et) Cacc[dt][et] = __builtin_amdgcn_mfma_f32_16x16x32_bf16(kf[dt], vf[et], Cacc[dt][et], 0, 0, 0);
      }
      if (c < 15) {
        const bf16_t* qp = P.Pb + (size_t)(row + 128) * NG1 + h * 256 + 8 * g;
#pragma unroll
        for (int ks = 0; ks < 8; ++ks) qf[ks] = *(const bf16x8*)(qp + 32 * ks);
        const bf16_t* sp = P.St + (size_t)(bh * 16 + c + 1) * 16384 + t * 128 + 8 * g;
#pragma unroll
        for (int ks = 0; ks < 4; ++ks) sf[ks] = *(const bf16x8*)(sp + 32 * ks);
      }
      const float den = __shfl(acc[2][0], l15);
      const float dd = fmaxf(fabsf(den), __expf(-(sB[c * 128 + t] + Mt)));
      const float inv = __builtin_amdgcn_rcpf(dd);
      const f32x4 o0 = acc[0] * inv, o1 = acc[1] * inv;
      bf16_t* hp = P.hA + (size_t)row * DM + h * 256 + 32 * j + 4 * g;
      *(u32x2*)hp = pack4(o0); *(u32x2*)(hp + 16) = pack4(o1);
      float ss = (o0[0] * o0[0] + o0[1] * o0[1]) + (o0[2] * o0[2] + o0[3] * o0[3]) + (o1[0] * o1[0] + o1[1] * o1[1]) + (o1[2] * o1[2] + o1[3] * o1[3]);
      ss += __shfl_xor(ss, 16); ss += __shfl_xor(ss, 32);
      if (g == 0) P.hss[(size_t)row * 32 + h * 8 + j] = ss;
    }
    LDS_BARRIER();
#pragma unroll
    for (int dt = 0; dt < 2; ++dt)
#pragma unroll
      for (int et = 0; et < 3; ++et) *(u32x2*)(Cl + (16 * et + l15) * KS_STRIDE + 32 * w + 16 * dt + 4 * g) = pack4(Cacc[dt][et]);
    if (c < 15) M2_WRITE_KV(c + 1);
    LDS_BARRIER();
  }
#undef M2_WRITE_KV
  const size_t sidx = (size_t)(l * 8 + b) * 4 + h;
#pragma unroll
  for (int dt = 0; dt < 2; ++dt)
#pragma unroll
    for (int r = 0; r < 4; ++r) {
      const int d = 32 * w + 16 * dt + 4 * g + r;
      P.out[O_CP + sidx * 65536 + (size_t)d * 256 + 32 * j + l15] = Cacc[dt][0][r];
      P.out[O_CP + sidx * 65536 + (size_t)d * 256 + 32 * j + 16 + l15] = Cacc[dt][1][r];
      if (j == 0 && l15 == 0) P.out[O_NP + sidx * 256 + d] = Cacc[dt][2][r];
    }
  if (j == 0 && tid == 0) P.out[O_MP + sidx] = chain[16];
  __syncthreads();
}

__device__ __forceinline__ void msample_item(const Params& P, int l, int item, unsigned char* shm) {
  const int tid = tidx(), w = tid >> 6, lane = tid & 63;
  const int b = item >> 2, h = item & 3, row = NP + b;
  float* q = (float*)shm; float* k = q + 256; float* v = k + 256; float* red = v + 256; float* red2 = red + 2048;
  if (tid < 256) {
    const bf16_t* pr = P.Pb + (size_t)row * NG1 + h * 256 + tid;
    q[tid] = bf2f(pr[0]); k[tid] = bf2f(pr[1024]); v[tid] = bf2f(pr[2048]);
  }
  const float ig = P.gat[(size_t)row * 8 + h], lf = P.gat[(size_t)row * 8 + 4 + h];
  const size_t sidx = (size_t)(l * 128 + b) * 4 + h;
  const float m0 = P.st_m[sidx];
  const float inter = lf + m0, mt = fmaxf(inter, ig), wi = __expf(inter - mt), wa = __expf(ig - mt);
  __syncthreads();
  const float* C0 = P.st_C + sidx * 65536; float* Co = P.out + O_CS + sidx * 65536;
  const float* n0 = P.st_n + sidx * 256;
  const f32x4 v4 = *(const f32x4*)(v + 4 * lane);
  f32x4 acc = (f32x4){0.f, 0.f, 0.f, 0.f};
#pragma unroll 8
  for (int dd = 0; dd < 32; ++dd) {
    const int d = 32 * w + dd;
    const f32x4 c4 = __builtin_nontemporal_load((const f32x4*)(C0 + (size_t)d * 256 + 4 * lane));
    const float kd = wa * k[d], qd = q[d];
    __builtin_nontemporal_store(c4 * wi + v4 * kd, (f32x4*)(Co + (size_t)d * 256 + 4 * lane));
    acc += c4 * qd;
  }
  *(f32x4*)(red + w * 256 + 4 * lane) = acc;
  float qk = 0.f, qn = 0.f;
#pragma unroll
  for (int i = 0; i < 4; ++i) { const int d = lane + 64 * i; qk += q[d] * k[d]; qn += q[d] * n0[d]; }
  qk = wave_sum(qk); qn = wave_sum(qn);
  __syncthreads();
  const float s = qk * wa, den = wi * qn + s, ddn = fmaxf(fabsf(den), __expf(-mt));
  float hval = 0.f;
  if (tid < 256) {
    float num = 0.f;
#pragma unroll
    for (int i = 0; i < 8; ++i) num += red[i * 256 + tid];
    hval = (wi * num + s * v[tid]) / ddn;
    P.hA[(size_t)row * DM + h * 256 + tid] = f2bf(hval);
    P.out[O_NS + sidx * 256 + tid] = wi * n0[tid] + wa * k[tid];
  }
  float ss = wave_sum(hval * hval);
  if (lane == 0) red2[w] = ss;
  __syncthreads();
  if (tid < 8) P.hss[(size_t)row * 32 + h * 8 + tid] = tid == 0 ? (red2[0] + red2[1] + red2[2] + red2[3]) : 0.f;
  if (tid == 0) P.out[O_MS + sidx] = mt;
  __syncthreads();
}

__device__ __forceinline__ void s5_load_C(const Params& P, int l, int g, float* Csh) {
  for (int i = tidx(); i < 2048; i += 512) { const int ri = i >> 10, c = (i >> 6) & 15, p = i & 63;
    Csh[ri * 1088 + c * 68 + p] = (ri ? P.C_im : P.C_re)[(size_t)l * 32768 + (g * 16 + c) * 64 + p]; }
}
__device__ __forceinline__ void s5_sample_item(const Params& P, int l, int item, unsigned char* shm) {
  const int tid = tidx(), w = tid >> 6, lane = tid & 63;
  const int g = item & 31, bs0 = (item >> 5) * 16 + 2 * w;
  float* Csh = (float*)shm; float* sbuf = Csh + 2176 + w * 2176;
  s5_load_C(P, l, g, Csh);
  const float are = P.abar[l][g * 64 + lane], aim = P.abar[l][2048 + g * 64 + lane];
  float bre[16], bim[16];
#pragma unroll
  for (int c = 0; c < 16; ++c) { bre[c] = P.bbar[l][(g * 16 + c) * 64 + lane]; bim[c] = P.bbar[l][32768 + (g * 16 + c) * 64 + lane]; }
  const int ch = lane >> 2, pq = lane & 3;
  const float Dc = P.D_skip[l * 512 + g * 16 + ch];
  __syncthreads();
#pragma unroll
  for (int rep = 0; rep < 2; ++rep) {
    const int bs = bs0 + rep, row = NP + bs;
    const size_t o = ((size_t)(l * 128 + bs) * 32 + g) * 64 + lane;
    const float s0r = P.st_sre[o], s0i = P.st_sim[o];
    const bf16_t* up = P.Pb + (size_t)row * NG1 + 4096 + g * 16;
    const u32x4 u0 = *(const u32x4*)up, u1 = *(const u32x4*)(up + 8);
    float br = 0.f, bi = 0.f;
#pragma unroll
    for (int i = 0; i < 4; ++i) {
      const float ua = bf2f(u0[i] & 0xffffu), ub = bf2f(u0[i] >> 16), uc = bf2f(u1[i] & 0xffffu), ud = bf2f(u1[i] >> 16);
      br += bre[2 * i] * ua + bre[2 * i + 1] * ub + bre[8 + 2 * i] * uc + bre[8 + 2 * i + 1] * ud;
      bi += bim[2 * i] * ua + bim[2 * i + 1] * ub + bim[8 + 2 * i] * uc + bim[8 + 2 * i + 1] * ud;
    }
    const float sr = are * s0r - aim * s0i + br, si = are * s0i + aim * s0r + bi;
    P.out[O_SRS + o] = sr; P.out[O_SIS + o] = si;
    sbuf[rep * 136 + lane] = sr; sbuf[rep * 136 + 68 + lane] = si;
    asm volatile("s_waitcnt lgkmcnt(0)" ::: "memory");
    float acc = 0.f;
#pragma unroll
    for (int p4 = 0; p4 < 4; ++p4) {
      const int p0 = 16 * pq + 4 * p4;
      const f32x4 vr = *(const f32x4*)(sbuf + rep * 136 + p0), vi = *(const f32x4*)(sbuf + rep * 136 + 68 + p0);
      const f32x4 cr = *(const f32x4*)(Csh + ch * 68 + p0), ci = *(const f32x4*)(Csh + 1088 + ch * 68 + p0);
      acc += (cr[0] * vr[0] + cr[1] * vr[1]) + (cr[2] * vr[2] + cr[3] * vr[3]) - (ci[0] * vi[0] + ci[1] * vi[1]) - (ci[2] * vi[2] + ci[3] * vi[3]);
    }
    acc += __shfl_xor(acc, 1); acc += __shfl_xor(acc, 2);
    if (pq == 0) {
      const float uc = bf2f(up[ch]);
      P.ysb[(size_t)row * 512 + g * 16 + ch] = f2bf(gelu_tanh(acc + Dc * uc));
    }
  }
  __syncthreads();
}

__device__ __forceinline__ void prep_s5tables(const Params& P, int item, unsigned char* shm) {
  const int tid = tidx(), qpart = item & 3, l = item >> 7, g = (item >> 2) & 31;
  float* pwr = (float*)shm; float* pwi = pwr + 17 * 64; float* bbr = pwi + 17 * 64; float* bbi = bbr + 1024; float* Ccr = bbi + 1024; float* Cci = Ccr + 1024;
  if (tid < 64) {
    const int p = tid, gp = g * 64 + p;
    const float dt = expf(P.log_dt[l * 32 + g]);
    const float Ar = P.A_re[l * 2048 + gp], Ai = P.A_im[l * 2048 + gp];
    const float mag = expf(dt * Ar);
    float sn, cs; sincosf(dt * Ai, &sn, &cs);
    const float abr = mag * cs, abi = mag * sn;
    const float den = Ar * Ar + Ai * Ai, nr = abr - 1.0f, ni = abi;
    const float fre = (nr * Ar + ni * Ai) / den, fim = (ni * Ar - nr * Ai) / den;
    float pr = 1.f, pi = 0.f;
    for (int t = 0; t <= 16; ++t) { pwr[t * 64 + p] = pr; pwi[t * 64 + p] = pi; const float a = pr * abr - pi * abi, b = pr * abi + pi * abr; pr = a; pi = b; }
    for (int c = 0; c < 16; ++c) {
      const float Br = P.B_re[(size_t)l * 32768 + gp * 16 + c], Bi = P.B_im[(size_t)l * 32768 + gp * 16 + c];
      bbr[p * 16 + c] = fre * Br - fim * Bi; bbi[p * 16 + c] = fre * Bi + fim * Br;
    }
  }
  for (int i = tid; i < 1024; i += 512) { Ccr[i] = P.C_re[(size_t)l * 32768 + g * 1024 + i]; Cci[i] = P.C_im[(size_t)l * 32768 + g * 1024 + i]; }
  __syncthreads();
  bf16_t* Kt = P.Kt[l] + (size_t)g * 17 * 256; bf16_t* Gm = P.Gm[l] + (size_t)g * 32768; bf16_t* Hm = P.Hm[l] + (size_t)g * 32768;
  for (int o = qpart * 1088 + tid; o < (qpart + 1) * 1088; o += 512) {
    const int tau = o >> 8, c = (o >> 4) & 15, c2 = o & 15;
    float acc = 0.f;
    if (tau < 16) for (int p = 0; p < 64; ++p) {
      const float pr = pwr[tau * 64 + p], pi = pwi[tau * 64 + p], br = bbr[p * 16 + c2], bi = bbi[p * 16 + c2];
      const float zr = pr * br - pi * bi, zi = pr * bi + pi * br;
      acc += Ccr[c * 64 + p] * zr - Cci[c * 64 + p] * zi;
    }
    Kt[o] = f2bf(acc);
  }
  for (int o = qpart * 8192 + tid; o < (qpart + 1) * 8192; o += 512) {
    { const int tc = o >> 7, q = o & 127, t = tc >> 4, c = tc & 15, p = q & 63;
      const float cr = Ccr[c * 64 + p], ci = Cci[c * 64 + p], pr = pwr[(t + 1) * 64 + p], pi = pwi[(t + 1) * 64 + p];
      Gm[o] = f2bf(q < 64 ? (cr * pr - ci * pi) : -(cr * pi + ci * pr)); }
    { const int q = o >> 8, jc = o & 255, j = jc >> 4, c2 = jc & 15, p = q & 63;
      const float pr = pwr[(15 - j) * 64 + p], pi = pwi[(15 - j) * 64 + p], br = bbr[p * 16 + c2], bi = bbi[p * 16 + c2];
      Hm[o] = f2bf(q < 64 ? (pr * br - pi * bi) : (pr * bi + pi * br)); }
  }
  if (tid < 64 && qpart == 0) { P.a16[l][g * 64 + tid] = pwr[16 * 64 + tid]; P.a16[l][2048 + g * 64 + tid] = pwi[16 * 64 + tid]; }
  __syncthreads();
}
constexpr int S3_R0 = 0, S3_SIN = 69632, S3_KT = 69632 + 34816;
__device__ __forceinline__ void s5_stage3_item(const Params& P, int l, int item, unsigned char* shm) {
  const int tid = tidx(), w = tid >> 6, lane = tid & 63, g4 = lane >> 4, l15 = lane & 15;
  const int b = item >> 5, g = item & 31;
  float* Ebuf = (float*)(shm + S3_R0); bf16_t* Gsh = (bf16_t*)(shm + S3_R0); bf16_t* Sin = (bf16_t*)(shm + S3_SIN); bf16_t* Ksh = (bf16_t*)(shm + S3_KT);
  { bf16_t* Hsh = (bf16_t*)(shm + S3_R0); const bf16_t* Hm = P.Hm[l] + (size_t)g * 32768;
#pragma unroll
    for (int i = 0; i < 8; ++i) { const int piece = tid + 512 * i, r = piece >> 5, pc = piece & 31; *(u32x4*)(Hsh + r * 264 + 8 * pc) = *(const u32x4*)(Hm + r * 256 + 8 * pc); } }
  { const bf16_t* Kt = P.Kt[l] + (size_t)g * 17 * 256; for (int i = tid; i < 544; i += 512) *(u32x4*)(Ksh + 8 * i) = *(const u32x4*)(Kt + 8 * i); }
  const int n = 16 * w + l15, r0 = b * 2048 + n * 16;
  bf16x8 uf[8];
#pragma unroll
  for (int ks = 0; ks < 8; ++ks) uf[ks] = *(const bf16x8*)(P.Pb + (size_t)(r0 + 2 * ks + (g4 >> 1)) * NG1 + 4096 + g * 16 + 8 * (g4 & 1));
  __syncthreads();
  {
    const bf16_t* Hsh = (const bf16_t*)(shm + S3_R0);
    f32x4 eacc[8];
#pragma unroll
    for (int qt = 0; qt < 8; ++qt) {
      eacc[qt] = (f32x4){0.f, 0.f, 0.f, 0.f};
#pragma unroll
      for (int ks = 0; ks < 8; ++ks) { const bf16x8 x = *(const bf16x8*)(Hsh + (16 * qt + l15) * 264 + 32 * ks + 8 * g4); eacc[qt] = __builtin_amdgcn_mfma_f32_16x16x32_bf16(x, uf[ks], eacc[qt], 0, 0, 0); }
    }
    __syncthreads();
#pragma unroll
    for (int qt = 0; qt < 8; ++qt) *(f32x4*)(Ebuf + n * 128 + 16 * qt + 4 * g4) = eacc[qt];
  }
  __syncthreads();
  {
    const float ar = P.a16[l][g * 64 + lane], ai = P.a16[l][2048 + g * 64 + lane];
    float lr[16], li[16], sr = 0.f, si = 0.f;
#pragma unroll
    for (int k = 0; k < 16; ++k) {
      lr[k] = sr; li[k] = si;
      const float er = Ebuf[(16 * w + k) * 128 + lane], ei = Ebuf[(16 * w + k) * 128 + 64 + lane];
      const float nr = ar * sr - ai * si + er, ni = ar * si + ai * sr + ei; sr = nr; si = ni;
    }
    float* wend = (float*)(shm + S3_KT + 8704);
    wend[w * 128 + lane] = sr; wend[w * 128 + 64 + lane] = si;
    float br = ar, bi = ai;
#pragma unroll
    for (int i = 0; i < 4; ++i) { const float nr = br * br - bi * bi, ni = 2.f * br * bi; br = nr; bi = ni; }
    __syncthreads();
    float cr = 0.f, ci = 0.f;
    for (int w2 = 0; w2 < w; ++w2) { const float er = wend[w2 * 128 + lane], ei = wend[w2 * 128 + 64 + lane]; const float nr = br * cr - bi * ci + er, ni = br * ci + bi * cr + ei; cr = nr; ci = ni; }
    float pr = 1.f, pi = 0.f;
#pragma unroll
    for (int k = 0; k < 16; ++k) {
      Sin[(16 * w + k) * 136 + lane] = f2bf(lr[k] + pr * cr - pi * ci); Sin[(16 * w + k) * 136 + 64 + lane] = f2bf(li[k] + pr * ci + pi * cr);
      const float nr = pr * ar - pi * ai, ni = pr * ai + pi * ar; pr = nr; pi = ni;
    }
    if (w == 7) { const size_t o = ((size_t)(l * 8 + b) * 32 + g) * 64 + lane; P.out[O_SRP + o] = sr + pr * cr - pi * ci; P.out[O_SIP + o] = si + pr * ci + pi * cr; }
  }
  __syncthreads();
  { const bf16_t* Gm = P.Gm[l] + (size_t)g * 32768;
#pragma unroll
    for (int i = 0; i < 8; ++i) { const int piece = tid + 512 * i, r = piece >> 4, pc = piece & 15; *(u32x4*)(Gsh + r * 136 + 8 * pc) = *(const u32x4*)(Gm + r * 128 + 8 * pc); } }
  __syncthreads();
  bf16x8 sf[4];
#pragma unroll
  for (int k2 = 0; k2 < 4; ++k2) sf[k2] = *(const bf16x8*)(Sin + n * 136 + 32 * k2 + 8 * g4);
  const f32x4 D4 = *(const f32x4*)(P.D_skip + l * 512 + g * 16 + 4 * g4);
#pragma unroll
  for (int t = 0; t < 16; ++t) {
    f32x4 acc = (f32x4){0.f, 0.f, 0.f, 0.f};
    const int row = r0 + t;
    const f32x4 u4 = unpack4(*(const u32x2*)(P.Pb + (size_t)row * NG1 + 4096 + g * 16 + 4 * g4));
#pragma unroll
    for (int ks = 0; ks <= (t >> 1); ++ks) {
      const int tau = t - (2 * ks + (g4 >> 1)), idx = tau >= 0 ? tau : 16;
      const bf16x8 x = *(const bf16x8*)(Ksh + (idx * 16 + l15) * 16 + 8 * (g4 & 1));
      acc = __builtin_amdgcn_mfma_f32_16x16x32_bf16(x, uf[ks], acc, 0, 0, 0);
    }
#pragma unroll
    for (int k2 = 0; k2 < 4; ++k2) { const bf16x8 x = *(const bf16x8*)(Gsh + (t * 16 + l15) * 136 + 32 * k2 + 8 * g4); acc = __builtin_amdgcn_mfma_f32_16x16x32_bf16(x, sf[k2], acc, 0, 0, 0); }
    f32x4 y;
#pragma unroll
    for (int r = 0; r < 4; ++r) y[r] = gelu_tanh(acc[r] + D4[r] * u4[r]);
    *(u32x2*)(P.ysb + (size_t)row * 512 + g * 16 + 4 * g4) = pack4(y);
  }
  __syncthreads();
}

__device__ __forceinline__ void headnorm_rows(const Params& P, int l, int bid, int G) {
  const int w = tidx() >> 6, lane = tidx() & 63;
  constexpr int R1 = 6400;
  const bool split = (G == 256);
  const int rbeg = split ? (bid < 128 ? bid * 8 + w : R1 + (bid - 128) * 8 + w) : bid * 8 + w;
  const int rend = split ? (bid < 128 ? R1 : NT) : NT, rstep = split ? 128 * 8 : G * 8;
  for (int row = rbeg; row < rend; row += rstep) {
    if (lane == 0) { P.ssA[row] = 0ull; P.ssB[row] = 0ull; }
#pragma unroll
    for (int h = 0; h < 4; ++h) {
      const f32x4 s0 = *(const f32x4*)(P.hss + (size_t)row * 32 + h * 8), s1 = *(const f32x4*)(P.hss + (size_t)row * 32 + h * 8 + 4);
      const float ss = (s0[0] + s0[1]) + (s0[2] + s0[3]) + (s1[0] + s1[1]) + (s1[2] + s1[3]);
      const float rh = rsqrtf(ss * (1.0f / 256.0f) + 1e-6f);
      const int col = h * 256 + 4 * lane;
      const f32x4 hv = unpack4(*(const u32x2*)(P.hA + (size_t)row * DM + col));
      const f32x4 so = unpack4(*(const u32x2*)(P.Pb + (size_t)row * NG1 + 3072 + col));
      const f32x4 gh = *(const f32x4*)(P.g_hn + l * 1024 + col);
      *(u32x2*)(P.xa + (size_t)row * DM + col) = pack4(so * hv * gh * rh);
    }
  }
}
__device__ __forceinline__ void final_rows(const Params& P, int bid, int G) {
  const int w = tidx() >> 6, lane = tidx() & 63;
  for (int row = bid * 8 + w; row < NT; row += G * 8) {
    const float rs = rs_of(P.ssA[row]);
    float* o = row < NP ? P.out + O_YP + (size_t)row * DM : P.out + O_YS + (size_t)(row - NP) * DM;
#pragma unroll
    for (int i = 0; i < 4; ++i) {
      const int col = 256 * i + 4 * lane;
      const f32x4 v = *(const f32x4*)(P.X2 + (size_t)row * DM + col);
      const f32x4 gf = *(const f32x4*)(P.g_final + col);
      *(f32x4*)(o + col) = v * gf * rs;
    }
  }
}


#define XB_TMO      128
#define XB_XCNT(j)  (256  + 64 * (j))
#define XB_XSUB(j)  (1280 + 64 * (j))
#define XB_XGEN(j)  (2304 + 64 * (j))
#define XB_TOP      3328
#define XB_TOPGEN   3392
#define XCD_BAR_WORDS 3456
#define XB_SPIN_CAP (1u << 22)
__device__ __forceinline__ unsigned xb_ld(unsigned* p)              { return __hip_atomic_load(p, __ATOMIC_RELAXED, __HIP_MEMORY_SCOPE_AGENT); }
__device__ __forceinline__ unsigned xb_add(unsigned* p, unsigned v) { return __hip_atomic_fetch_add(p, v, __ATOMIC_RELAXED, __HIP_MEMORY_SCOPE_AGENT); }
__device__ __forceinline__ unsigned xb_xcc_id() { return (unsigned)__builtin_amdgcn_s_getreg((3 << 11) | 20) & 0xFu; }
#define XB_SPIN(cond, bar) do { unsigned _sp = 0; while (cond) { __builtin_amdgcn_s_sleep(1); \
    if ((++_sp & 255u) == 0u) { if (xb_ld(&(bar)[XB_TMO])) break; if (_sp > XB_SPIN_CAP) { atomicAdd(&(bar)[XB_TMO], 1u); break; } } } } while (0)
struct XcdBarrier { unsigned* bar; unsigned x; volatile LAS unsigned* st; };
__device__ __forceinline__ XcdBarrier xcd_barrier_post(unsigned* bar, volatile LAS unsigned* st) {
  XcdBarrier b; b.bar = bar; b.x = xb_xcc_id(); b.st = st;
  if (threadIdx.x == 0) (void)xb_add(&bar[XB_XCNT(b.x)], 1u);
  return b;
}
__device__ __forceinline__ void xcd_barrier_complete(unsigned* bar, unsigned x, unsigned& nloc, unsigned& nx) {
  const unsigned G = gridDim.x * gridDim.y * gridDim.z;
  unsigned sum, cnt, mine, sp = 0u;
  for (;;) {
    sum = 0u; cnt = 0u; mine = 0u;
#pragma unroll
    for (unsigned j = 0; j < 16; ++j) { const unsigned c = xb_ld(&bar[XB_XCNT(j)]); sum += c; cnt += (c > 0u) ? 1u : 0u; mine = (j == x) ? c : mine; }
    if (sum == G) break;
    __builtin_amdgcn_s_sleep(1);
    if ((++sp & 255u) == 0u) { if (xb_ld(&bar[XB_TMO])) break; if (sp > XB_SPIN_CAP) { atomicAdd(&bar[XB_TMO], 1u); break; } }
  }
  nloc = mine > 0u ? mine : 1u; nx = cnt > 0u ? cnt : 1u;
}
__device__ __forceinline__ void xcd_barrier(const XcdBarrier& b) {
  asm volatile("s_waitcnt vmcnt(0)" ::: "memory");
  __syncthreads();
  if (threadIdx.x == 0) {
    unsigned* bar = b.bar;
    __builtin_amdgcn_s_waitcnt(0);
    unsigned nloc = b.st[0], nx = b.st[1];
    if (nloc == 0u) { xcd_barrier_complete(bar, b.x, nloc, nx); b.st[0] = nloc; b.st[1] = nx; }
    const unsigned old = xb_add(&bar[XB_XSUB(b.x)], 1u);
    const unsigned gen = old / nloc;
    if (old + 1u == (gen + 1u) * nloc) {
      __builtin_amdgcn_fence(__ATOMIC_RELEASE, "agent");
      asm volatile("s_waitcnt vmcnt(0)" ::: "memory");
      const unsigned og = xb_add(&bar[XB_TOP], 1u);
      const unsigned tg = og / nx;
      if (og + 1u == (tg + 1u) * nx) xb_add(&bar[XB_TOPGEN], 1u);
      else XB_SPIN(xb_ld(&bar[XB_TOPGEN]) == tg, bar);
      __builtin_amdgcn_fence(__ATOMIC_ACQUIRE, "agent");
      xb_add(&bar[XB_XGEN(b.x)], 1u);
      asm volatile("s_waitcnt vmcnt(0)" ::: "memory");
    } else {
      XB_SPIN(xb_ld(&bar[XB_XGEN(b.x)]) == gen, bar);
      __builtin_amdgcn_fence(__ATOMIC_ACQUIRE, "agent");
      asm volatile("s_waitcnt vmcnt(0)" ::: "memory");
    }
  }
  __syncthreads();
}

__global__ void __launch_bounds__(512) mega(const Params P) {
  extern __shared__ __attribute__((aligned(16))) unsigned char shm[];
  cg::grid_group grid = cg::this_grid();
  LAS unsigned char* lds = (LAS unsigned char*)shm;
  const int bid = blockIdx.x, G = gridDim.x;

  volatile LAS unsigned* xst = (volatile LAS unsigned*)(lds + LDS_BYTES - 16);
  if (threadIdx.x == 0) { xst[0] = 0u; xst[1] = 0u; }
  if (bid == 0) for (int i = threadIdx.x; i < XCD_BAR_WORDS; i += 512) P.bar[i] = 0u;
  REP(1) prep_phase(P, shm, bid, G);
  grid.sync();
  const XcdBarrier xb = xcd_barrier_post(P.bar, xst);

  for (int l = 0; l < 2; ++l) {
    REP(2) {
      F1 f; f.bias = P.b_in + l * PTOT; f.Pb = P.Pb; f.rs = P.ssA; f.ss = nullptr;
      gemm_main_window(lds, P.xb, P.WinT[l], 4096, 1024, f, 0, bid, G);
      gemm_main_window(lds, P.xb, P.WinT[l] + (size_t)4608 * 1024, 2048, 1024, f, 4608, bid, G);
      skinny_run<F1, 2>(f, P.xb, 1024, P.WinT[l], NP, 1, NG1 / 16, bid, G, shm, 0);
      Fg fg; fg.bias = P.b_in + l * PTOT + 4096; fg.gat = P.gat; fg.rs = P.ssA; fg.ss = nullptr;
      REP(256) skinny_run(fg, P.xb, 1024, P.WgT[l], 0, 129, 1, bid, G, shm, 0);
    }
    xcd_barrier(xb);
    { F1 f; f.bias = P.b_in + l * PTOT; f.Pb = P.Pb; f.rs = P.ssA; f.ss = nullptr;
      gemm_main_window(lds, P.xb, P.WinT[l] + (size_t)4096 * 1024, 512, 1024, f, 4096, bid, G); }
    {
      const int n1 = G == 256 ? (bid < 128 ? 1 : 3) : (512 - bid + G - 1) / G;
      for (int j = 0; j < n1; ++j) m1_item(P, G == 256 ? (bid < 128 ? bid : 128 + (bid - 128) * 3 + j) : bid + j * G, shm);
      for (int it = bid; it < 512; it += G) msample_item(P, l, it, shm);
      for (int it = bid; it < 256; it += G) s5_sample_item(P, l, it, shm);
    }
    xcd_barrier(xb);
    REP(8) for (int it = bid; it < 256; it += G) m2_item(P, l, G == 256 ? (((it & 7) * 4 + (it >> 6)) * 8 + ((it >> 3) & 7)) : it, shm);
    REP(16) for (int it = bid; it < 256; it += G) s5_stage3_item(P, l, G == 256 ? ((it & 7) * 32 + (it >> 3)) : it, shm);
    xcd_barrier(xb);
    REP(32) {
      Fglu f; f.bias = P.b_glu + l * 512; f.ysb = P.ysb; f.ys2 = P.ys2; f.ss = nullptr;
      gemm_all(lds, shm, P.ysb, P.WgluT[l], 512, 512, f, bid, G);
      headnorm_rows(P, l, bid, G);
    }
    xcd_barrier(xb);
    REP(32) {
      Fa fa; fa.Pb = P.Pb; fa.t1 = P.t1; fa.ss = nullptr;
      gemm_all(lds, shm, P.xa, P.WaT[l], 1024, 1024, fa, bid, G);
      Fb fb; fb.Pb = P.Pb; fb.t1 = P.t1; fb.mg = P.mg; fb.ss = nullptr;
      gemm_all(lds, shm, P.ys2, P.WbT[l], 1024, 512, fb, bid, G);
    }
    xcd_barrier(xb);
    REP(32) {
      Fres f; f.xinP = l == 0 ? P.x_prompt : P.X2; f.xinS = l == 0 ? P.x_sample : P.X2 + (size_t)NP * DM; f.xo = P.X1; f.xb = P.xb; f.ss = P.ssB;
      gemm_all(lds, shm, P.mg, P.WoT[l], 1024, 1024, f, bid, G);
    }
    xcd_barrier(xb);
    REP(64) {
      F13 f; f.rs = P.ssB; f.act = P.act;
      pg8::Gemm g; g.A = P.xb; g.Bt = P.W13T[l]; g.M = NP; g.N = 2 * DFF; g.K = 1024;
      pg8::StaticOrder S; S.init(NP, 2 * DFF, G, bid);
      EpiMain13 E; E.f = f;
      REP(512) pg8::gemm_phase(lds, g, S, E);
      REP(256) skinny_run13(f, P.xb, P.W13T[l], bid, G, shm);
    }
    xcd_barrier(xb);
    REP(64) {
      Fres f; f.xinP = P.X1; f.xinS = P.X1 + (size_t)NP * DM; f.xo = P.X2; f.xb = P.xb; f.ss = P.ssA;
      gemm_all(lds, shm, P.act, P.W2T[l], 1024, DFF, f, bid, G);
    }
    xcd_barrier(xb);
  }
  final_rows(P, bid, G);
}

extern "C" void kernel_launch(void* const* d_in, const int* in_sizes, int n_in, void* d_out, int out_size, void* d_ws, size_t ws_size, hipStream_t stream) {
  constexpr size_t kDynLds = LDS_BYTES;
  static int grid_blocks = 0;
  if (!grid_blocks) {
    int dev = 0, cus = 0, per_cu = 0;
    (void)hipGetDevice(&dev);
    (void)hipDeviceGetAttribute(&cus, hipDeviceAttributeMultiprocessorCount, dev);
    (void)hipFuncSetAttribute((const void*)mega, hipFuncAttributeMaxDynamicSharedMemorySize, (int)kDynLds);
    (void)hipOccupancyMaxActiveBlocksPerMultiprocessor(&per_cu, mega, 512, kDynLds);
    if (per_cu > 1) per_cu = 1;
    grid_blocks = cus * per_cu;
    if (grid_blocks > 256) grid_blocks = 256;
  }
  Params p;
  memset(&p, 0, sizeof(p));
  const float* const* in = (const float* const*)d_in;
  p.x_prompt = in[0]; p.x_sample = in[1]; p.st_C = in[2]; p.st_n = in[3]; p.st_m = in[4]; p.st_sre = in[5]; p.st_sim = in[6];
  p.g_mix = in[7]; p.w_in = in[8]; p.b_in = in[9]; p.g_hn = in[10]; p.w_a = in[11]; p.A_re = in[12]; p.A_im = in[13]; p.log_dt = in[14];
  p.B_re = in[15]; p.B_im = in[16]; p.C_re = in[17]; p.C_im = in[18]; p.D_skip = in[19]; p.w_glu = in[20]; p.b_glu = in[21]; p.w_b = in[22]; p.w_out = in[23];
  p.g_ffn = in[24]; p.w_ff1 = in[25]; p.w_ff3 = in[26]; p.w_ff2 = in[27]; p.g_final = in[28];
  p.out = (float*)d_out;
  char* base = (char*)d_ws; size_t off = 0;
  auto alloc = [&](size_t bytes) { char* r = base + off; off += (bytes + 255) & ~(size_t)255; return r; };
  for (int l = 0; l < 2; ++l) {
    p.WinT[l] = (bf16_t*)alloc((size_t)NG1 * 1024 * 2); p.WgT[l] = (bf16_t*)alloc(16 * 1024 * 2); p.WgluT[l] = (bf16_t*)alloc(512 * 512 * 2);
    p.WaT[l] = (bf16_t*)alloc(1024 * 1024 * 2); p.WbT[l] = (bf16_t*)alloc(1024 * 512 * 2); p.WoT[l] = (bf16_t*)alloc(1024 * 1024 * 2);
    p.W13T[l] = (bf16_t*)alloc((size_t)2 * DFF * 1024 * 2); p.W2T[l] = (bf16_t*)alloc((size_t)1024 * DFF * 2);
    p.abar[l] = (float*)alloc(4096 * 4); p.bbar[l] = (float*)alloc(65536 * 4);
  }
  p.xb = (bf16_t*)alloc((size_t)NT * DM * 2); p.Pb = (bf16_t*)alloc((size_t)NT * NG1 * 2); p.St = (bf16_t*)alloc((size_t)512 * 16384 * 2);
  p.ysb = (bf16_t*)alloc((size_t)NT * 512 * 2); p.ys2 = (bf16_t*)alloc((size_t)NT * 512 * 2); p.xa = (bf16_t*)alloc((size_t)NT * DM * 2);
  p.mg = (bf16_t*)alloc((size_t)NT * DM * 2); p.act = (bf16_t*)alloc((size_t)NT * DFF * 2);
  p.X1 = (float*)alloc((size_t)NT * DM * 4); p.X2 = (float*)alloc((size_t)NT * DM * 4);
  p.ssA = (unsigned long long*)alloc((size_t)NT * 8); p.ssB = (unsigned long long*)alloc((size_t)NT * 8); p.bar = (unsigned*)alloc(XCD_BAR_WORDS * 4);
  for (int l = 0; l < 2; ++l) { p.Kt[l] = (bf16_t*)alloc(32 * 17 * 256 * 2); p.Gm[l] = (bf16_t*)alloc(32 * 32768 * 2); p.Hm[l] = (bf16_t*)alloc(32 * 32768 * 2); p.a16[l] = (float*)alloc(4096 * 4); }
  p.E2 = (float*)alloc((size_t)8 * 128 * 32 * 128 * 4);
  p.gat = (float*)alloc((size_t)NT * 8 * 4); p.hA = (bf16_t*)alloc((size_t)NT * DM * 2); p.hss = (float*)alloc((size_t)NT * 32 * 4);
  p.t1 = (bf16_t*)alloc((size_t)NT * DM * 2); p.Eend = (float*)alloc((size_t)2 * 524288 * 4);
  int nj = 0, tile0 = 0;
  auto job = [&](const float* src, const float* scale, bf16_t* dst, int ldn, int c0, int ncols, int K, int mode, int r0, int nwrite) {
    TJob& J = p.jobs[nj++]; J.src = src; J.scale = scale; J.dst = dst; J.ldn = ldn; J.c0 = c0; J.ncols = ncols; J.K = K; J.mode = mode; J.r0 = r0;
    J.tile0 = tile0; J.ntn = (ncols + 63) / 64; J.nwrite = nwrite; J.pad = 0; tile0 += J.ntn * (K / 64);
  };
  for (int l = 0; l < 2; ++l) {
    const float* win = p.w_in + (size_t)l * 1024 * PTOT; const float* gm = p.g_mix + l * 1024; const float* gf = p.g_ffn + l * 1024;
    job(win, gm, p.WinT[l], PTOT, 0, 4096, 1024, 0, 0, 4096);
    job(win, gm, p.WinT[l], PTOT, 4104, 512, 1024, 0, 4096, 512);
    job(win, gm, p.WinT[l], PTOT, 4616, 2048, 1024, 0, 4608, 2048);
    job(win, gm, p.WgT[l], PTOT, 4096, 8, 1024, 0, 0, 16);
    job(p.w_glu + (size_t)l * 512 * 512, nullptr, p.WgluT[l], 512, 0, 512, 512, 0, 0, 512);
    job(p.w_a + (size_t)l * 1024 * 1024, nullptr, p.WaT[l], 1024, 0, 1024, 1024, 0, 0, 1024);
    job(p.w_b + (size_t)l * 512 * 1024, nullptr, p.WbT[l], 1024, 0, 1024, 512, 0, 0, 1024);
    job(p.w_out + (size_t)l * 1024 * 1024, nullptr, p.WoT[l], 1024, 0, 1024, 1024, 0, 0, 1024);
    job(p.w_ff1 + (size_t)l * 1024 * DFF, gf, p.W13T[l], DFF, 0, DFF, 1024, 1, 0, DFF);
    job(p.w_ff3 + (size_t)l * 1024 * DFF, gf, p.W13T[l], DFF, 0, DFF, 1024, 2, 0, DFF);
    job(p.w_ff2 + (size_t)l * DFF * 1024, nullptr, p.W2T[l], 1024, 0, 1024, DFF, 0, 0, 1024);
  }
  p.njobs = nj; p.total_tiles = tile0;
  void* args[] = {&p};
  hipError_t e = hipLaunchCooperativeKernel((void*)mega, dim3(grid_blocks), dim3(512), args, kDynLds, stream);
  if (e != hipSuccess) fprintf(stderr, "cooperative launch failed: %s (grid %d)\n", hipGetErrorString(e), grid_blocks);
}
```

```cpp
#include <hip/hip_runtime.h>
#include <hip/hip_cooperative_groups.h>
#include <cstdio>
#include <cstring>
namespace cg = cooperative_groups;

#define LAS __attribute__((address_space(3)))
typedef unsigned short bf16_t;
typedef short bf16x8 __attribute__((ext_vector_type(8)));
typedef short bf16x4 __attribute__((ext_vector_type(4)));
typedef float f32x4 __attribute__((ext_vector_type(4)));
typedef unsigned u32x4 __attribute__((ext_vector_type(4)));
typedef unsigned u32x2 __attribute__((ext_vector_type(2)));

constexpr int NP = 16384, NS = 128, NT = 16512, DM = 1024, NG1 = 6656, DFF = 2816, PTOT = 6664;
constexpr int LDS_BYTES = 150 * 1024;
#ifndef DUPMASK
#define DUPMASK 0
#endif
#define REP(bit) for (int rep_ = 0; rep_ < ((DUPMASK & (bit)) ? 2 : 1); ++rep_)
constexpr size_t O_YP = 0, O_YS = 16777216, O_CP = 16908288, O_NP = 21102592, O_MP = 21118976, O_SRP = 21119040, O_SIP = 21151808,
                 O_CS = 21184576, O_NS = 88293440, O_MS = 88555584, O_SRS = 88556608, O_SIS = 89080896;

struct TJob { const float* src; const float* scale; bf16_t* dst; int ldn, c0, ncols, K, mode, r0, tile0, ntn, nwrite, pad; };

struct Params {
  const float *x_prompt, *x_sample, *st_C, *st_n, *st_m, *st_sre, *st_sim;
  const float *g_mix, *w_in, *b_in, *g_hn, *w_a, *A_re, *A_im, *log_dt, *B_re, *B_im, *C_re, *C_im, *D_skip, *w_glu, *b_glu, *w_b, *w_out,
      *g_ffn, *w_ff1, *w_ff3, *w_ff2, *g_final;
  float* out;
  bf16_t *WinT[2], *WgT[2], *WgluT[2], *WaT[2], *WbT[2], *WoT[2], *W13T[2], *W2T[2];
  float *abar[2], *bbar[2];
  bf16_t *xb, *Pb, *St, *ysb, *ys2, *xa, *mg, *act;
  float *X1, *X2, *gat, *hss, *Eend; bf16_t *hA, *t1;
  unsigned long long *ssA, *ssB;
  unsigned* bar;
  bf16_t *Kt[2], *Gm[2], *Hm[2]; float *a16[2], *E2;
  TJob jobs[22];
  int njobs, total_tiles;
};

__device__ __forceinline__ bf16_t f2bf(float f) { return __builtin_bit_cast(bf16_t, (__bf16)f); }
__device__ __forceinline__ float bf2f(unsigned b) { return __uint_as_float(b << 16); }
typedef float f32x2 __attribute__((ext_vector_type(2)));
typedef __bf16 bf16x2v __attribute__((ext_vector_type(2)));
__device__ __forceinline__ unsigned pack2(float lo, float hi) { const f32x2 v = {lo, hi}; const bf16x2v b = __builtin_convertvector(v, bf16x2v); return __builtin_bit_cast(unsigned, b); }
__device__ __forceinline__ u32x2 pack4(f32x4 v) { u32x2 r; r.x = pack2(v[0], v[1]); r.y = pack2(v[2], v[3]); return r; }
__device__ __forceinline__ f32x4 unpack4(u32x2 u) { f32x4 r; r[0] = bf2f(u.x & 0xffffu); r[1] = bf2f(u.x >> 16); r[2] = bf2f(u.y & 0xffffu); r[3] = bf2f(u.y >> 16); return r; }
__device__ __forceinline__ float sigmoidf_(float x) { return __builtin_amdgcn_rcpf(1.0f + __expf(-x)); }
__device__ __forceinline__ float gelu_tanh(float x) { float z = 0.7978845608f * (x + 0.044715f * x * x * x); float e = __expf(2.0f * z); float th = 1.0f - 2.0f * __builtin_amdgcn_rcpf(e + 1.0f); return 0.5f * x * (1.0f + th); }
__device__ __forceinline__ int tidx() { int t = threadIdx.x; asm volatile("" : "+v"(t)); return t; }
#define LDS_BARRIER() do { asm volatile("s_waitcnt lgkmcnt(0)" ::: "memory"); __builtin_amdgcn_s_barrier(); asm volatile("" ::: "memory"); } while (0)
__device__ __forceinline__ float wave_sum(float v) { for (int o = 32; o > 0; o >>= 1) v += __shfl_xor(v, o); return v; }

namespace pg8 {
constexpr int BM = 256, BK = 64, HALF = 128, HTB = HALF * BK * 2, STAGE_BYTES = 8 * HTB, NXCD = 8, WGM = 8;
__host__ __device__ __forceinline__ int lds_byte(int r, int c) { const int st = (r >> 4) * 2 + (c >> 5), rr = r & 15, cc = c & 31, ob = rr * 64 + cc * 2; return st * 1024 + (ob ^ (((ob >> 9) & 1) << 5)); }
__host__ __device__ __forceinline__ void stage_rc(int b, int& R, int& C) { const int st = b / 1024, sb = b % 1024, swz = sb ^ (((sb >> 9) & 1) << 5); R = (st >> 1) * 16 + swz / 64; C = (st & 1) * 32 + (swz % 64) / 2; }
__host__ __device__ __forceinline__ int perm32(int rho) { const int n = rho >> 4, i = rho & 15; return 8 * (i >> 2) + 4 * n + (i & 3); }
struct Unit { int pm, pn; };
struct Gemm { const bf16_t* A; const bf16_t* Bt; int M, N, K; };
struct StaticOrder {
  int nM, nN, nwg, G, c;
  __device__ void init(int M, int N, int G_, int c_) { nM = M / BM; nN = N / BM; nwg = nM * nN; G = G_; c = c_; }
  __device__ bool next(int i, Unit& u) const {
    const long L = (long)i * G + c; if (L >= nwg) return false;
    int wgid = (int)L; { const int q = nwg / NXCD, r = nwg % NXCD, xcd = wgid % NXCD, off = wgid / NXCD; wgid = (xcd < r ? xcd * (q + 1) : r * (q + 1) + (xcd - r) * q) + off; }
    const int nig = WGM * nN, gid = wgid / nig, fm = gid * WGM, gsz = (nM - fm) < WGM ? (nM - fm) : WGM;
    u.pm = fm + ((wgid % nig) % gsz); u.pn = (wgid % nig) / gsz; return true;
  }
};

template <class Epi, class Sched>
__device__ __forceinline__ void gemm_phase(LAS unsigned char* lds, const Gemm g, const Sched& S, const Epi& E) {
  const int tid = tidx(), wid = __builtin_amdgcn_readfirstlane(tid >> 6), lane = tid & 63, wr = wid >> 2, wc = wid & 3, fr = lane & 15, fq = lane >> 4;
  const int K = g.K, nt = K / BK;
  unsigned voffA[2], voffB[2];
#pragma unroll
  for (int i = 0; i < 2; ++i) { int R, C; stage_rc(tid * 16 + i * 8192, R, C); voffA[i] = (unsigned)(R * K + C) * 2u; const int Rb = Epi::PERM ? ((R & ~31) + perm32(R & 31)) : R; voffB[i] = (unsigned)(Rb * K + C) * 2u; }
  const size_t kstep = (size_t)(BK * 2);
  const size_t hstep = (size_t)HALF * K * 2;
  const size_t tstep = 2 * hstep;
  const unsigned ldsw = (unsigned)wid * 1024u;
  const int aoff = lds_byte(wr * 64 + fr, fq * 8), boff = lds_byte(wc * 32 + fr, fq * 8);
#define PG8_SA(b, h) (((b) * 2 + (h)) * HTB)
#define PG8_SB(b, h) ((4 + (b) * 2 + (h)) * HTB)
#define PG8_STAGE(bufoff, gbase, voff) do { _Pragma("unroll") for (int _i = 0; _i < 2; ++_i) \
    __builtin_amdgcn_global_load_lds((const unsigned*)((const char*)(gbase) + (voff)[_i]), (LAS unsigned*)(lds + (bufoff) + ldsw + _i * 8192), 16, 0, 0); } while (0)
#define PG8_LDA(dst, b, h) do { _Pragma("unroll") for (int m = 0; m < 4; ++m) _Pragma("unroll") for (int k = 0; k < 2; ++k) dst[m][k] = *(const LAS bf16x8*)(lds + PG8_SA(b, h) + aoff + m * 2048 + k * 1024); } while (0)
#define PG8_LDB(dst, b, h) do { _Pragma("unroll") for (int n = 0; n < 2; ++n) _Pragma("unroll") for (int k = 0; k < 2; ++k) dst[n][k] = *(const LAS bf16x8*)(lds + PG8_SB(b, h) + boff + n * 2048 + k * 1024); } while (0)
#define PG8_MMA(ai, bj, At, Bt) do { __builtin_amdgcn_s_setprio(1); _Pragma("unroll") for (int m = 0; m < 4; ++m) _Pragma("unroll") for (int n = 0; n < 2; ++n) _Pragma("unroll") for (int k = 0; k < 2; ++k) \
    acc[ai][bj][m][n] = __builtin_amdgcn_mfma_f32_16x16x32_bf16(Bt[n][k], At[m][k], acc[ai][bj][m][n], 0, 0, 0); __builtin_amdgcn_s_setprio(0); } while (0)
#define PG8_WAIT_V(n) asm volatile("s_waitcnt vmcnt(" #n ")" ::: "memory")
#define PG8_WAIT_L(n) asm volatile("s_waitcnt lgkmcnt(" #n ")" ::: "memory")
#define PG8_BAR __builtin_amdgcn_s_barrier()
#define PG8_SCHED __builtin_amdgcn_sched_barrier(0)
  Unit cur, nxt; int ui = 0;
  if (!S.next(0, cur)) return;
  f32x4 acc[2][2][4][2];
#pragma unroll
  for (int a = 0; a < 2; ++a)
#pragma unroll
    for (int b = 0; b < 2; ++b)
#pragma unroll
      for (int m = 0; m < 4; ++m)
#pragma unroll
        for (int n = 0; n < 2; ++n) acc[a][b][m][n] = (f32x4){0.f, 0.f, 0.f, 0.f};
  bf16x8 At[4][2], B0[2][2], B1[2][2];
  const char* cA = (const char*)g.A + (size_t)cur.pm * tstep; const char* cB = (const char*)g.Bt + (size_t)cur.pn * tstep;
  PG8_STAGE(PG8_SB(0, 0), cB, voffB); PG8_STAGE(PG8_SA(0, 0), cA, voffA); PG8_STAGE(PG8_SB(0, 1), cB + hstep, voffB); PG8_STAGE(PG8_SA(0, 1), cA + hstep, voffA);
  if (wr == 1) PG8_BAR;
  PG8_WAIT_V(4); PG8_BAR;
  PG8_STAGE(PG8_SB(1, 0), cB + kstep, voffB); PG8_STAGE(PG8_SA(1, 0), cA + kstep, voffA); PG8_STAGE(PG8_SB(1, 1), cB + hstep + kstep, voffB);
  PG8_WAIT_V(6); PG8_BAR;
  for (;;) {
    const bool has_next = S.next(ui + 1, nxt);
    const char* nA = has_next ? (const char*)g.A + (size_t)nxt.pm * tstep : cA; const char* nB = has_next ? (const char*)g.Bt + (size_t)nxt.pn * tstep : cB;
    for (int t = 0; t < nt; t += 2) {
      const bool last = (t == nt - 2);
      const char* a1 = cA + (size_t)(t + 1) * kstep;
      const char* a2 = last ? nA : cA + (size_t)(t + 2) * kstep; const char* b2 = last ? nB : cB + (size_t)(t + 2) * kstep;
      const char* a3 = a2 + kstep; const char* b3 = b2 + kstep;
      PG8_LDB(B0, 0, 0); PG8_SCHED; PG8_LDA(At, 0, 0); PG8_STAGE(PG8_SA(1, 1), a1 + hstep, voffA);
      PG8_WAIT_L(8); PG8_BAR; PG8_WAIT_L(0); PG8_MMA(0, 0, At, B0); PG8_BAR; PG8_SCHED;
      PG8_LDB(B1, 0, 1); PG8_STAGE(PG8_SB(0, 0), b2, voffB);
      PG8_BAR; PG8_WAIT_L(0); PG8_MMA(0, 1, At, B1); PG8_BAR;
      PG8_LDA(At, 0, 1); PG8_STAGE(PG8_SA(0, 0), a2, voffA);
      PG8_BAR; PG8_WAIT_L(0); PG8_MMA(1, 0, At, B0); PG8_BAR; PG8_SCHED;
      PG8_STAGE(PG8_SB(0, 1), b2 + hstep, voffB);
      PG8_WAIT_V(6); PG8_BAR; PG8_MMA(1, 1, At, B1); PG8_BAR;
      PG8_LDB(B0, 1, 0); PG8_SCHED; PG8_LDA(At, 1, 0); PG8_STAGE(PG8_SA(0, 1), a2 + hstep, voffA);
      PG8_WAIT_L(8); PG8_BAR; PG8_WAIT_L(0); PG8_MMA(0, 0, At, B0); PG8_BAR; PG8_SCHED;
      PG8_LDB(B1, 1, 1); PG8_STAGE(PG8_SB(1, 0), b3, voffB);
      PG8_BAR; PG8_WAIT_L(0); PG8_MMA(0, 1, At, B1); PG8_BAR;
      PG8_LDA(At, 1, 1); PG8_STAGE(PG8_SA(1, 0), a3, voffA);
      PG8_BAR; PG8_WAIT_L(0); PG8_MMA(1, 0, At, B0); PG8_BAR; PG8_SCHED;
      PG8_STAGE(PG8_SB(1, 1), b3 + hstep, voffB);
      PG8_WAIT_V(6); PG8_BAR; PG8_MMA(1, 1, At, B1); PG8_BAR;
    }
    E(acc, cur, wr, wc, fr, fq);
    if (!has_next) break;
#pragma unroll
    for (int a = 0; a < 2; ++a)
#pragma unroll
      for (int b = 0; b < 2; ++b)
#pragma unroll
        for (int m = 0; m < 4; ++m)
#pragma unroll
          for (int n = 0; n < 2; ++n) acc[a][b][m][n] = (f32x4){0.f, 0.f, 0.f, 0.f};
    cur = nxt; cA = nA; cB = nB; ++ui;
  }
  PG8_WAIT_V(0);
  if (wr == 0) PG8_BAR;
  PG8_BAR;
#undef PG8_SA
#undef PG8_SB
#undef PG8_STAGE
#undef PG8_LDA
#undef PG8_LDB
#undef PG8_MMA
#undef PG8_WAIT_V
#undef PG8_WAIT_L
#undef PG8_BAR
#undef PG8_SCHED
}
}

typedef unsigned long long u64;
__device__ __forceinline__ u64 ss_fix(float ss) { return (u64)(ss * 16777216.0f); }
__device__ __forceinline__ float rs_of(u64 q) { const float f = (float)(unsigned)(q >> 32) * 4294967296.0f + (float)(unsigned)q; return rsqrtf(f * (1.0f / (16777216.0f * 1024.0f)) + 1e-6f); }
__device__ __forceinline__ void ss_add(u64* p, float ss) { __hip_atomic_fetch_add(p, ss_fix(ss), __ATOMIC_RELAXED, __HIP_MEMORY_SCOPE_AGENT); }
__device__ __forceinline__ int qcol(int cbase, int q) { return cbase + (q >> 1) * 128 + (q & 1) * 16; }
__device__ __forceinline__ f32x4 unlo(u32x4 u) { return unpack4((u32x2){u[0], u[1]}); }
__device__ __forceinline__ f32x4 unhi(u32x4 u) { return unpack4((u32x2){u[2], u[3]}); }
__device__ __forceinline__ u32x4 pack8(f32x4 a, f32x4 b) { const u32x2 p = pack4(a), q = pack4(b); return (u32x4){p.x, p.y, q.x, q.y}; }
struct F1 {
  static constexpr bool NEEDR = true, STAT = false, PERM = true; static constexpr int RB = 8;
  const float* bias; bf16_t* Pb; const u64* rs; u64* ss;
  struct ColData { f32x4 b[4]; }; struct RowData { u64 s; };
  __device__ __forceinline__ void load_cols(int cbase, ColData& cd) const {
#pragma unroll
    for (int q = 0; q < 4; ++q) { const int col = cbase + (q >> 1) * 128 + (q & 1) * 4; cd.b[q] = *(const f32x4*)(bias + (col < 4096 ? col : col + 8)); } }
  __device__ __forceinline__ void load_row(int row, int, RowData& rd) const { rd.s = rs[row]; }
  __device__ __forceinline__ float apply(int row, int cbase, const f32x4 (&v)[4], const ColData& cd, const RowData& rd) const {
    const float r = rs_of(rd.s);
    const int blk = cbase >> 8;
    const bool isk = blk >= 4 && blk < 8, issig = (blk >= 12 && blk < 16) || blk >= 18;
#pragma unroll
    for (int bj = 0; bj < 2; ++bj) {
      u32x4 pk;
#pragma unroll
      for (int n = 0; n < 2; ++n) {
        f32x4 o = v[bj * 2 + n] * r + cd.b[bj * 2 + n];
        if (isk) o = o * 0.0625f;
        else if (issig) { o[0] = sigmoidf_(o[0]); o[1] = sigmoidf_(o[1]); o[2] = sigmoidf_(o[2]); o[3] = sigmoidf_(o[3]); }
        const u32x2 p2 = pack4(o); pk[2 * n] = p2.x; pk[2 * n + 1] = p2.y;
      }
      *(u32x4*)(Pb + (size_t)row * NG1 + cbase + bj * 128) = pk;
    }
    return 0.f;
  }
  __device__ __forceinline__ float rowscale(int row) const { return rs_of(rs[row]); }
  __device__ __forceinline__ float operator()(int row, int col, f32x4 v, float r) const {
    const int bi = col < 4096 ? col : col + 8;
    const f32x4 b4 = *(const f32x4*)(bias + bi);
    f32x4 o = v * r + b4;
    if (col >= 1024 && col < 2048) o = o * 0.0625f;
    else if ((col >= 3072 && col < 4096) || col >= 4608) { o[0] = sigmoidf_(o[0]); o[1] = sigmoidf_(o[1]); o[2] = sigmoidf_(o[2]); o[3] = sigmoidf_(o[3]); }
    *(u32x2*)(Pb + (size_t)row * NG1 + col) = pack4(o);
    return 0.f;
  }
};
struct Fg {
  static constexpr bool NEEDR = true, STAT = false;
  const float* bias; float* gat; const u64* rs; u64* ss;
  __device__ __forceinline__ float rowscale(int row) const { return rs_of(rs[row]); }
  __device__ __forceinline__ float operator()(int row, int col, f32x4 v, float r) const {
    if (col < 8) {
      const f32x4 b4 = *(const f32x4*)(bias + col);
      f32x4 o = v * r + b4;
      if (col >= 4) {
#pragma unroll
        for (int i = 0; i < 4; ++i) { const float x = o[i]; o[i] = fminf(x, 0.f) - log1pf(__expf(-fabsf(x))); }
      }
      *(f32x4*)(gat + (size_t)row * 8 + col) = o;
    }
    return 0.f;
  }
};
struct Fglu {
  static constexpr bool NEEDR = false, STAT = false, PERM = true; static constexpr int RB = 8;
  const float* bias; const bf16_t* ysb; bf16_t* ys2; u64* ss;
  struct ColData { f32x4 b[4]; }; struct RowData { u32x4 y[2]; };
  __device__ __forceinline__ void load_cols(int cbase, ColData& cd) const {
#pragma unroll
    for (int q = 0; q < 4; ++q) cd.b[q] = *(const f32x4*)(bias + cbase + (q >> 1) * 128 + (q & 1) * 4); }
  __device__ __forceinline__ void load_row(int row, int cbase, RowData& rd) const {
#pragma unroll
    for (int bj = 0; bj < 2; ++bj) rd.y[bj] = *(const u32x4*)(ysb + (size_t)row * 512 + cbase + bj * 128); }
  __device__ __forceinline__ float apply(int row, int cbase, const f32x4 (&v)[4], const ColData& cd, const RowData& rd) const {
#pragma unroll
    for (int bj = 0; bj < 2; ++bj) {
      const f32x4 y0 = unlo(rd.y[bj]), y1 = unhi(rd.y[bj]); f32x4 o0, o1;
#pragma unroll
      for (int i = 0; i < 4; ++i) { o0[i] = y0[i] * sigmoidf_(v[bj * 2][i] + cd.b[bj * 2][i]); o1[i] = y1[i] * sigmoidf_(v[bj * 2 + 1][i] + cd.b[bj * 2 + 1][i]); }
      *(u32x4*)(ys2 + (size_t)row * 512 + cbase + bj * 128) = pack8(o0, o1);
    }
    return 0.f;
  }
  struct Pre { f32x4 b; u32x2 y; };
  __device__ __forceinline__ Pre pre(int row, int col) const { Pre p; p.b = *(const f32x4*)(bias + col); p.y = *(const u32x2*)(ysb + (size_t)row * 512 + col); return p; }
  __device__ __forceinline__ float post(int row, int col, f32x4 v, const Pre& p) const {
    const f32x4 y = unpack4(p.y); f32x4 o;
#pragma unroll
    for (int i = 0; i < 4; ++i) o[i] = y[i] * sigmoidf_(v[i] + p.b[i]);
    *(u32x2*)(ys2 + (size_t)row * 512 + col) = pack4(o); return 0.f; }
  __device__ __forceinline__ float rowscale(int) const { return 1.f; }
  __device__ __forceinline__ float operator()(int row, int col, f32x4 v, float) const {
    const f32x4 b4 = *(const f32x4*)(bias + col);
    const f32x4 y = unpack4(*(const u32x2*)(ysb + (size_t)row * 512 + col));
    f32x4 o;
#pragma unroll
    for (int i = 0; i < 4; ++i) o[i] = y[i] * sigmoidf_(v[i] + b4[i]);
    *(u32x2*)(ys2 + (size_t)row * 512 + col) = pack4(o);
    return 0.f;
  }
};
struct Fa {
  static constexpr bool NEEDR = false, STAT = false, PERM = true; static constexpr int RB = 8;
  const bf16_t* Pb; bf16_t* t1; u64* ss;
  struct ColData { int dummy; }; struct RowData { u32x4 g[2]; };
  __device__ __forceinline__ void load_cols(int, ColData&) const {}
  __device__ __forceinline__ void load_row(int row, int cbase, RowData& rd) const {
#pragma unroll
    for (int bj = 0; bj < 2; ++bj) rd.g[bj] = *(const u32x4*)(Pb + (size_t)row * NG1 + 4608 + cbase + bj * 128); }
  __device__ __forceinline__ float apply(int row, int cbase, const f32x4 (&v)[4], const ColData&, const RowData& rd) const {
#pragma unroll
    for (int bj = 0; bj < 2; ++bj) *(u32x4*)(t1 + (size_t)row * DM + cbase + bj * 128) = pack8(unlo(rd.g[bj]) * v[bj * 2], unhi(rd.g[bj]) * v[bj * 2 + 1]);
    return 0.f;
  }
  struct Pre { u32x2 g; };
  __device__ __forceinline__ Pre pre(int row, int col) const { Pre p; p.g = *(const u32x2*)(Pb + (size_t)row * NG1 + 4608 + col); return p; }
  __device__ __forceinline__ float post(int row, int col, f32x4 v, const Pre& p) const { *(u32x2*)(t1 + (size_t)row * DM + col) = pack4(unpack4(p.g) * v); return 0.f; }
  __device__ __forceinline__ float rowscale(int) const { return 1.f; }
  __device__ __forceinline__ float operator()(int row, int col, f32x4 v, float) const {
    const f32x4 sg = unpack4(*(const u32x2*)(Pb + (size_t)row * NG1 + 4608 + col));
    *(u32x2*)(t1 + (size_t)row * DM + col) = pack4(sg * v);
    return 0.f;
  }
};
struct Fb {
  static constexpr bool NEEDR = false, STAT = false, PERM = true; static constexpr int RB = 4;
  const bf16_t* Pb; const bf16_t* t1; bf16_t* mg; u64* ss;
  struct ColData { int dummy; }; struct RowData { u32x4 g[2]; u32x4 t[2]; };
  __device__ __forceinline__ void load_cols(int, ColData&) const {}
  __device__ __forceinline__ void load_row(int row, int cbase, RowData& rd) const {
#pragma unroll
    for (int bj = 0; bj < 2; ++bj) { rd.g[bj] = *(const u32x4*)(Pb + (size_t)row * NG1 + 5632 + cbase + bj * 128); rd.t[bj] = *(const u32x4*)(t1 + (size_t)row * DM + cbase + bj * 128); } }
  __device__ __forceinline__ float apply(int row, int cbase, const f32x4 (&v)[4], const ColData&, const RowData& rd) const {
#pragma unroll
    for (int bj = 0; bj < 2; ++bj) *(u32x4*)(mg + (size_t)row * DM + cbase + bj * 128) = pack8(unlo(rd.t[bj]) + unlo(rd.g[bj]) * v[bj * 2], unhi(rd.t[bj]) + unhi(rd.g[bj]) * v[bj * 2 + 1]);
    return 0.f;
  }
  struct Pre { u32x2 g; u32x2 t; };
  __device__ __forceinline__ Pre pre(int row, int col) const { Pre p; p.g = *(const u32x2*)(Pb + (size_t)row * NG1 + 5632 + col); p.t = *(const u32x2*)(t1 + (size_t)row * DM + col); return p; }
  __device__ __forceinline__ float post(int row, int col, f32x4 v, const Pre& p) const { *(u32x2*)(mg + (size_t)row * DM + col) = pack4(unpack4(p.t) + unpack4(p.g) * v); return 0.f; }
  __device__ __forceinline__ float rowscale(int) const { return 1.f; }
  __device__ __forceinline__ float operator()(int row, int col, f32x4 v, float) const {
    const f32x4 sg = unpack4(*(const u32x2*)(Pb + (size_t)row * NG1 + 5632 + col));
    const f32x4 t = unpack4(*(const u32x2*)(t1 + (size_t)row * DM + col));
    *(u32x2*)(mg + (size_t)row * DM + col) = pack4(t + sg * v);
    return 0.f;
  }
};
struct Fres {
  static constexpr bool NEEDR = false, STAT = true, PERM = true; static constexpr int RB = 4;
  const float *xinP, *xinS; float* xo; bf16_t* xb; u64* ss;
  struct ColData { int dummy; }; struct RowData { f32x4 x[4]; };
  __device__ __forceinline__ void load_cols(int, ColData&) const {}
  __device__ __forceinline__ void load_row(int row, int cbase, RowData& rd) const {
#pragma unroll
    for (int q = 0; q < 4; ++q) rd.x[q] = *(const f32x4*)(xinP + (size_t)row * DM + cbase + (q >> 1) * 128 + (q & 1) * 4); }
  __device__ __forceinline__ float apply(int row, int cbase, const f32x4 (&v)[4], const ColData&, const RowData& rd) const {
    float s = 0.f;
#pragma unroll
    for (int bj = 0; bj < 2; ++bj) {
      const f32x4 o0 = rd.x[bj * 2] + v[bj * 2], o1 = rd.x[bj * 2 + 1] + v[bj * 2 + 1];
      float* xp = xo + (size_t)row * DM + cbase + bj * 128;
      *(f32x4*)xp = o0; *(f32x4*)(xp + 4) = o1;
      const u32x2 p0 = pack4(o0), p1 = pack4(o1);
      *(u32x4*)(xb + (size_t)row * DM + cbase + bj * 128) = (u32x4){p0.x, p0.y, p1.x, p1.y};
      s += (o0[0] * o0[0] + o0[1] * o0[1]) + (o0[2] * o0[2] + o0[3] * o0[3]) + (o1[0] * o1[0] + o1[1] * o1[1]) + (o1[2] * o1[2] + o1[3] * o1[3]);
    }
    return s;
  }
  struct Pre { f32x4 x; };
  __device__ __forceinline__ Pre pre(int row, int col) const { Pre p; const float* xi = row < NP ? xinP + (size_t)row * DM : xinS + (size_t)(row - NP) * DM; p.x = *(const f32x4*)(xi + col); return p; }
  __device__ __forceinline__ float post(int row, int col, f32x4 v, const Pre& p) const {
    const f32x4 o = p.x + v;
    *(f32x4*)(xo + (size_t)row * DM + col) = o; *(u32x2*)(xb + (size_t)row * DM + col) = pack4(o);
    return (o[0] * o[0] + o[1] * o[1]) + (o[2] * o[2] + o[3] * o[3]); }
  __device__ __forceinline__ float rowscale(int) const { return 1.f; }
  __device__ __forceinline__ float operator()(int row, int col, f32x4 v, float) const {
    const float* xi = row < NP ? xinP + (size_t)row * DM : xinS + (size_t)(row - NP) * DM;
    const f32x4 o = *(const f32x4*)(xi + col) + v;
    *(f32x4*)(xo + (size_t)row * DM + col) = o;
    *(u32x2*)(xb + (size_t)row * DM + col) = pack4(o);
    return (o[0] * o[0] + o[1] * o[1]) + (o[2] * o[2] + o[3] * o[3]);
  }
};
struct F13 {
  const u64* rs; bf16_t* act;
  __device__ __forceinline__ float rowscale(int row) const { return rs_of(rs[row]); }
  __device__ __forceinline__ f32x4 glu(f32x4 a1, f32x4 a3, float r) const {
    f32x4 o;
#pragma unroll
    for (int i = 0; i < 4; ++i) { const float x1 = a1[i] * r, x3 = a3[i] * r; o[i] = x1 * sigmoidf_(x1) * x3; }
    return o;
  }
  __device__ __forceinline__ void pair(int row, int j, f32x4 a1, f32x4 a3, float r) const { *(u32x2*)(act + (size_t)row * DFF + j) = pack4(glu(a1, a3, r)); }
};

template <class F> struct EpiMain {
  static constexpr bool PERM = F::PERM;
  F f; int coff;
  __device__ __forceinline__ void operator()(const f32x4 (&acc)[2][2][4][2], const pg8::Unit& u, int wr, int wc, int fr, int fq) const {
    const int rbase = u.pm * 256 + wr * 64 + fr, cbase = coff + u.pn * 256 + wc * 32 + (F::PERM ? 8 : 4) * fq;
    typename F::ColData cd; f.load_cols(cbase, cd);
#pragma unroll
    for (int b0 = 0; b0 < 8; b0 += F::RB) {
      typename F::RowData rd[F::RB];
#pragma unroll
      for (int k = 0; k < F::RB; ++k) { const int i = b0 + k; f.load_row(rbase + (i >> 2) * 128 + (i & 3) * 16, cbase, rd[k]); }
      __builtin_amdgcn_sched_barrier(0);
#pragma unroll
      for (int k = 0; k < F::RB; ++k) {
        const int i = b0 + k, ai = i >> 2, m = i & 3, row = rbase + ai * 128 + m * 16;
        const f32x4 v[4] = {acc[ai][0][m][0], acc[ai][0][m][1], acc[ai][1][m][0], acc[ai][1][m][1]};
        float s = f.apply(row, cbase, v, cd, rd[k]);
        if (F::STAT) { s += __shfl_xor(s, 16); s += __shfl_xor(s, 32); if (fq == 0) ss_add(f.ss + row, s); }
      }
      __builtin_amdgcn_sched_barrier(0);
    }
  }
};
struct EpiMain13 {
  static constexpr bool PERM = true;
  F13 f;
  __device__ __forceinline__ void operator()(const f32x4 (&acc)[2][2][4][2], const pg8::Unit& u, int wr, int wc, int fr, int fq) const {
    const int rbase = u.pm * 256 + wr * 64 + fr, jbase = u.pn * 128 + wc * 32 + 8 * fq;
    u64 sq[8];
#pragma unroll
    for (int i = 0; i < 8; ++i) sq[i] = f.rs[rbase + (i >> 2) * 128 + (i & 3) * 16];
    __builtin_amdgcn_sched_barrier(0);
#pragma unroll
    for (int i = 0; i < 8; ++i) {
      const int ai = i >> 2, m = i & 3, row = rbase + ai * 128 + m * 16;
      const float r = rs_of(sq[i]);
      *(u32x4*)(f.act + (size_t)row * DFF + jbase) = pack8(f.glu(acc[ai][0][m][0], acc[ai][1][m][0], r), f.glu(acc[ai][0][m][1], acc[ai][1][m][1], r));
    }
  }
};

template <int NACC>
__device__ __forceinline__ void skinny_unit(const bf16_t* A, int K, const bf16_t* Bt, int row0, int brow0, int bstep, float* red, f32x4 (&out)[NACC]) {
  const int tid = tidx(), w = tid >> 6, lane = tid & 63, g4 = lane >> 4, l15 = lane & 15;
  const int nks = K >> 8, kbase = w * (K >> 3) + 8 * g4;
  f32x4 acc[8][NACC];
#pragma unroll
  for (int rt = 0; rt < 8; ++rt)
#pragma unroll
    for (int i = 0; i < NACC; ++i) acc[rt][i] = (f32x4){0.f, 0.f, 0.f, 0.f};
  const bf16_t* ap = A + (size_t)(row0 + l15) * K + kbase;
  const bf16_t* bp = Bt + (size_t)(brow0 + l15) * K + kbase;
  for (int ks = 0; ks < nks; ks += 2) {
    const bool two = ks + 1 < nks;
    bf16x8 a0[8], a1[8], b0[NACC], b1[NACC];
#pragma unroll
    for (int rt = 0; rt < 8; ++rt) a0[rt] = *(const bf16x8*)(ap + (size_t)16 * rt * K + 32 * ks);
#pragma unroll
    for (int i = 0; i < NACC; ++i) b0[i] = *(const bf16x8*)(bp + (size_t)bstep * i * K + 32 * ks);
    if (two) {
#pragma unroll
      for (int rt = 0; rt < 8; ++rt) a1[rt] = *(const bf16x8*)(ap + (size_t)16 * rt * K + 32 * ks + 32);
#pragma unroll
      for (int i = 0; i < NACC; ++i) b1[i] = *(const bf16x8*)(bp + (size_t)bstep * i * K + 32 * ks + 32);
    }
#pragma unroll
    for (int rt = 0; rt < 8; ++rt)
#pragma unroll
      for (int i = 0; i < NACC; ++i) acc[rt][i] = __builtin_amdgcn_mfma_f32_16x16x32_bf16(b0[i], a0[rt], acc[rt][i], 0, 0, 0);
    if (two) {
#pragma unroll
      for (int rt = 0; rt < 8; ++rt)
#pragma unroll
        for (int i = 0; i < NACC; ++i) acc[rt][i] = __builtin_amdgcn_mfma_f32_16x16x32_bf16(b1[i], a1[rt], acc[rt][i], 0, 0, 0);
    }
  }
#pragma unroll
  for (int rt = 0; rt < 8; ++rt)
#pragma unroll
    for (int i = 0; i < NACC; ++i) *(f32x4*)(red + (size_t)(((w * 8 + rt) * NACC + i) * 64 + lane) * 4) = acc[rt][i];
  __syncthreads();
#pragma unroll
  for (int i = 0; i < NACC; ++i) {
    f32x4 t = (f32x4){0.f, 0.f, 0.f, 0.f};
#pragma unroll
    for (int ww = 0; ww < 8; ++ww) t += *(const f32x4*)(red + (size_t)(((ww * 8 + w) * NACC + i) * 64 + lane) * 4);
    out[i] = t;
  }
}
template <class F, int NA = 1>
__device__ __forceinline__ void skinny_run(const F& f, const bf16_t* A, int K, const bf16_t* Bt, int rowbase, int nrt, int ncu, int bid, int G, unsigned char* shm, int c0 = 0) {
  const int tid = tidx(), w = tid >> 6, lane = tid & 63, g = lane >> 4;
  const int ncu2 = ncu / NA, total = nrt * ncu2, nc = G - c0;
  if (bid < c0) return;
  for (int su = (G - 1 - bid); su < total; su += nc) {
    const int rt = su / ncu2, cu = su - rt * ncu2;
    const int row0 = rowbase + rt * 128, arow = row0 + 16 * w + (lane & 15);
    f32x4 acc[NA];
    const float rs = F::NEEDR ? f.rowscale(arow) : 1.f;
    skinny_unit<NA>(A, K, Bt, row0, 16 * NA * cu, 16, (float*)shm, acc);
#pragma unroll
    for (int i = 0; i < NA; ++i) {
      float ss = f(arow, 16 * (NA * cu + i) + 4 * g, acc[i], rs);
      if (F::STAT) { ss += __shfl_xor(ss, 16); ss += __shfl_xor(ss, 32); if (g == 0) ss_add(f.ss + arow, ss); }
    }
    __syncthreads();
  }
}
template <class F>
__device__ __forceinline__ void skinny_run_quarter(const F& f, const bf16_t* A, int K, const bf16_t* Bt, int ncu, int bid, int G, unsigned char* shm, int c0) {
  const int tid = tidx(), w = tid >> 6, lane = tid & 63, g4 = lane >> 4, l15 = lane & 15;
  const int total = 4 * ncu, nc = G - c0;
  if (bid < c0) return;
  float* red = (float*)shm;
  for (int su = (G - 1 - bid); su < total; su += nc) {
    const int cu = su >> 2, rq = su & 3, rt = w >> 2, kq = w & 3;
    const int arow = NP + 32 * rq + 16 * rt + l15;
    const int kspan = K >> 2, kbase = kq * kspan + 8 * g4;
    const bf16_t* ap = A + (size_t)arow * K + kbase;
    const bf16_t* bp = Bt + (size_t)(16 * cu + l15) * K + kbase;
    f32x4 acc = (f32x4){0.f, 0.f, 0.f, 0.f};
    typename F::Pre pre;
    if (kq == 0) pre = f.pre(arow, 16 * cu + 4 * g4);
    for (int k0 = 0; k0 < kspan; k0 += 256) {
      bf16x8 a[8], b[8];
#pragma unroll
      for (int s8 = 0; s8 < 8; ++s8) { if (k0 + 32 * s8 < kspan) { a[s8] = *(const bf16x8*)(ap + k0 + 32 * s8); b[s8] = *(const bf16x8*)(bp + k0 + 32 * s8); } }
#pragma unroll
      for (int s8 = 0; s8 < 8; ++s8) { if (k0 + 32 * s8 < kspan) acc = __builtin_amdgcn_mfma_f32_16x16x32_bf16(b[s8], a[s8], acc, 0, 0, 0); }
    }
    *(f32x4*)(red + (size_t)(w * 64 + lane) * 4) = acc;
    __syncthreads();
    if (kq == 0) {
      f32x4 t = acc;
#pragma unroll
      for (int q = 1; q < 4; ++q) t += *(const f32x4*)(red + (size_t)((w + q) * 64 + lane) * 4);
      float ss = f.post(arow, 16 * cu + 4 * g4, t, pre);
      if (F::STAT) { ss += __shfl_xor(ss, 16); ss += __shfl_xor(ss, 32); if (g4 == 0) ss_add(f.ss + arow, ss); }
    }
    __syncthreads();
  }
}
__device__ __forceinline__ void skinny_run13(const F13& f, const bf16_t* A, const bf16_t* Bt, int bid, int G, unsigned char* shm) {
  const int tid = tidx(), w = tid >> 6, lane = tid & 63, g = lane >> 4;
  const int c0 = ((NP / 256) * (2 * DFF / 256)) % G, nc = G - c0;
  if (bid < c0) return;
  for (int su = (G - 1 - bid); su < DFF / 16; su += nc) {
    const int arow = NP + 16 * w + (lane & 15);
    f32x4 acc[2];
    const float rs13 = f.rowscale(arow);
    skinny_unit<2>(A, 1024, Bt, NP, ((16 * su) >> 7) * 256 + ((16 * su) & 127), 128, (float*)shm, acc);
    f.pair(arow, 16 * su + 4 * g, acc[0], acc[1], rs13);
    __syncthreads();
  }
}
template <class F>
__device__ __forceinline__ void gemm_all(LAS unsigned char* lds, unsigned char* shm, const bf16_t* A, const bf16_t* Bt, int N, int K, const F& f, int bid, int G) {
  pg8::Gemm g; g.A = A; g.Bt = Bt; g.M = NP; g.N = N; g.K = K;
  pg8::StaticOrder S; S.init(NP, N, G, bid);
  EpiMain<F> E; E.f = f; E.coff = 0;
  REP(F::STAT ? 0 : 512) pg8::gemm_phase(lds, g, S, E);
  const int c0 = ((NP / 256) * (N / 256)) % G;
  if ((N / 16) * 2 <= G - c0) skinny_run_quarter(f, A, K, Bt, N / 16, bid, G, shm, c0);
  else skinny_run(f, A, K, Bt, NP, 1, N / 16, bid, G, shm, c0);
}

template <class F>
__device__ __forceinline__ void gemm_main_window(LAS unsigned char* lds, const bf16_t* A, const bf16_t* Bt, int N, int K, const F& f, int coff, int bid, int G) {
  pg8::Gemm g; g.A = A; g.Bt = Bt; g.M = NP; g.N = N; g.K = K;
  pg8::StaticOrder S; S.init(NP, N, G, bid);
  EpiMain<F> E; E.f = f; E.coff = coff;
  pg8::gemm_phase(lds, g, S, E);
}

__device__ __forceinline__ void prep_s5tables(const Params& P, int item, unsigned char* shm);
__device__ __forceinline__ void prep_phase(const Params& P, unsigned char* shm, int bid, int G) {
  const int tid = tidx(), w = tid >> 6, lane = tid & 63;
  bf16_t* T = (bf16_t*)shm;
  int jcur = 0;
  for (int t0 = 4 * bid; t0 < P.total_tiles; t0 += 4 * G) {
    f32x4 v0[4], v1[4]; float sc[4]; int jix[4];
    const int kk = tid >> 3, jq = tid & 7, nn = jq * 8;
#pragma unroll
    for (int u = 0; u < 4; ++u) {
      const int tile = t0 + u;
      v0[u] = (f32x4){0.f, 0.f, 0.f, 0.f}; v1[u] = v0[u]; sc[u] = 1.f;
      if (tile < P.total_tiles) {
        while (jcur + 1 < P.njobs && P.jobs[jcur + 1].tile0 <= tile) ++jcur;
        jix[u] = jcur;
        const TJob& J = P.jobs[jcur];
        const int lt = tile - J.tile0, tn = lt % J.ntn, tk = lt / J.ntn, k0 = tk * 64, n0 = tn * 64;
        if (n0 + nn < J.ncols) { const float* sp = J.src + (size_t)(k0 + kk) * J.ldn + J.c0 + n0 + nn; v0[u] = *(const f32x4*)sp; v1[u] = *(const f32x4*)(sp + 4); }
        if (J.scale) sc[u] = J.scale[k0 + kk];
      }
    }
#pragma unroll
    for (int u = 0; u < 4; ++u) {
      bf16_t* Tu = T + u * (64 * 72);
      const int kx = kk ^ (8 * jq);
#pragma unroll
      for (int i = 0; i < 4; ++i) { Tu[(nn + i) * 72 + kx] = f2bf(v0[u][i] * sc[u]); Tu[(nn + 4 + i) * 72 + kx] = f2bf(v1[u][i] * sc[u]); }
    }
    __syncthreads();
#pragma unroll
    for (int u = 0; u < 4; ++u) {
      const int tile = t0 + u;
      if (tile < P.total_tiles) {
        const TJob& J = P.jobs[jix[u]];
        const int lt = tile - J.tile0, tn = lt % J.ntn, tk = lt / J.ntn, k0 = tk * 64, n0 = tn * 64;
        const int n = tid >> 3, k8 = (tid & 7) * 8, gn = n0 + n;
        if (gn < J.nwrite) {
          const int dr = J.mode == 0 ? J.r0 + gn : ((gn >> 7) * 256 + (J.mode == 2 ? 128 : 0) + (gn & 127));
          *(u32x4*)(J.dst + (size_t)dr * J.K + k0 + k8) = *(const u32x4*)(T + u * (64 * 72) + n * 72 + (k8 ^ (8 * ((n >> 3) & 7))));
        }
      }
    }
    __syncthreads();
  }
  for (int i = bid * 512 + tid; i < 2 * 2048; i += G * 512) {
    const int l = i >> 11, gp = i & 2047, g = gp >> 6, p = gp & 63;
    const float dt = expf(P.log_dt[l * 32 + g]);
    const float Ar = P.A_re[l * 2048 + gp], Ai = P.A_im[l * 2048 + gp];
    const float mag = expf(dt * Ar);
    float sn, cs; sincosf(dt * Ai, &sn, &cs);
    const float abr = mag * cs, abi = mag * sn;
    const float den = Ar * Ar + Ai * Ai, nr = abr - 1.0f, ni = abi;
    const float fre = (nr * Ar + ni * Ai) / den, fim = (ni * Ar - nr * Ai) / den;
    P.abar[l][gp] = abr; P.abar[l][2048 + gp] = abi;
    for (int c = 0; c < 16; ++c) {
      const float Br = P.B_re[(size_t)l * 32768 + gp * 16 + c], Bi = P.B_im[(size_t)l * 32768 + gp * 16 + c];
      P.bbar[l][(g * 16 + c) * 64 + p] = fre * Br - fim * Bi;
      P.bbar[l][32768 + (g * 16 + c) * 64 + p] = fre * Bi + fim * Br;
    }
  }
  for (int it = bid; it < 256; it += G) prep_s5tables(P, it, shm);
  for (int row = bid * 8 + w; row < NT; row += G * 8) {
    const float* xr = row < NP ? P.x_prompt + (size_t)row * DM : P.x_sample + (size_t)(row - NP) * DM;
    float ss = 0.f;
#pragma unroll
    for (int i = 0; i < 4; ++i) {
      const f32x4 v = *(const f32x4*)(xr + 256 * i + 4 * lane);
      ss += (v[0] * v[0] + v[1] * v[1]) + (v[2] * v[2] + v[3] * v[3]);
      *(u32x2*)(P.xb + (size_t)row * DM + 256 * i + 4 * lane) = pack4(v);
    }
    ss = wave_sum(ss);
    if (lane == 0) P.ssA[row] = ss_fix(ss);
  }
}

__device__ __forceinline__ void mlstm_scalars(const float* gat, int b, int h, float* sA, float* sM, float* sB, float* chain) {
  const int tid = tidx(), w = tid >> 6, lane = tid & 63;
  for (int cc = w; cc < 16; cc += 8) {
    const int t0 = cc * 128 + 2 * lane; const size_t r0 = (size_t)b * 2048 + t0;
    const float ig0 = gat[r0 * 8 + h], lf0 = gat[r0 * 8 + 4 + h], ig1 = gat[(r0 + 1) * 8 + h], lf1 = gat[(r0 + 1) * 8 + 4 + h];
    float x = lf0 + lf1;
    for (int off = 1; off < 64; off <<= 1) { const float y = __shfl_up(x, off); if (lane >= off) x += y; }
    const float b1 = x, b0 = x - lf1, a0 = ig0 - b0, a1 = ig1 - b1;
    float cm = fmaxf(a0, a1);
    for (int off = 1; off < 64; off <<= 1) { const float y = __shfl_up(cm, off); if (lane >= off) cm = fmaxf(cm, y); }
    const float prev = __shfl_up(cm, 1); const float cm0 = lane ? fmaxf(prev, a0) : a0;
    sB[t0] = b0; sB[t0 + 1] = b1; sA[t0] = a0; sA[t0 + 1] = a1; sM[t0] = cm0; sM[t0 + 1] = cm;
    if (lane == 63) { chain[33 + cc] = b1; chain[49 + cc] = cm; }
  }
  __syncthreads();
  if (tid == 0) { float m = 0.f; for (int cc = 0; cc < 16; ++cc) { chain[cc] = m; const float ml = fmaxf(m, chain[49 + cc]); chain[17 + cc] = ml; m = chain[33 + cc] + ml; } chain[16] = m; }
  __syncthreads();
  for (int t = tid; t < 2048; t += 512) sM[t] = fmaxf(chain[t >> 7], sM[t]);
  __syncthreads();
}

__device__ __forceinline__ void m1_item(const Params& P, int item, unsigned char* shm) {
  const int tid = tidx(), w = __builtin_amdgcn_readfirstlane(tid >> 6), lane = tid & 63, g = lane >> 4;
  const int b = item >> 6, h = (item >> 4) & 3, c = item & 15;
  float* sA = (float*)shm; float* sM = sA + 2048; float* sB = sM + 2048; float* chain = sB + 2048;
  mlstm_scalars(P.gat, b, h, sA, sM, sB, chain);
  const int row0 = b * 2048 + c * 128, t = 16 * w + (lane & 15);
  const bf16_t* qp = P.Pb + (size_t)(row0 + t) * NG1 + h * 256 + 8 * g;
  bf16x8 qf[8];
#pragma unroll
  for (int ks = 0; ks < 8; ++ks) qf[ks] = *(const bf16x8*)(qp + 32 * ks);
  const float Mt = sM[c * 128 + t];
  bf16_t* sp = P.St + (size_t)item * 16384 + t * 128;
#pragma unroll
  for (int sg = 0; sg < 8; sg += 4) {
    if (sg <= w) {
      bf16x8 kf[4][8];
#pragma unroll
      for (int u = 0; u < 4; ++u) {
        if (sg + u <= w) {
          const bf16_t* kp = P.Pb + (size_t)(row0 + 16 * (sg + u) + (lane & 15)) * NG1 + 1024 + h * 256 + 8 * g;
#pragma unroll
          for (int ks = 0; ks < 8; ++ks) kf[u][ks] = *(const bf16x8*)(kp + 32 * ks);
        }
      }
#pragma unroll
      for (int u = 0; u < 4; ++u) {
        const int st = sg + u;
        f32x4 acc = (f32x4){0.f, 0.f, 0.f, 0.f};
        if (st <= w) {
#pragma unroll
          for (int ks = 0; ks < 8; ++ks) acc = __builtin_amdgcn_mfma_f32_16x16x32_bf16(kf[u][ks], qf[ks], acc, 0, 0, 0);
#pragma unroll
          for (int r = 0; r < 4; ++r) { const int s2 = 16 * st + 4 * g + r; acc[r] = (s2 <= t) ? acc[r] * __expf(sA[c * 128 + s2] - Mt) : 0.f; }
        }
        *(u32x2*)(sp + 16 * st + 4 * g) = pack4(acc);
      }
    } else {
#pragma unroll
      for (int u = 0; u < 4; ++u) *(u32x2*)(sp + 16 * (sg + u) + 4 * g) = (u32x2){0u, 0u};
    }
  }
  __syncthreads();
}

__device__ __forceinline__ bf16x8 trread8(unsigned a0, unsigned a1) {
  bf16x4 lo, hi;
  asm volatile("ds_read_b64_tr_b16 %0, %2\n\tds_read_b64_tr_b16 %1, %3\n\ts_waitcnt lgkmcnt(0)" : "=&v"(lo), "=&v"(hi) : "v"(a0), "v"(a1) : "memory");
  return __builtin_shufflevector(lo, hi, 0, 1, 2, 3, 4, 5, 6, 7);
}
__device__ __forceinline__ void trread8x3(unsigned a0, unsigned a1, unsigned a2, unsigned dlt, bf16x8& r0, bf16x8& r1, bf16x8& r2) {
  bf16x4 l0, h0, l1, h1, l2, h2;
  asm volatile("ds_read_b64_tr_b16 %0, %6\n\tds_read_b64_tr_b16 %1, %7\n\tds_read_b64_tr_b16 %2, %8\n\tds_read_b64_tr_b16 %3, %9\n\tds_read_b64_tr_b16 %4, %10\n\tds_read_b64_tr_b16 %5, %11\n\ts_waitcnt lgkmcnt(0)"
               : "=&v"(l0), "=&v"(h0), "=&v"(l1), "=&v"(h1), "=&v"(l2), "=&v"(h2)
               : "v"(a0), "v"(a0 + dlt), "v"(a1), "v"(a1 + dlt), "v"(a2), "v"(a2 + dlt) : "memory");
  r0 = __builtin_shufflevector(l0, h0, 0, 1, 2, 3, 4, 5, 6, 7); r1 = __builtin_shufflevector(l1, h1, 0, 1, 2, 3, 4, 5, 6, 7); r2 = __builtin_shufflevector(l2, h2, 0, 1, 2, 3, 4, 5, 6, 7);
}
__device__ __forceinline__ void trread8x2(unsigned a0, unsigned a1, unsigned dlt, bf16x8& r0, bf16x8& r1) {
  bf16x4 l0, h0, l1, h1;
  asm volatile("ds_read_b64_tr_b16 %0, %4\n\tds_read_b64_tr_b16 %1, %5\n\tds_read_b64_tr_b16 %2, %6\n\tds_read_b64_tr_b16 %3, %7\n\ts_waitcnt lgkmcnt(0)"
               : "=&v"(l0), "=&v"(h0), "=&v"(l1), "=&v"(h1) : "v"(a0), "v"(a0 + dlt), "v"(a1), "v"(a1 + dlt) : "memory");
  r0 = __builtin_shufflevector(l0, h0, 0, 1, 2, 3, 4, 5, 6, 7); r1 = __builtin_shufflevector(l1, h1, 0, 1, 2, 3, 4, 5, 6, 7);
}

constexpr int KS_STRIDE = 272, VS_STRIDE = 56;
constexpr int M2_K = 0, M2_V = 69632, M2_CL = 83968, M2_SC = 110080;
__device__ __forceinline__ void m2_item(const Params& P, int l, int item, unsigned char* shm) {
  const int tid = tidx(), w = __builtin_amdgcn_readfirstlane(tid >> 6), lane = tid & 63, g = lane >> 4, l15 = lane & 15;
  const int bh = item >> 3, j = item & 7, b = bh >> 2, h = bh & 3;
  bf16_t* Ksh = (bf16_t*)(shm + M2_K); bf16_t* Vsh = (bf16_t*)(shm + M2_V); bf16_t* Cl = (bf16_t*)(shm + M2_CL);
  float* sA = (float*)(shm + M2_SC); float* sM = sA + 2048; float* sB = sM + 2048; float* chain = sB + 2048;
  const unsigned lbase = (unsigned)(size_t)shm;
  u32x4 kreg[8]; u32x4 vreg;
  const int vs = tid >> 2, vpc = tid & 3;
  {
    const int row0 = b * 2048;
#pragma unroll
    for (int i = 0; i < 8; ++i) { const int piece = tid + 512 * i, s = piece >> 5, pc = piece & 31; kreg[i] = *(const u32x4*)(P.Pb + (size_t)(row0 + s) * NG1 + 1024 + h * 256 + 8 * pc); }
    vreg = *(const u32x4*)(P.Pb + (size_t)(row0 + vs) * NG1 + 2048 + h * 256 + 32 * j + 8 * vpc);
  }
  bf16x8 qf[8], sf[4];
  {
    const int t = 16 * w + l15;
#pragma unroll
    for (int ks = 0; ks < 8; ++ks) qf[ks] = (bf16x8){0, 0, 0, 0, 0, 0, 0, 0};
    const bf16_t* sp0 = P.St + (size_t)(bh * 16) * 16384 + t * 128 + 8 * g;
#pragma unroll
    for (int ks = 0; ks < 4; ++ks) sf[ks] = *(const bf16x8*)(sp0 + 32 * ks);
  }
  mlstm_scalars(P.gat, b, h, sA, sM, sB, chain);
  f32x4 Cacc[2][3];
#pragma unroll
  for (int dt = 0; dt < 2; ++dt)
#pragma unroll
    for (int et = 0; et < 3; ++et) Cacc[dt][et] = (f32x4){0.f, 0.f, 0.f, 0.f};
  const int trq = l15 >> 2, trp = lane & 3;
#define M2_WRITE_KV(cc) do { \
    const float ml_ = chain[17 + (cc)]; \
    _Pragma("unroll") for (int i = 0; i < 8; ++i) { const int piece = tid + 512 * i, s = piece >> 5, pc = piece & 31; \
      const float wk = __expf(sA[(cc) * 128 + s] - ml_); u32x4 sc; \
      _Pragma("unroll") for (int e = 0; e < 4; ++e) { const unsigned u = kreg[i][e]; sc[e] = pack2(bf2f(u & 0xffffu) * wk, bf2f(u >> 16) * wk); } \
      *(u32x4*)(Ksh + s * KS_STRIDE + 8 * pc) = sc; } \
    *(u32x4*)(Vsh + vs * VS_STRIDE + 8 * vpc) = vreg; \
    if (vpc == 0) { unsigned zz = 0u; asm volatile("" : "+v"(zz)); const u32x4 z = (u32x4){zz, zz, zz, zz}; u32x4 o1 = z; o1[0] = 0x3F80u; \
      *(u32x4*)(Vsh + vs * VS_STRIDE + 32) = o1; *(u32x4*)(Vsh + vs * VS_STRIDE + 40) = z; } } while (0)
  M2_WRITE_KV(0);
  __syncthreads();
  for (int c = 0; c < 16; ++c) {
    const int row0 = b * 2048 + c * 128;
    const float mlast = chain[17 + c], mprev = chain[c];
    if (c < 15) {
      const int nrow0 = row0 + 128;
#pragma unroll
      for (int i = 0; i < 8; ++i) { const int piece = tid + 512 * i, s = piece >> 5, pc = piece & 31; kreg[i] = *(const u32x4*)(P.Pb + (size_t)(nrow0 + s) * NG1 + 1024 + h * 256 + 8 * pc); }
      vreg = *(const u32x4*)(P.Pb + (size_t)(nrow0 + vs) * NG1 + 2048 + h * 256 + 32 * j + 8 * vpc);
    }
    {
      const int t = 16 * w + l15, row = row0 + t;
      f32x4 acc[3]; acc[0] = (f32x4){0.f, 0.f, 0.f, 0.f}; acc[1] = acc[0]; acc[2] = acc[0];
      const float Mt = sM[c * 128 + t];
      if (c > 0) {
#pragma unroll
        for (int ks = 0; ks < 8; ++ks) {
          bf16x8 cf[3];
#pragma unroll
          for (int et = 0; et < 3; ++et) cf[et] = *(const bf16x8*)(Cl + (16 * et + l15) * KS_STRIDE + 32 * ks + 8 * g);
          __builtin_amdgcn_sched_barrier(0);
#pragma unroll
          for (int et = 0; et < 3; ++et) acc[et] = __builtin_amdgcn_mfma_f32_16x16x32_bf16(cf[et], qf[ks], acc[et], 0, 0, 0);
          __builtin_amdgcn_sched_barrier(0);
        }
        const float wi = __expf(mprev - Mt);
        acc[0] *= wi; acc[1] *= wi; acc[2] *= wi;
      }
      const float ac = __expf(mprev - mlast);
#pragma unroll
      for (int dt = 0; dt < 2; ++dt)
#pragma unroll
        for (int et = 0; et < 3; ++et) Cacc[dt][et] *= ac;
#pragma unroll
      for (int ks = 0; ks < 4; ++ks) {
        bf16x8 kf[2], vf[3];
        const unsigned va = lbase + M2_V + (unsigned)((32 * ks + 8 * g + trq) * VS_STRIDE + 4 * trp) * 2u;
        const unsigned ka = lbase + M2_K + (unsigned)((32 * ks + 8 * g + trq) * KS_STRIDE + 32 * w + 4 * trp) * 2u;
        trread8x3(va, va + 32u, va + 64u, 4u * VS_STRIDE * 2u, vf[0], vf[1], vf[2]);
        trread8x2(ka, ka + 32u, 4u * KS_STRIDE * 2u, kf[0], kf[1]);
#pragma unroll
        for (int et = 0; et < 3; ++et) acc[et] = __builtin_amdgcn_mfma_f32_16x16x32_bf16(vf[et], sf[ks], acc[et], 0, 0, 0);
#pragma unroll
        for (int dt = 0; dt < 2; ++dt)
#pragma unroll
          for (int et = 0; et < 3; ++et) Cacc[dt][et] = __builtin_amdgcn_mfma_f32_16x16x32_bf16(kf[dt], vf[et], Cacc[dt][et], 0, 0, 0);
      }
      if (c < 15) {
        const bf16_t* qp = P.Pb + (size_t)(row + 128) * NG1 + h * 256 + 8 * g;
#pragma unroll
        for (int ks = 0; ks < 8; ++ks) qf[ks] = *(const bf16x8*)(qp + 32 * ks);
        const bf16_t* sp = P.St + (size_t)(bh * 16 + c + 1) * 16384 + t * 128 + 8 * g;
#pragma unroll
        for (int ks = 0; ks < 4; ++ks) sf[ks] = *(const bf16x8*)(sp + 32 * ks);
      }
      const float den = __shfl(acc[2][0], l15);
      const float dd = fmaxf(fabsf(den), __expf(-(sB[c * 128 + t] + Mt)));
      const float inv = __builtin_amdgcn_rcpf(dd);
      const f32x4 o0 = acc[0] * inv, o1 = acc[1] * inv;
      bf16_t* hp = P.hA + (size_t)row * DM + h * 256 + 32 * j + 4 * g;
      *(u32x2*)hp = pack4(o0); *(u32x2*)(hp + 16) = pack4(o1);
      float ss = (o0[0] * o0[0] + o0[1] * o0[1]) + (o0[2] * o0[2] + o0[3] * o0[3]) + (o1[0] * o1[0] + o1[1] * o1[1]) + (o1[2] * o1[2] + o1[3] * o1[3]);
      ss += __shfl_xor(ss, 16); ss += __shfl_xor(ss, 32);
      if (g == 0) P.hss[(size_t)row * 32 + h * 8 + j] = ss;
    }
    LDS_BARRIER();
#pragma unroll
    for (int dt = 0; dt < 2; ++dt)
#pragma unroll
      for (int et = 0; et < 3; ++et) *(u32x2*)(Cl + (16 * et + l15) * KS_STRIDE + 32 * w + 16 * dt + 4 * g) = pack4(Cacc[dt][et]);
    if (c < 15) M2_WRITE_KV(c + 1);
    LDS_BARRIER();
  }
#undef M2_WRITE_KV
  const size_t sidx = (size_t)(l * 8 + b) * 4 + h;
#pragma unroll
  for (int dt = 0; dt < 2; ++dt)
#pragma unroll
    for (int r = 0; r < 4; ++r) {
      const int d = 32 * w + 16 * dt + 4 * g + r;
      P.out[O_CP + sidx * 65536 + (size_t)d * 256 + 32 * j + l15] = Cacc[dt][0][r];
      P.out[O_CP + sidx * 65536 + (size_t)d * 256 + 32 * j + 16 + l15] = Cacc[dt][1][r];
      if (j == 0 && l15 == 0) P.out[O_NP + sidx * 256 + d] = Cacc[dt][2][r];
    }
  if (j == 0 && tid == 0) P.out[O_MP + sidx] = chain[16];
  __syncthreads();
}

__device__ __forceinline__ void msample_item(const Params& P, int l, int item, unsigned char* shm) {
  const int tid = tidx(), w = tid >> 6, lane = tid & 63;
  const int b = item >> 2, h = item & 3, row = NP + b;
  float* q = (float*)shm; float* k = q + 256; float* v = k + 256; float* red = v + 256; float* red2 = red + 2048;
  if (tid < 256) {
    const bf16_t* pr = P.Pb + (size_t)row * NG1 + h * 256 + tid;
    q[tid] = bf2f(pr[0]); k[tid] = bf2f(pr[1024]); v[tid] = bf2f(pr[2048]);
  }
  const float ig = P.gat[(size_t)row * 8 + h], lf = P.gat[(size_t)row * 8 + 4 + h];
  const size_t sidx = (size_t)(l * 128 + b) * 4 + h;
  const float m0 = P.st_m[sidx];
  const float inter = lf + m0, mt = fmaxf(inter, ig), wi = __expf(inter - mt), wa = __expf(ig - mt);
  __syncthreads();
  const float* C0 = P.st_C + sidx * 65536; float* Co = P.out + O_CS + sidx * 65536;
  const float* n0 = P.st_n + sidx * 256;
  const f32x4 v4 = *(const f32x4*)(v + 4 * lane);
  f32x4 acc = (f32x4){0.f, 0.f, 0.f, 0.f};
#pragma unroll 8
  for (int dd = 0; dd < 32; ++dd) {
    const int d = 32 * w + dd;
    const f32x4 c4 = __builtin_nontemporal_load((const f32x4*)(C0 + (size_t)d * 256 + 4 * lane));
    const float kd = wa * k[d], qd = q[d];
    __builtin_nontemporal_store(c4 * wi + v4 * kd, (f32x4*)(Co + (size_t)d * 256 + 4 * lane));
    acc += c4 * qd;
  }
  *(f32x4*)(red + w * 256 + 4 * lane) = acc;
  float qk = 0.f, qn = 0.f;
#pragma unroll
  for (int i = 0; i < 4; ++i) { const int d = lane + 64 * i; qk += q[d] * k[d]; qn += q[d] * n0[d]; }
  qk = wave_sum(qk); qn = wave_sum(qn);
  __syncthreads();
  const float s = qk * wa, den = wi * qn + s, ddn = fmaxf(fabsf(den), __expf(-mt));
  float hval = 0.f;
  if (tid < 256) {
    float num = 0.f;
#pragma unroll
    for (int i = 0; i < 8; ++i) num += red[i * 256 + tid];
    hval = (wi * num + s * v[tid]) / ddn;
    P.hA[(size_t)row * DM + h * 256 + tid] = f2bf(hval);
    P.out[O_NS + sidx * 256 + tid] = wi * n0[tid] + wa * k[tid];
  }
  float ss = wave_sum(hval * hval);
  if (lane == 0) red2[w] = ss;
  __syncthreads();
  if (tid < 8) P.hss[(size_t)row * 32 + h * 8 + tid] = tid == 0 ? (red2[0] + red2[1] + red2[2] + red2[3]) : 0.f;
  if (tid == 0) P.out[O_MS + sidx] = mt;
  __syncthreads();
}

__device__ __forceinline__ void s5_load_C(const Params& P, int l, int g, float* Csh) {
  for (int i = tidx(); i < 2048; i += 512) { const int ri = i >> 10, c = (i >> 6) & 15, p = i & 63;
    Csh[ri * 1088 + c * 68 + p] = (ri ? P.C_im : P.C_re)[(size_t)l * 32768 + (g * 16 + c) * 64 + p]; }
}
__device__ __forceinline__ void s5_sample_item(const Params& P, int l, int item, unsigned char* shm) {
  const int tid = tidx(), w = tid >> 6, lane = tid & 63;
  const int g = item & 31, bs0 = (item >> 5) * 16 + 2 * w;
  float* Csh = (float*)shm; float* sbuf = Csh + 2176 + w * 2176;
  s5_load_C(P, l, g, Csh);
  const float are = P.abar[l][g * 64 + lane], aim = P.abar[l][2048 + g * 64 + lane];
  float bre[16], bim[16];
#pragma unroll
  for (int c = 0; c < 16; ++c) { bre[c] = P.bbar[l][(g * 16 + c) * 64 + lane]; bim[c] = P.bbar[l][32768 + (g * 16 + c) * 64 + lane]; }
  const int ch = lane >> 2, pq = lane & 3;
  const float Dc = P.D_skip[l * 512 + g * 16 + ch];
  __syncthreads();
#pragma unroll
  for (int rep = 0; rep < 2; ++rep) {
    const int bs = bs0 + rep, row = NP + bs;
    const size_t o = ((size_t)(l * 128 + bs) * 32 + g) * 64 + lane;
    const float s0r = P.st_sre[o], s0i = P.st_sim[o];
    const bf16_t* up = P.Pb + (size_t)row * NG1 + 4096 + g * 16;
    const u32x4 u0 = *(const u32x4*)up, u1 = *(const u32x4*)(up + 8);
    float br = 0.f, bi = 0.f;
#pragma unroll
    for (int i = 0; i < 4; ++i) {
      const float ua = bf2f(u0[i] & 0xffffu), ub = bf2f(u0[i] >> 16), uc = bf2f(u1[i] & 0xffffu), ud = bf2f(u1[i] >> 16);
      br += bre[2 * i] * ua + bre[2 * i + 1] * ub + bre[8 + 2 * i] * uc + bre[8 + 2 * i + 1] * ud;
      bi += bim[2 * i] * ua + bim[2 * i + 1] * ub + bim[8 + 2 * i] * uc + bim[8 + 2 * i + 1] * ud;
    }
    const float sr = are * s0r - aim * s0i + br, si = are * s0i + aim * s0r + bi;
    P.out[O_SRS + o] = sr; P.out[O_SIS + o] = si;
    sbuf[rep * 136 + lane] = sr; sbuf[rep * 136 + 68 + lane] = si;
    asm volatile("s_waitcnt lgkmcnt(0)" ::: "memory");
    float acc = 0.f;
#pragma unroll
    for (int p4 = 0; p4 < 4; ++p4) {
      const int p0 = 16 * pq + 4 * p4;
      const f32x4 vr = *(const f32x4*)(sbuf + rep * 136 + p0), vi = *(const f32x4*)(sbuf + rep * 136 + 68 + p0);
      const f32x4 cr = *(const f32x4*)(Csh + ch * 68 + p0), ci = *(const f32x4*)(Csh + 1088 + ch * 68 + p0);
      acc += (cr[0] * vr[0] + cr[1] * vr[1]) + (cr[2] * vr[2] + cr[3] * vr[3]) - (ci[0] * vi[0] + ci[1] * vi[1]) - (ci[2] * vi[2] + ci[3] * vi[3]);
    }
    acc += __shfl_xor(acc, 1); acc += __shfl_xor(acc, 2);
    if (pq == 0) {
      const float uc = bf2f(up[ch]);
      P.ysb[(size_t)row * 512 + g * 16 + ch] = f2bf(gelu_tanh(acc + Dc * uc));
    }
  }
  __syncthreads();
}

__device__ __forceinline__ void prep_s5tables(const Params& P, int item, unsigned char* shm) {
  const int tid = tidx(), qpart = item & 3, l = item >> 7, g = (item >> 2) & 31;
  float* pwr = (float*)shm; float* pwi = pwr + 17 * 64; float* bbr = pwi + 17 * 64; float* bbi = bbr + 1024; float* Ccr = bbi + 1024; float* Cci = Ccr + 1024;
  if (tid < 64) {
    const int p = tid, gp = g * 64 + p;
    const float dt = expf(P.log_dt[l * 32 + g]);
    const float Ar = P.A_re[l * 2048 + gp], Ai = P.A_im[l * 2048 + gp];
    const float mag = expf(dt * Ar);
    float sn, cs; sincosf(dt * Ai, &sn, &cs);
    const float abr = mag * cs, abi = mag * sn;
    const float den = Ar * Ar + Ai * Ai, nr = abr - 1.0f, ni = abi;
    const float fre = (nr * Ar + ni * Ai) / den, fim = (ni * Ar - nr * Ai) / den;
    float pr = 1.f, pi = 0.f;
    for (int t = 0; t <= 16; ++t) { pwr[t * 64 + p] = pr; pwi[t * 64 + p] = pi; const float a = pr * abr - pi * abi, b = pr * abi + pi * abr; pr = a; pi = b; }
    for (int c = 0; c < 16; ++c) {
      const float Br = P.B_re[(size_t)l * 32768 + gp * 16 + c], Bi = P.B_im[(size_t)l * 32768 + gp * 16 + c];
      bbr[p * 16 + c] = fre * Br - fim * Bi; bbi[p * 16 + c] = fre * Bi + fim * Br;
    }
  }
  for (int i = tid; i < 1024; i += 512) { Ccr[i] = P.C_re[(size_t)l * 32768 + g * 1024 + i]; Cci[i] = P.C_im[(size_t)l * 32768 + g * 1024 + i]; }
  __syncthreads();
  bf16_t* Kt = P.Kt[l] + (size_t)g * 17 * 256; bf16_t* Gm = P.Gm[l] + (size_t)g * 32768; bf16_t* Hm = P.Hm[l] + (size_t)g * 32768;
  for (int o = qpart * 1088 + tid; o < (qpart + 1) * 1088; o += 512) {
    const int tau = o >> 8, c = (o >> 4) & 15, c2 = o & 15;
    float acc = 0.f;
    if (tau < 16) for (int p = 0; p < 64; ++p) {
      const float pr = pwr[tau * 64 + p], pi = pwi[tau * 64 + p], br = bbr[p * 16 + c2], bi = bbi[p * 16 + c2];
      const float zr = pr * br - pi * bi, zi = pr * bi + pi * br;
      acc += Ccr[c * 64 + p] * zr - Cci[c * 64 + p] * zi;
    }
    Kt[o] = f2bf(acc);
  }
  for (int o = qpart * 8192 + tid; o < (qpart + 1) * 8192; o += 512) {
    { const int tc = o >> 7, q = o & 127, t = tc >> 4, c = tc & 15, p = q & 63;
      const float cr = Ccr[c * 64 + p], ci = Cci[c * 64 + p], pr = pwr[(t + 1) * 64 + p], pi = pwi[(t + 1) * 64 + p];
      Gm[o] = f2bf(q < 64 ? (cr * pr - ci * pi) : -(cr * pi + ci * pr)); }
    { const int q = o >> 8, jc = o & 255, j = jc >> 4, c2 = jc & 15, p = q & 63;
      const float pr = pwr[(15 - j) * 64 + p], pi = pwi[(15 - j) * 64 + p], br = bbr[p * 16 + c2], bi = bbi[p * 16 + c2];
      Hm[o] = f2bf(q < 64 ? (pr * br - pi * bi) : (pr * bi + pi * br)); }
  }
  if (tid < 64 && qpart == 0) { P.a16[l][g * 64 + tid] = pwr[16 * 64 + tid]; P.a16[l][2048 + g * 64 + tid] = pwi[16 * 64 + tid]; }
  __syncthreads();
}
constexpr int S3_R0 = 0, S3_SIN = 69632, S3_KT = 69632 + 34816;
__device__ __forceinline__ void s5_stage3_item(const Params& P, int l, int item, unsigned char* shm) {
  const int tid = tidx(), w = tid >> 6, lane = tid & 63, g4 = lane >> 4, l15 = lane & 15;
  const int b = item >> 5, g = item & 31;
  float* Ebuf = (float*)(shm + S3_R0); bf16_t* Gsh = (bf16_t*)(shm + S3_R0); bf16_t* Sin = (bf16_t*)(shm + S3_SIN); bf16_t* Ksh = (bf16_t*)(shm + S3_KT);
  { bf16_t* Hsh = (bf16_t*)(shm + S3_R0); const bf16_t* Hm = P.Hm[l] + (size_t)g * 32768;
#pragma unroll
    for (int i = 0; i < 8; ++i) { const int piece = tid + 512 * i, r = piece >> 5, pc = piece & 31; *(u32x4*)(Hsh + r * 264 + 8 * pc) = *(const u32x4*)(Hm + r * 256 + 8 * pc); } }
  { const bf16_t* Kt = P.Kt[l] + (size_t)g * 17 * 256; for (int i = tid; i < 544; i += 512) *(u32x4*)(Ksh + 8 * i) = *(const u32x4*)(Kt + 8 * i); }
  const int n = 16 * w + l15, r0 = b * 2048 + n * 16;
  bf16x8 uf[8];
#pragma unroll
  for (int ks = 0; ks < 8; ++ks) uf[ks] = *(const bf16x8*)(P.Pb + (size_t)(r0 + 2 * ks + (g4 >> 1)) * NG1 + 4096 + g * 16 + 8 * (g4 & 1));
  __syncthreads();
  {
    const bf16_t* Hsh = (const bf16_t*)(shm + S3_R0);
    f32x4 eacc[8];
#pragma unroll
    for (int qt = 0; qt < 8; ++qt) {
      eacc[qt] = (f32x4){0.f, 0.f, 0.f, 0.f};
#pragma unroll
      for (int ks = 0; ks < 8; ++ks) { const bf16x8 x = *(const bf16x8*)(Hsh + (16 * qt + l15) * 264 + 32 * ks + 8 * g4); eacc[qt] = __builtin_amdgcn_mfma_f32_16x16x32_bf16(x, uf[ks], eacc[qt], 0, 0, 0); }
    }
    __syncthreads();
#pragma unroll
    for (int qt = 0; qt < 8; ++qt) *(f32x4*)(Ebuf + n * 128 + 16 * qt + 4 * g4) = eacc[qt];
  }
  __syncthreads();
  {
    const float ar = P.a16[l][g * 64 + lane], ai = P.a16[l][2048 + g * 64 + lane];
    float lr[16], li[16], sr = 0.f, si = 0.f;
#pragma unroll
    for (int k = 0; k < 16; ++k) {
      lr[k] = sr; li[k] = si;
      const float er = Ebuf[(16 * w + k) * 128 + lane], ei = Ebuf[(16 * w + k) * 128 + 64 + lane];
      const float nr = ar * sr - ai * si + er, ni = ar * si + ai * sr + ei; sr = nr; si = ni;
    }
    float* wend = (float*)(shm + S3_KT + 8704);
    wend[w * 128 + lane] = sr; wend[w * 128 + 64 + lane] = si;
    float br = ar, bi = ai;
#pragma unroll
    for (int i = 0; i < 4; ++i) { const float nr = br * br - bi * bi, ni = 2.f * br * bi; br = nr; bi = ni; }
    __syncthreads();
    float cr = 0.f, ci = 0.f;
    for (int w2 = 0; w2 < w; ++w2) { const float er = wend[w2 * 128 + lane], ei = wend[w2 * 128 + 64 + lane]; const float nr = br * cr - bi * ci + er, ni = br * ci + bi * cr + ei; cr = nr; ci = ni; }
    float pr = 1.f, pi = 0.f;
#pragma unroll
    for (int k = 0; k < 16; ++k) {
      Sin[(16 * w + k) * 136 + lane] = f2bf(lr[k] + pr * cr - pi * ci); Sin[(16 * w + k) * 136 + 64 + lane] = f2bf(li[k] + pr * ci + pi * cr);
      const float nr = pr * ar - pi * ai, ni = pr * ai + pi * ar; pr = nr; pi = ni;
    }
    if (w == 7) { const size_t o = ((size_t)(l * 8 + b) * 32 + g) * 64 + lane; P.out[O_SRP + o] = sr + pr * cr - pi * ci; P.out[O_SIP + o] = si + pr * ci + pi * cr; }
  }
  __syncthreads();
  { const bf16_t* Gm = P.Gm[l] + (size_t)g * 32768;
#pragma unroll
    for (int i = 0; i < 8; ++i) { const int piece = tid + 512 * i, r = piece >> 4, pc = piece & 15; *(u32x4*)(Gsh + r * 136 + 8 * pc) = *(const u32x4*)(Gm + r * 128 + 8 * pc); } }
  __syncthreads();
  bf16x8 sf[4];
#pragma unroll
  for (int k2 = 0; k2 < 4; ++k2) sf[k2] = *(const bf16x8*)(Sin + n * 136 + 32 * k2 + 8 * g4);
  const f32x4 D4 = *(const f32x4*)(P.D_skip + l * 512 + g * 16 + 4 * g4);
#pragma unroll
  for (int t = 0; t < 16; ++t) {
    f32x4 acc = (f32x4){0.f, 0.f, 0.f, 0.f};
    const int row = r0 + t;
    const f32x4 u4 = unpack4(*(const u32x2*)(P.Pb + (size_t)row * NG1 + 4096 + g * 16 + 4 * g4));
#pragma unroll
    for (int ks = 0; ks <= (t >> 1); ++ks) {
      const int tau = t - (2 * ks + (g4 >> 1)), idx = tau >= 0 ? tau : 16;
      const bf16x8 x = *(const bf16x8*)(Ksh + (idx * 16 + l15) * 16 + 8 * (g4 & 1));
      acc = __builtin_amdgcn_mfma_f32_16x16x32_bf16(x, uf[ks], acc, 0, 0, 0);
    }
#pragma unroll
    for (int k2 = 0; k2 < 4; ++k2) { const bf16x8 x = *(const bf16x8*)(Gsh + (t * 16 + l15) * 136 + 32 * k2 + 8 * g4); acc = __builtin_amdgcn_mfma_f32_16x16x32_bf16(x, sf[k2], acc, 0, 0, 0); }
    f32x4 y;
#pragma unroll
    for (int r = 0; r < 4; ++r) y[r] = gelu_tanh(acc[r] + D4[r] * u4[r]);
    *(u32x2*)(P.ysb + (size_t)row * 512 + g * 16 + 4 * g4) = pack4(y);
  }
  __syncthreads();
}

__device__ __forceinline__ void headnorm_rows(const Params& P, int l, int bid, int G) {
  const int w = tidx() >> 6, lane = tidx() & 63;
  constexpr int R1 = 6400;
  const bool split = (G == 256);
  const int rbeg = split ? (bid < 128 ? bid * 8 + w : R1 + (bid - 128) * 8 + w) : bid * 8 + w;
  const int rend = split ? (bid < 128 ? R1 : NT) : NT, rstep = split ? 128 * 8 : G * 8;
  f32x4 gh[4];
#pragma unroll
  for (int h = 0; h < 4; ++h) gh[h] = *(const f32x4*)(P.g_hn + l * 1024 + h * 256 + 4 * lane);
  for (int row = rbeg; row < rend; row += 2 * rstep) {
    const int row2 = row + rstep; const bool has2 = row2 < rend; const int r2 = has2 ? row2 : row;
    if (lane == 0) { P.ssA[row] = 0ull; P.ssB[row] = 0ull; if (has2) { P.ssA[row2] = 0ull; P.ssB[row2] = 0ull; } }
    f32x4 s0[2][4], s1[2][4]; u32x2 hv[2][4], so[2][4];
#pragma unroll
    for (int k = 0; k < 2; ++k) { const int r = k ? r2 : row;
#pragma unroll
      for (int h = 0; h < 4; ++h) {
        s0[k][h] = *(const f32x4*)(P.hss + (size_t)r * 32 + h * 8); s1[k][h] = *(const f32x4*)(P.hss + (size_t)r * 32 + h * 8 + 4);
        hv[k][h] = *(const u32x2*)(P.hA + (size_t)r * DM + h * 256 + 4 * lane); so[k][h] = *(const u32x2*)(P.Pb + (size_t)r * NG1 + 3072 + h * 256 + 4 * lane);
      } }
#pragma unroll
    for (int k = 0; k < 2; ++k) { const int r = k ? r2 : row;
      if (k == 0 || has2) {
#pragma unroll
        for (int h = 0; h < 4; ++h) {
          const float ss = (s0[k][h][0] + s0[k][h][1]) + (s0[k][h][2] + s0[k][h][3]) + (s1[k][h][0] + s1[k][h][1]) + (s1[k][h][2] + s1[k][h][3]);
          const float rh = rsqrtf(ss * (1.0f / 256.0f) + 1e-6f);
          *(u32x2*)(P.xa + (size_t)r * DM + h * 256 + 4 * lane) = pack4(unpack4(so[k][h]) * unpack4(hv[k][h]) * gh[h] * rh);
        }
      } }
  }
}
__device__ __forceinline__ void final_rows(const Params& P, int bid, int G) {
  const int w = tidx() >> 6, lane = tidx() & 63;
  f32x4 gf[4];
#pragma unroll
  for (int i = 0; i < 4; ++i) gf[i] = *(const f32x4*)(P.g_final + 256 * i + 4 * lane);
  for (int row = bid * 8 + w; row < NT; row += 2 * G * 8) {
    const int row2 = row + G * 8; const bool has2 = row2 < NT;
    const int r2 = has2 ? row2 : row;
    const u64 q1 = P.ssA[row], q2 = P.ssA[r2];
    f32x4 v1[4], v2[4];
#pragma unroll
    for (int i = 0; i < 4; ++i) { v1[i] = *(const f32x4*)(P.X2 + (size_t)row * DM + 256 * i + 4 * lane); v2[i] = *(const f32x4*)(P.X2 + (size_t)r2 * DM + 256 * i + 4 * lane); }
    const float rs1 = rs_of(q1), rs2 = rs_of(q2);
    float* o1 = row < NP ? P.out + O_YP + (size_t)row * DM : P.out + O_YS + (size_t)(row - NP) * DM;
    float* o2 = r2 < NP ? P.out + O_YP + (size_t)r2 * DM : P.out + O_YS + (size_t)(r2 - NP) * DM;
#pragma unroll
    for (int i = 0; i < 4; ++i) *(f32x4*)(o1 + 256 * i + 4 * lane) = v1[i] * gf[i] * rs1;
    if (has2) {
#pragma unroll
      for (int i = 0; i < 4; ++i) *(f32x4*)(o2 + 256 * i + 4 * lane) = v2[i] * gf[i] * rs2;
    }
  }
}


#define XB_TMO      128
#define XB_XCNT(j)  (256  + 64 * (j))
#define XB_XSUB(j)  (1280 + 64 * (j))
#define XB_XGEN(j)  (2304 + 64 * (j))
#define XB_TOP      3328
#define XB_TOPGEN   3392
#define XCD_BAR_WORDS 3456
#define XB_SPIN_CAP (1u << 22)
__device__ __forceinline__ unsigned xb_ld(unsigned* p)              { return __hip_atomic_load(p, __ATOMIC_RELAXED, __HIP_MEMORY_SCOPE_AGENT); }
__device__ __forceinline__ unsigned xb_add(unsigned* p, unsigned v) { return __hip_atomic_fetch_add(p, v, __ATOMIC_RELAXED, __HIP_MEMORY_SCOPE_AGENT); }
__device__ __forceinline__ unsigned xb_xcc_id() { return (unsigned)__builtin_amdgcn_s_getreg((3 << 11) | 20) & 0xFu; }
#define XB_SPIN(cond, bar) do { unsigned _sp = 0; while (cond) { __builtin_amdgcn_s_sleep(1); \
    if ((++_sp & 255u) == 0u) { if (xb_ld(&(bar)[XB_TMO])) break; if (_sp > XB_SPIN_CAP) { atomicAdd(&(bar)[XB_TMO], 1u); break; } } } } while (0)
struct XcdBarrier { unsigned* bar; unsigned x; volatile LAS unsigned* st; };
__device__ __forceinline__ XcdBarrier xcd_barrier_post(unsigned* bar, volatile LAS unsigned* st) {
  XcdBarrier b; b.bar = bar; b.x = xb_xcc_id(); b.st = st;
  if (threadIdx.x == 0) (void)xb_add(&bar[XB_XCNT(b.x)], 1u);
  return b;
}
__device__ __forceinline__ void xcd_barrier_complete(unsigned* bar, unsigned x, unsigned& nloc, unsigned& nx) {
  const unsigned G = gridDim.x * gridDim.y * gridDim.z;
  unsigned sum, cnt, mine, sp = 0u;
  for (;;) {
    sum = 0u; cnt = 0u; mine = 0u;
#pragma unroll
    for (unsigned j = 0; j < 16; ++j) { const unsigned c = xb_ld(&bar[XB_XCNT(j)]); sum += c; cnt += (c > 0u) ? 1u : 0u; mine = (j == x) ? c : mine; }
    if (sum == G) break;
    __builtin_amdgcn_s_sleep(1);
    if ((++sp & 255u) == 0u) { if (xb_ld(&bar[XB_TMO])) break; if (sp > XB_SPIN_CAP) { atomicAdd(&bar[XB_TMO], 1u); break; } }
  }
  nloc = mine > 0u ? mine : 1u; nx = cnt > 0u ? cnt : 1u;
}
__device__ __forceinline__ void xcd_barrier(const XcdBarrier& b) {
  asm volatile("s_waitcnt vmcnt(0)" ::: "memory");
  __syncthreads();
  if (threadIdx.x == 0) {
    unsigned* bar = b.bar;
    __builtin_amdgcn_s_waitcnt(0);
    unsigned nloc = b.st[0], nx = b.st[1];
    if (nloc == 0u) { xcd_barrier_complete(bar, b.x, nloc, nx); b.st[0] = nloc; b.st[1] = nx; }
    const unsigned old = xb_add(&bar[XB_XSUB(b.x)], 1u);
    const unsigned gen = old / nloc;
    if (old + 1u == (gen + 1u) * nloc) {
      __builtin_amdgcn_fence(__ATOMIC_RELEASE, "agent");
      asm volatile("s_waitcnt vmcnt(0)" ::: "memory");
      const unsigned og = xb_add(&bar[XB_TOP], 1u);
      const unsigned tg = og / nx;
      if (og + 1u == (tg + 1u) * nx) xb_add(&bar[XB_TOPGEN], 1u);
      else XB_SPIN(xb_ld(&bar[XB_TOPGEN]) == tg, bar);
      __builtin_amdgcn_fence(__ATOMIC_ACQUIRE, "agent");
      xb_add(&bar[XB_XGEN(b.x)], 1u);
      asm volatile("s_waitcnt vmcnt(0)" ::: "memory");
    } else {
      XB_SPIN(xb_ld(&bar[XB_XGEN(b.x)]) == gen, bar);
      __builtin_amdgcn_fence(__ATOMIC_ACQUIRE, "agent");
      asm volatile("s_waitcnt vmcnt(0)" ::: "memory");
    }
  }
  __syncthreads();
}

__global__ void __launch_bounds__(512) mega(const Params P) {
  extern __shared__ __attribute__((aligned(16))) unsigned char shm[];
  cg::grid_group grid = cg::this_grid();
  LAS unsigned char* lds = (LAS unsigned char*)shm;
  const int bid = blockIdx.x, G = gridDim.x;

  volatile LAS unsigned* xst = (volatile LAS unsigned*)(lds + LDS_BYTES - 16);
  if (threadIdx.x == 0) { xst[0] = 0u; xst[1] = 0u; }
  if (bid == 0) for (int i = threadIdx.x; i < XCD_BAR_WORDS; i += 512) P.bar[i] = 0u;
  REP(1) prep_phase(P, shm, bid, G);
  grid.sync();
  const XcdBarrier xb = xcd_barrier_post(P.bar, xst);

  for (int l = 0; l < 2; ++l) {
    REP(2) {
      F1 f; f.bias = P.b_in + l * PTOT; f.Pb = P.Pb; f.rs = P.ssA; f.ss = nullptr;
      gemm_main_window(lds, P.xb, P.WinT[l], 4096, 1024, f, 0, bid, G);
      gemm_main_window(lds, P.xb, P.WinT[l] + (size_t)4608 * 1024, 2048, 1024, f, 4608, bid, G);
      skinny_run<F1, 2>(f, P.xb, 1024, P.WinT[l], NP, 1, NG1 / 16, bid, G, shm, 0);
      Fg fg; fg.bias = P.b_in + l * PTOT + 4096; fg.gat = P.gat; fg.rs = P.ssA; fg.ss = nullptr;
      REP(256) skinny_run(fg, P.xb, 1024, P.WgT[l], 0, 129, 1, bid, G, shm, 0);
    }
    xcd_barrier(xb);
    { F1 f; f.bias = P.b_in + l * PTOT; f.Pb = P.Pb; f.rs = P.ssA; f.ss = nullptr;
      gemm_main_window(lds, P.xb, P.WinT[l] + (size_t)4096 * 1024, 512, 1024, f, 4096, bid, G); }
    {
      const int n1 = G == 256 ? (bid < 128 ? 1 : 3) : (512 - bid + G - 1) / G;
      for (int j = 0; j < n1; ++j) m1_item(P, G == 256 ? (bid < 128 ? bid : 128 + (bid - 128) * 3 + j) : bid + j * G, shm);
      for (int it = bid; it < 512; it += G) msample_item(P, l, it, shm);
      for (int it = bid; it < 256; it += G) s5_sample_item(P, l, it, shm);
    }
    xcd_barrier(xb);
    REP(8) for (int it = bid; it < 256; it += G) m2_item(P, l, G == 256 ? (((it & 7) * 4 + (it >> 6)) * 8 + ((it >> 3) & 7)) : it, shm);
    REP(16) for (int it = bid; it < 256; it += G) s5_stage3_item(P, l, G == 256 ? ((it & 7) * 32 + (it >> 3)) : it, shm);
    xcd_barrier(xb);
    REP(32) {
      Fglu f; f.bias = P.b_glu + l * 512; f.ysb = P.ysb; f.ys2 = P.ys2; f.ss = nullptr;
      gemm_all(lds, shm, P.ysb, P.WgluT[l], 512, 512, f, bid, G);
      headnorm_rows(P, l, bid, G);
    }
    xcd_barrier(xb);
    REP(32) {
      Fa fa; fa.Pb = P.Pb; fa.t1 = P.t1; fa.ss = nullptr;
      gemm_all(lds, shm, P.xa, P.WaT[l], 1024, 1024, fa, bid, G);
      Fb fb; fb.Pb = P.Pb; fb.t1 = P.t1; fb.mg = P.mg; fb.ss = nullptr;
      gemm_all(lds, shm, P.ys2, P.WbT[l], 1024, 512, fb, bid, G);
    }
    xcd_barrier(xb);
    REP(32) {
      Fres f; f.xinP = l == 0 ? P.x_prompt : P.X2; f.xinS = l == 0 ? P.x_sample : P.X2 + (size_t)NP * DM; f.xo = P.X1; f.xb = P.xb; f.ss = P.ssB;
      gemm_all(lds, shm, P.mg, P.WoT[l], 1024, 1024, f, bid, G);
    }
    xcd_barrier(xb);
    REP(64) {
      F13 f; f.rs = P.ssB; f.act = P.act;
      pg8::Gemm g; g.A = P.xb; g.Bt = P.W13T[l]; g.M = NP; g.N = 2 * DFF; g.K = 1024;
      pg8::StaticOrder S; S.init(NP, 2 * DFF, G, bid);
      EpiMain13 E; E.f = f;
      REP(512) pg8::gemm_phase(lds, g, S, E);
      REP(256) skinny_run13(f, P.xb, P.W13T[l], bid, G, shm);
    }
    xcd_barrier(xb);
    REP(64) {
      Fres f; f.xinP = P.X1; f.xinS = P.X1 + (size_t)NP * DM; f.xo = P.X2; f.xb = P.xb; f.ss = P.ssA;
      gemm_all(lds, shm, P.act, P.W2T[l], 1024, DFF, f, bid, G);
    }
    xcd_barrier(xb);
  }
  final_rows(P, bid, G);
}

extern "C" void kernel_launch(void* const* d_in, const int* in_sizes, int n_in, void* d_out, int out_size, void* d_ws, size_t ws_size, hipStream_t stream) {
  constexpr size_t kDynLds = LDS_BYTES;
  static int grid_blocks = 0;
  if (!grid_blocks) {
    int dev = 0, cus = 0, per_cu = 0;
    (void)hipGetDevice(&dev);
    (void)hipDeviceGetAttribute(&cus, hipDeviceAttributeMultiprocessorCount, dev);
    (void)hipFuncSetAttribute((const void*)mega, hipFuncAttributeMaxDynamicSharedMemorySize, (int)kDynLds);
    (void)hipOccupancyMaxActiveBlocksPerMultiprocessor(&per_cu, mega, 512, kDynLds);
    if (per_cu > 1) per_cu = 1;
    grid_blocks = cus * per_cu;
    if (grid_blocks > 256) grid_blocks = 256;
  }
  Params p;
  memset(&p, 0, sizeof(p));
  const float* const* in = (const float* const*)d_in;
  p.x_prompt = in[0]; p.x_sample = in[1]; p.st_C = in[2]; p.st_n = in[3]; p.st_m = in[4]; p.st_sre = in[5]; p.st_sim = in[6];
  p.g_mix = in[7]; p.w_in = in[8]; p.b_in = in[9]; p.g_hn = in[10]; p.w_a = in[11]; p.A_re = in[12]; p.A_im = in[13]; p.log_dt = in[14];
  p.B_re = in[15]; p.B_im = in[16]; p.C_re = in[17]; p.C_im = in[18]; p.D_skip = in[19]; p.w_glu = in[20]; p.b_glu = in[21]; p.w_b = in[22]; p.w_out = in[23];
  p.g_ffn = in[24]; p.w_ff1 = in[25]; p.w_ff3 = in[26]; p.w_ff2 = in[27]; p.g_final = in[28];
  p.out = (float*)d_out;
  char* base = (char*)d_ws; size_t off = 0;
  auto alloc = [&](size_t bytes) { char* r = base + off; off += (bytes + 255) & ~(size_t)255; return r; };
  for (int l = 0; l < 2; ++l) {
    p.WinT[l] = (bf16_t*)alloc((size_t)NG1 * 1024 * 2); p.WgT[l] = (bf16_t*)alloc(16 * 1024 * 2); p.WgluT[l] = (bf16_t*)alloc(512 * 512 * 2);
    p.WaT[l] = (bf16_t*)alloc(1024 * 1024 * 2); p.WbT[l] = (bf16_t*)alloc(1024 * 512 * 2); p.WoT[l] = (bf16_t*)alloc(1024 * 1024 * 2);
    p.W13T[l] = (bf16_t*)alloc((size_t)2 * DFF * 1024 * 2); p.W2T[l] = (bf16_t*)alloc((size_t)1024 * DFF * 2);
    p.abar[l] = (float*)alloc(4096 * 4); p.bbar[l] = (float*)alloc(65536 * 4);
  }
  p.xb = (bf16_t*)alloc((size_t)NT * DM * 2); p.Pb = (bf16_t*)alloc((size_t)NT * NG1 * 2); p.St = (bf16_t*)alloc((size_t)512 * 16384 * 2);
  p.ysb = (bf16_t*)alloc((size_t)NT * 512 * 2); p.ys2 = (bf16_t*)alloc((size_t)NT * 512 * 2); p.xa = (bf16_t*)alloc((size_t)NT * DM * 2);
  p.mg = (bf16_t*)alloc((size_t)NT * DM * 2); p.act = (bf16_t*)alloc((size_t)NT * DFF * 2);
  p.X1 = (float*)alloc((size_t)NT * DM * 4); p.X2 = (float*)alloc((size_t)NT * DM * 4);
  p.ssA = (unsigned long long*)alloc((size_t)NT * 8); p.ssB = (unsigned long long*)alloc((size_t)NT * 8); p.bar = (unsigned*)alloc(XCD_BAR_WORDS * 4);
  for (int l = 0; l < 2; ++l) { p.Kt[l] = (bf16_t*)alloc(32 * 17 * 256 * 2); p.Gm[l] = (bf16_t*)alloc(32 * 32768 * 2); p.Hm[l] = (bf16_t*)alloc(32 * 32768 * 2); p.a16[l] = (float*)alloc(4096 * 4); }
  p.E2 = (float*)alloc((size_t)8 * 128 * 32 * 128 * 4);
  p.gat = (float*)alloc((size_t)NT * 8 * 4); p.hA = (bf16_t*)alloc((size_t)NT * DM * 2); p.hss = (float*)alloc((size_t)NT * 32 * 4);
  p.t1 = (bf16_t*)alloc((size_t)NT * DM * 2); p.Eend = (float*)alloc((size_t)2 * 524288 * 4);
  int nj = 0, tile0 = 0;
  auto job = [&](const float* src, const float* scale, bf16_t* dst, int ldn, int c0, int ncols, int K, int mode, int r0, int nwrite) {
    TJob& J = p.jobs[nj++]; J.src = src; J.scale = scale; J.dst = dst; J.ldn = ldn; J.c0 = c0; J.ncols = ncols; J.K = K; J.mode = mode; J.r0 = r0;
    J.tile0 = tile0; J.ntn = (ncols + 63) / 64; J.nwrite = nwrite; J.pad = 0; tile0 += J.ntn * (K / 64);
  };
  for (int l = 0; l < 2; ++l) {
    const float* win = p.w_in + (size_t)l * 1024 * PTOT; const float* gm = p.g_mix + l * 1024; const float* gf = p.g_ffn + l * 1024;
    job(win, gm, p.WinT[l], PTOT, 0, 4096, 1024, 0, 0, 4096);
    job(win, gm, p.WinT[l], PTOT, 4104, 512, 1024, 0, 4096, 512);
    job(win, gm, p.WinT[l], PTOT, 4616, 2048, 1024, 0, 4608, 2048);
    job(win, gm, p.WgT[l], PTOT, 4096, 8, 1024, 0, 0, 16);
    job(p.w_glu + (size_t)l * 512 * 512, nullptr, p.WgluT[l], 512, 0, 512, 512, 0, 0, 512);
    job(p.w_a + (size_t)l * 1024 * 1024, nullptr, p.WaT[l], 1024, 0, 1024, 1024, 0, 0, 1024);
    job(p.w_b + (size_t)l * 512 * 1024, nullptr, p.WbT[l], 1024, 0, 1024, 512, 0, 0, 1024);
    job(p.w_out + (size_t)l * 1024 * 1024, nullptr, p.WoT[l], 1024, 0, 1024, 1024, 0, 0, 1024);
    job(p.w_ff1 + (size_t)l * 1024 * DFF, gf, p.W13T[l], DFF, 0, DFF, 1024, 1, 0, DFF);
    job(p.w_ff3 + (size_t)l * 1024 * DFF, gf, p.W13T[l], DFF, 0, DFF, 1024, 2, 0, DFF);
    job(p.w_ff2 + (size_t)l * DFF * 1024, nullptr, p.W2T[l], 1024, 0, 1024, DFF, 0, 0, 1024);
  }
  p.njobs = nj; p.total_tiles = tile0;
  void* args[] = {&p};
  hipError_t e = hipLaunchCooperativeKernel((void*)mega, dim3(grid_blocks), dim3(512), args, kDynLds, stream);
  if (e != hipSuccess) fprintf(stderr, "cooperative launch failed: %s (grid %d)\n", hipGetErrorString(e), grid_blocks);
}
```

```cpp
#include <hip/hip_runtime.h>
#include <hip/hip_cooperative_groups.h>
#include <cstdio>
#include <cstring>
namespace cg = cooperative_groups;

#define LAS __attribute__((address_space(3)))
typedef unsigned short bf16_t;
typedef short bf16x8 __attribute__((ext_vector_type(8)));
typedef short bf16x4 __attribute__((ext_vector_type(4)));
typedef float f32x4 __attribute__((ext_vector_type(4)));
typedef unsigned u32x4 __attribute__((ext_vector_type(4)));
typedef unsigned u32x2 __attribute__((ext_vector_type(2)));

constexpr int NP = 16384, NS = 128, NT = 16512, DM = 1024, NG1 = 6656, DFF = 2816, PTOT = 6664;
constexpr int LDS_BYTES = 150 * 1024;
#ifndef DUPMASK
#define DUPMASK 0
#endif
#define REP(bit) for (int rep_ = 0; rep_ < ((DUPMASK & (bit)) ? 2 : 1); ++rep_)
constexpr size_t O_YP = 0, O_YS = 16777216, O_CP = 16908288, O_NP = 21102592, O_MP = 21118976, O_SRP = 21119040, O_SIP = 21151808,
                 O_CS = 21184576, O_NS = 88293440, O_MS = 88555584, O_SRS = 88556608, O_SIS = 89080896;

struct TJob { const float* src; const float* scale; bf16_t* dst; int ldn, c0, ncols, K, mode, r0, tile0, ntn, nwrite, pad; };

struct Params {
  const float *x_prompt, *x_sample, *st_C, *st_n, *st_m, *st_sre, *st_sim;
  const float *g_mix, *w_in, *b_in, *g_hn, *w_a, *A_re, *A_im, *log_dt, *B_re, *B_im, *C_re, *C_im, *D_skip, *w_glu, *b_glu, *w_b, *w_out,
      *g_ffn, *w_ff1, *w_ff3, *w_ff2, *g_final;
  float* out;
  bf16_t *WinT[2], *WgT[2], *WgluT[2], *WaT[2], *WbT[2], *WoT[2], *W13T[2], *W2T[2];
  float *abar[2], *bbar[2];
  bf16_t *xb, *Pb, *St, *ysb, *ys2, *xa, *mg, *act;
  float *X1, *X2, *gat, *hss, *Eend; bf16_t *hA, *t1;
  unsigned long long *ssA, *ssB;
  unsigned* bar;
  bf16_t *Kt[2], *Gm[2], *Hm[2]; float *a16[2], *E2;
  TJob jobs[22];
  int njobs, total_tiles;
};

__device__ __forceinline__ bf16_t f2bf(float f) { return __builtin_bit_cast(bf16_t, (__bf16)f); }
__device__ __forceinline__ float bf2f(unsigned b) { return __uint_as_float(b << 16); }
typedef float f32x2 __attribute__((ext_vector_type(2)));
typedef __bf16 bf16x2v __attribute__((ext_vector_type(2)));
__device__ __forceinline__ unsigned pack2(float lo, float hi) { const f32x2 v = {lo, hi}; const bf16x2v b = __builtin_convertvector(v, bf16x2v); return __builtin_bit_cast(unsigned, b); }
__device__ __forceinline__ u32x2 pack4(f32x4 v) { u32x2 r; r.x = pack2(v[0], v[1]); r.y = pack2(v[2], v[3]); return r; }
__device__ __forceinline__ f32x4 unpack4(u32x2 u) { f32x4 r; r[0] = bf2f(u.x & 0xffffu); r[1] = bf2f(u.x >> 16); r[2] = bf2f(u.y & 0xffffu); r[3] = bf2f(u.y >> 16); return r; }
__device__ __forceinline__ float sigmoidf_(float x) { return __builtin_amdgcn_rcpf(1.0f + __expf(-x)); }
__device__ __forceinline__ float gelu_tanh(float x) { float z = 0.7978845608f * (x + 0.044715f * x * x * x); float e = __expf(2.0f * z); float th = 1.0f - 2.0f * __builtin_amdgcn_rcpf(e + 1.0f); return 0.5f * x * (1.0f + th); }
__device__ __forceinline__ int tidx() { int t = threadIdx.x; asm volatile("" : "+v"(t)); return t; }
#define LDS_BARRIER() do { asm volatile("s_waitcnt lgkmcnt(0)" ::: "memory"); __builtin_amdgcn_s_barrier(); asm volatile("" ::: "memory"); } while (0)
__device__ __forceinline__ float wave_sum(float v) { for (int o = 32; o > 0; o >>= 1) v += __shfl_xor(v, o); return v; }

namespace pg8 {
constexpr int BM = 256, BK = 64, HALF = 128, HTB = HALF * BK * 2, STAGE_BYTES = 8 * HTB, NXCD = 8, WGM = 8;
__host__ __device__ __forceinline__ int lds_byte(int r, int c) { const int st = (r >> 4) * 2 + (c >> 5), rr = r & 15, cc = c & 31, ob = rr * 64 + cc * 2; return st * 1024 + (ob ^ (((ob >> 9) & 1) << 5)); }
__host__ __device__ __forceinline__ void stage_rc(int b, int& R, int& C) { const int st = b / 1024, sb = b % 1024, swz = sb ^ (((sb >> 9) & 1) << 5); R = (st >> 1) * 16 + swz / 64; C = (st & 1) * 32 + (swz % 64) / 2; }
__host__ __device__ __forceinline__ int perm32(int rho) { const int n = rho >> 4, i = rho & 15; return 8 * (i >> 2) + 4 * n + (i & 3); }
struct Unit { int pm, pn; };
struct Gemm { const bf16_t* A; const bf16_t* Bt; int M, N, K; };
struct StaticOrder {
  int nM, nN, nwg, G, c;
  __device__ void init(int M, int N, int G_, int c_) { nM = M / BM; nN = N / BM; nwg = nM * nN; G = G_; c = c_; }
  __device__ bool next(int i, Unit& u) const {
    const long L = (long)i * G + c; if (L >= nwg) return false;
    int wgid = (int)L; { const int q = nwg / NXCD, r = nwg % NXCD, xcd = wgid % NXCD, off = wgid / NXCD; wgid = (xcd < r ? xcd * (q + 1) : r * (q + 1) + (xcd - r) * q) + off; }
    const int nig = WGM * nN, gid = wgid / nig, fm = gid * WGM, gsz = (nM - fm) < WGM ? (nM - fm) : WGM;
    u.pm = fm + ((wgid % nig) % gsz); u.pn = (wgid % nig) / gsz; return true;
  }
};

template <class Epi, class Sched>
__device__ __forceinline__ void gemm_phase(LAS unsigned char* lds, const Gemm g, const Sched& S, const Epi& E) {
  const int tid = tidx(), wid = __builtin_amdgcn_readfirstlane(tid >> 6), lane = tid & 63, wr = wid >> 2, wc = wid & 3, fr = lane & 15, fq = lane >> 4;
  const int K = g.K, nt = K / BK;
  unsigned voffA[2], voffB[2];
#pragma unroll
  for (int i = 0; i < 2; ++i) { int R, C; stage_rc(tid * 16 + i * 8192, R, C); voffA[i] = (unsigned)(R * K + C) * 2u; const int Rb = Epi::PERM ? ((R & ~31) + perm32(R & 31)) : R; voffB[i] = (unsigned)(Rb * K + C) * 2u; }
  const size_t kstep = (size_t)(BK * 2);
  const size_t hstep = (size_t)HALF * K * 2;
  const size_t tstep = 2 * hstep;
  const unsigned ldsw = (unsigned)wid * 1024u;
  const int aoff = lds_byte(wr * 64 + fr, fq * 8), boff = lds_byte(wc * 32 + fr, fq * 8);
#define PG8_SA(b, h) (((b) * 2 + (h)) * HTB)
#define PG8_SB(b, h) ((4 + (b) * 2 + (h)) * HTB)
#define PG8_STAGE(bufoff, gbase, voff) do { _Pragma("unroll") for (int _i = 0; _i < 2; ++_i) \
    __builtin_amdgcn_global_load_lds((const unsigned*)((const char*)(gbase) + (voff)[_i]), (LAS unsigned*)(lds + (bufoff) + ldsw + _i * 8192), 16, 0, 0); } while (0)
#define PG8_LDA(dst, b, h) do { _Pragma("unroll") for (int m = 0; m < 4; ++m) _Pragma("unroll") for (int k = 0; k < 2; ++k) dst[m][k] = *(const LAS bf16x8*)(lds + PG8_SA(b, h) + aoff + m * 2048 + k * 1024); } while (0)
#define PG8_LDB(dst, b, h) do { _Pragma("unroll") for (int n = 0; n < 2; ++n) _Pragma("unroll") for (int k = 0; k < 2; ++k) dst[n][k] = *(const LAS bf16x8*)(lds + PG8_SB(b, h) + boff + n * 2048 + k * 1024); } while (0)
#define PG8_MMA(ai, bj, At, Bt) do { __builtin_amdgcn_s_setprio(1); _Pragma("unroll") for (int m = 0; m < 4; ++m) _Pragma("unroll") for (int n = 0; n < 2; ++n) _Pragma("unroll") for (int k = 0; k < 2; ++k) \
    acc[ai][bj][m][n] = __builtin_amdgcn_mfma_f32_16x16x32_bf16(Bt[n][k], At[m][k], acc[ai][bj][m][n], 0, 0, 0); __builtin_amdgcn_s_setprio(0); } while (0)
#define PG8_WAIT_V(n) asm volatile("s_waitcnt vmcnt(" #n ")" ::: "memory")
#define PG8_WAIT_L(n) asm volatile("s_waitcnt lgkmcnt(" #n ")" ::: "memory")
#define PG8_BAR __builtin_amdgcn_s_barrier()
#define PG8_SCHED __builtin_amdgcn_sched_barrier(0)
  Unit cur, nxt; int ui = 0;
  if (!S.next(0, cur)) return;
  f32x4 acc[2][2][4][2];
#pragma unroll
  for (int a = 0; a < 2; ++a)
#pragma unroll
    for (int b = 0; b < 2; ++b)
#pragma unroll
      for (int m = 0; m < 4; ++m)
#pragma unroll
        for (int n = 0; n < 2; ++n) acc[a][b][m][n] = (f32x4){0.f, 0.f, 0.f, 0.f};
  bf16x8 At[4][2], B0[2][2], B1[2][2];
  const char* cA = (const char*)g.A + (size_t)cur.pm * tstep; const char* cB = (const char*)g.Bt + (size_t)cur.pn * tstep;
  PG8_STAGE(PG8_SB(0, 0), cB, voffB); PG8_STAGE(PG8_SA(0, 0), cA, voffA); PG8_STAGE(PG8_SB(0, 1), cB + hstep, voffB); PG8_STAGE(PG8_SA(0, 1), cA + hstep, voffA);
  if (wr == 1) PG8_BAR;
  PG8_WAIT_V(4); PG8_BAR;
  PG8_STAGE(PG8_SB(1, 0), cB + kstep, voffB); PG8_STAGE(PG8_SA(1, 0), cA + kstep, voffA); PG8_STAGE(PG8_SB(1, 1), cB + hstep + kstep, voffB);
  PG8_WAIT_V(6); PG8_BAR;
  for (;;) {
    const bool has_next = S.next(ui + 1, nxt);
    const char* nA = has_next ? (const char*)g.A + (size_t)nxt.pm * tstep : cA; const char* nB = has_next ? (const char*)g.Bt + (size_t)nxt.pn * tstep : cB;
    for (int t = 0; t < nt; t += 2) {
      const bool last = (t == nt - 2);
      const char* a1 = cA + (size_t)(t + 1) * kstep;
      const char* a2 = last ? nA : cA + (size_t)(t + 2) * kstep; const char* b2 = last ? nB : cB + (size_t)(t + 2) * kstep;
      const char* a3 = a2 + kstep; const char* b3 = b2 + kstep;
      PG8_LDB(B0, 0, 0); PG8_SCHED; PG8_LDA(At, 0, 0); PG8_STAGE(PG8_SA(1, 1), a1 + hstep, voffA);
      PG8_WAIT_L(8); PG8_BAR; PG8_WAIT_L(0); PG8_MMA(0, 0, At, B0); PG8_BAR; PG8_SCHED;
      PG8_LDB(B1, 0, 1); PG8_STAGE(PG8_SB(0, 0), b2, voffB);
      PG8_BAR; PG8_WAIT_L(0); PG8_MMA(0, 1, At, B1); PG8_BAR;
      PG8_LDA(At, 0, 1); PG8_STAGE(PG8_SA(0, 0), a2, voffA);
      PG8_BAR; PG8_WAIT_L(0); PG8_MMA(1, 0, At, B0); PG8_BAR; PG8_SCHED;
      PG8_STAGE(PG8_SB(0, 1), b2 + hstep, voffB);
      PG8_WAIT_V(6); PG8_BAR; PG8_MMA(1, 1, At, B1); PG8_BAR;
      PG8_LDB(B0, 1, 0); PG8_SCHED; PG8_LDA(At, 1, 0); PG8_STAGE(PG8_SA(0, 1), a2 + hstep, voffA);
      PG8_WAIT_L(8); PG8_BAR; PG8_WAIT_L(0); PG8_MMA(0, 0, At, B0); PG8_BAR; PG8_SCHED;
      PG8_LDB(B1, 1, 1); PG8_STAGE(PG8_SB(1, 0), b3, voffB);
      PG8_BAR; PG8_WAIT_L(0); PG8_MMA(0, 1, At, B1); PG8_BAR;
      PG8_LDA(At, 1, 1); PG8_STAGE(PG8_SA(1, 0), a3, voffA);
      PG8_BAR; PG8_WAIT_L(0); PG8_MMA(1, 0, At, B0); PG8_BAR; PG8_SCHED;
      PG8_STAGE(PG8_SB(1, 1), b3 + hstep, voffB);
      PG8_WAIT_V(6); PG8_BAR; PG8_MMA(1, 1, At, B1); PG8_BAR;
    }
    E(acc, cur, wr, wc, fr, fq);
    if (!has_next) break;
#pragma unroll
    for (int a = 0; a < 2; ++a)
#pragma unroll
      for (int b = 0; b < 2; ++b)
#pragma unroll
        for (int m = 0; m < 4; ++m)
#pragma unroll
          for (int n = 0; n < 2; ++n) acc[a][b][m][n] = (f32x4){0.f, 0.f, 0.f, 0.f};
    cur = nxt; cA = nA; cB = nB; ++ui;
  }
  PG8_WAIT_V(0);
  if (wr == 0) PG8_BAR;
  PG8_BAR;
#undef PG8_SA
#undef PG8_SB
#undef PG8_STAGE
#undef PG8_LDA
#undef PG8_LDB
#undef PG8_MMA
#undef PG8_WAIT_V
#undef PG8_WAIT_L
#undef PG8_BAR
#undef PG8_SCHED
}
}

typedef unsigned long long u64;
__device__ __forceinline__ u64 ss_fix(float ss) { return (u64)(ss * 16777216.0f); }
__device__ __forceinline__ float rs_of(u64 q) { const float f = (float)(unsigned)(q >> 32) * 4294967296.0f + (float)(unsigned)q; return rsqrtf(f * (1.0f / (16777216.0f * 1024.0f)) + 1e-6f); }
__device__ __forceinline__ void ss_add(u64* p, float ss) { __hip_atomic_fetch_add(p, ss_fix(ss), __ATOMIC_RELAXED, __HIP_MEMORY_SCOPE_AGENT); }
__device__ __forceinline__ int qcol(int cbase, int q) { return cbase + (q >> 1) * 128 + (q & 1) * 16; }
__device__ __forceinline__ f32x4 unlo(u32x4 u) { return unpack4((u32x2){u[0], u[1]}); }
__device__ __forceinline__ f32x4 unhi(u32x4 u) { return unpack4((u32x2){u[2], u[3]}); }
__device__ __forceinline__ u32x4 pack8(f32x4 a, f32x4 b) { const u32x2 p = pack4(a), q = pack4(b); return (u32x4){p.x, p.y, q.x, q.y}; }
struct F1 {
  static constexpr bool NEEDR = true, STAT = false, PERM = true; static constexpr int RB = 8;
  const float* bias; bf16_t* Pb; const u64* rs; u64* ss;
  struct ColData { f32x4 b[4]; }; struct RowData { u64 s; };
  __device__ __forceinline__ void load_cols(int cbase, ColData& cd) const {
#pragma unroll
    for (int q = 0; q < 4; ++q) { const int col = cbase + (q >> 1) * 128 + (q & 1) * 4; cd.b[q] = *(const f32x4*)(bias + (col < 4096 ? col : col + 8)); } }
  __device__ __forceinline__ void load_row(int row, int, RowData& rd) const { rd.s = rs[row]; }
  __device__ __forceinline__ float apply(int row, int cbase, const f32x4 (&v)[4], const ColData& cd, const RowData& rd) const {
    const float r = rs_of(rd.s);
    const int blk = cbase >> 8;
    const bool isk = blk >= 4 && blk < 8, issig = (blk >= 12 && blk < 16) || blk >= 18;
#pragma unroll
    for (int bj = 0; bj < 2; ++bj) {
      u32x4 pk;
#pragma unroll
      for (int n = 0; n < 2; ++n) {
        f32x4 o = v[bj * 2 + n] * r + cd.b[bj * 2 + n];
        if (isk) o = o * 0.0625f;
        else if (issig) { o[0] = sigmoidf_(o[0]); o[1] = sigmoidf_(o[1]); o[2] = sigmoidf_(o[2]); o[3] = sigmoidf_(o[3]); }
        const u32x2 p2 = pack4(o); pk[2 * n] = p2.x; pk[2 * n + 1] = p2.y;
      }
      *(u32x4*)(Pb + (size_t)row * NG1 + cbase + bj * 128) = pk;
    }
    return 0.f;
  }
  __device__ __forceinline__ float rowscale(int row) const { return rs_of(rs[row]); }
  __device__ __forceinline__ float operator()(int row, int col, f32x4 v, float r) const {
    const int bi = col < 4096 ? col : col + 8;
    const f32x4 b4 = *(const f32x4*)(bias + bi);
    f32x4 o = v * r + b4;
    if (col >= 1024 && col < 2048) o = o * 0.0625f;
    else if ((col >= 3072 && col < 4096) || col >= 4608) { o[0] = sigmoidf_(o[0]); o[1] = sigmoidf_(o[1]); o[2] = sigmoidf_(o[2]); o[3] = sigmoidf_(o[3]); }
    *(u32x2*)(Pb + (size_t)row * NG1 + col) = pack4(o);
    return 0.f;
  }
};
struct Fg {
  static constexpr bool NEEDR = true, STAT = false;
  const float* bias; float* gat; const u64* rs; u64* ss;
  __device__ __forceinline__ float rowscale(int row) const { return rs_of(rs[row]); }
  __device__ __forceinline__ float operator()(int row, int col, f32x4 v, float r) const {
    if (col < 8) {
      const f32x4 b4 = *(const f32x4*)(bias + col);
      f32x4 o = v * r + b4;
      if (col >= 4) {
#pragma unroll
        for (int i = 0; i < 4; ++i) { const float x = o[i]; o[i] = fminf(x, 0.f) - log1pf(__expf(-fabsf(x))); }
      }
      *(f32x4*)(gat + (size_t)row * 8 + col) = o;
    }
    return 0.f;
  }
};
struct Fglu {
  static constexpr bool NEEDR = false, STAT = false, PERM = true; static constexpr int RB = 8;
  const float* bias; const bf16_t* ysb; bf16_t* ys2; u64* ss;
  struct ColData { f32x4 b[4]; }; struct RowData { u32x4 y[2]; };
  __device__ __forceinline__ void load_cols(int cbase, ColData& cd) const {
#pragma unroll
    for (int q = 0; q < 4; ++q) cd.b[q] = *(const f32x4*)(bias + cbase + (q >> 1) * 128 + (q & 1) * 4); }
  __device__ __forceinline__ void load_row(int row, int cbase, RowData& rd) const {
#pragma unroll
    for (int bj = 0; bj < 2; ++bj) rd.y[bj] = *(const u32x4*)(ysb + (size_t)row * 512 + cbase + bj * 128); }
  __device__ __forceinline__ float apply(int row, int cbase, const f32x4 (&v)[4], const ColData& cd, const RowData& rd) const {
#pragma unroll
    for (int bj = 0; bj < 2; ++bj) {
      const f32x4 y0 = unlo(rd.y[bj]), y1 = unhi(rd.y[bj]); f32x4 o0, o1;
#pragma unroll
      for (int i = 0; i < 4; ++i) { o0[i] = y0[i] * sigmoidf_(v[bj * 2][i] + cd.b[bj * 2][i]); o1[i] = y1[i] * sigmoidf_(v[bj * 2 + 1][i] + cd.b[bj * 2 + 1][i]); }
      *(u32x4*)(ys2 + (size_t)row * 512 + cbase + bj * 128) = pack8(o0, o1);
    }
    return 0.f;
  }
  struct Pre { f32x4 b; u32x2 y; };
  __device__ __forceinline__ Pre pre(int row, int col) const { Pre p; p.b = *(const f32x4*)(bias + col); p.y = *(const u32x2*)(ysb + (size_t)row * 512 + col); return p; }
  __device__ __forceinline__ float post(int row, int col, f32x4 v, const Pre& p) const {
    const f32x4 y = unpack4(p.y); f32x4 o;
#pragma unroll
    for (int i = 0; i < 4; ++i) o[i] = y[i] * sigmoidf_(v[i] + p.b[i]);
    *(u32x2*)(ys2 + (size_t)row * 512 + col) = pack4(o); return 0.f; }
  __device__ __forceinline__ float rowscale(int) const { return 1.f; }
  __device__ __forceinline__ float operator()(int row, int col, f32x4 v, float) const {
    const f32x4 b4 = *(const f32x4*)(bias + col);
    const f32x4 y = unpack4(*(const u32x2*)(ysb + (size_t)row * 512 + col));
    f32x4 o;
#pragma unroll
    for (int i = 0; i < 4; ++i) o[i] = y[i] * sigmoidf_(v[i] + b4[i]);
    *(u32x2*)(ys2 + (size_t)row * 512 + col) = pack4(o);
    return 0.f;
  }
};
struct Fa {
  static constexpr bool NEEDR = false, STAT = false, PERM = true; static constexpr int RB = 8;
  const bf16_t* Pb; bf16_t* t1; u64* ss;
  struct ColData { int dummy; }; struct RowData { u32x4 g[2]; };
  __device__ __forceinline__ void load_cols(int, ColData&) const {}
  __device__ __forceinline__ void load_row(int row, int cbase, RowData& rd) const {
#pragma unroll
    for (int bj = 0; bj < 2; ++bj) rd.g[bj] = *(const u32x4*)(Pb + (size_t)row * NG1 + 4608 + cbase + bj * 128); }
  __device__ __forceinline__ float apply(int row, int cbase, const f32x4 (&v)[4], const ColData&, const RowData& rd) const {
#pragma unroll
    for (int bj = 0; bj < 2; ++bj) *(u32x4*)(t1 + (size_t)row * DM + cbase + bj * 128) = pack8(unlo(rd.g[bj]) * v[bj * 2], unhi(rd.g[bj]) * v[bj * 2 + 1]);
    return 0.f;
  }
  struct Pre { u32x2 g; };
  __device__ __forceinline__ Pre pre(int row, int col) const { Pre p; p.g = *(const u32x2*)(Pb + (size_t)row * NG1 + 4608 + col); return p; }
  __device__ __forceinline__ float post(int row, int col, f32x4 v, const Pre& p) const { *(u32x2*)(t1 + (size_t)row * DM + col) = pack4(unpack4(p.g) * v); return 0.f; }
  __device__ __forceinline__ float rowscale(int) const { return 1.f; }
  __device__ __forceinline__ float operator()(int row, int col, f32x4 v, float) const {
    const f32x4 sg = unpack4(*(const u32x2*)(Pb + (size_t)row * NG1 + 4608 + col));
    *(u32x2*)(t1 + (size_t)row * DM + col) = pack4(sg * v);
    return 0.f;
  }
};
struct Fb {
  static constexpr bool NEEDR = false, STAT = false, PERM = true; static constexpr int RB = 4;
  const bf16_t* Pb; const bf16_t* t1; bf16_t* mg; u64* ss;
  struct ColData { int dummy; }; struct RowData { u32x4 g[2]; u32x4 t[2]; };
  __device__ __forceinline__ void load_cols(int, ColData&) const {}
  __device__ __forceinline__ void load_row(int row, int cbase, RowData& rd) const {
#pragma unroll
    for (int bj = 0; bj < 2; ++bj) { rd.g[bj] = *(const u32x4*)(Pb + (size_t)row * NG1 + 5632 + cbase + bj * 128); rd.t[bj] = *(const u32x4*)(t1 + (size_t)row * DM + cbase + bj * 128); } }
  __device__ __forceinline__ float apply(int row, int cbase, const f32x4 (&v)[4], const ColData&, const RowData& rd) const {
#pragma unroll
    for (int bj = 0; bj < 2; ++bj) *(u32x4*)(mg + (size_t)row * DM + cbase + bj * 128) = pack8(unlo(rd.t[bj]) + unlo(rd.g[bj]) * v[bj * 2], unhi(rd.t[bj]) + unhi(rd.g[bj]) * v[bj * 2 + 1]);
    return 0.f;
  }
  struct Pre { u32x2 g; u32x2 t; };
  __device__ __forceinline__ Pre pre(int row, int col) const { Pre p; p.g = *(const u32x2*)(Pb + (size_t)row * NG1 + 5632 + col); p.t = *(const u32x2*)(t1 + (size_t)row * DM + col); return p; }
  __device__ __forceinline__ float post(int row, int col, f32x4 v, const Pre& p) const { *(u32x2*)(mg + (size_t)row * DM + col) = pack4(unpack4(p.t) + unpack4(p.g) * v); return 0.f; }
  __device__ __forceinline__ float rowscale(int) const { return 1.f; }
  __device__ __forceinline__ float operator()(int row, int col, f32x4 v, float) const {
    const f32x4 sg = unpack4(*(const u32x2*)(Pb + (size_t)row * NG1 + 5632 + col));
    const f32x4 t = unpack4(*(const u32x2*)(t1 + (size_t)row * DM + col));
    *(u32x2*)(mg + (size_t)row * DM + col) = pack4(t + sg * v);
    return 0.f;
  }
};
struct Fres {
  static constexpr bool NEEDR = false, STAT = true, PERM = true; static constexpr int RB = 4;
  const float *xinP, *xinS; float* xo; bf16_t* xb; u64* ss;
  struct ColData { int dummy; }; struct RowData { f32x4 x[4]; };
  __device__ __forceinline__ void load_cols(int, ColData&) const {}
  __device__ __forceinline__ void load_row(int row, int cbase, RowData& rd) const {
#pragma unroll
    for (int q = 0; q < 4; ++q) rd.x[q] = *(const f32x4*)(xinP + (size_t)row * DM + cbase + (q >> 1) * 128 + (q & 1) * 4); }
  __device__ __forceinline__ float apply(int row, int cbase, const f32x4 (&v)[4], const ColData&, const RowData& rd) const {
    float s = 0.f;
#pragma unroll
    for (int bj = 0; bj < 2; ++bj) {
      const f32x4 o0 = rd.x[bj * 2] + v[bj * 2], o1 = rd.x[bj * 2 + 1] + v[bj * 2 + 1];
      float* xp = xo + (size_t)row * DM + cbase + bj * 128;
      *(f32x4*)xp = o0; *(f32x4*)(xp + 4) = o1;
      const u32x2 p0 = pack4(o0), p1 = pack4(o1);
      *(u32x4*)(xb + (size_t)row * DM + cbase + bj * 128) = (u32x4){p0.x, p0.y, p1.x, p1.y};
      s += (o0[0] * o0[0] + o0[1] * o0[1]) + (o0[2] * o0[2] + o0[3] * o0[3]) + (o1[0] * o1[0] + o1[1] * o1[1]) + (o1[2] * o1[2] + o1[3] * o1[3]);
    }
    return s;
  }
  struct Pre { f32x4 x; };
  __device__ __forceinline__ Pre pre(int row, int col) const { Pre p; const float* xi = row < NP ? xinP + (size_t)row * DM : xinS + (size_t)(row - NP) * DM; p.x = *(const f32x4*)(xi + col); return p; }
  __device__ __forceinline__ float post(int row, int col, f32x4 v, const Pre& p) const {
    const f32x4 o = p.x + v;
    *(f32x4*)(xo + (size_t)row * DM + col) = o; *(u32x2*)(xb + (size_t)row * DM + col) = pack4(o);
    return (o[0] * o[0] + o[1] * o[1]) + (o[2] * o[2] + o[3] * o[3]); }
  __device__ __forceinline__ float rowscale(int) const { return 1.f; }
  __device__ __forceinline__ float operator()(int row, int col, f32x4 v, float) const {
    const float* xi = row < NP ? xinP + (size_t)row * DM : xinS + (size_t)(row - NP) * DM;
    const f32x4 o = *(const f32x4*)(xi + col) + v;
    *(f32x4*)(xo + (size_t)row * DM + col) = o;
    *(u32x2*)(xb + (size_t)row * DM + col) = pack4(o);
    return (o[0] * o[0] + o[1] * o[1]) + (o[2] * o[2] + o[3] * o[3]);
  }
};
struct F13 {
  const u64* rs; bf16_t* act;
  __device__ __forceinline__ float rowscale(int row) const { return rs_of(rs[row]); }
  __device__ __forceinline__ f32x4 glu(f32x4 a1, f32x4 a3, float r) const {
    f32x4 o;
#pragma unroll
    for (int i = 0; i < 4; ++i) { const float x1 = a1[i] * r, x3 = a3[i] * r; o[i] = x1 * sigmoidf_(x1) * x3; }
    return o;
  }
  __device__ __forceinline__ void pair(int row, int j, f32x4 a1, f32x4 a3, float r) const { *(u32x2*)(act + (size_t)row * DFF + j) = pack4(glu(a1, a3, r)); }
};

template <class F> struct EpiMain {
  static constexpr bool PERM = F::PERM;
  F f; int coff;
  __device__ __forceinline__ void operator()(const f32x4 (&acc)[2][2][4][2], const pg8::Unit& u, int wr, int wc, int fr, int fq) const {
    const int rbase = u.pm * 256 + wr * 64 + fr, cbase = coff + u.pn * 256 + wc * 32 + (F::PERM ? 8 : 4) * fq;
    typename F::ColData cd; f.load_cols(cbase, cd);
#pragma unroll
    for (int b0 = 0; b0 < 8; b0 += F::RB) {
      typename F::RowData rd[F::RB];
#pragma unroll
      for (int k = 0; k < F::RB; ++k) { const int i = b0 + k; f.load_row(rbase + (i >> 2) * 128 + (i & 3) * 16, cbase, rd[k]); }
      __builtin_amdgcn_sched_barrier(0);
#pragma unroll
      for (int k = 0; k < F::RB; ++k) {
        const int i = b0 + k, ai = i >> 2, m = i & 3, row = rbase + ai * 128 + m * 16;
        const f32x4 v[4] = {acc[ai][0][m][0], acc[ai][0][m][1], acc[ai][1][m][0], acc[ai][1][m][1]};
        float s = f.apply(row, cbase, v, cd, rd[k]);
        if (F::STAT) { s += __shfl_xor(s, 16); s += __shfl_xor(s, 32); if (fq == 0) ss_add(f.ss + row, s); }
      }
      __builtin_amdgcn_sched_barrier(0);
    }
  }
};
struct EpiMain13 {
  static constexpr bool PERM = true;
  F13 f;
  __device__ __forceinline__ void operator()(const f32x4 (&acc)[2][2][4][2], const pg8::Unit& u, int wr, int wc, int fr, int fq) const {
    const int rbase = u.pm * 256 + wr * 64 + fr, jbase = u.pn * 128 + wc * 32 + 8 * fq;
    u64 sq[8];
#pragma unroll
    for (int i = 0; i < 8; ++i) sq[i] = f.rs[rbase + (i >> 2) * 128 + (i & 3) * 16];
    __builtin_amdgcn_sched_barrier(0);
#pragma unroll
    for (int i = 0; i < 8; ++i) {
      const int ai = i >> 2, m = i & 3, row = rbase + ai * 128 + m * 16;
      const float r = rs_of(sq[i]);
      *(u32x4*)(f.act + (size_t)row * DFF + jbase) = pack8(f.glu(acc[ai][0][m][0], acc[ai][1][m][0], r), f.glu(acc[ai][0][m][1], acc[ai][1][m][1], r));
    }
  }
};

template <int NACC>
__device__ __forceinline__ void skinny_unit(const bf16_t* A, int K, const bf16_t* Bt, int row0, int brow0, int bstep, float* red, f32x4 (&out)[NACC]) {
  const int tid = tidx(), w = tid >> 6, lane = tid & 63, g4 = lane >> 4, l15 = lane & 15;
  const int nks = K >> 8, kbase = w * (K >> 3) + 8 * g4;
  f32x4 acc[8][NACC];
#pragma unroll
  for (int rt = 0; rt < 8; ++rt)
#pragma unroll
    for (int i = 0; i < NACC; ++i) acc[rt][i] = (f32x4){0.f, 0.f, 0.f, 0.f};
  const bf16_t* ap = A + (size_t)(row0 + l15) * K + kbase;
  const bf16_t* bp = Bt + (size_t)(brow0 + l15) * K + kbase;
  for (int ks = 0; ks < nks; ks += 2) {
    const bool two = ks + 1 < nks;
    bf16x8 a0[8], a1[8], b0[NACC], b1[NACC];
#pragma unroll
    for (int rt = 0; rt < 8; ++rt) a0[rt] = *(const bf16x8*)(ap + (size_t)16 * rt * K + 32 * ks);
#pragma unroll
    for (int i = 0; i < NACC; ++i) b0[i] = *(const bf16x8*)(bp + (size_t)bstep * i * K + 32 * ks);
    if (two) {
#pragma unroll
      for (int rt = 0; rt < 8; ++rt) a1[rt] = *(const bf16x8*)(ap + (size_t)16 * rt * K + 32 * ks + 32);
#pragma unroll
      for (int i = 0; i < NACC; ++i) b1[i] = *(const bf16x8*)(bp + (size_t)bstep * i * K + 32 * ks + 32);
    }
#pragma unroll
    for (int rt = 0; rt < 8; ++rt)
#pragma unroll
      for (int i = 0; i < NACC; ++i) acc[rt][i] = __builtin_amdgcn_mfma_f32_16x16x32_bf16(b0[i], a0[rt], acc[rt][i], 0, 0, 0);
    if (two) {
#pragma unroll
      for (int rt = 0; rt < 8; ++rt)
#pragma unroll
        for (int i = 0; i < NACC; ++i) acc[rt][i] = __builtin_amdgcn_mfma_f32_16x16x32_bf16(b1[i], a1[rt], acc[rt][i], 0, 0, 0);
    }
  }
#pragma unroll
  for (int rt = 0; rt < 8; ++rt)
#pragma unroll
    for (int i = 0; i < NACC; ++i) *(f32x4*)(red + (size_t)(((w * 8 + rt) * NACC + i) * 64 + lane) * 4) = acc[rt][i];
  __syncthreads();
#pragma unroll
  for (int i = 0; i < NACC; ++i) {
    f32x4 t = (f32x4){0.f, 0.f, 0.f, 0.f};
#pragma unroll
    for (int ww = 0; ww < 8; ++ww) t += *(const f32x4*)(red + (size_t)(((ww * 8 + w) * NACC + i) * 64 + lane) * 4);
    out[i] = t;
  }
}
template <class F, int NA = 1>
__device__ __forceinline__ void skinny_run(const F& f, const bf16_t* A, int K, const bf16_t* Bt, int rowbase, int nrt, int ncu, int bid, int G, unsigned char* shm, int c0 = 0) {
  const int tid = tidx(), w = tid >> 6, lane = tid & 63, g = lane >> 4;
  const int ncu2 = ncu / NA, total = nrt * ncu2, nc = G - c0;
  if (bid < c0) return;
  for (int su = (G - 1 - bid); su < total; su += nc) {
    const int rt = su / ncu2, cu = su - rt * ncu2;
    const int row0 = rowbase + rt * 128, arow = row0 + 16 * w + (lane & 15);
    f32x4 acc[NA];
    const float rs = F::NEEDR ? f.rowscale(arow) : 1.f;
    skinny_unit<NA>(A, K, Bt, row0, 16 * NA * cu, 16, (float*)shm, acc);
#pragma unroll
    for (int i = 0; i < NA; ++i) {
      float ss = f(arow, 16 * (NA * cu + i) + 4 * g, acc[i], rs);
      if (F::STAT) { ss += __shfl_xor(ss, 16); ss += __shfl_xor(ss, 32); if (g == 0) ss_add(f.ss + arow, ss); }
    }
    __syncthreads();
  }
}
template <class F>
__device__ __forceinline__ void skinny_run_quarter(const F& f, const bf16_t* A, int K, const bf16_t* Bt, int ncu, int bid, int G, unsigned char* shm, int c0) {
  const int tid = tidx(), w = tid >> 6, lane = tid & 63, g4 = lane >> 4, l15 = lane & 15;
  const int total = 4 * ncu, nc = G - c0;
  if (bid < c0) return;
  float* red = (float*)shm;
  for (int su = (G - 1 - bid); su < total; su += nc) {
    const int cu = su >> 2, rq = su & 3, rt = w >> 2, kq = w & 3;
    const int arow = NP + 32 * rq + 16 * rt + l15;
    const int kspan = K >> 2, kbase = kq * kspan + 8 * g4;
    const bf16_t* ap = A + (size_t)arow * K + kbase;
    const bf16_t* bp = Bt + (size_t)(16 * cu + l15) * K + kbase;
    f32x4 acc = (f32x4){0.f, 0.f, 0.f, 0.f};
    typename F::Pre pre;
    if (kq == 0) pre = f.pre(arow, 16 * cu + 4 * g4);
    for (int k0 = 0; k0 < kspan; k0 += 256) {
      bf16x8 a[8], b[8];
#pragma unroll
      for (int s8 = 0; s8 < 8; ++s8) { if (k0 + 32 * s8 < kspan) { a[s8] = *(const bf16x8*)(ap + k0 + 32 * s8); b[s8] = *(const bf16x8*)(bp + k0 + 32 * s8); } }
#pragma unroll
      for (int s8 = 0; s8 < 8; ++s8) { if (k0 + 32 * s8 < kspan) acc = __builtin_amdgcn_mfma_f32_16x16x32_bf16(b[s8], a[s8], acc, 0, 0, 0); }
    }
    *(f32x4*)(red + (size_t)(w * 64 + lane) * 4) = acc;
    __syncthreads();
    if (kq == 0) {
      f32x4 t = acc;
#pragma unroll
      for (int q = 1; q < 4; ++q) t += *(const f32x4*)(red + (size_t)((w + q) * 64 + lane) * 4);
      float ss = f.post(arow, 16 * cu + 4 * g4, t, pre);
      if (F::STAT) { ss += __shfl_xor(ss, 16); ss += __shfl_xor(ss, 32); if (g4 == 0) ss_add(f.ss + arow, ss); }
    }
    __syncthreads();
  }
}
__device__ __forceinline__ void skinny_run13(const F13& f, const bf16_t* A, const bf16_t* Bt, int bid, int G, unsigned char* shm) {
  const int tid = tidx(), w = tid >> 6, lane = tid & 63, g = lane >> 4;
  const int c0 = ((NP / 256) * (2 * DFF / 256)) % G, nc = G - c0;
  if (bid < c0) return;
  for (int su = (G - 1 - bid); su < DFF / 16; su += nc) {
    const int arow = NP + 16 * w + (lane & 15);
    f32x4 acc[2];
    const float rs13 = f.rowscale(arow);
    skinny_unit<2>(A, 1024, Bt, NP, ((16 * su) >> 7) * 256 + ((16 * su) & 127), 128, (float*)shm, acc);
    f.pair(arow, 16 * su + 4 * g, acc[0], acc[1], rs13);
    __syncthreads();
  }
}
template <class F>
__device__ __forceinline__ void gemm_all(LAS unsigned char* lds, unsigned char* shm, const bf16_t* A, const bf16_t* Bt, int N, int K, const F& f, int bid, int G) {
  pg8::Gemm g; g.A = A; g.Bt = Bt; g.M = NP; g.N = N; g.K = K;
  pg8::StaticOrder S; S.init(NP, N, G, bid);
  EpiMain<F> E; E.f = f; E.coff = 0;
  REP(F::STAT ? 0 : 512) pg8::gemm_phase(lds, g, S, E);
  const int c0 = ((NP / 256) * (N / 256)) % G;
  if ((N / 16) * 2 <= G - c0) skinny_run_quarter(f, A, K, Bt, N / 16, bid, G, shm, c0);
  else skinny_run(f, A, K, Bt, NP, 1, N / 16, bid, G, shm, c0);
}

template <class F>
__device__ __forceinline__ void gemm_main_window(LAS unsigned char* lds, const bf16_t* A, const bf16_t* Bt, int N, int K, const F& f, int coff, int bid, int G) {
  pg8::Gemm g; g.A = A; g.Bt = Bt; g.M = NP; g.N = N; g.K = K;
  pg8::StaticOrder S; S.init(NP, N, G, bid);
  EpiMain<F> E; E.f = f; E.coff = coff;
  pg8::gemm_phase(lds, g, S, E);
}

__device__ __forceinline__ void prep_s5tables(const Params& P, int item, unsigned char* shm);
__device__ __forceinline__ void prep_phase(const Params& P, unsigned char* shm, int bid, int G) {
  const int tid = tidx(), w = tid >> 6, lane = tid & 63;
  bf16_t* T = (bf16_t*)shm;
  int jcur = 0;
  for (int t0 = 4 * bid; t0 < P.total_tiles; t0 += 4 * G) {
    f32x4 v0[4], v1[4]; float sc[4]; int jix[4];
    const int kk = tid >> 3, jq = tid & 7, nn = jq * 8;
#pragma unroll
    for (int u = 0; u < 4; ++u) {
      const int tile = t0 + u;
      v0[u] = (f32x4){0.f, 0.f, 0.f, 0.f}; v1[u] = v0[u]; sc[u] = 1.f;
      if (tile < P.total_tiles) {
        while (jcur + 1 < P.njobs && P.jobs[jcur + 1].tile0 <= tile) ++jcur;
        jix[u] = jcur;
        const TJob& J = P.jobs[jcur];
        const int lt = tile - J.tile0, tn = lt % J.ntn, tk = lt / J.ntn, k0 = tk * 64, n0 = tn * 64;
        if (n0 + nn < J.ncols) { const float* sp = J.src + (size_t)(k0 + kk) * J.ldn + J.c0 + n0 + nn; v0[u] = *(const f32x4*)sp; v1[u] = *(const f32x4*)(sp + 4); }
        if (J.scale) sc[u] = J.scale[k0 + kk];
      }
    }
#pragma unroll
    for (int u = 0; u < 4; ++u) {
      bf16_t* Tu = T + u * (64 * 72);
      const int kx = kk ^ (8 * jq);
#pragma unroll
      for (int i = 0; i < 4; ++i) { Tu[(nn + i) * 72 + kx] = f2bf(v0[u][i] * sc[u]); Tu[(nn + 4 + i) * 72 + kx] = f2bf(v1[u][i] * sc[u]); }
    }
    __syncthreads();
#pragma unroll
    for (int u = 0; u < 4; ++u) {
      const int tile = t0 + u;
      if (tile < P.total_tiles) {
        const TJob& J = P.jobs[jix[u]];
        const int lt = tile - J.tile0, tn = lt % J.ntn, tk = lt / J.ntn, k0 = tk * 64, n0 = tn * 64;
        const int n = tid >> 3, k8 = (tid & 7) * 8, gn = n0 + n;
        if (gn < J.nwrite) {
          const int dr = J.mode == 0 ? J.r0 + gn : ((gn >> 7) * 256 + (J.mode == 2 ? 128 : 0) + (gn & 127));
          *(u32x4*)(J.dst + (size_t)dr * J.K + k0 + k8) = *(const u32x4*)(T + u * (64 * 72) + n * 72 + (k8 ^ (8 * ((n >> 3) & 7))));
        }
      }
    }
    __syncthreads();
  }
  for (int i = bid * 512 + tid; i < 2 * 2048; i += G * 512) {
    const int l = i >> 11, gp = i & 2047, g = gp >> 6, p = gp & 63;
    const float dt = expf(P.log_dt[l * 32 + g]);
    const float Ar = P.A_re[l * 2048 + gp], Ai = P.A_im[l * 2048 + gp];
    const float mag = expf(dt * Ar);
    float sn, cs; sincosf(dt * Ai, &sn, &cs);
    const float abr = mag * cs, abi = mag * sn;
    const float den = Ar * Ar + Ai * Ai, nr = abr - 1.0f, ni = abi;
    const float fre = (nr * Ar + ni * Ai) / den, fim = (ni * Ar - nr * Ai) / den;
    P.abar[l][gp] = abr; P.abar[l][2048 + gp] = abi;
    for (int c = 0; c < 16; ++c) {
      const float Br = P.B_re[(size_t)l * 32768 + gp * 16 + c], Bi = P.B_im[(size_t)l * 32768 + gp * 16 + c];
      P.bbar[l][(g * 16 + c) * 64 + p] = fre * Br - fim * Bi;
      P.bbar[l][32768 + (g * 16 + c) * 64 + p] = fre * Bi + fim * Br;
    }
  }
  for (int it = bid; it < 256; it += G) prep_s5tables(P, it, shm);
  for (int row = bid * 8 + w; row < NT; row += 4 * G * 8) {
    f32x4 v[4][4]; int rr[4];
#pragma unroll
    for (int k = 0; k < 4; ++k) {
      const int r = row + k * G * 8; rr[k] = r < NT ? r : row;
      const float* xr = rr[k] < NP ? P.x_prompt + (size_t)rr[k] * DM : P.x_sample + (size_t)(rr[k] - NP) * DM;
#pragma unroll
      for (int i = 0; i < 4; ++i) v[k][i] = *(const f32x4*)(xr + 256 * i + 4 * lane);
    }
#pragma unroll
    for (int k = 0; k < 4; ++k) {
      if (k == 0 || row + k * G * 8 < NT) {
        float ss = 0.f;
#pragma unroll
        for (int i = 0; i < 4; ++i) {
          ss += (v[k][i][0] * v[k][i][0] + v[k][i][1] * v[k][i][1]) + (v[k][i][2] * v[k][i][2] + v[k][i][3] * v[k][i][3]);
          *(u32x2*)(P.xb + (size_t)rr[k] * DM + 256 * i + 4 * lane) = pack4(v[k][i]);
        }
        ss = wave_sum(ss);
        if (lane == 0) P.ssA[rr[k]] = ss_fix(ss);
      }
    }
  }
}

__device__ __forceinline__ void mlstm_scalars(const float* gat, int b, int h, float* sA, float* sM, float* sB, float* chain) {
  const int tid = tidx(), w = tid >> 6, lane = tid & 63;
  for (int cc = w; cc < 16; cc += 8) {
    const int t0 = cc * 128 + 2 * lane; const size_t r0 = (size_t)b * 2048 + t0;
    const float ig0 = gat[r0 * 8 + h], lf0 = gat[r0 * 8 + 4 + h], ig1 = gat[(r0 + 1) * 8 + h], lf1 = gat[(r0 + 1) * 8 + 4 + h];
    float x = lf0 + lf1;
    for (int off = 1; off < 64; off <<= 1) { const float y = __shfl_up(x, off); if (lane >= off) x += y; }
    const float b1 = x, b0 = x - lf1, a0 = ig0 - b0, a1 = ig1 - b1;
    float cm = fmaxf(a0, a1);
    for (int off = 1; off < 64; off <<= 1) { const float y = __shfl_up(cm, off); if (lane >= off) cm = fmaxf(cm, y); }
    const float prev = __shfl_up(cm, 1); const float cm0 = lane ? fmaxf(prev, a0) : a0;
    sB[t0] = b0; sB[t0 + 1] = b1; sA[t0] = a0; sA[t0 + 1] = a1; sM[t0] = cm0; sM[t0 + 1] = cm;
    if (lane == 63) { chain[33 + cc] = b1; chain[49 + cc] = cm; }
  }
  __syncthreads();
  if (tid == 0) { float m = 0.f; for (int cc = 0; cc < 16; ++cc) { chain[cc] = m; const float ml = fmaxf(m, chain[49 + cc]); chain[17 + cc] = ml; m = chain[33 + cc] + ml; } chain[16] = m; }
  __syncthreads();
  for (int t = tid; t < 2048; t += 512) sM[t] = fmaxf(chain[t >> 7], sM[t]);
  __syncthreads();
}

__device__ __forceinline__ void m1_item(const Params& P, int item, unsigned char* shm) {
  const int tid = tidx(), w = __builtin_amdgcn_readfirstlane(tid >> 6), lane = tid & 63, g = lane >> 4;
  const int b = item >> 6, h = (item >> 4) & 3, c = item & 15;
  float* sA = (float*)shm; float* sM = sA + 2048; float* sB = sM + 2048; float* chain = sB + 2048;
  mlstm_scalars(P.gat, b, h, sA, sM, sB, chain);
  const int row0 = b * 2048 + c * 128, t = 16 * w + (lane & 15);
  const bf16_t* qp = P.Pb + (size_t)(row0 + t) * NG1 + h * 256 + 8 * g;
  bf16x8 qf[8];
#pragma unroll
  for (int ks = 0; ks < 8; ++ks) qf[ks] = *(const bf16x8*)(qp + 32 * ks);
  const float Mt = sM[c * 128 + t];
  bf16_t* sp = P.St + (size_t)item * 16384 + t * 128;
#pragma unroll
  for (int sg = 0; sg < 8; sg += 4) {
    if (sg <= w) {
      bf16x8 kf[4][8];
#pragma unroll
      for (int u = 0; u < 4; ++u) {
        if (sg + u <= w) {
          const bf16_t* kp = P.Pb + (size_t)(row0 + 16 * (sg + u) + (lane & 15)) * NG1 + 1024 + h * 256 + 8 * g;
#pragma unroll
          for (int ks = 0; ks < 8; ++ks) kf[u][ks] = *(const bf16x8*)(kp + 32 * ks);
        }
      }
#pragma unroll
      for (int u = 0; u < 4; ++u) {
        const int st = sg + u;
        f32x4 acc = (f32x4){0.f, 0.f, 0.f, 0.f};
        if (st <= w) {
#pragma unroll
          for (int ks = 0; ks < 8; ++ks) acc = __builtin_amdgcn_mfma_f32_16x16x32_bf16(kf[u][ks], qf[ks], acc, 0, 0, 0);
#pragma unroll
          for (int r = 0; r < 4; ++r) { const int s2 = 16 * st + 4 * g + r; acc[r] = (s2 <= t) ? acc[r] * __expf(sA[c * 128 + s2] - Mt) : 0.f; }
        }
        *(u32x2*)(sp + 16 * st + 4 * g) = pack4(acc);
      }
    } else {
#pragma unroll
      for (int u = 0; u < 4; ++u) *(u32x2*)(sp + 16 * (sg + u) + 4 * g) = (u32x2){0u, 0u};
    }
  }
  __syncthreads();
}

__device__ __forceinline__ bf16x8 trread8(unsigned a0, unsigned a1) {
  bf16x4 lo, hi;
  asm volatile("ds_read_b64_tr_b16 %0, %2\n\tds_read_b64_tr_b16 %1, %3\n\ts_waitcnt lgkmcnt(0)" : "=&v"(lo), "=&v"(hi) : "v"(a0), "v"(a1) : "memory");
  return __builtin_shufflevector(lo, hi, 0, 1, 2, 3, 4, 5, 6, 7);
}
__device__ __forceinline__ void trread8x3(unsigned a0, unsigned a1, unsigned a2, unsigned dlt, bf16x8& r0, bf16x8& r1, bf16x8& r2) {
  bf16x4 l0, h0, l1, h1, l2, h2;
  asm volatile("ds_read_b64_tr_b16 %0, %6\n\tds_read_b64_tr_b16 %1, %7\n\tds_read_b64_tr_b16 %2, %8\n\tds_read_b64_tr_b16 %3, %9\n\tds_read_b64_tr_b16 %4, %10\n\tds_read_b64_tr_b16 %5, %11\n\ts_waitcnt lgkmcnt(0)"
               : "=&v"(l0), "=&v"(h0), "=&v"(l1), "=&v"(h1), "=&v"(l2), "=&v"(h2)
               : "v"(a0), "v"(a0 + dlt), "v"(a1), "v"(a1 + dlt), "v"(a2), "v"(a2 + dlt) : "memory");
  r0 = __builtin_shufflevector(l0, h0, 0, 1, 2, 3, 4, 5, 6, 7); r1 = __builtin_shufflevector(l1, h1, 0, 1, 2, 3, 4, 5, 6, 7); r2 = __builtin_shufflevector(l2, h2, 0, 1, 2, 3, 4, 5, 6, 7);
}
__device__ __forceinline__ void trread8x2(unsigned a0, unsigned a1, unsigned dlt, bf16x8& r0, bf16x8& r1) {
  bf16x4 l0, h0, l1, h1;
  asm volatile("ds_read_b64_tr_b16 %0, %4\n\tds_read_b64_tr_b16 %1, %5\n\tds_read_b64_tr_b16 %2, %6\n\tds_read_b64_tr_b16 %3, %7\n\ts_waitcnt lgkmcnt(0)"
               : "=&v"(l0), "=&v"(h0), "=&v"(l1), "=&v"(h1) : "v"(a0), "v"(a0 + dlt), "v"(a1), "v"(a1 + dlt) : "memory");
  r0 = __builtin_shufflevector(l0, h0, 0, 1, 2, 3, 4, 5, 6, 7); r1 = __builtin_shufflevector(l1, h1, 0, 1, 2, 3, 4, 5, 6, 7);
}

constexpr int KS_STRIDE = 272, VS_STRIDE = 56;
constexpr int M2_K = 0, M2_V = 69632, M2_CL = 83968, M2_SC = 110080;
__device__ __forceinline__ void m2_item(const Params& P, int l, int item, unsigned char* shm) {
  const int tid = tidx(), w = __builtin_amdgcn_readfirstlane(tid >> 6), lane = tid & 63, g = lane >> 4, l15 = lane & 15;
  const int bh = item >> 3, j = item & 7, b = bh >> 2, h = bh & 3;
  bf16_t* Ksh = (bf16_t*)(shm + M2_K); bf16_t* Vsh = (bf16_t*)(shm + M2_V); bf16_t* Cl = (bf16_t*)(shm + M2_CL);
  float* sA = (float*)(shm + M2_SC); float* sM = sA + 2048; float* sB = sM + 2048; float* chain = sB + 2048;
  const unsigned lbase = (unsigned)(size_t)shm;
  u32x4 kreg[8]; u32x4 vreg;
  const int vs = tid >> 2, vpc = tid & 3;
  {
    const int row0 = b * 2048;
#pragma unroll
    for (int i = 0; i < 8; ++i) { const int piece = tid + 512 * i, s = piece >> 5, pc = piece & 31; kreg[i] = *(const u32x4*)(P.Pb + (size_t)(row0 + s) * NG1 + 1024 + h * 256 + 8 * pc); }
    vreg = *(const u32x4*)(P.Pb + (size_t)(row0 + vs) * NG1 + 2048 + h * 256 + 32 * j + 8 * vpc);
  }
  bf16x8 qf[8], sf[4];
  {
    const int t = 16 * w + l15;
#pragma unroll
    for (int ks = 0; ks < 8; ++ks) qf[ks] = (bf16x8){0, 0, 0, 0, 0, 0, 0, 0};
    const bf16_t* sp0 = P.St + (size_t)(bh * 16) * 16384 + t * 128 + 8 * g;
#pragma unroll
    for (int ks = 0; ks < 4; ++ks) sf[ks] = *(const bf16x8*)(sp0 + 32 * ks);
  }
  mlstm_scalars(P.gat, b, h, sA, sM, sB, chain);
  f32x4 Cacc[2][3];
#pragma unroll
  for (int dt = 0; dt < 2; ++dt)
#pragma unroll
    for (int et = 0; et < 3; ++et) Cacc[dt][et] = (f32x4){0.f, 0.f, 0.f, 0.f};
  const int trq = l15 >> 2, trp = lane & 3;
#define M2_WRITE_KV(cc) do { \
    const float ml_ = chain[17 + (cc)]; \
    _Pragma("unroll") for (int i = 0; i < 8; ++i) { const int piece = tid + 512 * i, s = piece >> 5, pc = piece & 31; \
      const float wk = __expf(sA[(cc) * 128 + s] - ml_); u32x4 sc; \
      _Pragma("unroll") for (int e = 0; e < 4; ++e) { const unsigned u = kreg[i][e]; sc[e] = pack2(bf2f(u & 0xffffu) * wk, bf2f(u >> 16) * wk); } \
      *(u32x4*)(Ksh + s * KS_STRIDE + 8 * pc) = sc; } \
    *(u32x4*)(Vsh + vs * VS_STRIDE + 8 * vpc) = vreg; \
    if (vpc == 0) { unsigned zz = 0u; asm volatile("" : "+v"(zz)); const u32x4 z = (u32x4){zz, zz, zz, zz}; u32x4 o1 = z; o1[0] = 0x3F80u; \
      *(u32x4*)(Vsh + vs * VS_STRIDE + 32) = o1; *(u32x4*)(Vsh + vs * VS_STRIDE + 40) = z; } } while (0)
  M2_WRITE_KV(0);
  __syncthreads();
  for (int c = 0; c < 16; ++c) {
    const int row0 = b * 2048 + c * 128;
    const float mlast = chain[17 + c], mprev = chain[c];
    if (c < 15) {
      const int nrow0 = row0 + 128;
#pragma unroll
      for (int i = 0; i < 8; ++i) { const int piece = tid + 512 * i, s = piece >> 5, pc = piece & 31; kreg[i] = *(const u32x4*)(P.Pb + (size_t)(nrow0 + s) * NG1 + 1024 + h * 256 + 8 * pc); }
      vreg = *(const u32x4*)(P.Pb + (size_t)(nrow0 + vs) * NG1 + 2048 + h * 256 + 32 * j + 8 * vpc);
    }
    {
      const int t = 16 * w + l15, row = row0 + t;
      f32x4 acc[3]; acc[0] = (f32x4){0.f, 0.f, 0.f, 0.f}; acc[1] = acc[0]; acc[2] = acc[0];
      const float Mt = sM[c * 128 + t];
      if (c > 0) {
#pragma unroll
        for (int ks = 0; ks < 8; ++ks) {
          bf16x8 cf[3];
#pragma unroll
          for (int et = 0; et < 3; ++et) cf[et] = *(const bf16x8*)(Cl + (16 * et + l15) * KS_STRIDE + 32 * ks + 8 * g);
          __builtin_amdgcn_sched_barrier(0);
#pragma unroll
          for (int et = 0; et < 3; ++et) acc[et] = __builtin_amdgcn_mfma_f32_16x16x32_bf16(cf[et], qf[ks], acc[et], 0, 0, 0);
          __builtin_amdgcn_sched_barrier(0);
        }
        const float wi = __expf(mprev - Mt);
        acc[0] *= wi; acc[1] *= wi; acc[2] *= wi;
      }
      const float ac = __expf(mprev - mlast);
#pragma unroll
      for (int dt = 0; dt < 2; ++dt)
#pragma unroll
        for (int et = 0; et < 3; ++et) Cacc[dt][et] *= ac;
#pragma unroll
      for (int ks = 0; ks < 4; ++ks) {
        bf16x8 kf[2], vf[3];
        const unsigned va = lbase + M2_V + (unsigned)((32 * ks + 8 * g + trq) * VS_STRIDE + 4 * trp) * 2u;
        const unsigned ka = lbase + M2_K + (unsigned)((32 * ks + 8 * g + trq) * KS_STRIDE + 32 * w + 4 * trp) * 2u;
        trread8x3(va, va + 32u, va + 64u, 4u * VS_STRIDE * 2u, vf[0], vf[1], vf[2]);
        trread8x2(ka, ka + 32u, 4u * KS_STRIDE * 2u, kf[0], kf[1]);
#pragma unroll
        for (int et = 0; et < 3; ++et) acc[et] = __builtin_amdgcn_mfma_f32_16x16x32_bf16(vf[et], sf[ks], acc[et], 0, 0, 0);
#pragma unroll
        for (int dt = 0; dt < 2; ++dt)
#pragma unroll
          for (int et = 0; et < 3; ++et) Cacc[dt][et] = __builtin_amdgcn_mfma_f32_16x16x32_bf16(kf[dt], vf[et], Cacc[dt][et], 0, 0, 0);
      }
      if (c < 15) {
        const bf16_t* qp = P.Pb + (size_t)(row + 128) * NG1 + h * 256 + 8 * g;
#pragma unroll
        for (int ks = 0; ks < 8; ++ks) qf[ks] = *(const bf16x8*)(qp + 32 * ks);
        const bf16_t* sp = P.St + (size_t)(bh * 16 + c + 1) * 16384 + t * 128 + 8 * g;
#pragma unroll
        for (int ks = 0; ks < 4; ++ks) sf[ks] = *(const bf16x8*)(sp + 32 * ks);
      }
      const float den = __shfl(acc[2][0], l15);
      const float dd = fmaxf(fabsf(den), __expf(-(sB[c * 128 + t] + Mt)));
      const float inv = __builtin_amdgcn_rcpf(dd);
      const f32x4 o0 = acc[0] * inv, o1 = acc[1] * inv;
      bf16_t* hp = P.hA + (size_t)row * DM + h * 256 + 32 * j + 4 * g;
      *(u32x2*)hp = pack4(o0); *(u32x2*)(hp + 16) = pack4(o1);
      float ss = (o0[0] * o0[0] + o0[1] * o0[1]) + (o0[2] * o0[2] + o0[3] * o0[3]) + (o1[0] * o1[0] + o1[1] * o1[1]) + (o1[2] * o1[2] + o1[3] * o1[3]);
      ss += __shfl_xor(ss, 16); ss += __shfl_xor(ss, 32);
      if (g == 0) P.hss[(size_t)row * 32 + h * 8 + j] = ss;
    }
    LDS_BARRIER();
#pragma unroll
    for (int dt = 0; dt < 2; ++dt)
#pragma unroll
      for (int et = 0; et < 3; ++et) *(u32x2*)(Cl + (16 * et + l15) * KS_STRIDE + 32 * w + 16 * dt + 4 * g) = pack4(Cacc[dt][et]);
    if (c < 15) M2_WRITE_KV(c + 1);
    LDS_BARRIER();
  }
#undef M2_WRITE_KV
  const size_t sidx = (size_t)(l * 8 + b) * 4 + h;
#pragma unroll
  for (int dt = 0; dt < 2; ++dt)
#pragma unroll
    for (int r = 0; r < 4; ++r) {
      const int d = 32 * w + 16 * dt + 4 * g + r;
      P.out[O_CP + sidx * 65536 + (size_t)d * 256 + 32 * j + l15] = Cacc[dt][0][r];
      P.out[O_CP + sidx * 65536 + (size_t)d * 256 + 32 * j + 16 + l15] = Cacc[dt][1][r];
      if (j == 0 && l15 == 0) P.out[O_NP + sidx * 256 + d] = Cacc[dt][2][r];
    }
  if (j == 0 && tid == 0) P.out[O_MP + sidx] = chain[16];
  __syncthreads();
}

__device__ __forceinline__ void msample_item(const Params& P, int l, int item, unsigned char* shm) {
  const int tid = tidx(), w = tid >> 6, lane = tid & 63;
  const int b = item >> 2, h = item & 3, row = NP + b;
  float* q = (float*)shm; float* k = q + 256; float* v = k + 256; float* red = v + 256; float* red2 = red + 2048;
  if (tid < 256) {
    const bf16_t* pr = P.Pb + (size_t)row * NG1 + h * 256 + tid;
    q[tid] = bf2f(pr[0]); k[tid] = bf2f(pr[1024]); v[tid] = bf2f(pr[2048]);
  }
  const float ig = P.gat[(size_t)row * 8 + h], lf = P.gat[(size_t)row * 8 + 4 + h];
  const size_t sidx = (size_t)(l * 128 + b) * 4 + h;
  const float m0 = P.st_m[sidx];
  const float inter = lf + m0, mt = fmaxf(inter, ig), wi = __expf(inter - mt), wa = __expf(ig - mt);
  __syncthreads();
  const float* C0 = P.st_C + sidx * 65536; float* Co = P.out + O_CS + sidx * 65536;
  const float* n0 = P.st_n + sidx * 256;
  const f32x4 v4 = *(const f32x4*)(v + 4 * lane);
  f32x4 acc = (f32x4){0.f, 0.f, 0.f, 0.f};
#pragma unroll 8
  for (int dd = 0; dd < 32; ++dd) {
    const int d = 32 * w + dd;
    const f32x4 c4 = __builtin_nontemporal_load((const f32x4*)(C0 + (size_t)d * 256 + 4 * lane));
    const float kd = wa * k[d], qd = q[d];
    __builtin_nontemporal_store(c4 * wi + v4 * kd, (f32x4*)(Co + (size_t)d * 256 + 4 * lane));
    acc += c4 * qd;
  }
  *(f32x4*)(red + w * 256 + 4 * lane) = acc;
  float qk = 0.f, qn = 0.f;
#pragma unroll
  for (int i = 0; i < 4; ++i) { const int d = lane + 64 * i; qk += q[d] * k[d]; qn += q[d] * n0[d]; }
  qk = wave_sum(qk); qn = wave_sum(qn);
  __syncthreads();
  const float s = qk * wa, den = wi * qn + s, ddn = fmaxf(fabsf(den), __expf(-mt));
  float hval = 0.f;
  if (tid < 256) {
    float num = 0.f;
#pragma unroll
    for (int i = 0; i < 8; ++i) num += red[i * 256 + tid];
    hval = (wi * num + s * v[tid]) / ddn;
    P.hA[(size_t)row * DM + h * 256 + tid] = f2bf(hval);
    P.out[O_NS + sidx * 256 + tid] = wi * n0[tid] + wa * k[tid];
  }
  float ss = wave_sum(hval * hval);
  if (lane == 0) red2[w] = ss;
  __syncthreads();
  if (tid < 8) P.hss[(size_t)row * 32 + h * 8 + tid] = tid == 0 ? (red2[0] + red2[1] + red2[2] + red2[3]) : 0.f;
  if (tid == 0) P.out[O_MS + sidx] = mt;
  __syncthreads();
}

__device__ __forceinline__ void s5_load_C(const Params& P, int l, int g, float* Csh) {
  for (int i = tidx(); i < 2048; i += 512) { const int ri = i >> 10, c = (i >> 6) & 15, p = i & 63;
    Csh[ri * 1088 + c * 68 + p] = (ri ? P.C_im : P.C_re)[(size_t)l * 32768 + (g * 16 + c) * 64 + p]; }
}
__device__ __forceinline__ void s5_sample_item(const Params& P, int l, int item, unsigned char* shm) {
  const int tid = tidx(), w = tid >> 6, lane = tid & 63;
  const int g = item & 31, bs0 = (item >> 5) * 16 + 2 * w;
  float* Csh = (float*)shm; float* sbuf = Csh + 2176 + w * 2176;
  s5_load_C(P, l, g, Csh);
  const float are = P.abar[l][g * 64 + lane], aim = P.abar[l][2048 + g * 64 + lane];
  float bre[16], bim[16];
#pragma unroll
  for (int c = 0; c < 16; ++c) { bre[c] = P.bbar[l][(g * 16 + c) * 64 + lane]; bim[c] = P.bbar[l][32768 + (g * 16 + c) * 64 + lane]; }
  const int ch = lane >> 2, pq = lane & 3;
  const float Dc = P.D_skip[l * 512 + g * 16 + ch];
  __syncthreads();
#pragma unroll
  for (int rep = 0; rep < 2; ++rep) {
    const int bs = bs0 + rep, row = NP + bs;
    const size_t o = ((size_t)(l * 128 + bs) * 32 + g) * 64 + lane;
    const float s0r = P.st_sre[o], s0i = P.st_sim[o];
    const bf16_t* up = P.Pb + (size_t)row * NG1 + 4096 + g * 16;
    const u32x4 u0 = *(const u32x4*)up, u1 = *(const u32x4*)(up + 8);
    float br = 0.f, bi = 0.f;
#pragma unroll
    for (int i = 0; i < 4; ++i) {
      const float ua = bf2f(u0[i] & 0xffffu), ub = bf2f(u0[i] >> 16), uc = bf2f(u1[i] & 0xffffu), ud = bf2f(u1[i] >> 16);
      br += bre[2 * i] * ua + bre[2 * i + 1] * ub + bre[8 + 2 * i] * uc + bre[8 + 2 * i + 1] * ud;
      bi += bim[2 * i] * ua + bim[2 * i + 1] * ub + bim[8 + 2 * i] * uc + bim[8 + 2 * i + 1] * ud;
    }
    const float sr = are * s0r - aim * s0i + br, si = are * s0i + aim * s0r + bi;
    P.out[O_SRS + o] = sr; P.out[O_SIS + o] = si;
    sbuf[rep * 136 + lane] = sr; sbuf[rep * 136 + 68 + lane] = si;
    asm volatile("s_waitcnt lgkmcnt(0)" ::: "memory");
    float acc = 0.f;
#pragma unroll
    for (int p4 = 0; p4 < 4; ++p4) {
      const int p0 = 16 * pq + 4 * p4;
      const f32x4 vr = *(const f32x4*)(sbuf + rep * 136 + p0), vi = *(const f32x4*)(sbuf + rep * 136 + 68 + p0);
      const f32x4 cr = *(const f32x4*)(Csh + ch * 68 + p0), ci = *(const f32x4*)(Csh + 1088 + ch * 68 + p0);
      acc += (cr[0] * vr[0] + cr[1] * vr[1]) + (cr[2] * vr[2] + cr[3] * vr[3]) - (ci[0] * vi[0] + ci[1] * vi[1]) - (ci[2] * vi[2] + ci[3] * vi[3]);
    }
    acc += __shfl_xor(acc, 1); acc += __shfl_xor(acc, 2);
    if (pq == 0) {
      const float uc = bf2f(up[ch]);
      P.ysb[(size_t)row * 512 + g * 16 + ch] = f2bf(gelu_tanh(acc + Dc * uc));
    }
  }
  __syncthreads();
}

__device__ __forceinline__ void prep_s5tables(const Params& P, int item, unsigned char* shm) {
  const int tid = tidx(), qpart = item & 3, l = item >> 7, g = (item >> 2) & 31;
  float* pwr = (float*)shm; float* pwi = pwr + 17 * 64; float* bbr = pwi + 17 * 64; float* bbi = bbr + 1024; float* Ccr = bbi + 1024; float* Cci = Ccr + 1024;
  if (tid < 64) {
    const int p = tid, gp = g * 64 + p;
    const float dt = expf(P.log_dt[l * 32 + g]);
    const float Ar = P.A_re[l * 2048 + gp], Ai = P.A_im[l * 2048 + gp];
    const float mag = expf(dt * Ar);
    float sn, cs; sincosf(dt * Ai, &sn, &cs);
    const float abr = mag * cs, abi = mag * sn;
    const float den = Ar * Ar + Ai * Ai, nr = abr - 1.0f, ni = abi;
    const float fre = (nr * Ar + ni * Ai) / den, fim = (ni * Ar - nr * Ai) / den;
    float pr = 1.f, pi = 0.f;
    for (int t = 0; t <= 16; ++t) { pwr[t * 64 + p] = pr; pwi[t * 64 + p] = pi; const float a = pr * abr - pi * abi, b = pr * abi + pi * abr; pr = a; pi = b; }
    for (int c = 0; c < 16; ++c) {
      const float Br = P.B_re[(size_t)l * 32768 + gp * 16 + c], Bi = P.B_im[(size_t)l * 32768 + gp * 16 + c];
      bbr[p * 16 + c] = fre * Br - fim * Bi; bbi[p * 16 + c] = fre * Bi + fim * Br;
    }
  }
  for (int i = tid; i < 1024; i += 512) { Ccr[i] = P.C_re[(size_t)l * 32768 + g * 1024 + i]; Cci[i] = P.C_im[(size_t)l * 32768 + g * 1024 + i]; }
  __syncthreads();
  bf16_t* Kt = P.Kt[l] + (size_t)g * 17 * 256; bf16_t* Gm = P.Gm[l] + (size_t)g * 32768; bf16_t* Hm = P.Hm[l] + (size_t)g * 32768;
  for (int o = qpart * 1088 + tid; o < (qpart + 1) * 1088; o += 512) {
    const int tau = o >> 8, c = (o >> 4) & 15, c2 = o & 15;
    float acc = 0.f;
    if (tau < 16) for (int p = 0; p < 64; ++p) {
      const float pr = pwr[tau * 64 + p], pi = pwi[tau * 64 + p], br = bbr[p * 16 + c2], bi = bbi[p * 16 + c2];
      const float zr = pr * br - pi * bi, zi = pr * bi + pi * br;
      acc += Ccr[c * 64 + p] * zr - Cci[c * 64 + p] * zi;
    }
    Kt[o] = f2bf(acc);
  }
  for (int o = qpart * 8192 + tid; o < (qpart + 1) * 8192; o += 512) {
    { const int tc = o >> 7, q = o & 127, t = tc >> 4, c = tc & 15, p = q & 63;
      const float cr = Ccr[c * 64 + p], ci = Cci[c * 64 + p], pr = pwr[(t + 1) * 64 + p], pi = pwi[(t + 1) * 64 + p];
      Gm[o] = f2bf(q < 64 ? (cr * pr - ci * pi) : -(cr * pi + ci * pr)); }
    { const int q = o >> 8, jc = o & 255, j = jc >> 4, c2 = jc & 15, p = q & 63;
      const float pr = pwr[(15 - j) * 64 + p], pi = pwi[(15 - j) * 64 + p], br = bbr[p * 16 + c2], bi = bbi[p * 16 + c2];
      Hm[o] = f2bf(q < 64 ? (pr * br - pi * bi) : (pr * bi + pi * br)); }
  }
  if (tid < 64 && qpart == 0) { P.a16[l][g * 64 + tid] = pwr[16 * 64 + tid]; P.a16[l][2048 + g * 64 + tid] = pwi[16 * 64 + tid]; }
  __syncthreads();
}
constexpr int S3_R0 = 0, S3_SIN = 69632, S3_KT = 69632 + 34816;
__device__ __forceinline__ void s5_stage3_item(const Params& P, int l, int item, unsigned char* shm) {
  const int tid = tidx(), w = tid >> 6, lane = tid & 63, g4 = lane >> 4, l15 = lane & 15;
  const int b = item >> 5, g = item & 31;
  float* Ebuf = (float*)(shm + S3_R0); bf16_t* Gsh = (bf16_t*)(shm + S3_R0); bf16_t* Sin = (bf16_t*)(shm + S3_SIN); bf16_t* Ksh = (bf16_t*)(shm + S3_KT);
  { bf16_t* Hsh = (bf16_t*)(shm + S3_R0); const bf16_t* Hm = P.Hm[l] + (size_t)g * 32768;
#pragma unroll
    for (int i = 0; i < 8; ++i) { const int piece = tid + 512 * i, r = piece >> 5, pc = piece & 31; *(u32x4*)(Hsh + r * 264 + 8 * pc) = *(const u32x4*)(Hm + r * 256 + 8 * pc); } }
  { const bf16_t* Kt = P.Kt[l] + (size_t)g * 17 * 256; for (int i = tid; i < 544; i += 512) *(u32x4*)(Ksh + 8 * i) = *(const u32x4*)(Kt + 8 * i); }
  const int n = 16 * w + l15, r0 = b * 2048 + n * 16;
  bf16x8 uf[8];
#pragma unroll
  for (int ks = 0; ks < 8; ++ks) uf[ks] = *(const bf16x8*)(P.Pb + (size_t)(r0 + 2 * ks + (g4 >> 1)) * NG1 + 4096 + g * 16 + 8 * (g4 & 1));
  __syncthreads();
  {
    const bf16_t* Hsh = (const bf16_t*)(shm + S3_R0);
    f32x4 eacc[8];
#pragma unroll
    for (int qt = 0; qt < 8; ++qt) {
      eacc[qt] = (f32x4){0.f, 0.f, 0.f, 0.f};
#pragma unroll
      for (int ks = 0; ks < 8; ++ks) { const bf16x8 x = *(const bf16x8*)(Hsh + (16 * qt + l15) * 264 + 32 * ks + 8 * g4); eacc[qt] = __builtin_amdgcn_mfma_f32_16x16x32_bf16(x, uf[ks], eacc[qt], 0, 0, 0); }
    }
    __syncthreads();
#pragma unroll
    for (int qt = 0; qt < 8; ++qt) *(f32x4*)(Ebuf + n * 128 + 16 * qt + 4 * g4) = eacc[qt];
  }
  __syncthreads();
  {
    const float ar = P.a16[l][g * 64 + lane], ai = P.a16[l][2048 + g * 64 + lane];
    float lr[16], li[16], sr = 0.f, si = 0.f;
#pragma unroll
    for (int k = 0; k < 16; ++k) {
      lr[k] = sr; li[k] = si;
      const float er = Ebuf[(16 * w + k) * 128 + lane], ei = Ebuf[(16 * w + k) * 128 + 64 + lane];
      const float nr = ar * sr - ai * si + er, ni = ar * si + ai * sr + ei; sr = nr; si = ni;
    }
    float* wend = (float*)(shm + S3_KT + 8704);
    wend[w * 128 + lane] = sr; wend[w * 128 + 64 + lane] = si;
    float br = ar, bi = ai;
#pragma unroll
    for (int i = 0; i < 4; ++i) { const float nr = br * br - bi * bi, ni = 2.f * br * bi; br = nr; bi = ni; }
    __syncthreads();
    float cr = 0.f, ci = 0.f;
    for (int w2 = 0; w2 < w; ++w2) { const float er = wend[w2 * 128 + lane], ei = wend[w2 * 128 + 64 + lane]; const float nr = br * cr - bi * ci + er, ni = br * ci + bi * cr + ei; cr = nr; ci = ni; }
    float pr = 1.f, pi = 0.f;
#pragma unroll
    for (int k = 0; k < 16; ++k) {
      Sin[(16 * w + k) * 136 + lane] = f2bf(lr[k] + pr * cr - pi * ci); Sin[(16 * w + k) * 136 + 64 + lane] = f2bf(li[k] + pr * ci + pi * cr);
      const float nr = pr * ar - pi * ai, ni = pr * ai + pi * ar; pr = nr; pi = ni;
    }
    if (w == 7) { const size_t o = ((size_t)(l * 8 + b) * 32 + g) * 64 + lane; P.out[O_SRP + o] = sr + pr * cr - pi * ci; P.out[O_SIP + o] = si + pr * ci + pi * cr; }
  }
  __syncthreads();
  { const bf16_t* Gm = P.Gm[l] + (size_t)g * 32768;
#pragma unroll
    for (int i = 0; i < 8; ++i) { const int piece = tid + 512 * i, r = piece >> 4, pc = piece & 15; *(u32x4*)(Gsh + r * 136 + 8 * pc) = *(const u32x4*)(Gm + r * 128 + 8 * pc); } }
  __syncthreads();
  bf16x8 sf[4];
#pragma unroll
  for (int k2 = 0; k2 < 4; ++k2) sf[k2] = *(const bf16x8*)(Sin + n * 136 + 32 * k2 + 8 * g4);
  const f32x4 D4 = *(const f32x4*)(P.D_skip + l * 512 + g * 16 + 4 * g4);
#pragma unroll
  for (int t = 0; t < 16; ++t) {
    f32x4 acc = (f32x4){0.f, 0.f, 0.f, 0.f};
    const int row = r0 + t;
    const f32x4 u4 = unpack4(*(const u32x2*)(P.Pb + (size_t)row * NG1 + 4096 + g * 16 + 4 * g4));
#pragma unroll
    for (int ks = 0; ks <= (t >> 1); ++ks) {
      const int tau = t - (2 * ks + (g4 >> 1)), idx = tau >= 0 ? tau : 16;
      const bf16x8 x = *(const bf16x8*)(Ksh + (idx * 16 + l15) * 16 + 8 * (g4 & 1));
      acc = __builtin_amdgcn_mfma_f32_16x16x32_bf16(x, uf[ks], acc, 0, 0, 0);
    }
#pragma unroll
    for (int k2 = 0; k2 < 4; ++k2) { const bf16x8 x = *(const bf16x8*)(Gsh + (t * 16 + l15) * 136 + 32 * k2 + 8 * g4); acc = __builtin_amdgcn_mfma_f32_16x16x32_bf16(x, sf[k2], acc, 0, 0, 0); }
    f32x4 y;
#pragma unroll
    for (int r = 0; r < 4; ++r) y[r] = gelu_tanh(acc[r] + D4[r] * u4[r]);
    *(u32x2*)(P.ysb + (size_t)row * 512 + g * 16 + 4 * g4) = pack4(y);
  }
  __syncthreads();
}

__device__ __forceinline__ void headnorm_rows(const Params& P, int l, int bid, int G) {
  const int w = tidx() >> 6, lane = tidx() & 63;
  constexpr int R1 = 6400;
  const bool split = (G == 256);
  const int rbeg = split ? (bid < 128 ? bid * 8 + w : R1 + (bid - 128) * 8 + w) : bid * 8 + w;
  const int rend = split ? (bid < 128 ? R1 : NT) : NT, rstep = split ? 128 * 8 : G * 8;
  f32x4 gh[4];
#pragma unroll
  for (int h = 0; h < 4; ++h) gh[h] = *(const f32x4*)(P.g_hn + l * 1024 + h * 256 + 4 * lane);
  for (int row = rbeg; row < rend; row += 2 * rstep) {
    const int row2 = row + rstep; const bool has2 = row2 < rend; const int r2 = has2 ? row2 : row;
    if (lane == 0) { P.ssA[row] = 0ull; P.ssB[row] = 0ull; if (has2) { P.ssA[row2] = 0ull; P.ssB[row2] = 0ull; } }
    f32x4 s0[2][4], s1[2][4]; u32x2 hv[2][4], so[2][4];
#pragma unroll
    for (int k = 0; k < 2; ++k) { const int r = k ? r2 : row;
#pragma unroll
      for (int h = 0; h < 4; ++h) {
        s0[k][h] = *(const f32x4*)(P.hss + (size_t)r * 32 + h * 8); s1[k][h] = *(const f32x4*)(P.hss + (size_t)r * 32 + h * 8 + 4);
        hv[k][h] = *(const u32x2*)(P.hA + (size_t)r * DM + h * 256 + 4 * lane); so[k][h] = *(const u32x2*)(P.Pb + (size_t)r * NG1 + 3072 + h * 256 + 4 * lane);
      } }
#pragma unroll
    for (int k = 0; k < 2; ++k) { const int r = k ? r2 : row;
      if (k == 0 || has2) {
#pragma unroll
        for (int h = 0; h < 4; ++h) {
          const float ss = (s0[k][h][0] + s0[k][h][1]) + (s0[k][h][2] + s0[k][h][3]) + (s1[k][h][0] + s1[k][h][1]) + (s1[k][h][2] + s1[k][h][3]);
          const float rh = rsqrtf(ss * (1.0f / 256.0f) + 1e-6f);
          *(u32x2*)(P.xa + (size_t)r * DM + h * 256 + 4 * lane) = pack4(unpack4(so[k][h]) * unpack4(hv[k][h]) * gh[h] * rh);
        }
      } }
  }
}
__device__ __forceinline__ void final_rows(const Params& P, int bid, int G) {
  const int w = tidx() >> 6, lane = tidx() & 63;
  f32x4 gf[4];
#pragma unroll
  for (int i = 0; i < 4; ++i) gf[i] = *(const f32x4*)(P.g_final + 256 * i + 4 * lane);
  for (int row = bid * 8 + w; row < NT; row += 4 * G * 8) {
    f32x4 v[4][4]; u64 q[4]; int rr[4];
#pragma unroll
    for (int k = 0; k < 4; ++k) {
      const int r = row + k * G * 8; rr[k] = r < NT ? r : row;
      q[k] = P.ssA[rr[k]];
#pragma unroll
      for (int i = 0; i < 4; ++i) v[k][i] = *(const f32x4*)(P.X2 + (size_t)rr[k] * DM + 256 * i + 4 * lane);
    }
#pragma unroll
    for (int k = 0; k < 4; ++k) {
      if (k == 0 || row + k * G * 8 < NT) {
        const float rs = rs_of(q[k]);
        float* o = rr[k] < NP ? P.out + O_YP + (size_t)rr[k] * DM : P.out + O_YS + (size_t)(rr[k] - NP) * DM;
#pragma unroll
        for (int i = 0; i < 4; ++i) *(f32x4*)(o + 256 * i + 4 * lane) = v[k][i] * gf[i] * rs;
      }
    }
  }
}


#define XB_TMO      128
#define XB_XCNT(j)  (256  + 64 * (j))
#define XB_XSUB(j)  (1280 + 64 * (j))
#define XB_XGEN(j)  (2304 + 64 * (j))
#define XB_TOP      3328
#define XB_TOPGEN   3392
#define XCD_BAR_WORDS 3456
#define XB_SPIN_CAP (1u << 22)
__device__ __forceinline__ unsigned xb_ld(unsigned* p)              { return __hip_atomic_load(p, __ATOMIC_RELAXED, __HIP_MEMORY_SCOPE_AGENT); }
__device__ __forceinline__ unsigned xb_add(unsigned* p, unsigned v) { return __hip_atomic_fetch_add(p, v, __ATOMIC_RELAXED, __HIP_MEMORY_SCOPE_AGENT); }
__device__ __forceinline__ unsigned xb_xcc_id() { return (unsigned)__builtin_amdgcn_s_getreg((3 << 11) | 20) & 0xFu; }
#define XB_SPIN(cond, bar) do { unsigned _sp = 0; while (cond) { __builtin_amdgcn_s_sleep(1); \
    if ((++_sp & 255u) == 0u) { if (xb_ld(&(bar)[XB_TMO])) break; if (_sp > XB_SPIN_CAP) { atomicAdd(&(bar)[XB_TMO], 1u); break; } } } } while (0)
struct XcdBarrier { unsigned* bar; unsigned x; volatile LAS unsigned* st; };
__device__ __forceinline__ XcdBarrier xcd_barrier_post(unsigned* bar, volatile LAS unsigned* st) {
  XcdBarrier b; b.bar = bar; b.x = xb_xcc_id(); b.st = st;
  if (threadIdx.x == 0) (void)xb_add(&bar[XB_XCNT(b.x)], 1u);
  return b;
}
__device__ __forceinline__ void xcd_barrier_complete(unsigned* bar, unsigned x, unsigned& nloc, unsigned& nx) {
  const unsigned G = gridDim.x * gridDim.y * gridDim.z;
  unsigned sum, cnt, mine, sp = 0u;
  for (;;) {
    sum = 0u; cnt = 0u; mine = 0u;
#pragma unroll
    for (unsigned j = 0; j < 16; ++j) { const unsigned c = xb_ld(&bar[XB_XCNT(j)]); sum += c; cnt += (c > 0u) ? 1u : 0u; mine = (j == x) ? c : mine; }
    if (sum == G) break;
    __builtin_amdgcn_s_sleep(1);
    if ((++sp & 255u) == 0u) { if (xb_ld(&bar[XB_TMO])) break; if (sp > XB_SPIN_CAP) { atomicAdd(&bar[XB_TMO], 1u); break; } }
  }
  nloc = mine > 0u ? mine : 1u; nx = cnt > 0u ? cnt : 1u;
}
__device__ __forceinline__ void xcd_barrier(const XcdBarrier& b) {
  asm volatile("s_waitcnt vmcnt(0)" ::: "memory");
  __syncthreads();
  if (threadIdx.x == 0) {
    unsigned* bar = b.bar;
    __builtin_amdgcn_s_waitcnt(0);
    unsigned nloc = b.st[0], nx = b.st[1];
    if (nloc == 0u) { xcd_barrier_complete(bar, b.x, nloc, nx); b.st[0] = nloc; b.st[1] = nx; }
    const unsigned old = xb_add(&bar[XB_XSUB(b.x)], 1u);
    const unsigned gen = old / nloc;
    if (old + 1u == (gen + 1u) * nloc) {
      __builtin_amdgcn_fence(__ATOMIC_RELEASE, "agent");
      asm volatile("s_waitcnt vmcnt(0)" ::: "memory");
      const unsigned og = xb_add(&bar[XB_TOP], 1u);
      const unsigned tg = og / nx;
      if (og + 1u == (tg + 1u) * nx) xb_add(&bar[XB_TOPGEN], 1u);
      else XB_SPIN(xb_ld(&bar[XB_TOPGEN]) == tg, bar);
      __builtin_amdgcn_fence(__ATOMIC_ACQUIRE, "agent");
      xb_add(&bar[XB_XGEN(b.x)], 1u);
      asm volatile("s_waitcnt vmcnt(0)" ::: "memory");
    } else {
      XB_SPIN(xb_ld(&bar[XB_XGEN(b.x)]) == gen, bar);
      __builtin_amdgcn_fence(__ATOMIC_ACQUIRE, "agent");
      asm volatile("s_waitcnt vmcnt(0)" ::: "memory");
    }
  }
  __syncthreads();
}

__global__ void __launch_bounds__(512) mega(const Params P) {
  extern __shared__ __attribute__((aligned(16))) unsigned char shm[];
  cg::grid_group grid = cg::this_grid();
  LAS unsigned char* lds = (LAS unsigned char*)shm;
  const int bid = blockIdx.x, G = gridDim.x;

  volatile LAS unsigned* xst = (volatile LAS unsigned*)(lds + LDS_BYTES - 16);
  if (threadIdx.x == 0) { xst[0] = 0u; xst[1] = 0u; }
  if (bid == 0) for (int i = threadIdx.x; i < XCD_BAR_WORDS; i += 512) P.bar[i] = 0u;
  REP(1) prep_phase(P, shm, bid, G);
  grid.sync();
  const XcdBarrier xb = xcd_barrier_post(P.bar, xst);

  for (int l = 0; l < 2; ++l) {
    REP(2) {
      F1 f; f.bias = P.b_in + l * PTOT; f.Pb = P.Pb; f.rs = P.ssA; f.ss = nullptr;
      gemm_main_window(lds, P.xb, P.WinT[l], 4096, 1024, f, 0, bid, G);
      gemm_main_window(lds, P.xb, P.WinT[l] + (size_t)4608 * 1024, 2048, 1024, f, 4608, bid, G);
      skinny_run<F1, 2>(f, P.xb, 1024, P.WinT[l], NP, 1, NG1 / 16, bid, G, shm, 0);
      Fg fg; fg.bias = P.b_in + l * PTOT + 4096; fg.gat = P.gat; fg.rs = P.ssA; fg.ss = nullptr;
      REP(256) skinny_run(fg, P.xb, 1024, P.WgT[l], 0, 129, 1, bid, G, shm, 0);
    }
    xcd_barrier(xb);
    { F1 f; f.bias = P.b_in + l * PTOT; f.Pb = P.Pb; f.rs = P.ssA; f.ss = nullptr;
      gemm_main_window(lds, P.xb, P.WinT[l] + (size_t)4096 * 1024, 512, 1024, f, 4096, bid, G); }
    {
      const int n1 = G == 256 ? (bid < 128 ? 1 : 3) : (512 - bid + G - 1) / G;
      for (int j = 0; j < n1; ++j) m1_item(P, G == 256 ? (bid < 128 ? bid : 128 + (bid - 128) * 3 + j) : bid + j * G, shm);
      for (int it = bid; it < 512; it += G) msample_item(P, l, it, shm);
      for (int it = bid; it < 256; it += G) s5_sample_item(P, l, it, shm);
    }
    xcd_barrier(xb);
    REP(8) for (int it = bid; it < 256; it += G) m2_item(P, l, G == 256 ? (((it & 7) * 4 + (it >> 6)) * 8 + ((it >> 3) & 7)) : it, shm);
    REP(16) for (int it = bid; it < 256; it += G) s5_stage3_item(P, l, G == 256 ? ((it & 7) * 32 + (it >> 3)) : it, shm);
    xcd_barrier(xb);
    REP(32) {
      Fglu f; f.bias = P.b_glu + l * 512; f.ysb = P.ysb; f.ys2 = P.ys2; f.ss = nullptr;
      gemm_all(lds, shm, P.ysb, P.WgluT[l], 512, 512, f, bid, G);
      headnorm_rows(P, l, bid, G);
    }
    xcd_barrier(xb);
    REP(32) {
      Fa fa; fa.Pb = P.Pb; fa.t1 = P.t1; fa.ss = nullptr;
      gemm_all(lds, shm, P.xa, P.WaT[l], 1024, 1024, fa, bid, G);
      Fb fb; fb.Pb = P.Pb; fb.t1 = P.t1; fb.mg = P.mg; fb.ss = nullptr;
      gemm_all(lds, shm, P.ys2, P.WbT[l], 1024, 512, fb, bid, G);
    }
    xcd_barrier(xb);
    REP(32) {
      Fres f; f.xinP = l == 0 ? P.x_prompt : P.X2; f.xinS = l == 0 ? P.x_sample : P.X2 + (size_t)NP * DM; f.xo = P.X1; f.xb = P.xb; f.ss = P.ssB;
      gemm_all(lds, shm, P.mg, P.WoT[l], 1024, 1024, f, bid, G);
    }
    xcd_barrier(xb);
    REP(64) {
      F13 f; f.rs = P.ssB; f.act = P.act;
      pg8::Gemm g; g.A = P.xb; g.Bt = P.W13T[l]; g.M = NP; g.N = 2 * DFF; g.K = 1024;
      pg8::StaticOrder S; S.init(NP, 2 * DFF, G, bid);
      EpiMain13 E; E.f = f;
      REP(512) pg8::gemm_phase(lds, g, S, E);
      REP(256) skinny_run13(f, P.xb, P.W13T[l], bid, G, shm);
    }
    xcd_barrier(xb);
    REP(64) {
      Fres f; f.xinP = P.X1; f.xinS = P.X1 + (size_t)NP * DM; f.xo = P.X2; f.xb = P.xb; f.ss = P.ssA;
      gemm_all(lds, shm, P.act, P.W2T[l], 1024, DFF, f, bid, G);
    }
    xcd_barrier(xb);
  }
  final_rows(P, bid, G);
}

extern "C" void kernel_launch(void* const* d_in, const int* in_sizes, int n_in, void* d_out, int out_size, void* d_ws, size_t ws_size, hipStream_t stream) {
  constexpr size_t kDynLds = LDS_BYTES;
  static int grid_blocks = 0;
  if (!grid_blocks) {
    int dev = 0, cus = 0, per_cu = 0;
    (void)hipGetDevice(&dev);
    (void)hipDeviceGetAttribute(&cus, hipDeviceAttributeMultiprocessorCount, dev);
    (void)hipFuncSetAttribute((const void*)mega, hipFuncAttributeMaxDynamicSharedMemorySize, (int)kDynLds);
    (void)hipOccupancyMaxActiveBlocksPerMultiprocessor(&per_cu, mega, 512, kDynLds);
    if (per_cu > 1) per_cu = 1;
    grid_blocks = cus * per_cu;
    if (grid_blocks > 256) grid_blocks = 256;
  }
  Params p;
  memset(&p, 0, sizeof(p));
  const float* const* in = (const float* const*)d_in;
  p.x_prompt = in[0]; p.x_sample = in[1]; p.st_C = in[2]; p.st_n = in[3]; p.st_m = in[4]; p.st_sre = in[5]; p.st_sim = in[6];
  p.g_mix = in[7]; p.w_in = in[8]; p.b_in = in[9]; p.g_hn = in[10]; p.w_a = in[11]; p.A_re = in[12]; p.A_im = in[13]; p.log_dt = in[14];
  p.B_re = in[15]; p.B_im = in[16]; p.C_re = in[17]; p.C_im = in[18]; p.D_skip = in[19]; p.w_glu = in[20]; p.b_glu = in[21]; p.w_b = in[22]; p.w_out = in[23];
  p.g_ffn = in[24]; p.w_ff1 = in[25]; p.w_ff3 = in[26]; p.w_ff2 = in[27]; p.g_final = in[28];
  p.out = (float*)d_out;
  char* base = (char*)d_ws; size_t off = 0;
  auto alloc = [&](size_t bytes) { char* r = base + off; off += (bytes + 255) & ~(size_t)255; return r; };
  for (int l = 0; l < 2; ++l) {
    p.WinT[l] = (bf16_t*)alloc((size_t)NG1 * 1024 * 2); p.WgT[l] = (bf16_t*)alloc(16 * 1024 * 2); p.WgluT[l] = (bf16_t*)alloc(512 * 512 * 2);
    p.WaT[l] = (bf16_t*)alloc(1024 * 1024 * 2); p.WbT[l] = (bf16_t*)alloc(1024 * 512 * 2); p.WoT[l] = (bf16_t*)alloc(1024 * 1024 * 2);
    p.W13T[l] = (bf16_t*)alloc((size_t)2 * DFF * 1024 * 2); p.W2T[l] = (bf16_t*)alloc((size_t)1024 * DFF * 2);
    p.abar[l] = (float*)alloc(4096 * 4); p.bbar[l] = (float*)alloc(65536 * 4);
  }
  p.xb = (bf16_t*)alloc((size_t)NT * DM * 2); p.Pb = (bf16_t*)alloc((size_t)NT * NG1 * 2); p.St = (bf16_t*)alloc((size_t)512 * 16384 * 2);
  p.ysb = (bf16_t*)alloc((size_t)NT * 512 * 2); p.ys2 = (bf16_t*)alloc((size_t)NT * 512 * 2); p.xa = (bf16_t*)alloc((size_t)NT * DM * 2);
  p.mg = (bf16_t*)alloc((size_t)NT * DM * 2); p.act = (bf16_t*)alloc((size_t)NT * DFF * 2);
  p.X1 = (float*)alloc((size_t)NT * DM * 4); p.X2 = (float*)alloc((size_t)NT * DM * 4);
  p.ssA = (unsigned long long*)alloc((size_t)NT * 8); p.ssB = (unsigned long long*)alloc((size_t)NT * 8); p.bar = (unsigned*)alloc(XCD_BAR_WORDS * 4);
  for (int l = 0; l < 2; ++l) { p.Kt[l] = (bf16_t*)alloc(32 * 17 * 256 * 2); p.Gm[l] = (bf16_t*)alloc(32 * 32768 * 2); p.Hm[l] = (bf16_t*)alloc(32 * 32768 * 2); p.a16[l] = (float*)alloc(4096 * 4); }
  p.E2 = (float*)alloc((size_t)8 * 128 * 32 * 128 * 4);
  p.gat = (float*)alloc((size_t)NT * 8 * 4); p.hA = (bf16_t*)alloc((size_t)NT * DM * 2); p.hss = (float*)alloc((size_t)NT * 32 * 4);
  p.t1 = (bf16_t*)alloc((size_t)NT * DM * 2); p.Eend = (float*)alloc((size_t)2 * 524288 * 4);
  int nj = 0, tile0 = 0;
  auto job = [&](const float* src, const float* scale, bf16_t* dst, int ldn, int c0, int ncols, int K, int mode, int r0, int nwrite) {
    TJob& J = p.jobs[nj++]; J.src = src; J.scale = scale; J.dst = dst; J.ldn = ldn; J.c0 = c0; J.ncols = ncols; J.K = K; J.mode = mode; J.r0 = r0;
    J.tile0 = tile0; J.ntn = (ncols + 63) / 64; J.nwrite = nwrite; J.pad = 0; tile0 += J.ntn * (K / 64);
  };
  for (int l = 0; l < 2; ++l) {
    const float* win = p.w_in + (size_t)l * 1024 * PTOT; const float* gm = p.g_mix + l * 1024; const float* gf = p.g_ffn + l * 1024;
    job(win, gm, p.WinT[l], PTOT, 0, 4096, 1024, 0, 0, 4096);
    job(win, gm, p.WinT[l], PTOT, 4104, 512, 1024, 0, 4096, 512);
    job(win, gm, p.WinT[l], PTOT, 4616, 2048, 1024, 0, 4608, 2048);
    job(win, gm, p.WgT[l], PTOT, 4096, 8, 1024, 0, 0, 16);
    job(p.w_glu + (size_t)l * 512 * 512, nullptr, p.WgluT[l], 512, 0, 512, 512, 0, 0, 512);
    job(p.w_a + (size_t)l * 1024 * 1024, nullptr, p.WaT[l], 1024, 0, 1024, 1024, 0, 0, 1024);
    job(p.w_b + (size_t)l * 512 * 1024, nullptr, p.WbT[l], 1024, 0, 1024, 512, 0, 0, 1024);
    job(p.w_out + (size_t)l * 1024 * 1024, nullptr, p.WoT[l], 1024, 0, 1024, 1024, 0, 0, 1024);
    job(p.w_ff1 + (size_t)l * 1024 * DFF, gf, p.W13T[l], DFF, 0, DFF, 1024, 1, 0, DFF);
    job(p.w_ff3 + (size_t)l * 1024 * DFF, gf, p.W13T[l], DFF, 0, DFF, 1024, 2, 0, DFF);
    job(p.w_ff2 + (size_t)l * DFF * 1024, nullptr, p.W2T[l], 1024, 0, 1024, DFF, 0, 0, 1024);
  }
  p.njobs = nj; p.total_tiles = tile0;
  void* args[] = {&p};
  hipError_t e = hipLaunchCooperativeKernel((void*)mega, dim3(grid_blocks), dim3(512), args, kDynLds, stream);
  if (e != hipSuccess) fprintf(stderr, "cooperative launch failed: %s (grid %d)\n", hipGetErrorString(e), grid_blocks);
}
```

```cpp
#include <hip/hip_runtime.h>
#include <hip/hip_cooperative_groups.h>
#include <cstdio>
#include <cstring>
namespace cg = cooperative_groups;

#define LAS __attribute__((address_space(3)))
typedef unsigned short bf16_t;
typedef short bf16x8 __attribute__((ext_vector_type(8)));
typedef short bf16x4 __attribute__((ext_vector_type(4)));
typedef float f32x4 __attribute__((ext_vector_type(4)));
typedef unsigned u32x4 __attribute__((ext_vector_type(4)));
typedef unsigned u32x2 __attribute__((ext_vector_type(2)));

constexpr int NP = 16384, NS = 128, NT = 16512, DM = 1024, NG1 = 6656, DFF = 2816, PTOT = 6664;
constexpr int LDS_BYTES = 150 * 1024;
#ifndef DUPMASK
#define DUPMASK 0
#endif
#define REP(bit) for (int rep_ = 0; rep_ < ((DUPMASK & (bit)) ? 2 : 1); ++rep_)
constexpr size_t O_YP = 0, O_YS = 16777216, O_CP = 16908288, O_NP = 21102592, O_MP = 21118976, O_SRP = 21119040, O_SIP = 21151808,
                 O_CS = 21184576, O_NS = 88293440, O_MS = 88555584, O_SRS = 88556608, O_SIS = 89080896;

struct TJob { const float* src; const float* scale; bf16_t* dst; int ldn, c0, ncols, K, mode, r0, tile0, ntn, nwrite, pad; };

struct Params {
  const float *x_prompt, *x_sample, *st_C, *st_n, *st_m, *st_sre, *st_sim;
  const float *g_mix, *w_in, *b_in, *g_hn, *w_a, *A_re, *A_im, *log_dt, *B_re, *B_im, *C_re, *C_im, *D_skip, *w_glu, *b_glu, *w_b, *w_out,
      *g_ffn, *w_ff1, *w_ff3, *w_ff2, *g_final;
  float* out;
  bf16_t *WinT[2], *WgT[2], *WgluT[2], *WaT[2], *WbT[2], *WoT[2], *W13T[2], *W2T[2];
  float *abar[2], *bbar[2];
  bf16_t *xb, *Pb, *St, *ysb, *ys2, *xa, *mg, *act;
  float *X1, *X2, *gat, *hss, *Eend; bf16_t *hA, *t1;
  unsigned long long *ssA, *ssB;
  unsigned* bar;
  bf16_t *Kt[2], *Gm[2], *Hm[2]; float *a16[2], *E2;
  TJob jobs[22];
  int njobs, total_tiles;
};

__device__ __forceinline__ bf16_t f2bf(float f) { return __builtin_bit_cast(bf16_t, (__bf16)f); }
__device__ __forceinline__ float bf2f(unsigned b) { return __uint_as_float(b << 16); }
typedef float f32x2 __attribute__((ext_vector_type(2)));
typedef __bf16 bf16x2v __attribute__((ext_vector_type(2)));
__device__ __forceinline__ unsigned pack2(float lo, float hi) { const f32x2 v = {lo, hi}; const bf16x2v b = __builtin_convertvector(v, bf16x2v); return __builtin_bit_cast(unsigned, b); }
__device__ __forceinline__ u32x2 pack4(f32x4 v) { u32x2 r; r.x = pack2(v[0], v[1]); r.y = pack2(v[2], v[3]); return r; }
__device__ __forceinline__ f32x4 unpack4(u32x2 u) { f32x4 r; r[0] = bf2f(u.x & 0xffffu); r[1] = bf2f(u.x >> 16); r[2] = bf2f(u.y & 0xffffu); r[3] = bf2f(u.y >> 16); return r; }
__device__ __forceinline__ float sigmoidf_(float x) { return __builtin_amdgcn_rcpf(1.0f + __expf(-x)); }
__device__ __forceinline__ float gelu_tanh(float x) { float z = 0.7978845608f * (x + 0.044715f * x * x * x); float e = __expf(2.0f * z); float th = 1.0f - 2.0f * __builtin_amdgcn_rcpf(e + 1.0f); return 0.5f * x * (1.0f + th); }
__device__ __forceinline__ int tidx() { int t = threadIdx.x; asm volatile("" : "+v"(t)); return t; }
#define LDS_BARRIER() do { asm volatile("s_waitcnt lgkmcnt(0)" ::: "memory"); __builtin_amdgcn_s_barrier(); asm volatile("" ::: "memory"); } while (0)
__device__ __forceinline__ float wave_sum(float v) { for (int o = 32; o > 0; o >>= 1) v += __shfl_xor(v, o); return v; }

namespace pg8 {
constexpr int BM = 256, BK = 64, HALF = 128, HTB = HALF * BK * 2, STAGE_BYTES = 8 * HTB, NXCD = 8, WGM = 8;
__host__ __device__ __forceinline__ int lds_byte(int r, int c) { const int st = (r >> 4) * 2 + (c >> 5), rr = r & 15, cc = c & 31, ob = rr * 64 + cc * 2; return st * 1024 + (ob ^ (((ob >> 9) & 1) << 5)); }
__host__ __device__ __forceinline__ void stage_rc(int b, int& R, int& C) { const int st = b / 1024, sb = b % 1024, swz = sb ^ (((sb >> 9) & 1) << 5); R = (st >> 1) * 16 + swz / 64; C = (st & 1) * 32 + (swz % 64) / 2; }
__host__ __device__ __forceinline__ int perm32(int rho) { const int n = rho >> 4, i = rho & 15; return 8 * (i >> 2) + 4 * n + (i & 3); }
struct Unit { int pm, pn; };
struct Gemm { const bf16_t* A; const bf16_t* Bt; int M, N, K; };
struct StaticOrder {
  int nM, nN, nwg, G, c;
  __device__ void init(int M, int N, int G_, int c_) { nM = M / BM; nN = N / BM; nwg = nM * nN; G = G_; c = c_; }
  __device__ bool next(int i, Unit& u) const {
    const long L = (long)i * G + c; if (L >= nwg) return false;
    int wgid = (int)L; { const int q = nwg / NXCD, r = nwg % NXCD, xcd = wgid % NXCD, off = wgid / NXCD; wgid = (xcd < r ? xcd * (q + 1) : r * (q + 1) + (xcd - r) * q) + off; }
    const int nig = WGM * nN, gid = wgid / nig, fm = gid * WGM, gsz = (nM - fm) < WGM ? (nM - fm) : WGM;
    u.pm = fm + ((wgid % nig) % gsz); u.pn = (wgid % nig) / gsz; return true;
  }
};

template <class Epi, class Sched>
__device__ __forceinline__ void gemm_phase(LAS unsigned char* lds, const Gemm g, const Sched& S, const Epi& E) {
  const int tid = tidx(), wid = __builtin_amdgcn_readfirstlane(tid >> 6), lane = tid & 63, wr = wid >> 2, wc = wid & 3, fr = lane & 15, fq = lane >> 4;
  const int K = g.K, nt = K / BK;
  unsigned voffA[2], voffB[2];
#pragma unroll
  for (int i = 0; i < 2; ++i) { int R, C; stage_rc(tid * 16 + i * 8192, R, C); voffA[i] = (unsigned)(R * K + C) * 2u; const int Rb = Epi::PERM ? ((R & ~31) + perm32(R & 31)) : R; voffB[i] = (unsigned)(Rb * K + C) * 2u; }
  const size_t kstep = (size_t)(BK * 2);
  const size_t hstep = (size_t)HALF * K * 2;
  const size_t tstep = 2 * hstep;
  const unsigned ldsw = (unsigned)wid * 1024u;
  const int aoff = lds_byte(wr * 64 + fr, fq * 8), boff = lds_byte(wc * 32 + fr, fq * 8);
#define PG8_SA(b, h) (((b) * 2 + (h)) * HTB)
#define PG8_SB(b, h) ((4 + (b) * 2 + (h)) * HTB)
#define PG8_STAGE(bufoff, gbase, voff) do { _Pragma("unroll") for (int _i = 0; _i < 2; ++_i) \
    __builtin_amdgcn_global_load_lds((const unsigned*)((const char*)(gbase) + (voff)[_i]), (LAS unsigned*)(lds + (bufoff) + ldsw + _i * 8192), 16, 0, 0); } while (0)
#define PG8_LDA(dst, b, h) do { _Pragma("unroll") for (int m = 0; m < 4; ++m) _Pragma("unroll") for (int k = 0; k < 2; ++k) dst[m][k] = *(const LAS bf16x8*)(lds + PG8_SA(b, h) + aoff + m * 2048 + k * 1024); } while (0)
#define PG8_LDB(dst, b, h) do { _Pragma("unroll") for (int n = 0; n < 2; ++n) _Pragma("unroll") for (int k = 0; k < 2; ++k) dst[n][k] = *(const LAS bf16x8*)(lds + PG8_SB(b, h) + boff + n * 2048 + k * 1024); } while (0)
#define PG8_MMA(ai, bj, At, Bt) do { __builtin_amdgcn_s_setprio(1); _Pragma("unroll") for (int m = 0; m < 4; ++m) _Pragma("unroll") for (int n = 0; n < 2; ++n) _Pragma("unroll") for (int k = 0; k < 2; ++k) \
    acc[ai][bj][m][n] = __builtin_amdgcn_mfma_f32_16x16x32_bf16(Bt[n][k], At[m][k], acc[ai][bj][m][n], 0, 0, 0); __builtin_amdgcn_s_setprio(0); } while (0)
#define PG8_WAIT_V(n) asm volatile("s_waitcnt vmcnt(" #n ")" ::: "memory")
#define PG8_WAIT_L(n) asm volatile("s_waitcnt lgkmcnt(" #n ")" ::: "memory")
#define PG8_BAR __builtin_amdgcn_s_barrier()
#define PG8_SCHED __builtin_amdgcn_sched_barrier(0)
  Unit cur, nxt; int ui = 0;
  if (!S.next(0, cur)) return;
  f32x4 acc[2][2][4][2];
#pragma unroll
  for (int a = 0; a < 2; ++a)
#pragma unroll
    for (int b = 0; b < 2; ++b)
#pragma unroll
      for (int m = 0; m < 4; ++m)
#pragma unroll
        for (int n = 0; n < 2; ++n) acc[a][b][m][n] = (f32x4){0.f, 0.f, 0.f, 0.f};
  bf16x8 At[4][2], B0[2][2], B1[2][2];
  const char* cA = (const char*)g.A + (size_t)cur.pm * tstep; const char* cB = (const char*)g.Bt + (size_t)cur.pn * tstep;
  PG8_STAGE(PG8_SB(0, 0), cB, voffB); PG8_STAGE(PG8_SA(0, 0), cA, voffA); PG8_STAGE(PG8_SB(0, 1), cB + hstep, voffB); PG8_STAGE(PG8_SA(0, 1), cA + hstep, voffA);
  if (wr == 1) PG8_BAR;
  PG8_WAIT_V(4); PG8_BAR;
  PG8_STAGE(PG8_SB(1, 0), cB + kstep, voffB); PG8_STAGE(PG8_SA(1, 0), cA + kstep, voffA); PG8_STAGE(PG8_SB(1, 1), cB + hstep + kstep, voffB);
  PG8_WAIT_V(6); PG8_BAR;
  for (;;) {
    const bool has_next = S.next(ui + 1, nxt);
    const char* nA = has_next ? (const char*)g.A + (size_t)nxt.pm * tstep : cA; const char* nB = has_next ? (const char*)g.Bt + (size_t)nxt.pn * tstep : cB;
    for (int t = 0; t < nt; t += 2) {
      const bool last = (t == nt - 2);
      const char* a1 = cA + (size_t)(t + 1) * kstep;
      const char* a2 = last ? nA : cA + (size_t)(t + 2) * kstep; const char* b2 = last ? nB : cB + (size_t)(t + 2) * kstep;
      const char* a3 = a2 + kstep; const char* b3 = b2 + kstep;
      PG8_LDB(B0, 0, 0); PG8_SCHED; PG8_LDA(At, 0, 0); PG8_STAGE(PG8_SA(1, 1), a1 + hstep, voffA);
      PG8_WAIT_L(8); PG8_BAR; PG8_WAIT_L(0); PG8_MMA(0, 0, At, B0); PG8_BAR; PG8_SCHED;
      PG8_LDB(B1, 0, 1); PG8_STAGE(PG8_SB(0, 0), b2, voffB);
      PG8_BAR; PG8_WAIT_L(0); PG8_MMA(0, 1, At, B1); PG8_BAR;
      PG8_LDA(At, 0, 1); PG8_STAGE(PG8_SA(0, 0), a2, voffA);
      PG8_BAR; PG8_WAIT_L(0); PG8_MMA(1, 0, At, B0); PG8_BAR; PG8_SCHED;
      PG8_STAGE(PG8_SB(0, 1), b2 + hstep, voffB);
      PG8_WAIT_V(6); PG8_BAR; PG8_MMA(1, 1, At, B1); PG8_BAR;
      PG8_LDB(B0, 1, 0); PG8_SCHED; PG8_LDA(At, 1, 0); PG8_STAGE(PG8_SA(0, 1), a2 + hstep, voffA);
      PG8_WAIT_L(8); PG8_BAR; PG8_WAIT_L(0); PG8_MMA(0, 0, At, B0); PG8_BAR; PG8_SCHED;
      PG8_LDB(B1, 1, 1); PG8_STAGE(PG8_SB(1, 0), b3, voffB);
      PG8_BAR; PG8_WAIT_L(0); PG8_MMA(0, 1, At, B1); PG8_BAR;
      PG8_LDA(At, 1, 1); PG8_STAGE(PG8_SA(1, 0), a3, voffA);
      PG8_BAR; PG8_WAIT_L(0); PG8_MMA(1, 0, At, B0); PG8_BAR; PG8_SCHED;
      PG8_STAGE(PG8_SB(1, 1), b3 + hstep, voffB);
      PG8_WAIT_V(6); PG8_BAR; PG8_MMA(1, 1, At, B1); PG8_BAR;
    }
    E(acc, cur, wr, wc, fr, fq);
    if (!has_next) break;
#pragma unroll
    for (int a = 0; a < 2; ++a)
#pragma unroll
      for (int b = 0; b < 2; ++b)
#pragma unroll
        for (int m = 0; m < 4; ++m)
#pragma unroll
          for (int n = 0; n < 2; ++n) acc[a][b][m][n] = (f32x4){0.f, 0.f, 0.f, 0.f};
    cur = nxt; cA = nA; cB = nB; ++ui;
  }
  PG8_WAIT_V(0);
  if (wr == 0) PG8_BAR;
  PG8_BAR;
#undef PG8_SA
#undef PG8_SB
#undef PG8_STAGE
#undef PG8_LDA
#undef PG8_LDB
#undef PG8_MMA
#undef PG8_WAIT_V
#undef PG8_WAIT_L
#undef PG8_BAR
#undef PG8_SCHED
}
}

typedef unsigned long long u64;
__device__ __forceinline__ u64 ss_fix(float ss) { return (u64)(ss * 16777216.0f); }
__device__ __forceinline__ float rs_of(u64 q) { const float f = (float)(unsigned)(q >> 32) * 4294967296.0f + (float)(unsigned)q; return rsqrtf(f * (1.0f / (16777216.0f * 1024.0f)) + 1e-6f); }
__device__ __forceinline__ void ss_add(u64* p, float ss) { __hip_atomic_fetch_add(p, ss_fix(ss), __ATOMIC_RELAXED, __HIP_MEMORY_SCOPE_AGENT); }
__device__ __forceinline__ int qcol(int cbase, int q) { return cbase + (q >> 1) * 128 + (q & 1) * 16; }
__device__ __forceinline__ f32x4 unlo(u32x4 u) { return unpack4((u32x2){u[0], u[1]}); }
__device__ __forceinline__ f32x4 unhi(u32x4 u) { return unpack4((u32x2){u[2], u[3]}); }
__device__ __forceinline__ u32x4 pack8(f32x4 a, f32x4 b) { const u32x2 p = pack4(a), q = pack4(b); return (u32x4){p.x, p.y, q.x, q.y}; }
struct F1 {
  static constexpr bool NEEDR = true, STAT = false, PERM = true; static constexpr int RB = 8;
  const float* bias; bf16_t* Pb; const u64* rs; u64* ss;
  struct ColData { f32x4 b[4]; }; struct RowData { u64 s; };
  __device__ __forceinline__ void load_cols(int cbase, ColData& cd) const {
#pragma unroll
    for (int q = 0; q < 4; ++q) { const int col = cbase + (q >> 1) * 128 + (q & 1) * 4; cd.b[q] = *(const f32x4*)(bias + (col < 4096 ? col : col + 8)); } }
  __device__ __forceinline__ void load_row(int row, int, RowData& rd) const { rd.s = rs[row]; }
  __device__ __forceinline__ float apply(int row, int cbase, const f32x4 (&v)[4], const ColData& cd, const RowData& rd) const {
    const float r = rs_of(rd.s);
    const int blk = cbase >> 8;
    const bool isk = blk >= 4 && blk < 8, issig = (blk >= 12 && blk < 16) || blk >= 18;
#pragma unroll
    for (int bj = 0; bj < 2; ++bj) {
      u32x4 pk;
#pragma unroll
      for (int n = 0; n < 2; ++n) {
        f32x4 o = v[bj * 2 + n] * r + cd.b[bj * 2 + n];
        if (isk) o = o * 0.0625f;
        else if (issig) { o[0] = sigmoidf_(o[0]); o[1] = sigmoidf_(o[1]); o[2] = sigmoidf_(o[2]); o[3] = sigmoidf_(o[3]); }
        const u32x2 p2 = pack4(o); pk[2 * n] = p2.x; pk[2 * n + 1] = p2.y;
      }
      *(u32x4*)(Pb + (size_t)row * NG1 + cbase + bj * 128) = pk;
    }
    return 0.f;
  }
  __device__ __forceinline__ float rowscale(int row) const { return rs_of(rs[row]); }
  __device__ __forceinline__ float operator()(int row, int col, f32x4 v, float r) const {
    const int bi = col < 4096 ? col : col + 8;
    const f32x4 b4 = *(const f32x4*)(bias + bi);
    f32x4 o = v * r + b4;
    if (col >= 1024 && col < 2048) o = o * 0.0625f;
    else if ((col >= 3072 && col < 4096) || col >= 4608) { o[0] = sigmoidf_(o[0]); o[1] = sigmoidf_(o[1]); o[2] = sigmoidf_(o[2]); o[3] = sigmoidf_(o[3]); }
    *(u32x2*)(Pb + (size_t)row * NG1 + col) = pack4(o);
    return 0.f;
  }
};
struct Fg {
  static constexpr bool NEEDR = true, STAT = false;
  const float* bias; float* gat; const u64* rs; u64* ss;
  __device__ __forceinline__ float rowscale(int row) const { return rs_of(rs[row]); }
  __device__ __forceinline__ float operator()(int row, int col, f32x4 v, float r) const {
    if (col < 8) {
      const f32x4 b4 = *(const f32x4*)(bias + col);
      f32x4 o = v * r + b4;
      if (col >= 4) {
#pragma unroll
        for (int i = 0; i < 4; ++i) { const float x = o[i]; o[i] = fminf(x, 0.f) - log1pf(__expf(-fabsf(x))); }
      }
      *(f32x4*)(gat + (size_t)row * 8 + col) = o;
    }
    return 0.f;
  }
};
struct Fglu {
  static constexpr bool NEEDR = false, STAT = false, PERM = true; static constexpr int RB = 8;
  const float* bias; const bf16_t* ysb; bf16_t* ys2; u64* ss;
  struct ColData { f32x4 b[4]; }; struct RowData { u32x4 y[2]; };
  __device__ __forceinline__ void load_cols(int cbase, ColData& cd) const {
#pragma unroll
    for (int q = 0; q < 4; ++q) cd.b[q] = *(const f32x4*)(bias + cbase + (q >> 1) * 128 + (q & 1) * 4); }
  __device__ __forceinline__ void load_row(int row, int cbase, RowData& rd) const {
#pragma unroll
    for (int bj = 0; bj < 2; ++bj) rd.y[bj] = *(const u32x4*)(ysb + (size_t)row * 512 + cbase + bj * 128); }
  __device__ __forceinline__ float apply(int row, int cbase, const f32x4 (&v)[4], const ColData& cd, const RowData& rd) const {
#pragma unroll
    for (int bj = 0; bj < 2; ++bj) {
      const f32x4 y0 = unlo(rd.y[bj]), y1 = unhi(rd.y[bj]); f32x4 o0, o1;
#pragma unroll
      for (int i = 0; i < 4; ++i) { o0[i] = y0[i] * sigmoidf_(v[bj * 2][i] + cd.b[bj * 2][i]); o1[i] = y1[i] * sigmoidf_(v[bj * 2 + 1][i] + cd.b[bj * 2 + 1][i]); }
      *(u32x4*)(ys2 + (size_t)row * 512 + cbase + bj * 128) = pack8(o0, o1);
    }
    return 0.f;
  }
  struct Pre { f32x4 b; u32x2 y; };
  __device__ __forceinline__ Pre pre(int row, int col) const { Pre p; p.b = *(const f32x4*)(bias + col); p.y = *(const u32x2*)(ysb + (size_t)row * 512 + col); return p; }
  __device__ __forceinline__ float post(int row, int col, f32x4 v, const Pre& p) const {
    const f32x4 y = unpack4(p.y); f32x4 o;
#pragma unroll
    for (int i = 0; i < 4; ++i) o[i] = y[i] * sigmoidf_(v[i] + p.b[i]);
    *(u32x2*)(ys2 + (size_t)row * 512 + col) = pack4(o); return 0.f; }
  __device__ __forceinline__ float rowscale(int) const { return 1.f; }
  __device__ __forceinline__ float operator()(int row, int col, f32x4 v, float) const {
    const f32x4 b4 = *(const f32x4*)(bias + col);
    const f32x4 y = unpack4(*(const u32x2*)(ysb + (size_t)row * 512 + col));
    f32x4 o;
#pragma unroll
    for (int i = 0; i < 4; ++i) o[i] = y[i] * sigmoidf_(v[i] + b4[i]);
    *(u32x2*)(ys2 + (size_t)row * 512 + col) = pack4(o);
    return 0.f;
  }
};
struct Fa {
  static constexpr bool NEEDR = false, STAT = false, PERM = true; static constexpr int RB = 8;
  const bf16_t* Pb; bf16_t* t1; u64* ss;
  struct ColData { int dummy; }; struct RowData { u32x4 g[2]; };
  __device__ __forceinline__ void load_cols(int, ColData&) const {}
  __device__ __forceinline__ void load_row(int row, int cbase, RowData& rd) const {
#pragma unroll
    for (int bj = 0; bj < 2; ++bj) rd.g[bj] = *(const u32x4*)(Pb + (size_t)row * NG1 + 4608 + cbase + bj * 128); }
  __device__ __forceinline__ float apply(int row, int cbase, const f32x4 (&v)[4], const ColData&, const RowData& rd) const {
#pragma unroll
    for (int bj = 0; bj < 2; ++bj) *(u32x4*)(t1 + (size_t)row * DM + cbase + bj * 128) = pack8(unlo(rd.g[bj]) * v[bj * 2], unhi(rd.g[bj]) * v[bj * 2 + 1]);
    return 0.f;
  }
  struct Pre { u32x2 g; };
  __device__ __forceinline__ Pre pre(int row, int col) const { Pre p; p.g = *(const u32x2*)(Pb + (size_t)row * NG1 + 4608 + col); return p; }
  __device__ __forceinline__ float post(int row, int col, f32x4 v, const Pre& p) const { *(u32x2*)(t1 + (size_t)row * DM + col) = pack4(unpack4(p.g) * v); return 0.f; }
  __device__ __forceinline__ float rowscale(int) const { return 1.f; }
  __device__ __forceinline__ float operator()(int row, int col, f32x4 v, float) const {
    const f32x4 sg = unpack4(*(const u32x2*)(Pb + (size_t)row * NG1 + 4608 + col));
    *(u32x2*)(t1 + (size_t)row * DM + col) = pack4(sg * v);
    return 0.f;
  }
};
struct Fb {
  static constexpr bool NEEDR = false, STAT = false, PERM = true; static constexpr int RB = 4;
  const bf16_t* Pb; const bf16_t* t1; bf16_t* mg; u64* ss;
  struct ColData { int dummy; }; struct RowData { u32x4 g[2]; u32x4 t[2]; };
  __device__ __forceinline__ void load_cols(int, ColData&) const {}
  __device__ __forceinline__ void load_row(int row, int cbase, RowData& rd) const {
#pragma unroll
    for (int bj = 0; bj < 2; ++bj) { rd.g[bj] = *(const u32x4*)(Pb + (size_t)row * NG1 + 5632 + cbase + bj * 128); rd.t[bj] = *(const u32x4*)(t1 + (size_t)row * DM + cbase + bj * 128); } }
  __device__ __forceinline__ float apply(int row, int cbase, const f32x4 (&v)[4], const ColData&, const RowData& rd) const {
#pragma unroll
    for (int bj = 0; bj < 2; ++bj) *(u32x4*)(mg + (size_t)row * DM + cbase + bj * 128) = pack8(unlo(rd.t[bj]) + unlo(rd.g[bj]) * v[bj * 2], unhi(rd.t[bj]) + unhi(rd.g[bj]) * v[bj * 2 + 1]);
    return 0.f;
  }
  struct Pre { u32x2 g; u32x2 t; };
  __device__ __forceinline__ Pre pre(int row, int col) const { Pre p; p.g = *(const u32x2*)(Pb + (size_t)row * NG1 + 5632 + col); p.t = *(const u32x2*)(t1 + (size_t)row * DM + col); return p; }
  __device__ __forceinline__ float post(int row, int col, f32x4 v, const Pre& p) const { *(u32x2*)(mg + (size_t)row * DM + col) = pack4(unpack4(p.t) + unpack4(p.g) * v); return 0.f; }
  __device__ __forceinline__ float rowscale(int) const { return 1.f; }
  __device__ __forceinline__ float operator()(int row, int col, f32x4 v, float) const {
    const f32x4 sg = unpack4(*(const u32x2*)(Pb + (size_t)row * NG1 + 5632 + col));
    const f32x4 t = unpack4(*(const u32x2*)(t1 + (size_t)row * DM + col));
    *(u32x2*)(mg + (size_t)row * DM + col) = pack4(t + sg * v);
    return 0.f;
  }
};
struct Fres {
  static constexpr bool NEEDR = false, STAT = true, PERM = true; static constexpr int RB = 4;
  const float *xinP, *xinS; float* xo; bf16_t* xb; u64* ss;
  struct ColData { int dummy; }; struct RowData { f32x4 x[4]; };
  __device__ __forceinline__ void load_cols(int, ColData&) const {}
  __device__ __forceinline__ void load_row(int row, int cbase, RowData& rd) const {
#pragma unroll
    for (int q = 0; q < 4; ++q) rd.x[q] = *(const f32x4*)(xinP + (size_t)row * DM + cbase + (q >> 1) * 128 + (q & 1) * 4); }
  __device__ __forceinline__ float apply(int row, int cbase, const f32x4 (&v)[4], const ColData&, const RowData& rd) const {
    float s = 0.f;
#pragma unroll
    for (int bj = 0; bj < 2; ++bj) {
      const f32x4 o0 = rd.x[bj * 2] + v[bj * 2], o1 = rd.x[bj * 2 + 1] + v[bj * 2 + 1];
      float* xp = xo + (size_t)row * DM + cbase + bj * 128;
      *(f32x4*)xp = o0; *(f32x4*)(xp + 4) = o1;
      const u32x2 p0 = pack4(o0), p1 = pack4(o1);
      *(u32x4*)(xb + (size_t)row * DM + cbase + bj * 128) = (u32x4){p0.x, p0.y, p1.x, p1.y};
      s += (o0[0] * o0[0] + o0[1] * o0[1]) + (o0[2] * o0[2] + o0[3] * o0[3]) + (o1[0] * o1[0] + o1[1] * o1[1]) + (o1[2] * o1[2] + o1[3] * o1[3]);
    }
    return s;
  }
  struct Pre { f32x4 x; };
  __device__ __forceinline__ Pre pre(int row, int col) const { Pre p; const float* xi = row < NP ? xinP + (size_t)row * DM : xinS + (size_t)(row - NP) * DM; p.x = *(const f32x4*)(xi + col); return p; }
  __device__ __forceinline__ float post(int row, int col, f32x4 v, const Pre& p) const {
    const f32x4 o = p.x + v;
    *(f32x4*)(xo + (size_t)row * DM + col) = o; *(u32x2*)(xb + (size_t)row * DM + col) = pack4(o);
    return (o[0] * o[0] + o[1] * o[1]) + (o[2] * o[2] + o[3] * o[3]); }
  __device__ __forceinline__ float rowscale(int) const { return 1.f; }
  __device__ __forceinline__ float operator()(int row, int col, f32x4 v, float) const {
    const float* xi = row < NP ? xinP + (size_t)row * DM : xinS + (size_t)(row - NP) * DM;
    const f32x4 o = *(const f32x4*)(xi + col) + v;
    *(f32x4*)(xo + (size_t)row * DM + col) = o;
    *(u32x2*)(xb + (size_t)row * DM + col) = pack4(o);
    return (o[0] * o[0] + o[1] * o[1]) + (o[2] * o[2] + o[3] * o[3]);
  }
};
struct F13 {
  const u64* rs; bf16_t* act;
  __device__ __forceinline__ float rowscale(int row) const { return rs_of(rs[row]); }
  __device__ __forceinline__ f32x4 glu(f32x4 a1, f32x4 a3, float r) const {
    f32x4 o;
#pragma unroll
    for (int i = 0; i < 4; ++i) { const float x1 = a1[i] * r, x3 = a3[i] * r; o[i] = x1 * sigmoidf_(x1) * x3; }
    return o;
  }
  __device__ __forceinline__ void pair(int row, int j, f32x4 a1, f32x4 a3, float r) const { *(u32x2*)(act + (size_t)row * DFF + j) = pack4(glu(a1, a3, r)); }
};

template <class F> struct EpiMain {
  static constexpr bool PERM = F::PERM;
  F f; int coff;
  __device__ __forceinline__ void operator()(const f32x4 (&acc)[2][2][4][2], const pg8::Unit& u, int wr, int wc, int fr, int fq) const {
    const int rbase = u.pm * 256 + wr * 64 + fr, cbase = coff + u.pn * 256 + wc * 32 + (F::PERM ? 8 : 4) * fq;
    typename F::ColData cd; f.load_cols(cbase, cd);
#pragma unroll
    for (int b0 = 0; b0 < 8; b0 += F::RB) {
      typename F::RowData rd[F::RB];
#pragma unroll
      for (int k = 0; k < F::RB; ++k) { const int i = b0 + k; f.load_row(rbase + (i >> 2) * 128 + (i & 3) * 16, cbase, rd[k]); }
      __builtin_amdgcn_sched_barrier(0);
#pragma unroll
      for (int k = 0; k < F::RB; ++k) {
        const int i = b0 + k, ai = i >> 2, m = i & 3, row = rbase + ai * 128 + m * 16;
        const f32x4 v[4] = {acc[ai][0][m][0], acc[ai][0][m][1], acc[ai][1][m][0], acc[ai][1][m][1]};
        float s = f.apply(row, cbase, v, cd, rd[k]);
        if (F::STAT) { s += __shfl_xor(s, 16); s += __shfl_xor(s, 32); if (fq == 0) ss_add(f.ss + row, s); }
      }
      __builtin_amdgcn_sched_barrier(0);
    }
  }
};
struct EpiMain13 {
  static constexpr bool PERM = true;
  F13 f;
  __device__ __forceinline__ void operator()(const f32x4 (&acc)[2][2][4][2], const pg8::Unit& u, int wr, int wc, int fr, int fq) const {
    const int rbase = u.pm * 256 + wr * 64 + fr, jbase = u.pn * 128 + wc * 32 + 8 * fq;
    u64 sq[8];
#pragma unroll
    for (int i = 0; i < 8; ++i) sq[i] = f.rs[rbase + (i >> 2) * 128 + (i & 3) * 16];
    __builtin_amdgcn_sched_barrier(0);
#pragma unroll
    for (int i = 0; i < 8; ++i) {
      const int ai = i >> 2, m = i & 3, row = rbase + ai * 128 + m * 16;
      const float r = rs_of(sq[i]);
      *(u32x4*)(f.act + (size_t)row * DFF + jbase) = pack8(f.glu(acc[ai][0][m][0], acc[ai][1][m][0], r), f.glu(acc[ai][0][m][1], acc[ai][1][m][1], r));
    }
  }
};

template <int NACC>
__device__ __forceinline__ void skinny_unit(const bf16_t* A, int K, const bf16_t* Bt, int row0, int brow0, int bstep, float* red, f32x4 (&out)[NACC]) {
  const int tid = tidx(), w = tid >> 6, lane = tid & 63, g4 = lane >> 4, l15 = lane & 15;
  const int nks = K >> 8, kbase = w * (K >> 3) + 8 * g4;
  f32x4 acc[8][NACC];
#pragma unroll
  for (int rt = 0; rt < 8; ++rt)
#pragma unroll
    for (int i = 0; i < NACC; ++i) acc[rt][i] = (f32x4){0.f, 0.f, 0.f, 0.f};
  const bf16_t* ap = A + (size_t)(row0 + l15) * K + kbase;
  const bf16_t* bp = Bt + (size_t)(brow0 + l15) * K + kbase;
  for (int ks = 0; ks < nks; ks += 2) {
    const bool two = ks + 1 < nks;
    bf16x8 a0[8], a1[8], b0[NACC], b1[NACC];
#pragma unroll
    for (int rt = 0; rt < 8; ++rt) a0[rt] = *(const bf16x8*)(ap + (size_t)16 * rt * K + 32 * ks);
#pragma unroll
    for (int i = 0; i < NACC; ++i) b0[i] = *(const bf16x8*)(bp + (size_t)bstep * i * K + 32 * ks);
    if (two) {
#pragma unroll
      for (int rt = 0; rt < 8; ++rt) a1[rt] = *(const bf16x8*)(ap + (size_t)16 * rt * K + 32 * ks + 32);
#pragma unroll
      for (int i = 0; i < NACC; ++i) b1[i] = *(const bf16x8*)(bp + (size_t)bstep * i * K + 32 * ks + 32);
    }
#pragma unroll
    for (int rt = 0; rt < 8; ++rt)
#pragma unroll
      for (int i = 0; i < NACC; ++i) acc[rt][i] = __builtin_amdgcn_mfma_f32_16x16x32_bf16(b0[i], a0[rt], acc[rt][i], 0, 0, 0);
    if (two) {
#pragma unroll
      for (int rt = 0; rt < 8; ++rt)
#pragma unroll
        for (int i = 0; i < NACC; ++i) acc[rt][i] = __builtin_amdgcn_mfma_f32_16x16x32_bf16(b1[i], a1[rt], acc[rt][i], 0, 0, 0);
    }
  }
#pragma unroll
  for (int rt = 0; rt < 8; ++rt)
#pragma unroll
    for (int i = 0; i < NACC; ++i) *(f32x4*)(red + (size_t)(((w * 8 + rt) * NACC + i) * 64 + lane) * 4) = acc[rt][i];
  __syncthreads();
#pragma unroll
  for (int i = 0; i < NACC; ++i) {
    f32x4 t = (f32x4){0.f, 0.f, 0.f, 0.f};
#pragma unroll
    for (int ww = 0; ww < 8; ++ww) t += *(const f32x4*)(red + (size_t)(((ww * 8 + w) * NACC + i) * 64 + lane) * 4);
    out[i] = t;
  }
}
template <class F, int NA = 1>
__device__ __forceinline__ void skinny_run(const F& f, const bf16_t* A, int K, const bf16_t* Bt, int rowbase, int nrt, int ncu, int bid, int G, unsigned char* shm, int c0 = 0) {
  const int tid = tidx(), w = tid >> 6, lane = tid & 63, g = lane >> 4;
  const int ncu2 = ncu / NA, total = nrt * ncu2, nc = G - c0;
  if (bid < c0) return;
  for (int su = (G - 1 - bid); su < total; su += nc) {
    const int rt = su / ncu2, cu = su - rt * ncu2;
    const int row0 = rowbase + rt * 128, arow = row0 + 16 * w + (lane & 15);
    f32x4 acc[NA];
    const float rs = F::NEEDR ? f.rowscale(arow) : 1.f;
    skinny_unit<NA>(A, K, Bt, row0, 16 * NA * cu, 16, (float*)shm, acc);
#pragma unroll
    for (int i = 0; i < NA; ++i) {
      float ss = f(arow, 16 * (NA * cu + i) + 4 * g, acc[i], rs);
      if (F::STAT) { ss += __shfl_xor(ss, 16); ss += __shfl_xor(ss, 32); if (g == 0) ss_add(f.ss + arow, ss); }
    }
    __syncthreads();
  }
}
template <class F>
__device__ __forceinline__ void skinny_run_quarter(const F& f, const bf16_t* A, int K, const bf16_t* Bt, int ncu, int bid, int G, unsigned char* shm, int c0) {
  const int tid = tidx(), w = tid >> 6, lane = tid & 63, g4 = lane >> 4, l15 = lane & 15;
  const int total = 4 * ncu, nc = G - c0;
  if (bid < c0) return;
  float* red = (float*)shm;
  for (int su = (G - 1 - bid); su < total; su += nc) {
    const int cu = su >> 2, rq = su & 3, rt = w >> 2, kq = w & 3;
    const int arow = NP + 32 * rq + 16 * rt + l15;
    const int kspan = K >> 2, kbase = kq * kspan + 8 * g4;
    const bf16_t* ap = A + (size_t)arow * K + kbase;
    const bf16_t* bp = Bt + (size_t)(16 * cu + l15) * K + kbase;
    f32x4 acc = (f32x4){0.f, 0.f, 0.f, 0.f};
    typename F::Pre pre;
    if (kq == 0) pre = f.pre(arow, 16 * cu + 4 * g4);
    for (int k0 = 0; k0 < kspan; k0 += 256) {
      bf16x8 a[8], b[8];
#pragma unroll
      for (int s8 = 0; s8 < 8; ++s8) { if (k0 + 32 * s8 < kspan) { a[s8] = *(const bf16x8*)(ap + k0 + 32 * s8); b[s8] = *(const bf16x8*)(bp + k0 + 32 * s8); } }
#pragma unroll
      for (int s8 = 0; s8 < 8; ++s8) { if (k0 + 32 * s8 < kspan) acc = __builtin_amdgcn_mfma_f32_16x16x32_bf16(b[s8], a[s8], acc, 0, 0, 0); }
    }
    *(f32x4*)(red + (size_t)(w * 64 + lane) * 4) = acc;
    __syncthreads();
    if (kq == 0) {
      f32x4 t = acc;
#pragma unroll
      for (int q = 1; q < 4; ++q) t += *(const f32x4*)(red + (size_t)((w + q) * 64 + lane) * 4);
      float ss = f.post(arow, 16 * cu + 4 * g4, t, pre);
      if (F::STAT) { ss += __shfl_xor(ss, 16); ss += __shfl_xor(ss, 32); if (g4 == 0) ss_add(f.ss + arow, ss); }
    }
    __syncthreads();
  }
}
__device__ __forceinline__ void skinny_run13(const F13& f, const bf16_t* A, const bf16_t* Bt, int bid, int G, unsigned char* shm) {
  const int tid = tidx(), w = tid >> 6, lane = tid & 63, g = lane >> 4;
  const int c0 = ((NP / 256) * (2 * DFF / 256)) % G, nc = G - c0;
  if (bid < c0) return;
  for (int su = (G - 1 - bid); su < DFF / 16; su += nc) {
    const int arow = NP + 16 * w + (lane & 15);
    f32x4 acc[2];
    const float rs13 = f.rowscale(arow);
    skinny_unit<2>(A, 1024, Bt, NP, ((16 * su) >> 7) * 256 + ((16 * su) & 127), 128, (float*)shm, acc);
    f.pair(arow, 16 * su + 4 * g, acc[0], acc[1], rs13);
    __syncthreads();
  }
}
template <class F>
__device__ __forceinline__ void gemm_all(LAS unsigned char* lds, unsigned char* shm, const bf16_t* A, const bf16_t* Bt, int N, int K, const F& f, int bid, int G) {
  pg8::Gemm g; g.A = A; g.Bt = Bt; g.M = NP; g.N = N; g.K = K;
  pg8::StaticOrder S; S.init(NP, N, G, bid);
  EpiMain<F> E; E.f = f; E.coff = 0;
  REP(F::STAT ? 0 : 512) pg8::gemm_phase(lds, g, S, E);
  const int c0 = ((NP / 256) * (N / 256)) % G;
  if ((N / 16) * 2 <= G - c0) skinny_run_quarter(f, A, K, Bt, N / 16, bid, G, shm, c0);
  else skinny_run(f, A, K, Bt, NP, 1, N / 16, bid, G, shm, c0);
}

template <class F>
__device__ __forceinline__ void gemm_main_window(LAS unsigned char* lds, const bf16_t* A, const bf16_t* Bt, int N, int K, const F& f, int coff, int bid, int G) {
  pg8::Gemm g; g.A = A; g.Bt = Bt; g.M = NP; g.N = N; g.K = K;
  pg8::StaticOrder S; S.init(NP, N, G, bid);
  EpiMain<F> E; E.f = f; E.coff = coff;
  pg8::gemm_phase(lds, g, S, E);
}

__device__ __forceinline__ void prep_s5tables(const Params& P, int item, unsigned char* shm);
__device__ __forceinline__ void prep_phase(const Params& P, unsigned char* shm, int bid, int G) {
  const int tid = tidx(), w = tid >> 6, lane = tid & 63;
  bf16_t* T = (bf16_t*)shm;
  int jcur = 0;
  for (int t0 = 4 * bid; t0 < P.total_tiles; t0 += 4 * G) {
    f32x4 v0[4], v1[4]; float sc[4]; int jix[4];
    const int kk = tid >> 3, jq = tid & 7, nn = jq * 8;
#pragma unroll
    for (int u = 0; u < 4; ++u) {
      const int tile = t0 + u;
      v0[u] = (f32x4){0.f, 0.f, 0.f, 0.f}; v1[u] = v0[u]; sc[u] = 1.f;
      if (tile < P.total_tiles) {
        while (jcur + 1 < P.njobs && P.jobs[jcur + 1].tile0 <= tile) ++jcur;
        jix[u] = jcur;
        const TJob& J = P.jobs[jcur];
        const int lt = tile - J.tile0, tn = lt % J.ntn, tk = lt / J.ntn, k0 = tk * 64, n0 = tn * 64;
        if (n0 + nn < J.ncols) { const float* sp = J.src + (size_t)(k0 + kk) * J.ldn + J.c0 + n0 + nn; v0[u] = *(const f32x4*)sp; v1[u] = *(const f32x4*)(sp + 4); }
        if (J.scale) sc[u] = J.scale[k0 + kk];
      }
    }
#pragma unroll
    for (int u = 0; u < 4; ++u) {
      bf16_t* Tu = T + u * (64 * 72);
      const int kx = kk ^ (8 * jq);
#pragma unroll
      for (int i = 0; i < 4; ++i) { Tu[(nn + i) * 72 + kx] = f2bf(v0[u][i] * sc[u]); Tu[(nn + 4 + i) * 72 + kx] = f2bf(v1[u][i] * sc[u]); }
    }
    __syncthreads();
#pragma unroll
    for (int u = 0; u < 4; ++u) {
      const int tile = t0 + u;
      if (tile < P.total_tiles) {
        const TJob& J = P.jobs[jix[u]];
        const int lt = tile - J.tile0, tn = lt % J.ntn, tk = lt / J.ntn, k0 = tk * 64, n0 = tn * 64;
        const int n = tid >> 3, k8 = (tid & 7) * 8, gn = n0 + n;
        if (gn < J.nwrite) {
          const int dr = J.mode == 0 ? J.r0 + gn : ((gn >> 7) * 256 + (J.mode == 2 ? 128 : 0) + (gn & 127));
          *(u32x4*)(J.dst + (size_t)dr * J.K + k0 + k8) = *(const u32x4*)(T + u * (64 * 72) + n * 72 + (k8 ^ (8 * ((n >> 3) & 7))));
        }
      }
    }
    __syncthreads();
  }
  for (int i = bid * 512 + tid; i < 2 * 2048; i += G * 512) {
    const int l = i >> 11, gp = i & 2047, g = gp >> 6, p = gp & 63;
    const float dt = expf(P.log_dt[l * 32 + g]);
    const float Ar = P.A_re[l * 2048 + gp], Ai = P.A_im[l * 2048 + gp];
    const float mag = expf(dt * Ar);
    float sn, cs; sincosf(dt * Ai, &sn, &cs);
    const float abr = mag * cs, abi = mag * sn;
    const float den = Ar * Ar + Ai * Ai, nr = abr - 1.0f, ni = abi;
    const float fre = (nr * Ar + ni * Ai) / den, fim = (ni * Ar - nr * Ai) / den;
    P.abar[l][gp] = abr; P.abar[l][2048 + gp] = abi;
    for (int c = 0; c < 16; ++c) {
      const float Br = P.B_re[(size_t)l * 32768 + gp * 16 + c], Bi = P.B_im[(size_t)l * 32768 + gp * 16 + c];
      P.bbar[l][(g * 16 + c) * 64 + p] = fre * Br - fim * Bi;
      P.bbar[l][32768 + (g * 16 + c) * 64 + p] = fre * Bi + fim * Br;
    }
  }
  for (int it = bid; it < 256; it += G) prep_s5tables(P, it, shm);
  for (int row = bid * 8 + w; row < NT; row += 4 * G * 8) {
    f32x4 v[4][4]; int rr[4];
#pragma unroll
    for (int k = 0; k < 4; ++k) {
      const int r = row + k * G * 8; rr[k] = r < NT ? r : row;
      const float* xr = rr[k] < NP ? P.x_prompt + (size_t)rr[k] * DM : P.x_sample + (size_t)(rr[k] - NP) * DM;
#pragma unroll
      for (int i = 0; i < 4; ++i) v[k][i] = *(const f32x4*)(xr + 256 * i + 4 * lane);
    }
#pragma unroll
    for (int k = 0; k < 4; ++k) {
      if (k == 0 || row + k * G * 8 < NT) {
        float ss = 0.f;
#pragma unroll
        for (int i = 0; i < 4; ++i) {
          ss += (v[k][i][0] * v[k][i][0] + v[k][i][1] * v[k][i][1]) + (v[k][i][2] * v[k][i][2] + v[k][i][3] * v[k][i][3]);
          *(u32x2*)(P.xb + (size_t)rr[k] * DM + 256 * i + 4 * lane) = pack4(v[k][i]);
        }
        ss = wave_sum(ss);
        if (lane == 0) P.ssA[rr[k]] = ss_fix(ss);
      }
    }
  }
}

__device__ __forceinline__ void mlstm_scalars(const float* gat, int b, int h, float* sA, float* sM, float* sB, float* chain) {
  const int tid = tidx(), w = tid >> 6, lane = tid & 63;
  for (int cc = w; cc < 16; cc += 8) {
    const int t0 = cc * 128 + 2 * lane; const size_t r0 = (size_t)b * 2048 + t0;
    const float ig0 = gat[r0 * 8 + h], lf0 = gat[r0 * 8 + 4 + h], ig1 = gat[(r0 + 1) * 8 + h], lf1 = gat[(r0 + 1) * 8 + 4 + h];
    float x = lf0 + lf1;
    for (int off = 1; off < 64; off <<= 1) { const float y = __shfl_up(x, off); if (lane >= off) x += y; }
    const float b1 = x, b0 = x - lf1, a0 = ig0 - b0, a1 = ig1 - b1;
    float cm = fmaxf(a0, a1);
    for (int off = 1; off < 64; off <<= 1) { const float y = __shfl_up(cm, off); if (lane >= off) cm = fmaxf(cm, y); }
    const float prev = __shfl_up(cm, 1); const float cm0 = lane ? fmaxf(prev, a0) : a0;
    sB[t0] = b0; sB[t0 + 1] = b1; sA[t0] = a0; sA[t0 + 1] = a1; sM[t0] = cm0; sM[t0 + 1] = cm;
    if (lane == 63) { chain[33 + cc] = b1; chain[49 + cc] = cm; }
  }
  __syncthreads();
  if (tid == 0) { float m = 0.f; for (int cc = 0; cc < 16; ++cc) { chain[cc] = m; const float ml = fmaxf(m, chain[49 + cc]); chain[17 + cc] = ml; m = chain[33 + cc] + ml; } chain[16] = m; }
  __syncthreads();
  for (int t = tid; t < 2048; t += 512) sM[t] = fmaxf(chain[t >> 7], sM[t]);
  __syncthreads();
}

__device__ __forceinline__ void m1_item(const Params& P, int item, unsigned char* shm) {
  const int tid = tidx(), w = __builtin_amdgcn_readfirstlane(tid >> 6), lane = tid & 63, g = lane >> 4;
  const int b = item >> 6, h = (item >> 4) & 3, c = item & 15;
  float* sA = (float*)shm; float* sM = sA + 2048; float* sB = sM + 2048; float* chain = sB + 2048;
  mlstm_scalars(P.gat, b, h, sA, sM, sB, chain);
  const int row0 = b * 2048 + c * 128, t = 16 * w + (lane & 15);
  const bf16_t* qp = P.Pb + (size_t)(row0 + t) * NG1 + h * 256 + 8 * g;
  bf16x8 qf[8];
#pragma unroll
  for (int ks = 0; ks < 8; ++ks) qf[ks] = *(const bf16x8*)(qp + 32 * ks);
  const float Mt = sM[c * 128 + t];
  bf16_t* sp = P.St + (size_t)item * 16384 + t * 128;
#pragma unroll
  for (int sg = 0; sg < 8; sg += 4) {
    if (sg <= w) {
      bf16x8 kf[4][8];
#pragma unroll
      for (int u = 0; u < 4; ++u) {
        if (sg + u <= w) {
          const bf16_t* kp = P.Pb + (size_t)(row0 + 16 * (sg + u) + (lane & 15)) * NG1 + 1024 + h * 256 + 8 * g;
#pragma unroll
          for (int ks = 0; ks < 8; ++ks) kf[u][ks] = *(const bf16x8*)(kp + 32 * ks);
        }
      }
#pragma unroll
      for (int u = 0; u < 4; ++u) {
        const int st = sg + u;
        f32x4 acc = (f32x4){0.f, 0.f, 0.f, 0.f};
        if (st <= w) {
#pragma unroll
          for (int ks = 0; ks < 8; ++ks) acc = __builtin_amdgcn_mfma_f32_16x16x32_bf16(kf[u][ks], qf[ks], acc, 0, 0, 0);
#pragma unroll
          for (int r = 0; r < 4; ++r) { const int s2 = 16 * st + 4 * g + r; acc[r] = (s2 <= t) ? acc[r] * __expf(sA[c * 128 + s2] - Mt) : 0.f; }
        }
        *(u32x2*)(sp + 16 * st + 4 * g) = pack4(acc);
      }
    } else {
#pragma unroll
      for (int u = 0; u < 4; ++u) *(u32x2*)(sp + 16 * (sg + u) + 4 * g) = (u32x2){0u, 0u};
    }
  }
  __syncthreads();
}

__device__ __forceinline__ bf16x8 trread8(unsigned a0, unsigned a1) {
  bf16x4 lo, hi;
  asm volatile("ds_read_b64_tr_b16 %0, %2\n\tds_read_b64_tr_b16 %1, %3\n\ts_waitcnt lgkmcnt(0)" : "=&v"(lo), "=&v"(hi) : "v"(a0), "v"(a1) : "memory");
  return __builtin_shufflevector(lo, hi, 0, 1, 2, 3, 4, 5, 6, 7);
}
__device__ __forceinline__ void trread8x3(unsigned a0, unsigned a1, unsigned a2, unsigned dlt, bf16x8& r0, bf16x8& r1, bf16x8& r2) {
  bf16x4 l0, h0, l1, h1, l2, h2;
  asm volatile("ds_read_b64_tr_b16 %0, %6\n\tds_read_b64_tr_b16 %1, %7\n\tds_read_b64_tr_b16 %2, %8\n\tds_read_b64_tr_b16 %3, %9\n\tds_read_b64_tr_b16 %4, %10\n\tds_read_b64_tr_b16 %5, %11\n\ts_waitcnt lgkmcnt(0)"
               : "=&v"(l0), "=&v"(h0), "=&v"(l1), "=&v"(h1), "=&v"(l2), "=&v"(h2)
               : "v"(a0), "v"(a0 + dlt), "v"(a1), "v"(a1 + dlt), "v"(a2), "v"(a2 + dlt) : "memory");
  r0 = __builtin_shufflevector(l0, h0, 0, 1, 2, 3, 4, 5, 6, 7); r1 = __builtin_shufflevector(l1, h1, 0, 1, 2, 3, 4, 5, 6, 7); r2 = __builtin_shufflevector(l2, h2, 0, 1, 2, 3, 4, 5, 6, 7);
}
__device__ __forceinline__ void trread8x2(unsigned a0, unsigned a1, unsigned dlt, bf16x8& r0, bf16x8& r1) {
  bf16x4 l0, h0, l1, h1;
  asm volatile("ds_read_b64_tr_b16 %0, %4\n\tds_read_b64_tr_b16 %1, %5\n\tds_read_b64_tr_b16 %2, %6\n\tds_read_b64_tr_b16 %3, %7\n\ts_waitcnt lgkmcnt(0)"
               : "=&v"(l0), "=&v"(h0), "=&v"(l1), "=&v"(h1) : "v"(a0), "v"(a0 + dlt), "v"(a1), "v"(a1 + dlt) : "memory");
  r0 = __builtin_shufflevector(l0, h0, 0, 1, 2, 3, 4, 5, 6, 7); r1 = __builtin_shufflevector(l1, h1, 0, 1, 2, 3, 4, 5, 6, 7);
}

constexpr int KS_STRIDE = 272, VS_STRIDE = 56;
constexpr int M2_K = 0, M2_V = 69632, M2_CL = 83968, M2_SC = 110080;
__device__ __forceinline__ void m2_item(const Params& P, int l, int item, unsigned char* shm) {
  const int tid = tidx(), w = __builtin_amdgcn_readfirstlane(tid >> 6), lane = tid & 63, g = lane >> 4, l15 = lane & 15;
  const int bh = item >> 3, j = item & 7, b = bh >> 2, h = bh & 3;
  bf16_t* Ksh = (bf16_t*)(shm + M2_K); bf16_t* Vsh = (bf16_t*)(shm + M2_V); bf16_t* Cl = (bf16_t*)(shm + M2_CL);
  float* sA = (float*)(shm + M2_SC); float* sM = sA + 2048; float* sB = sM + 2048; float* chain = sB + 2048;
  const unsigned lbase = (unsigned)(size_t)shm;
  u32x4 kreg[8]; u32x4 vreg;
  const int vs = tid >> 2, vpc = tid & 3;
  {
    const int row0 = b * 2048;
#pragma unroll
    for (int i = 0; i < 8; ++i) { const int piece = tid + 512 * i, s = piece >> 5, pc = piece & 31; kreg[i] = *(const u32x4*)(P.Pb + (size_t)(row0 + s) * NG1 + 1024 + h * 256 + 8 * pc); }
    vreg = *(const u32x4*)(P.Pb + (size_t)(row0 + vs) * NG1 + 2048 + h * 256 + 32 * j + 8 * vpc);
  }
  bf16x8 qf[8], sf[4];
  {
    const int t = 16 * w + l15;
#pragma unroll
    for (int ks = 0; ks < 8; ++ks) qf[ks] = (bf16x8){0, 0, 0, 0, 0, 0, 0, 0};
    const bf16_t* sp0 = P.St + (size_t)(bh * 16) * 16384 + t * 128 + 8 * g;
#pragma unroll
    for (int ks = 0; ks < 4; ++ks) sf[ks] = *(const bf16x8*)(sp0 + 32 * ks);
  }
  mlstm_scalars(P.gat, b, h, sA, sM, sB, chain);
  f32x4 Cacc[2][3];
#pragma unroll
  for (int dt = 0; dt < 2; ++dt)
#pragma unroll
    for (int et = 0; et < 3; ++et) Cacc[dt][et] = (f32x4){0.f, 0.f, 0.f, 0.f};
  const int trq = l15 >> 2, trp = lane & 3;
#define M2_WRITE_KV(cc) do { \
    const float ml_ = chain[17 + (cc)]; \
    _Pragma("unroll") for (int i = 0; i < 8; ++i) { const int piece = tid + 512 * i, s = piece >> 5, pc = piece & 31; \
      const float wk = __expf(sA[(cc) * 128 + s] - ml_); u32x4 sc; \
      _Pragma("unroll") for (int e = 0; e < 4; ++e) { const unsigned u = kreg[i][e]; sc[e] = pack2(bf2f(u & 0xffffu) * wk, bf2f(u >> 16) * wk); } \
      *(u32x4*)(Ksh + s * KS_STRIDE + 8 * pc) = sc; } \
    *(u32x4*)(Vsh + vs * VS_STRIDE + 8 * vpc) = vreg; \
    if (vpc == 0) { unsigned zz = 0u; asm volatile("" : "+v"(zz)); const u32x4 z = (u32x4){zz, zz, zz, zz}; u32x4 o1 = z; o1[0] = 0x3F80u; \
      *(u32x4*)(Vsh + vs * VS_STRIDE + 32) = o1; *(u32x4*)(Vsh + vs * VS_STRIDE + 40) = z; } } while (0)
  M2_WRITE_KV(0);
  __syncthreads();
  for (int c = 0; c < 16; ++c) {
    const int row0 = b * 2048 + c * 128;
    const float mlast = chain[17 + c], mprev = chain[c];
    if (c < 15) {
      const int nrow0 = row0 + 128;
#pragma unroll
      for (int i = 0; i < 8; ++i) { const int piece = tid + 512 * i, s = piece >> 5, pc = piece & 31; kreg[i] = *(const u32x4*)(P.Pb + (size_t)(nrow0 + s) * NG1 + 1024 + h * 256 + 8 * pc); }
      vreg = *(const u32x4*)(P.Pb + (size_t)(nrow0 + vs) * NG1 + 2048 + h * 256 + 32 * j + 8 * vpc);
    }
    {
      const int t = 16 * w + l15, row = row0 + t;
      f32x4 acc[3]; acc[0] = (f32x4){0.f, 0.f, 0.f, 0.f}; acc[1] = acc[0]; acc[2] = acc[0];
      const float Mt = sM[c * 128 + t];
      if (c > 0) {
#pragma unroll
        for (int ks = 0; ks < 8; ++ks) {
          bf16x8 cf[3];
#pragma unroll
          for (int et = 0; et < 3; ++et) cf[et] = *(const bf16x8*)(Cl + (16 * et + l15) * KS_STRIDE + 32 * ks + 8 * g);
          __builtin_amdgcn_sched_barrier(0);
#pragma unroll
          for (int et = 0; et < 3; ++et) acc[et] = __builtin_amdgcn_mfma_f32_16x16x32_bf16(cf[et], qf[ks], acc[et], 0, 0, 0);
          __builtin_amdgcn_sched_barrier(0);
        }
        const float wi = __expf(mprev - Mt);
        acc[0] *= wi; acc[1] *= wi; acc[2] *= wi;
      }
      const float ac = __expf(mprev - mlast);
#pragma unroll
      for (int dt = 0; dt < 2; ++dt)
#pragma unroll
        for (int et = 0; et < 3; ++et) Cacc[dt][et] *= ac;
#pragma unroll
      for (int ks = 0; ks < 4; ++ks) {
        bf16x8 kf[2], vf[3];
        const unsigned va = lbase + M2_V + (unsigned)((32 * ks + 8 * g + trq) * VS_STRIDE + 4 * trp) * 2u;
        const unsigned ka = lbase + M2_K + (unsigned)((32 * ks + 8 * g + trq) * KS_STRIDE + 32 * w + 4 * trp) * 2u;
        trread8x3(va, va + 32u, va + 64u, 4u * VS_STRIDE * 2u, vf[0], vf[1], vf[2]);
        trread8x2(ka, ka + 32u, 4u * KS_STRIDE * 2u, kf[0], kf[1]);
#pragma unroll
        for (int et = 0; et < 3; ++et) acc[et] = __builtin_amdgcn_mfma_f32_16x16x32_bf16(vf[et], sf[ks], acc[et], 0, 0, 0);
#pragma unroll
        for (int dt = 0; dt < 2; ++dt)
#pragma unroll
          for (int et = 0; et < 3; ++et) Cacc[dt][et] = __builtin_amdgcn_mfma_f32_16x16x32_bf16(kf[dt], vf[et], Cacc[dt][et], 0, 0, 0);
      }
      if (c < 15) {
        const bf16_t* qp = P.Pb + (size_t)(row + 128) * NG1 + h * 256 + 8 * g;
#pragma unroll
        for (int ks = 0; ks < 8; ++ks) qf[ks] = *(const bf16x8*)(qp + 32 * ks);
        const bf16_t* sp = P.St + (size_t)(bh * 16 + c + 1) * 16384 + t * 128 + 8 * g;
#pragma unroll
        for (int ks = 0; ks < 4; ++ks) sf[ks] = *(const bf16x8*)(sp + 32 * ks);
      }
      const float den = __shfl(acc[2][0], l15);
      const float dd = fmaxf(fabsf(den), __expf(-(sB[c * 128 + t] + Mt)));
      const float inv = __builtin_amdgcn_rcpf(dd);
      const f32x4 o0 = acc[0] * inv, o1 = acc[1] * inv;
      bf16_t* hp = P.hA + (size_t)row * DM + h * 256 + 32 * j + 4 * g;
      *(u32x2*)hp = pack4(o0); *(u32x2*)(hp + 16) = pack4(o1);
      float ss = (o0[0] * o0[0] + o0[1] * o0[1]) + (o0[2] * o0[2] + o0[3] * o0[3]) + (o1[0] * o1[0] + o1[1] * o1[1]) + (o1[2] * o1[2] + o1[3] * o1[3]);
      ss += __shfl_xor(ss, 16); ss += __shfl_xor(ss, 32);
      if (g == 0) P.hss[(size_t)row * 32 + h * 8 + j] = ss;
    }
    LDS_BARRIER();
#pragma unroll
    for (int dt = 0; dt < 2; ++dt)
#pragma unroll
      for (int et = 0; et < 3; ++et) *(u32x2*)(Cl + (16 * et + l15) * KS_STRIDE + 32 * w + 16 * dt + 4 * g) = pack4(Cacc[dt][et]);
    if (c < 15) M2_WRITE_KV(c + 1);
    LDS_BARRIER();
  }
#undef M2_WRITE_KV
  const size_t sidx = (size_t)(l * 8 + b) * 4 + h;
#pragma unroll
  for (int dt = 0; dt < 2; ++dt)
#pragma unroll
    for (int r = 0; r < 4; ++r) {
      const int d = 32 * w + 16 * dt + 4 * g + r;
      P.out[O_CP + sidx * 65536 + (size_t)d * 256 + 32 * j + l15] = Cacc[dt][0][r];
      P.out[O_CP + sidx * 65536 + (size_t)d * 256 + 32 * j + 16 + l15] = Cacc[dt][1][r];
      if (j == 0 && l15 == 0) P.out[O_NP + sidx * 256 + d] = Cacc[dt][2][r];
    }
  if (j == 0 && tid == 0) P.out[O_MP + sidx] = chain[16];
  __syncthreads();
}

__device__ __forceinline__ void msample_item(const Params& P, int l, int item, unsigned char* shm) {
  const int tid = tidx(), w = tid >> 6, lane = tid & 63;
  const int b = item >> 2, h = item & 3, row = NP + b;
  float* q = (float*)shm; float* k = q + 256; float* v = k + 256; float* red = v + 256; float* red2 = red + 2048;
  if (tid < 256) {
    const bf16_t* pr = P.Pb + (size_t)row * NG1 + h * 256 + tid;
    q[tid] = bf2f(pr[0]); k[tid] = bf2f(pr[1024]); v[tid] = bf2f(pr[2048]);
  }
  const float ig = P.gat[(size_t)row * 8 + h], lf = P.gat[(size_t)row * 8 + 4 + h];
  const size_t sidx = (size_t)(l * 128 + b) * 4 + h;
  const float m0 = P.st_m[sidx];
  const float inter = lf + m0, mt = fmaxf(inter, ig), wi = __expf(inter - mt), wa = __expf(ig - mt);
  __syncthreads();
  const float* C0 = P.st_C + sidx * 65536; float* Co = P.out + O_CS + sidx * 65536;
  const float* n0 = P.st_n + sidx * 256;
  const f32x4 v4 = *(const f32x4*)(v + 4 * lane);
  f32x4 acc = (f32x4){0.f, 0.f, 0.f, 0.f};
#pragma unroll 16
  for (int dd = 0; dd < 32; ++dd) {
    const int d = 32 * w + dd;
    const f32x4 c4 = __builtin_nontemporal_load((const f32x4*)(C0 + (size_t)d * 256 + 4 * lane));
    const float kd = wa * k[d], qd = q[d];
    __builtin_nontemporal_store(c4 * wi + v4 * kd, (f32x4*)(Co + (size_t)d * 256 + 4 * lane));
    acc += c4 * qd;
  }
  *(f32x4*)(red + w * 256 + 4 * lane) = acc;
  float qk = 0.f, qn = 0.f;
#pragma unroll
  for (int i = 0; i < 4; ++i) { const int d = lane + 64 * i; qk += q[d] * k[d]; qn += q[d] * n0[d]; }
  qk = wave_sum(qk); qn = wave_sum(qn);
  __syncthreads();
  const float s = qk * wa, den = wi * qn + s, ddn = fmaxf(fabsf(den), __expf(-mt));
  float hval = 0.f;
  if (tid < 256) {
    float num = 0.f;
#pragma unroll
    for (int i = 0; i < 8; ++i) num += red[i * 256 + tid];
    hval = (wi * num + s * v[tid]) / ddn;
    P.hA[(size_t)row * DM + h * 256 + tid] = f2bf(hval);
    P.out[O_NS + sidx * 256 + tid] = wi * n0[tid] + wa * k[tid];
  }
  float ss = wave_sum(hval * hval);
  if (lane == 0) red2[w] = ss;
  __syncthreads();
  if (tid < 8) P.hss[(size_t)row * 32 + h * 8 + tid] = tid == 0 ? (red2[0] + red2[1] + red2[2] + red2[3]) : 0.f;
  if (tid == 0) P.out[O_MS + sidx] = mt;
  __syncthreads();
}

__device__ __forceinline__ void s5_load_C(const Params& P, int l, int g, float* Csh) {
  for (int i = tidx(); i < 2048; i += 512) { const int ri = i >> 10, c = (i >> 6) & 15, p = i & 63;
    Csh[ri * 1088 + c * 68 + p] = (ri ? P.C_im : P.C_re)[(size_t)l * 32768 + (g * 16 + c) * 64 + p]; }
}
__device__ __forceinline__ void s5_sample_item(const Params& P, int l, int item, unsigned char* shm) {
  const int tid = tidx(), w = tid >> 6, lane = tid & 63;
  const int g = item & 31, bs0 = (item >> 5) * 16 + 2 * w;
  float* Csh = (float*)shm; float* sbuf = Csh + 2176 + w * 2176;
  s5_load_C(P, l, g, Csh);
  const float are = P.abar[l][g * 64 + lane], aim = P.abar[l][2048 + g * 64 + lane];
  float bre[16], bim[16];
#pragma unroll
  for (int c = 0; c < 16; ++c) { bre[c] = P.bbar[l][(g * 16 + c) * 64 + lane]; bim[c] = P.bbar[l][32768 + (g * 16 + c) * 64 + lane]; }
  const int ch = lane >> 2, pq = lane & 3;
  const float Dc = P.D_skip[l * 512 + g * 16 + ch];
  __syncthreads();
#pragma unroll
  for (int rep = 0; rep < 2; ++rep) {
    const int bs = bs0 + rep, row = NP + bs;
    const size_t o = ((size_t)(l * 128 + bs) * 32 + g) * 64 + lane;
    const float s0r = P.st_sre[o], s0i = P.st_sim[o];
    const bf16_t* up = P.Pb + (size_t)row * NG1 + 4096 + g * 16;
    const u32x4 u0 = *(const u32x4*)up, u1 = *(const u32x4*)(up + 8);
    float br = 0.f, bi = 0.f;
#pragma unroll
    for (int i = 0; i < 4; ++i) {
      const float ua = bf2f(u0[i] & 0xffffu), ub = bf2f(u0[i] >> 16), uc = bf2f(u1[i] & 0xffffu), ud = bf2f(u1[i] >> 16);
      br += bre[2 * i] * ua + bre[2 * i + 1] * ub + bre[8 + 2 * i] * uc + bre[8 + 2 * i + 1] * ud;
      bi += bim[2 * i] * ua + bim[2 * i + 1] * ub + bim[8 + 2 * i] * uc + bim[8 + 2 * i + 1] * ud;
    }
    const float sr = are * s0r - aim * s0i + br, si = are * s0i + aim * s0r + bi;
    P.out[O_SRS + o] = sr; P.out[O_SIS + o] = si;
    sbuf[rep * 136 + lane] = sr; sbuf[rep * 136 + 68 + lane] = si;
    asm volatile("s_waitcnt lgkmcnt(0)" ::: "memory");
    float acc = 0.f;
#pragma unroll
    for (int p4 = 0; p4 < 4; ++p4) {
      const int p0 = 16 * pq + 4 * p4;
      const f32x4 vr = *(const f32x4*)(sbuf + rep * 136 + p0), vi = *(const f32x4*)(sbuf + rep * 136 + 68 + p0);
      const f32x4 cr = *(const f32x4*)(Csh + ch * 68 + p0), ci = *(const f32x4*)(Csh + 1088 + ch * 68 + p0);
      acc += (cr[0] * vr[0] + cr[1] * vr[1]) + (cr[2] * vr[2] + cr[3] * vr[3]) - (ci[0] * vi[0] + ci[1] * vi[1]) - (ci[2] * vi[2] + ci[3] * vi[3]);
    }
    acc += __shfl_xor(acc, 1); acc += __shfl_xor(acc, 2);
    if (pq == 0) {
      const float uc = bf2f(up[ch]);
      P.ysb[(size_t)row * 512 + g * 16 + ch] = f2bf(gelu_tanh(acc + Dc * uc));
    }
  }
  __syncthreads();
}

__device__ __forceinline__ void prep_s5tables(const Params& P, int item, unsigned char* shm) {
  const int tid = tidx(), qpart = item & 3, l = item >> 7, g = (item >> 2) & 31;
  float* pwr = (float*)shm; float* pwi = pwr + 17 * 64; float* bbr = pwi + 17 * 64; float* bbi = bbr + 1024; float* Ccr = bbi + 1024; float* Cci = Ccr + 1024;
  if (tid < 64) {
    const int p = tid, gp = g * 64 + p;
    const float dt = expf(P.log_dt[l * 32 + g]);
    const float Ar = P.A_re[l * 2048 + gp], Ai = P.A_im[l * 2048 + gp];
    const float mag = expf(dt * Ar);
    float sn, cs; sincosf(dt * Ai, &sn, &cs);
    const float abr = mag * cs, abi = mag * sn;
    const float den = Ar * Ar + Ai * Ai, nr = abr - 1.0f, ni = abi;
    const float fre = (nr * Ar + ni * Ai) / den, fim = (ni * Ar - nr * Ai) / den;
    float pr = 1.f, pi = 0.f;
    for (int t = 0; t <= 16; ++t) { pwr[t * 64 + p] = pr; pwi[t * 64 + p] = pi; const float a = pr * abr - pi * abi, b = pr * abi + pi * abr; pr = a; pi = b; }
    for (int c = 0; c < 16; ++c) {
      const float Br = P.B_re[(size_t)l * 32768 + gp * 16 + c], Bi = P.B_im[(size_t)l * 32768 + gp * 16 + c];
      bbr[p * 16 + c] = fre * Br - fim * Bi; bbi[p * 16 + c] = fre * Bi + fim * Br;
    }
  }
  for (int i = tid; i < 1024; i += 512) { Ccr[i] = P.C_re[(size_t)l * 32768 + g * 1024 + i]; Cci[i] = P.C_im[(size_t)l * 32768 + g * 1024 + i]; }
  __syncthreads();
  bf16_t* Kt = P.Kt[l] + (size_t)g * 17 * 256; bf16_t* Gm = P.Gm[l] + (size_t)g * 32768; bf16_t* Hm = P.Hm[l] + (size_t)g * 32768;
  for (int o = qpart * 1088 + tid; o < (qpart + 1) * 1088; o += 512) {
    const int tau = o >> 8, c = (o >> 4) & 15, c2 = o & 15;
    float acc = 0.f;
    if (tau < 16) for (int p = 0; p < 64; ++p) {
      const float pr = pwr[tau * 64 + p], pi = pwi[tau * 64 + p], br = bbr[p * 16 + c2], bi = bbi[p * 16 + c2];
      const float zr = pr * br - pi * bi, zi = pr * bi + pi * br;
      acc += Ccr[c * 64 + p] * zr - Cci[c * 64 + p] * zi;
    }
    Kt[o] = f2bf(acc);
  }
  for (int o = qpart * 8192 + tid; o < (qpart + 1) * 8192; o += 512) {
    { const int tc = o >> 7, q = o & 127, t = tc >> 4, c = tc & 15, p = q & 63;
      const float cr = Ccr[c * 64 + p], ci = Cci[c * 64 + p], pr = pwr[(t + 1) * 64 + p], pi = pwi[(t + 1) * 64 + p];
      Gm[o] = f2bf(q < 64 ? (cr * pr - ci * pi) : -(cr * pi + ci * pr)); }
    { const int q = o >> 8, jc = o & 255, j = jc >> 4, c2 = jc & 15, p = q & 63;
      const float pr = pwr[(15 - j) * 64 + p], pi = pwi[(15 - j) * 64 + p], br = bbr[p * 16 + c2], bi = bbi[p * 16 + c2];
      Hm[o] = f2bf(q < 64 ? (pr * br - pi * bi) : (pr * bi + pi * br)); }
  }
  if (tid < 64 && qpart == 0) { P.a16[l][g * 64 + tid] = pwr[16 * 64 + tid]; P.a16[l][2048 + g * 64 + tid] = pwi[16 * 64 + tid]; }
  __syncthreads();
}
constexpr int S3_R0 = 0, S3_SIN = 69632, S3_KT = 69632 + 34816;
__device__ __forceinline__ void s5_stage3_item(const Params& P, int l, int item, unsigned char* shm) {
  const int tid = tidx(), w = tid >> 6, lane = tid & 63, g4 = lane >> 4, l15 = lane & 15;
  const int b = item >> 5, g = item & 31;
  float* Ebuf = (float*)(shm + S3_R0); bf16_t* Gsh = (bf16_t*)(shm + S3_R0); bf16_t* Sin = (bf16_t*)(shm + S3_SIN); bf16_t* Ksh = (bf16_t*)(shm + S3_KT);
  { bf16_t* Hsh = (bf16_t*)(shm + S3_R0); const bf16_t* Hm = P.Hm[l] + (size_t)g * 32768;
#pragma unroll
    for (int i = 0; i < 8; ++i) { const int piece = tid + 512 * i, r = piece >> 5, pc = piece & 31; *(u32x4*)(Hsh + r * 264 + 8 * pc) = *(const u32x4*)(Hm + r * 256 + 8 * pc); } }
  { const bf16_t* Kt = P.Kt[l] + (size_t)g * 17 * 256; for (int i = tid; i < 544; i += 512) *(u32x4*)(Ksh + 8 * i) = *(const u32x4*)(Kt + 8 * i); }
  const int n = 16 * w + l15, r0 = b * 2048 + n * 16;
  bf16x8 uf[8];
#pragma unroll
  for (int ks = 0; ks < 8; ++ks) uf[ks] = *(const bf16x8*)(P.Pb + (size_t)(r0 + 2 * ks + (g4 >> 1)) * NG1 + 4096 + g * 16 + 8 * (g4 & 1));
  __syncthreads();
  {
    const bf16_t* Hsh = (const bf16_t*)(shm + S3_R0);
    f32x4 eacc[8];
#pragma unroll
    for (int qt = 0; qt < 8; ++qt) {
      eacc[qt] = (f32x4){0.f, 0.f, 0.f, 0.f};
#pragma unroll
      for (int ks = 0; ks < 8; ++ks) { const bf16x8 x = *(const bf16x8*)(Hsh + (16 * qt + l15) * 264 + 32 * ks + 8 * g4); eacc[qt] = __builtin_amdgcn_mfma_f32_16x16x32_bf16(x, uf[ks], eacc[qt], 0, 0, 0); }
    }
    __syncthreads();
#pragma unroll
    for (int qt = 0; qt < 8; ++qt) *(f32x4*)(Ebuf + n * 128 + 16 * qt + 4 * g4) = eacc[qt];
  }
  __syncthreads();
  {
    const float ar = P.a16[l][g * 64 + lane], ai = P.a16[l][2048 + g * 64 + lane];
    float lr[16], li[16], sr = 0.f, si = 0.f;
#pragma unroll
    for (int k = 0; k < 16; ++k) {
      lr[k] = sr; li[k] = si;
      const float er = Ebuf[(16 * w + k) * 128 + lane], ei = Ebuf[(16 * w + k) * 128 + 64 + lane];
      const float nr = ar * sr - ai * si + er, ni = ar * si + ai * sr + ei; sr = nr; si = ni;
    }
    float* wend = (float*)(shm + S3_KT + 8704);
    wend[w * 128 + lane] = sr; wend[w * 128 + 64 + lane] = si;
    float br = ar, bi = ai;
#pragma unroll
    for (int i = 0; i < 4; ++i) { const float nr = br * br - bi * bi, ni = 2.f * br * bi; br = nr; bi = ni; }
    __syncthreads();
    float cr = 0.f, ci = 0.f;
    for (int w2 = 0; w2 < w; ++w2) { const float er = wend[w2 * 128 + lane], ei = wend[w2 * 128 + 64 + lane]; const float nr = br * cr - bi * ci + er, ni = br * ci + bi * cr + ei; cr = nr; ci = ni; }
    float pr = 1.f, pi = 0.f;
#pragma unroll
    for (int k = 0; k < 16; ++k) {
      Sin[(16 * w + k) * 136 + lane] = f2bf(lr[k] + pr * cr - pi * ci); Sin[(16 * w + k) * 136 + 64 + lane] = f2bf(li[k] + pr * ci + pi * cr);
      const float nr = pr * ar - pi * ai, ni = pr * ai + pi * ar; pr = nr; pi = ni;
    }
    if (w == 7) { const size_t o = ((size_t)(l * 8 + b) * 32 + g) * 64 + lane; P.out[O_SRP + o] = sr + pr * cr - pi * ci; P.out[O_SIP + o] = si + pr * ci + pi * cr; }
  }
  __syncthreads();
  { const bf16_t* Gm = P.Gm[l] + (size_t)g * 32768;
#pragma unroll
    for (int i = 0; i < 8; ++i) { const int piece = tid + 512 * i, r = piece >> 4, pc = piece & 15; *(u32x4*)(Gsh + r * 136 + 8 * pc) = *(const u32x4*)(Gm + r * 128 + 8 * pc); } }
  __syncthreads();
  bf16x8 sf[4];
#pragma unroll
  for (int k2 = 0; k2 < 4; ++k2) sf[k2] = *(const bf16x8*)(Sin + n * 136 + 32 * k2 + 8 * g4);
  const f32x4 D4 = *(const f32x4*)(P.D_skip + l * 512 + g * 16 + 4 * g4);
#pragma unroll
  for (int t = 0; t < 16; ++t) {
    f32x4 acc = (f32x4){0.f, 0.f, 0.f, 0.f};
    const int row = r0 + t;
    const f32x4 u4 = unpack4(*(const u32x2*)(P.Pb + (size_t)row * NG1 + 4096 + g * 16 + 4 * g4));
#pragma unroll
    for (int ks = 0; ks <= (t >> 1); ++ks) {
      const int tau = t - (2 * ks + (g4 >> 1)), idx = tau >= 0 ? tau : 16;
      const bf16x8 x = *(const bf16x8*)(Ksh + (idx * 16 + l15) * 16 + 8 * (g4 & 1));
      acc = __builtin_amdgcn_mfma_f32_16x16x32_bf16(x, uf[ks], acc, 0, 0, 0);
    }
#pragma unroll
    for (int k2 = 0; k2 < 4; ++k2) { const bf16x8 x = *(const bf16x8*)(Gsh + (t * 16 + l15) * 136 + 32 * k2 + 8 * g4); acc = __builtin_amdgcn_mfma_f32_16x16x32_bf16(x, sf[k2], acc, 0, 0, 0); }
    f32x4 y;
#pragma unroll
    for (int r = 0; r < 4; ++r) y[r] = gelu_tanh(acc[r] + D4[r] * u4[r]);
    *(u32x2*)(P.ysb + (size_t)row * 512 + g * 16 + 4 * g4) = pack4(y);
  }
  __syncthreads();
}

__device__ __forceinline__ void headnorm_rows(const Params& P, int l, int bid, int G) {
  const int w = tidx() >> 6, lane = tidx() & 63;
  constexpr int R1 = 6400;
  const bool split = (G == 256);
  const int rbeg = split ? (bid < 128 ? bid * 8 + w : R1 + (bid - 128) * 8 + w) : bid * 8 + w;
  const int rend = split ? (bid < 128 ? R1 : NT) : NT, rstep = split ? 128 * 8 : G * 8;
  f32x4 gh[4];
#pragma unroll
  for (int h = 0; h < 4; ++h) gh[h] = *(const f32x4*)(P.g_hn + l * 1024 + h * 256 + 4 * lane);
  for (int row = rbeg; row < rend; row += 2 * rstep) {
    const int row2 = row + rstep; const bool has2 = row2 < rend; const int r2 = has2 ? row2 : row;
    if (lane == 0) { P.ssA[row] = 0ull; P.ssB[row] = 0ull; if (has2) { P.ssA[row2] = 0ull; P.ssB[row2] = 0ull; } }
    f32x4 s0[2][4], s1[2][4]; u32x2 hv[2][4], so[2][4];
#pragma unroll
    for (int k = 0; k < 2; ++k) { const int r = k ? r2 : row;
#pragma unroll
      for (int h = 0; h < 4; ++h) {
        s0[k][h] = *(const f32x4*)(P.hss + (size_t)r * 32 + h * 8); s1[k][h] = *(const f32x4*)(P.hss + (size_t)r * 32 + h * 8 + 4);
        hv[k][h] = *(const u32x2*)(P.hA + (size_t)r * DM + h * 256 + 4 * lane); so[k][h] = *(const u32x2*)(P.Pb + (size_t)r * NG1 + 3072 + h * 256 + 4 * lane);
      } }
#pragma unroll
    for (int k = 0; k < 2; ++k) { const int r = k ? r2 : row;
      if (k == 0 || has2) {
#pragma unroll
        for (int h = 0; h < 4; ++h) {
          const float ss = (s0[k][h][0] + s0[k][h][1]) + (s0[k][h][2] + s0[k][h][3]) + (s1[k][h][0] + s1[k][h][1]) + (s1[k][h][2] + s1[k][h][3]);
          const float rh = rsqrtf(ss * (1.0f / 256.0f) + 1e-6f);
          *(u32x2*)(P.xa + (size_t)r * DM + h * 256 + 4 * lane) = pack4(unpack4(so[k][h]) * unpack4(hv[k][h]) * gh[h] * rh);
        }
      } }
  }
}
__device__ __forceinline__ void final_rows(const Params& P, int bid, int G) {
  const int w = tidx() >> 6, lane = tidx() & 63;
  f32x4 gf[4];
#pragma unroll
  for (int i = 0; i < 4; ++i) gf[i] = *(const f32x4*)(P.g_final + 256 * i + 4 * lane);
  for (int row = bid * 8 + w; row < NT; row += 4 * G * 8) {
    f32x4 v[4][4]; u64 q[4]; int rr[4];
#pragma unroll
    for (int k = 0; k < 4; ++k) {
      const int r = row + k * G * 8; rr[k] = r < NT ? r : row;
      q[k] = P.ssA[rr[k]];
#pragma unroll
      for (int i = 0; i < 4; ++i) v[k][i] = *(const f32x4*)(P.X2 + (size_t)rr[k] * DM + 256 * i + 4 * lane);
    }
#pragma unroll
    for (int k = 0; k < 4; ++k) {
      if (k == 0 || row + k * G * 8 < NT) {
        const float rs = rs_of(q[k]);
        float* o = rr[k] < NP ? P.out + O_YP + (size_t)rr[k] * DM : P.out + O_YS + (size_t)(rr[k] - NP) * DM;
#pragma unroll
        for (int i = 0; i < 4; ++i) *(f32x4*)(o + 256 * i + 4 * lane) = v[k][i] * gf[i] * rs;
      }
    }
  }
}


#define XB_TMO      128
#define XB_XCNT(j)  (256  + 64 * (j))
#define XB_XSUB(j)  (1280 + 64 * (j))
#define XB_XGEN(j)  (2304 + 64 * (j))
#define XB_TOP      3328
#define XB_TOPGEN   3392
#define XCD_BAR_WORDS 3456
#define XB_SPIN_CAP (1u << 22)
__device__ __forceinline__ unsigned xb_ld(unsigned* p)              { return __hip_atomic_load(p, __ATOMIC_RELAXED, __HIP_MEMORY_SCOPE_AGENT); }
__device__ __forceinline__ unsigned xb_add(unsigned* p, unsigned v) { return __hip_atomic_fetch_add(p, v, __ATOMIC_RELAXED, __HIP_MEMORY_SCOPE_AGENT); }
__device__ __forceinline__ unsigned xb_xcc_id() { return (unsigned)__builtin_amdgcn_s_getreg((3 << 11) | 20) & 0xFu; }
#define XB_SPIN(cond, bar) do { unsigned _sp = 0; while (cond) { __builtin_amdgcn_s_sleep(1); \
    if ((++_sp & 255u) == 0u) { if (xb_ld(&(bar)[XB_TMO])) break; if (_sp > XB_SPIN_CAP) { atomicAdd(&(bar)[XB_TMO], 1u); break; } } } } while (0)
struct XcdBarrier { unsigned* bar; unsigned x; volatile LAS unsigned* st; };
__device__ __forceinline__ XcdBarrier xcd_barrier_post(unsigned* bar, volatile LAS unsigned* st) {
  XcdBarrier b; b.bar = bar; b.x = xb_xcc_id(); b.st = st;
  if (threadIdx.x == 0) (void)xb_add(&bar[XB_XCNT(b.x)], 1u);
  return b;
}
__device__ __forceinline__ void xcd_barrier_complete(unsigned* bar, unsigned x, unsigned& nloc, unsigned& nx) {
  const unsigned G = gridDim.x * gridDim.y * gridDim.z;
  unsigned sum, cnt, mine, sp = 0u;
  for (;;) {
    sum = 0u; cnt = 0u; mine = 0u;
#pragma unroll
    for (unsigned j = 0; j < 16; ++j) { const unsigned c = xb_ld(&bar[XB_XCNT(j)]); sum += c; cnt += (c > 0u) ? 1u : 0u; mine = (j == x) ? c : mine; }
    if (sum == G) break;
    __builtin_amdgcn_s_sleep(1);
    if ((++sp & 255u) == 0u) { if (xb_ld(&bar[XB_TMO])) break; if (sp > XB_SPIN_CAP) { atomicAdd(&bar[XB_TMO], 1u); break; } }
  }
  nloc = mine > 0u ? mine : 1u; nx = cnt > 0u ? cnt : 1u;
}
__device__ __forceinline__ void xcd_barrier(const XcdBarrier& b) {
  asm volatile("s_waitcnt vmcnt(0)" ::: "memory");
  __syncthreads();
  if (threadIdx.x == 0) {
    unsigned* bar = b.bar;
    __builtin_amdgcn_s_waitcnt(0);
    unsigned nloc = b.st[0], nx = b.st[1];
    if (nloc == 0u) { xcd_barrier_complete(bar, b.x, nloc, nx); b.st[0] = nloc; b.st[1] = nx; }
    const unsigned old = xb_add(&bar[XB_XSUB(b.x)], 1u);
    const unsigned gen = old / nloc;
    if (old + 1u == (gen + 1u) * nloc) {
      __builtin_amdgcn_fence(__ATOMIC_RELEASE, "agent");
      asm volatile("s_waitcnt vmcnt(0)" ::: "memory");
      const unsigned og = xb_add(&bar[XB_TOP], 1u);
      const unsigned tg = og / nx;
      if (og + 1u == (tg + 1u) * nx) xb_add(&bar[XB_TOPGEN], 1u);
      else XB_SPIN(xb_ld(&bar[XB_TOPGEN]) == tg, bar);
      __builtin_amdgcn_fence(__ATOMIC_ACQUIRE, "agent");
      xb_add(&bar[XB_XGEN(b.x)], 1u);
      asm volatile("s_waitcnt vmcnt(0)" ::: "memory");
    } else {
      XB_SPIN(xb_ld(&bar[XB_XGEN(b.x)]) == gen, bar);
      __builtin_amdgcn_fence(__ATOMIC_ACQUIRE, "agent");
      asm volatile("s_waitcnt vmcnt(0)" ::: "memory");
    }
  }
  __syncthreads();
}

__global__ void __launch_bounds__(512) mega(const Params P) {
  extern __shared__ __attribute__((aligned(16))) unsigned char shm[];
  cg::grid_group grid = cg::this_grid();
  LAS unsigned char* lds = (LAS unsigned char*)shm;
  const int bid = blockIdx.x, G = gridDim.x;

  volatile LAS unsigned* xst = (volatile LAS unsigned*)(lds + LDS_BYTES - 16);
  if (threadIdx.x == 0) { xst[0] = 0u; xst[1] = 0u; }
  if (bid == 0) for (int i = threadIdx.x; i < XCD_BAR_WORDS; i += 512) P.bar[i] = 0u;
  REP(1) prep_phase(P, shm, bid, G);
  grid.sync();
  const XcdBarrier xb = xcd_barrier_post(P.bar, xst);

  for (int l = 0; l < 2; ++l) {
    REP(2) {
      F1 f; f.bias = P.b_in + l * PTOT; f.Pb = P.Pb; f.rs = P.ssA; f.ss = nullptr;
      gemm_main_window(lds, P.xb, P.WinT[l], 4096, 1024, f, 0, bid, G);
      gemm_main_window(lds, P.xb, P.WinT[l] + (size_t)4608 * 1024, 2048, 1024, f, 4608, bid, G);
      skinny_run<F1, 2>(f, P.xb, 1024, P.WinT[l], NP, 1, NG1 / 16, bid, G, shm, 0);
      Fg fg; fg.bias = P.b_in + l * PTOT + 4096; fg.gat = P.gat; fg.rs = P.ssA; fg.ss = nullptr;
      REP(256) skinny_run(fg, P.xb, 1024, P.WgT[l], 0, 129, 1, bid, G, shm, 0);
    }
    xcd_barrier(xb);
    { F1 f; f.bias = P.b_in + l * PTOT; f.Pb = P.Pb; f.rs = P.ssA; f.ss = nullptr;
      gemm_main_window(lds, P.xb, P.WinT[l] + (size_t)4096 * 1024, 512, 1024, f, 4096, bid, G); }
    {
      const int n1 = G == 256 ? (bid < 128 ? 1 : 3) : (512 - bid + G - 1) / G;
      for (int j = 0; j < n1; ++j) m1_item(P, G == 256 ? (bid < 128 ? bid : 128 + (bid - 128) * 3 + j) : bid + j * G, shm);
      for (int it = bid; it < 512; it += G) msample_item(P, l, it, shm);
      for (int it = bid; it < 256; it += G) s5_sample_item(P, l, it, shm);
    }
    xcd_barrier(xb);
    REP(8) for (int it = bid; it < 256; it += G) m2_item(P, l, G == 256 ? (((it & 7) * 4 + (it >> 6)) * 8 + ((it >> 3) & 7)) : it, shm);
    REP(16) for (int it = bid; it < 256; it += G) s5_stage3_item(P, l, G == 256 ? ((it & 7) * 32 + (it >> 3)) : it, shm);
    xcd_barrier(xb);
    REP(32) {
      Fglu f; f.bias = P.b_glu + l * 512; f.ysb = P.ysb; f.ys2 = P.ys2; f.ss = nullptr;
      gemm_all(lds, shm, P.ysb, P.WgluT[l], 512, 512, f, bid, G);
      headnorm_rows(P, l, bid, G);
    }
    xcd_barrier(xb);
    REP(32) {
      Fa fa; fa.Pb = P.Pb; fa.t1 = P.t1; fa.ss = nullptr;
      gemm_all(lds, shm, P.xa, P.WaT[l], 1024, 1024, fa, bid, G);
      Fb fb; fb.Pb = P.Pb; fb.t1 = P.t1; fb.mg = P.mg; fb.ss = nullptr;
      gemm_all(lds, shm, P.ys2, P.WbT[l], 1024, 512, fb, bid, G);
    }
    xcd_barrier(xb);
    REP(32) {
      Fres f; f.xinP = l == 0 ? P.x_prompt : P.X2; f.xinS = l == 0 ? P.x_sample : P.X2 + (size_t)NP * DM; f.xo = P.X1; f.xb = P.xb; f.ss = P.ssB;
      gemm_all(lds, shm, P.mg, P.WoT[l], 1024, 1024, f, bid, G);
    }
    xcd_barrier(xb);
    REP(64) {
      F13 f; f.rs = P.ssB; f.act = P.act;
      pg8::Gemm g; g.A = P.xb; g.Bt = P.W13T[l]; g.M = NP; g.N = 2 * DFF; g.K = 1024;
      pg8::StaticOrder S; S.init(NP, 2 * DFF, G, bid);
      EpiMain13 E; E.f = f;
      REP(512) pg8::gemm_phase(lds, g, S, E);
      REP(256) skinny_run13(f, P.xb, P.W13T[l], bid, G, shm);
    }
    xcd_barrier(xb);
    REP(64) {
      Fres f; f.xinP = P.X1; f.xinS = P.X1 + (size_t)NP * DM; f.xo = P.X2; f.xb = P.xb; f.ss = P.ssA;
      gemm_all(lds, shm, P.act, P.W2T[l], 1024, DFF, f, bid, G);
    }
    xcd_barrier(xb);
  }
  final_rows(P, bid, G);
}

extern "C" void kernel_launch(void* const* d_in, const int* in_sizes, int n_in, void* d_out, int out_size, void* d_ws, size_t ws_size, hipStream_t stream) {
  constexpr size_t kDynLds = LDS_BYTES;
  static int grid_blocks = 0;
  if (!grid_blocks) {
    int dev = 0, cus = 0, per_cu = 0;
    (void)hipGetDevice(&dev);
    (void)hipDeviceGetAttribute(&cus, hipDeviceAttributeMultiprocessorCount, dev);
    (void)hipFuncSetAttribute((const void*)mega, hipFuncAttributeMaxDynamicSharedMemorySize, (int)kDynLds);
    (void)hipOccupancyMaxActiveBlocksPerMultiprocessor(&per_cu, mega, 512, kDynLds);
    if (per_cu > 1) per_cu = 1;
    grid_blocks = cus * per_cu;
    if (grid_blocks > 256) grid_blocks = 256;
  }
  Params p;
  memset(&p, 0, sizeof(p));
  const float* const* in = (const float* const*)d_in;
  p.x_prompt = in[0]; p.x_sample = in[1]; p.st_C = in[2]; p.st_n = in[3]; p.st_m = in[4]; p.st_sre = in[5]; p.st_sim = in[6];
  p.g_mix = in[7]; p.w_in = in[8]; p.b_in = in[9]; p.g_hn = in[10]; p.w_a = in[11]; p.A_re = in[12]; p.A_im = in[13]; p.log_dt = in[14];
  p.B_re = in[15]; p.B_im = in[16]; p.C_re = in[17]; p.C_im = in[18]; p.D_skip = in[19]; p.w_glu = in[20]; p.b_glu = in[21]; p.w_b = in[22]; p.w_out = in[23];
  p.g_ffn = in[24]; p.w_ff1 = in[25]; p.w_ff3 = in[26]; p.w_ff2 = in[27]; p.g_final = in[28];
  p.out = (float*)d_out;
  char* base = (char*)d_ws; size_t off = 0;
  auto alloc = [&](size_t bytes) { char* r = base + off; off += (bytes + 255) & ~(size_t)255; return r; };
  for (int l = 0; l < 2; ++l) {
    p.WinT[l] = (bf16_t*)alloc((size_t)NG1 * 1024 * 2); p.WgT[l] = (bf16_t*)alloc(16 * 1024 * 2); p.WgluT[l] = (bf16_t*)alloc(512 * 512 * 2);
    p.WaT[l] = (bf16_t*)alloc(1024 * 1024 * 2); p.WbT[l] = (bf16_t*)alloc(1024 * 512 * 2); p.WoT[l] = (bf16_t*)alloc(1024 * 1024 * 2);
    p.W13T[l] = (bf16_t*)alloc((size_t)2 * DFF * 1024 * 2); p.W2T[l] = (bf16_t*)alloc((size_t)1024 * DFF * 2);
    p.abar[l] = (float*)alloc(4096 * 4); p.bbar[l] = (float*)alloc(65536 * 4);
  }
  p.xb = (bf16_t*)alloc((size_t)NT * DM * 2); p.Pb = (bf16_t*)alloc((size_t)NT * NG1 * 2); p.St = (bf16_t*)alloc((size_t)512 * 16384 * 2);
  p.ysb = (bf16_t*)alloc((size_t)NT * 512 * 2); p.ys2 = (bf16_t*)alloc((size_t)NT * 512 * 2); p.xa = (bf16_t*)alloc((size_t)NT * DM * 2);
  p.mg = (bf16_t*)alloc((size_t)NT * DM * 2); p.act = (bf16_t*)alloc((size_t)NT * DFF * 2);
  p.X1 = (float*)alloc((size_t)NT * DM * 4); p.X2 = (float*)alloc((size_t)NT * DM * 4);
  p.ssA = (unsigned long long*)alloc((size_t)NT * 8); p.ssB = (unsigned long long*)alloc((size_t)NT * 8); p.bar = (unsigned*)alloc(XCD_BAR_WORDS * 4);
  for (int l = 0; l < 2; ++l) { p.Kt[l] = (bf16_t*)alloc(32 * 17 * 256 * 2); p.Gm[l] = (bf16_t*)alloc(32 * 32768 * 2); p.Hm[l] = (bf16_t*)alloc(32 * 32768 * 2); p.a16[l] = (float*)alloc(4096 * 4); }
  p.E2 = (float*)alloc((size_t)8 * 128 * 32 * 128 * 4);
  p.gat = (float*)alloc((size_t)NT * 8 * 4); p.hA = (bf16_t*)alloc((size_t)NT * DM * 2); p.hss = (float*)alloc((size_t)NT * 32 * 4);
  p.t1 = (bf16_t*)alloc((size_t)NT * DM * 2); p.Eend = (float*)alloc((size_t)2 * 524288 * 4);
  int nj = 0, tile0 = 0;
  auto job = [&](const float* src, const float* scale, bf16_t* dst, int ldn, int c0, int ncols, int K, int mode, int r0, int nwrite) {
    TJob& J = p.jobs[nj++]; J.src = src; J.scale = scale; J.dst = dst; J.ldn = ldn; J.c0 = c0; J.ncols = ncols; J.K = K; J.mode = mode; J.r0 = r0;
    J.tile0 = tile0; J.ntn = (ncols + 63) / 64; J.nwrite = nwrite; J.pad = 0; tile0 += J.ntn * (K / 64);
  };
  for (int l = 0; l < 2; ++l) {
    const float* win = p.w_in + (size_t)l * 1024 * PTOT; const float* gm = p.g_mix + l * 1024; const float* gf = p.g_ffn + l * 1024;
    job(win, gm, p.WinT[l], PTOT, 0, 4096, 1024, 0, 0, 4096);
    job(win, gm, p.WinT[l], PTOT, 4104, 512, 1024, 0, 4096, 512);
    job(win, gm, p.WinT[l], PTOT, 4616, 2048, 1024, 0, 4608, 2048);
    job(win, gm, p.WgT[l], PTOT, 4096, 8, 1024, 0, 0, 16);
    job(p.w_glu + (size_t)l * 512 * 512, nullptr, p.WgluT[l], 512, 0, 512, 512, 0, 0, 512);
    job(p.w_a + (size_t)l * 1024 * 1024, nullptr, p.WaT[l], 1024, 0, 1024, 1024, 0, 0, 1024);
    job(p.w_b + (size_t)l * 512 * 1024, nullptr, p.WbT[l], 1024, 0, 1024, 512, 0, 0, 1024);
    job(p.w_out + (size_t)l * 1024 * 1024, nullptr, p.WoT[l], 1024, 0, 1024, 1024, 0, 0, 1024);
    job(p.w_ff1 + (size_t)l * 1024 * DFF, gf, p.W13T[l], DFF, 0, DFF, 1024, 1, 0, DFF);
    job(p.w_ff3 + (size_t)l * 1024 * DFF, gf, p.W13T[l], DFF, 0, DFF, 1024, 2, 0, DFF);
    job(p.w_ff2 + (size_t)l * DFF * 1024, nullptr, p.W2T[l], 1024, 0, 1024, DFF, 0, 0, 1024);
  }
  p.njobs = nj; p.total_tiles = tile0;
  void* args[] = {&p};
  hipError_t e = hipLaunchCooperativeKernel((void*)mega, dim3(grid_blocks), dim3(512), args, kDynLds, stream);
  if (e != hipSuccess) fprintf(stderr, "cooperative launch failed: %s (grid %d)\n", hipGetErrorString(e), grid_blocks);
}
```

```cpp
#include <hip/hip_runtime.h>
#include <hip/hip_cooperative_groups.h>
#include <cstdio>
#include <cstring>
namespace cg = cooperative_groups;

#define LAS __attribute__((address_space(3)))
typedef unsigned short bf16_t;
typedef short bf16x8 __attribute__((ext_vector_type(8)));
typedef short bf16x4 __attribute__((ext_vector_type(4)));
typedef float f32x4 __attribute__((ext_vector_type(4)));
typedef unsigned u32x4 __attribute__((ext_vector_type(4)));
typedef unsigned u32x2 __attribute__((ext_vector_type(2)));

constexpr int NP = 16384, NS = 128, NT = 16512, DM = 1024, NG1 = 6656, DFF = 2816, PTOT = 6664;
constexpr int LDS_BYTES = 150 * 1024;
#ifndef DUPMASK
#define DUPMASK 0
#endif
#define REP(bit) for (int rep_ = 0; rep_ < ((DUPMASK & (bit)) ? 2 : 1); ++rep_)
constexpr size_t O_YP = 0, O_YS = 16777216, O_CP = 16908288, O_NP = 21102592, O_MP = 21118976, O_SRP = 21119040, O_SIP = 21151808,
                 O_CS = 21184576, O_NS = 88293440, O_MS = 88555584, O_SRS = 88556608, O_SIS = 89080896;

struct TJob { const float* src; const float* scale; bf16_t* dst; int ldn, c0, ncols, K, mode, r0, tile0, ntn, nwrite, pad; };

struct Params {
  const float *x_prompt, *x_sample, *st_C, *st_n, *st_m, *st_sre, *st_sim;
  const float *g_mix, *w_in, *b_in, *g_hn, *w_a, *A_re, *A_im, *log_dt, *B_re, *B_im, *C_re, *C_im, *D_skip, *w_glu, *b_glu, *w_b, *w_out,
      *g_ffn, *w_ff1, *w_ff3, *w_ff2, *g_final;
  float* out;
  bf16_t *WinT[2], *WgT[2], *WgluT[2], *WaT[2], *WbT[2], *WoT[2], *W13T[2], *W2T[2];
  float *abar[2], *bbar[2];
  bf16_t *xb, *Pb, *St, *ysb, *ys2, *xa, *mg, *act;
  float *X1, *X2, *gat, *hss, *Eend; bf16_t *hA, *t1;
  unsigned long long *ssA, *ssB;
  unsigned* bar;
  bf16_t *Kt[2], *Gm[2], *Hm[2]; float *a16[2], *E2;
  TJob jobs[22];
  int njobs, total_tiles;
};

__device__ __forceinline__ bf16_t f2bf(float f) { return __builtin_bit_cast(bf16_t, (__bf16)f); }
__device__ __forceinline__ float bf2f(unsigned b) { return __uint_as_float(b << 16); }
typedef float f32x2 __attribute__((ext_vector_type(2)));
typedef __bf16 bf16x2v __attribute__((ext_vector_type(2)));
__device__ __forceinline__ unsigned pack2(float lo, float hi) { const f32x2 v = {lo, hi}; const bf16x2v b = __builtin_convertvector(v, bf16x2v); return __builtin_bit_cast(unsigned, b); }
__device__ __forceinline__ u32x2 pack4(f32x4 v) { u32x2 r; r.x = pack2(v[0], v[1]); r.y = pack2(v[2], v[3]); return r; }
__device__ __forceinline__ f32x4 unpack4(u32x2 u) { f32x4 r; r[0] = bf2f(u.x & 0xffffu); r[1] = bf2f(u.x >> 16); r[2] = bf2f(u.y & 0xffffu); r[3] = bf2f(u.y >> 16); return r; }
__device__ __forceinline__ float sigmoidf_(float x) { return __builtin_amdgcn_rcpf(1.0f + __expf(-x)); }
__device__ __forceinline__ float gelu_tanh(float x) { float z = 0.7978845608f * (x + 0.044715f * x * x * x); float e = __expf(2.0f * z); float th = 1.0f - 2.0f * __builtin_amdgcn_rcpf(e + 1.0f); return 0.5f * x * (1.0f + th); }
__device__ __forceinline__ int tidx() { int t = threadIdx.x; asm volatile("" : "+v"(t)); return t; }
#define LDS_BARRIER() do { asm volatile("s_waitcnt lgkmcnt(0)" ::: "memory"); __builtin_amdgcn_s_barrier(); asm volatile("" ::: "memory"); } while (0)
__device__ __forceinline__ float wave_sum(float v) { for (int o = 32; o > 0; o >>= 1) v += __shfl_xor(v, o); return v; }

namespace pg8 {
constexpr int BM = 256, BK = 64, HALF = 128, HTB = HALF * BK * 2, STAGE_BYTES = 8 * HTB, NXCD = 8, WGM = 8;
__host__ __device__ __forceinline__ int lds_byte(int r, int c) { const int st = (r >> 4) * 2 + (c >> 5), rr = r & 15, cc = c & 31, ob = rr * 64 + cc * 2; return st * 1024 + (ob ^ (((ob >> 9) & 1) << 5)); }
__host__ __device__ __forceinline__ void stage_rc(int b, int& R, int& C) { const int st = b / 1024, sb = b % 1024, swz = sb ^ (((sb >> 9) & 1) << 5); R = (st >> 1) * 16 + swz / 64; C = (st & 1) * 32 + (swz % 64) / 2; }
__host__ __device__ __forceinline__ int perm32(int rho) { const int n = rho >> 4, i = rho & 15; return 8 * (i >> 2) + 4 * n + (i & 3); }
struct Unit { int pm, pn; };
struct Gemm { const bf16_t* A; const bf16_t* Bt; int M, N, K; };
struct StaticOrder {
  int nM, nN, nwg, G, c;
  __device__ void init(int M, int N, int G_, int c_) { nM = M / BM; nN = N / BM; nwg = nM * nN; G = G_; c = c_; }
  __device__ bool next(int i, Unit& u) const {
    const long L = (long)i * G + c; if (L >= nwg) return false;
    int wgid = (int)L; { const int q = nwg / NXCD, r = nwg % NXCD, xcd = wgid % NXCD, off = wgid / NXCD; wgid = (xcd < r ? xcd * (q + 1) : r * (q + 1) + (xcd - r) * q) + off; }
    const int nig = WGM * nN, gid = wgid / nig, fm = gid * WGM, gsz = (nM - fm) < WGM ? (nM - fm) : WGM;
    u.pm = fm + ((wgid % nig) % gsz); u.pn = (wgid % nig) / gsz; return true;
  }
};

template <class Epi, class Sched>
__device__ __forceinline__ void gemm_phase(LAS unsigned char* lds, const Gemm g, const Sched& S, const Epi& E) {
  const int tid = tidx(), wid = __builtin_amdgcn_readfirstlane(tid >> 6), lane = tid & 63, wr = wid >> 2, wc = wid & 3, fr = lane & 15, fq = lane >> 4;
  const int K = g.K, nt = K / BK;
  unsigned voffA[2], voffB[2];
#pragma unroll
  for (int i = 0; i < 2; ++i) { int R, C; stage_rc(tid * 16 + i * 8192, R, C); voffA[i] = (unsigned)(R * K + C) * 2u; const int Rb = Epi::PERM ? ((R & ~31) + perm32(R & 31)) : R; voffB[i] = (unsigned)(Rb * K + C) * 2u; }
  const size_t kstep = (size_t)(BK * 2);
  const size_t hstep = (size_t)HALF * K * 2;
  const size_t tstep = 2 * hstep;
  const unsigned ldsw = (unsigned)wid * 1024u;
  const int aoff = lds_byte(wr * 64 + fr, fq * 8), boff = lds_byte(wc * 32 + fr, fq * 8);
#define PG8_SA(b, h) (((b) * 2 + (h)) * HTB)
#define PG8_SB(b, h) ((4 + (b) * 2 + (h)) * HTB)
#define PG8_STAGE(bufoff, gbase, voff) do { _Pragma("unroll") for (int _i = 0; _i < 2; ++_i) \
    __builtin_amdgcn_global_load_lds((const unsigned*)((const char*)(gbase) + (voff)[_i]), (LAS unsigned*)(lds + (bufoff) + ldsw + _i * 8192), 16, 0, 0); } while (0)
#define PG8_LDA(dst, b, h) do { _Pragma("unroll") for (int m = 0; m < 4; ++m) _Pragma("unroll") for (int k = 0; k < 2; ++k) dst[m][k] = *(const LAS bf16x8*)(lds + PG8_SA(b, h) + aoff + m * 2048 + k * 1024); } while (0)
#define PG8_LDB(dst, b, h) do { _Pragma("unroll") for (int n = 0; n < 2; ++n) _Pragma("unroll") for (int k = 0; k < 2; ++k) dst[n][k] = *(const LAS bf16x8*)(lds + PG8_SB(b, h) + boff + n * 2048 + k * 1024); } while (0)
#define PG8_MMA(ai, bj, At, Bt) do { __builtin_amdgcn_s_setprio(1); _Pragma("unroll") for (int m = 0; m < 4; ++m) _Pragma("unroll") for (int n = 0; n < 2; ++n) _Pragma("unroll") for (int k = 0; k < 2; ++k) \
    acc[ai][bj][m][n] = __builtin_amdgcn_mfma_f32_16x16x32_bf16(Bt[n][k], At[m][k], acc[ai][bj][m][n], 0, 0, 0); __builtin_amdgcn_s_setprio(0); } while (0)
#define PG8_WAIT_V(n) asm volatile("s_waitcnt vmcnt(" #n ")" ::: "memory")
#define PG8_WAIT_L(n) asm volatile("s_waitcnt lgkmcnt(" #n ")" ::: "memory")
#define PG8_BAR __builtin_amdgcn_s_barrier()
#define PG8_SCHED __builtin_amdgcn_sched_barrier(0)
  Unit cur, nxt; int ui = 0;
  if (!S.next(0, cur)) return;
  f32x4 acc[2][2][4][2];
#pragma unroll
  for (int a = 0; a < 2; ++a)
#pragma unroll
    for (int b = 0; b < 2; ++b)
#pragma unroll
      for (int m = 0; m < 4; ++m)
#pragma unroll
        for (int n = 0; n < 2; ++n) acc[a][b][m][n] = (f32x4){0.f, 0.f, 0.f, 0.f};
  bf16x8 At[4][2], B0[2][2], B1[2][2];
  const char* cA = (const char*)g.A + (size_t)cur.pm * tstep; const char* cB = (const char*)g.Bt + (size_t)cur.pn * tstep;
  PG8_STAGE(PG8_SB(0, 0), cB, voffB); PG8_STAGE(PG8_SA(0, 0), cA, voffA); PG8_STAGE(PG8_SB(0, 1), cB + hstep, voffB); PG8_STAGE(PG8_SA(0, 1), cA + hstep, voffA);
  if (wr == 1) PG8_BAR;
  PG8_WAIT_V(4); PG8_BAR;
  PG8_STAGE(PG8_SB(1, 0), cB + kstep, voffB); PG8_STAGE(PG8_SA(1, 0), cA + kstep, voffA); PG8_STAGE(PG8_SB(1, 1), cB + hstep + kstep, voffB);
  PG8_WAIT_V(6); PG8_BAR;
  for (;;) {
    const bool has_next = S.next(ui + 1, nxt);
    const char* nA = has_next ? (const char*)g.A + (size_t)nxt.pm * tstep : cA; const char* nB = has_next ? (const char*)g.Bt + (size_t)nxt.pn * tstep : cB;
    for (int t = 0; t < nt; t += 2) {
      const bool last = (t == nt - 2);
      const char* a1 = cA + (size_t)(t + 1) * kstep;
      const char* a2 = last ? nA : cA + (size_t)(t + 2) * kstep; const char* b2 = last ? nB : cB + (size_t)(t + 2) * kstep;
      const char* a3 = a2 + kstep; const char* b3 = b2 + kstep;
      PG8_LDB(B0, 0, 0); PG8_SCHED; PG8_LDA(At, 0, 0); PG8_STAGE(PG8_SA(1, 1), a1 + hstep, voffA);
      PG8_WAIT_L(8); PG8_BAR; PG8_WAIT_L(0); PG8_MMA(0, 0, At, B0); PG8_BAR; PG8_SCHED;
      PG8_LDB(B1, 0, 1); PG8_STAGE(PG8_SB(0, 0), b2, voffB);
      PG8_BAR; PG8_WAIT_L(0); PG8_MMA(0, 1, At, B1); PG8_BAR;
      PG8_LDA(At, 0, 1); PG8_STAGE(PG8_SA(0, 0), a2, voffA);
      PG8_BAR; PG8_WAIT_L(0); PG8_MMA(1, 0, At, B0); PG8_BAR; PG8_SCHED;
      PG8_STAGE(PG8_SB(0, 1), b2 + hstep, voffB);
      PG8_WAIT_V(6); PG8_BAR; PG8_MMA(1, 1, At, B1); PG8_BAR;
      PG8_LDB(B0, 1, 0); PG8_SCHED; PG8_LDA(At, 1, 0); PG8_STAGE(PG8_SA(0, 1), a2 + hstep, voffA);
      PG8_WAIT_L(8); PG8_BAR; PG8_WAIT_L(0); PG8_MMA(0, 0, At, B0); PG8_BAR; PG8_SCHED;
      PG8_LDB(B1, 1, 1); PG8_STAGE(PG8_SB(1, 0), b3, voffB);
      PG8_BAR; PG8_WAIT_L(0); PG8_MMA(0, 1, At, B1); PG8_BAR;
      PG8_LDA(At, 1, 1); PG8_STAGE(PG8_SA(1, 0), a3, voffA);
      PG8_BAR; PG8_WAIT_L(0); PG8_MMA(1, 0, At, B0); PG8_BAR; PG8_SCHED;
      PG8_STAGE(PG8_SB(1, 1), b3 + hstep, voffB);
      PG8_WAIT_V(6); PG8_BAR; PG8_MMA(1, 1, At, B1); PG8_BAR;
    }
    E(acc, cur, wr, wc, fr, fq);
    if (!has_next) break;
#pragma unroll
    for (int a = 0; a < 2; ++a)
#pragma unroll
      for (int b = 0; b < 2; ++b)
#pragma unroll
        for (int m = 0; m < 4; ++m)
#pragma unroll
          for (int n = 0; n < 2; ++n) acc[a][b][m][n] = (f32x4){0.f, 0.f, 0.f, 0.f};
    cur = nxt; cA = nA; cB = nB; ++ui;
  }
  PG8_WAIT_V(0);
  if (wr == 0) PG8_BAR;
  PG8_BAR;
#undef PG8_SA
#undef PG8_SB
#undef PG8_STAGE
#undef PG8_LDA
#undef PG8_LDB
#undef PG8_MMA
#undef PG8_WAIT_V
#undef PG8_WAIT_L
#undef PG8_BAR
#undef PG8_SCHED
}
}

typedef unsigned long long u64;
__device__ __forceinline__ u64 ss_fix(float ss) { return (u64)(ss * 16777216.0f); }
__device__ __forceinline__ float rs_of(u64 q) { const float f = (float)(unsigned)(q >> 32) * 4294967296.0f + (float)(unsigned)q; return rsqrtf(f * (1.0f / (16777216.0f * 1024.0f)) + 1e-6f); }
__device__ __forceinline__ void ss_add(u64* p, float ss) { __hip_atomic_fetch_add(p, ss_fix(ss), __ATOMIC_RELAXED, __HIP_MEMORY_SCOPE_AGENT); }
__device__ __forceinline__ int qcol(int cbase, int q) { return cbase + (q >> 1) * 128 + (q & 1) * 16; }
__device__ __forceinline__ f32x4 unlo(u32x4 u) { return unpack4((u32x2){u[0], u[1]}); }
__device__ __forceinline__ f32x4 unhi(u32x4 u) { return unpack4((u32x2){u[2], u[3]}); }
__device__ __forceinline__ u32x4 pack8(f32x4 a, f32x4 b) { const u32x2 p = pack4(a), q = pack4(b); return (u32x4){p.x, p.y, q.x, q.y}; }
struct F1 {
  static constexpr bool NEEDR = true, STAT = false, PERM = true; static constexpr int RB = 8;
  const float* bias; bf16_t* Pb; const u64* rs; u64* ss;
  struct ColData { f32x4 b[4]; }; struct RowData { u64 s; };
  __device__ __forceinline__ void load_cols(int cbase, ColData& cd) const {
#pragma unroll
    for (int q = 0; q < 4; ++q) { const int col = cbase + (q >> 1) * 128 + (q & 1) * 4; cd.b[q] = *(const f32x4*)(bias + (col < 4096 ? col : col + 8)); } }
  __device__ __forceinline__ void load_row(int row, int, RowData& rd) const { rd.s = rs[row]; }
  __device__ __forceinline__ float apply(int row, int cbase, const f32x4 (&v)[4], const ColData& cd, const RowData& rd) const {
    const float r = rs_of(rd.s);
    const int blk = cbase >> 8;
    const bool isk = blk >= 4 && blk < 8, issig = (blk >= 12 && blk < 16) || blk >= 18;
#pragma unroll
    for (int bj = 0; bj < 2; ++bj) {
      u32x4 pk;
#pragma unroll
      for (int n = 0; n < 2; ++n) {
        f32x4 o = v[bj * 2 + n] * r + cd.b[bj * 2 + n];
        if (isk) o = o * 0.0625f;
        else if (issig) { o[0] = sigmoidf_(o[0]); o[1] = sigmoidf_(o[1]); o[2] = sigmoidf_(o[2]); o[3] = sigmoidf_(o[3]); }
        const u32x2 p2 = pack4(o); pk[2 * n] = p2.x; pk[2 * n + 1] = p2.y;
      }
      *(u32x4*)(Pb + (size_t)row * NG1 + cbase + bj * 128) = pk;
    }
    return 0.f;
  }
  __device__ __forceinline__ float rowscale(int row) const { return rs_of(rs[row]); }
  __device__ __forceinline__ float operator()(int row, int col, f32x4 v, float r) const {
    const int bi = col < 4096 ? col : col + 8;
    const f32x4 b4 = *(const f32x4*)(bias + bi);
    f32x4 o = v * r + b4;
    if (col >= 1024 && col < 2048) o = o * 0.0625f;
    else if ((col >= 3072 && col < 4096) || col >= 4608) { o[0] = sigmoidf_(o[0]); o[1] = sigmoidf_(o[1]); o[2] = sigmoidf_(o[2]); o[3] = sigmoidf_(o[3]); }
    *(u32x2*)(Pb + (size_t)row * NG1 + col) = pack4(o);
    return 0.f;
  }
};
struct Fg {
  static constexpr bool NEEDR = true, STAT = false;
  const float* bias; float* gat; const u64* rs; u64* ss;
  __device__ __forceinline__ float rowscale(int row) const { return rs_of(rs[row]); }
  __device__ __forceinline__ float operator()(int row, int col, f32x4 v, float r) const {
    if (col < 8) {
      const f32x4 b4 = *(const f32x4*)(bias + col);
      f32x4 o = v * r + b4;
      if (col >= 4) {
#pragma unroll
        for (int i = 0; i < 4; ++i) { const float x = o[i]; o[i] = fminf(x, 0.f) - log1pf(__expf(-fabsf(x))); }
      }
      *(f32x4*)(gat + (size_t)row * 8 + col) = o;
    }
    return 0.f;
  }
};
struct Fglu {
  static constexpr bool NEEDR = false, STAT = false, PERM = true; static constexpr int RB = 8;
  const float* bias; const bf16_t* ysb; bf16_t* ys2; u64* ss;
  struct ColData { f32x4 b[4]; }; struct RowData { u32x4 y[2]; };
  __device__ __forceinline__ void load_cols(int cbase, ColData& cd) const {
#pragma unroll
    for (int q = 0; q < 4; ++q) cd.b[q] = *(const f32x4*)(bias + cbase + (q >> 1) * 128 + (q & 1) * 4); }
  __device__ __forceinline__ void load_row(int row, int cbase, RowData& rd) const {
#pragma unroll
    for (int bj = 0; bj < 2; ++bj) rd.y[bj] = *(const u32x4*)(ysb + (size_t)row * 512 + cbase + bj * 128); }
  __device__ __forceinline__ float apply(int row, int cbase, const f32x4 (&v)[4], const ColData& cd, const RowData& rd) const {
#pragma unroll
    for (int bj = 0; bj < 2; ++bj) {
      const f32x4 y0 = unlo(rd.y[bj]), y1 = unhi(rd.y[bj]); f32x4 o0, o1;
#pragma unroll
      for (int i = 0; i < 4; ++i) { o0[i] = y0[i] * sigmoidf_(v[bj * 2][i] + cd.b[bj * 2][i]); o1[i] = y1[i] * sigmoidf_(v[bj * 2 + 1][i] + cd.b[bj * 2 + 1][i]); }
      *(u32x4*)(ys2 + (size_t)row * 512 + cbase + bj * 128) = pack8(o0, o1);
    }
    return 0.f;
  }
  struct Pre { f32x4 b; u32x2 y; };
  __device__ __forceinline__ Pre pre(int row, int col) const { Pre p; p.b = *(const f32x4*)(bias + col); p.y = *(const u32x2*)(ysb + (size_t)row * 512 + col); return p; }
  __device__ __forceinline__ float post(int row, int col, f32x4 v, const Pre& p) const {
    const f32x4 y = unpack4(p.y); f32x4 o;
#pragma unroll
    for (int i = 0; i < 4; ++i) o[i] = y[i] * sigmoidf_(v[i] + p.b[i]);
    *(u32x2*)(ys2 + (size_t)row * 512 + col) = pack4(o); return 0.f; }
  __device__ __forceinline__ float rowscale(int) const { return 1.f; }
  __device__ __forceinline__ float operator()(int row, int col, f32x4 v, float) const {
    const f32x4 b4 = *(const f32x4*)(bias + col);
    const f32x4 y = unpack4(*(const u32x2*)(ysb + (size_t)row * 512 + col));
    f32x4 o;
#pragma unroll
    for (int i = 0; i < 4; ++i) o[i] = y[i] * sigmoidf_(v[i] + b4[i]);
    *(u32x2*)(ys2 + (size_t)row * 512 + col) = pack4(o);
    return 0.f;
  }
};
struct Fa {
  static constexpr bool NEEDR = false, STAT = false, PERM = true; static constexpr int RB = 8;
  const bf16_t* Pb; bf16_t* t1; u64* ss;
  struct ColData { int dummy; }; struct RowData { u32x4 g[2]; };
  __device__ __forceinline__ void load_cols(int, ColData&) const {}
  __device__ __forceinline__ void load_row(int row, int cbase, RowData& rd) const {
#pragma unroll
    for (int bj = 0; bj < 2; ++bj) rd.g[bj] = *(const u32x4*)(Pb + (size_t)row * NG1 + 4608 + cbase + bj * 128); }
  __device__ __forceinline__ float apply(int row, int cbase, const f32x4 (&v)[4], const ColData&, const RowData& rd) const {
#pragma unroll
    for (int bj = 0; bj < 2; ++bj) *(u32x4*)(t1 + (size_t)row * DM + cbase + bj * 128) = pack8(unlo(rd.g[bj]) * v[bj * 2], unhi(rd.g[bj]) * v[bj * 2 + 1]);
    return 0.f;
  }
  struct Pre { u32x2 g; };
  __device__ __forceinline__ Pre pre(int row, int col) const { Pre p; p.g = *(const u32x2*)(Pb + (size_t)row * NG1 + 4608 + col); return p; }
  __device__ __forceinline__ float post(int row, int col, f32x4 v, const Pre& p) const { *(u32x2*)(t1 + (size_t)row * DM + col) = pack4(unpack4(p.g) * v); return 0.f; }
  __device__ __forceinline__ float rowscale(int) const { return 1.f; }
  __device__ __forceinline__ float operator()(int row, int col, f32x4 v, float) const {
    const f32x4 sg = unpack4(*(const u32x2*)(Pb + (size_t)row * NG1 + 4608 + col));
    *(u32x2*)(t1 + (size_t)row * DM + col) = pack4(sg * v);
    return 0.f;
  }
};
struct Fb {
  static constexpr bool NEEDR = false, STAT = false, PERM = true; static constexpr int RB = 4;
  const bf16_t* Pb; const bf16_t* t1; bf16_t* mg; u64* ss;
  struct ColData { int dummy; }; struct RowData { u32x4 g[2]; u32x4 t[2]; };
  __device__ __forceinline__ void load_cols(int, ColData&) const {}
  __device__ __forceinline__ void load_row(int row, int cbase, RowData& rd) const {
#pragma unroll
    for (int bj = 0; bj < 2; ++bj) { rd.g[bj] = *(const u32x4*)(Pb + (size_t)row * NG1 + 5632 + cbase + bj * 128); rd.t[bj] = *(const u32x4*)(t1 + (size_t)row * DM + cbase + bj * 128); } }
  __device__ __forceinline__ float apply(int row, int cbase, const f32x4 (&v)[4], const ColData&, const RowData& rd) const {
#pragma unroll
    for (int bj = 0; bj < 2; ++bj) *(u32x4*)(mg + (size_t)row * DM + cbase + bj * 128) = pack8(unlo(rd.t[bj]) + unlo(rd.g[bj]) * v[bj * 2], unhi(rd.t[bj]) + unhi(rd.g[bj]) * v[bj * 2 + 1]);
    return 0.f;
  }
  struct Pre { u32x2 g; u32x2 t; };
  __device__ __forceinline__ Pre pre(int row, int col) const { Pre p; p.g = *(const u32x2*)(Pb + (size_t)row * NG1 + 5632 + col); p.t = *(const u32x2*)(t1 + (size_t)row * DM + col); return p; }
  __device__ __forceinline__ float post(int row, int col, f32x4 v, const Pre& p) const { *(u32x2*)(mg + (size_t)row * DM + col) = pack4(unpack4(p.t) + unpack4(p.g) * v); return 0.f; }
  __device__ __forceinline__ float rowscale(int) const { return 1.f; }
  __device__ __forceinline__ float operator()(int row, int col, f32x4 v, float) const {
    const f32x4 sg = unpack4(*(const u32x2*)(Pb + (size_t)row * NG1 + 5632 + col));
    const f32x4 t = unpack4(*(const u32x2*)(t1 + (size_t)row * DM + col));
    *(u32x2*)(mg + (size_t)row * DM + col) = pack4(t + sg * v);
    return 0.f;
  }
};
struct Fres {
  static constexpr bool NEEDR = false, STAT = true, PERM = true; static constexpr int RB = 4;
  const float *xinP, *xinS; float* xo; bf16_t* xb; u64* ss;
  struct ColData { int dummy; }; struct RowData { f32x4 x[4]; };
  __device__ __forceinline__ void load_cols(int, ColData&) const {}
  __device__ __forceinline__ void load_row(int row, int cbase, RowData& rd) const {
#pragma unroll
    for (int q = 0; q < 4; ++q) rd.x[q] = *(const f32x4*)(xinP + (size_t)row * DM + cbase + (q >> 1) * 128 + (q & 1) * 4); }
  __device__ __forceinline__ float apply(int row, int cbase, const f32x4 (&v)[4], const ColData&, const RowData& rd) const {
    float s = 0.f;
#pragma unroll
    for (int bj = 0; bj < 2; ++bj) {
      const f32x4 o0 = rd.x[bj * 2] + v[bj * 2], o1 = rd.x[bj * 2 + 1] + v[bj * 2 + 1];
      float* xp = xo + (size_t)row * DM + cbase + bj * 128;
      *(f32x4*)xp = o0; *(f32x4*)(xp + 4) = o1;
      const u32x2 p0 = pack4(o0), p1 = pack4(o1);
      *(u32x4*)(xb + (size_t)row * DM + cbase + bj * 128) = (u32x4){p0.x, p0.y, p1.x, p1.y};
      s += (o0[0] * o0[0] + o0[1] * o0[1]) + (o0[2] * o0[2] + o0[3] * o0[3]) + (o1[0] * o1[0] + o1[1] * o1[1]) + (o1[2] * o1[2] + o1[3] * o1[3]);
    }
    return s;
  }
  struct Pre { f32x4 x; };
  __device__ __forceinline__ Pre pre(int row, int col) const { Pre p; const float* xi = row < NP ? xinP + (size_t)row * DM : xinS + (size_t)(row - NP) * DM; p.x = *(const f32x4*)(xi + col); return p; }
  __device__ __forceinline__ float post(int row, int col, f32x4 v, const Pre& p) const {
    const f32x4 o = p.x + v;
    *(f32x4*)(xo + (size_t)row * DM + col) = o; *(u32x2*)(xb + (size_t)row * DM + col) = pack4(o);
    return (o[0] * o[0] + o[1] * o[1]) + (o[2] * o[2] + o[3] * o[3]); }
  __device__ __forceinline__ float rowscale(int) const { return 1.f; }
  __device__ __forceinline__ float operator()(int row, int col, f32x4 v, float) const {
    const float* xi = row < NP ? xinP + (size_t)row * DM : xinS + (size_t)(row - NP) * DM;
    const f32x4 o = *(const f32x4*)(xi + col) + v;
    *(f32x4*)(xo + (size_t)row * DM + col) = o;
    *(u32x2*)(xb + (size_t)row * DM + col) = pack4(o);
    return (o[0] * o[0] + o[1] * o[1]) + (o[2] * o[2] + o[3] * o[3]);
  }
};
struct F13 {
  const u64* rs; bf16_t* act;
  __device__ __forceinline__ float rowscale(int row) const { return rs_of(rs[row]); }
  __device__ __forceinline__ f32x4 glu(f32x4 a1, f32x4 a3, float r) const {
    f32x4 o;
#pragma unroll
    for (int i = 0; i < 4; ++i) { const float x1 = a1[i] * r, x3 = a3[i] * r; o[i] = x1 * sigmoidf_(x1) * x3; }
    return o;
  }
  __device__ __forceinline__ void pair(int row, int j, f32x4 a1, f32x4 a3, float r) const { *(u32x2*)(act + (size_t)row * DFF + j) = pack4(glu(a1, a3, r)); }
};

template <class F> struct EpiMain {
  static constexpr bool PERM = F::PERM;
  F f; int coff;
  __device__ __forceinline__ void operator()(const f32x4 (&acc)[2][2][4][2], const pg8::Unit& u, int wr, int wc, int fr, int fq) const {
    const int rbase = u.pm * 256 + wr * 64 + fr, cbase = coff + u.pn * 256 + wc * 32 + (F::PERM ? 8 : 4) * fq;
    typename F::ColData cd; f.load_cols(cbase, cd);
#pragma unroll
    for (int b0 = 0; b0 < 8; b0 += F::RB) {
      typename F::RowData rd[F::RB];
#pragma unroll
      for (int k = 0; k < F::RB; ++k) { const int i = b0 + k; f.load_row(rbase + (i >> 2) * 128 + (i & 3) * 16, cbase, rd[k]); }
      __builtin_amdgcn_sched_barrier(0);
#pragma unroll
      for (int k = 0; k < F::RB; ++k) {
        const int i = b0 + k, ai = i >> 2, m = i & 3, row = rbase + ai * 128 + m * 16;
        const f32x4 v[4] = {acc[ai][0][m][0], acc[ai][0][m][1], acc[ai][1][m][0], acc[ai][1][m][1]};
        float s = f.apply(row, cbase, v, cd, rd[k]);
        if (F::STAT) { s += __shfl_xor(s, 16); s += __shfl_xor(s, 32); if (fq == 0) ss_add(f.ss + row, s); }
      }
      __builtin_amdgcn_sched_barrier(0);
    }
  }
};
struct EpiMain13 {
  static constexpr bool PERM = true;
  F13 f;
  __device__ __forceinline__ void operator()(const f32x4 (&acc)[2][2][4][2], const pg8::Unit& u, int wr, int wc, int fr, int fq) const {
    const int rbase = u.pm * 256 + wr * 64 + fr, jbase = u.pn * 128 + wc * 32 + 8 * fq;
    u64 sq[8];
#pragma unroll
    for (int i = 0; i < 8; ++i) sq[i] = f.rs[rbase + (i >> 2) * 128 + (i & 3) * 16];
    __builtin_amdgcn_sched_barrier(0);
#pragma unroll
    for (int i = 0; i < 8; ++i) {
      const int ai = i >> 2, m = i & 3, row = rbase + ai * 128 + m * 16;
      const float r = rs_of(sq[i]);
      *(u32x4*)(f.act + (size_t)row * DFF + jbase) = pack8(f.glu(acc[ai][0][m][0], acc[ai][1][m][0], r), f.glu(acc[ai][0][m][1], acc[ai][1][m][1], r));
    }
  }
};

template <int NACC>
__device__ __forceinline__ void skinny_unit(const bf16_t* A, int K, const bf16_t* Bt, int row0, int brow0, int bstep, float* red, f32x4 (&out)[NACC]) {
  const int tid = tidx(), w = tid >> 6, lane = tid & 63, g4 = lane >> 4, l15 = lane & 15;
  const int nks = K >> 8, kbase = w * (K >> 3) + 8 * g4;
  f32x4 acc[8][NACC];
#pragma unroll
  for (int rt = 0; rt < 8; ++rt)
#pragma unroll
    for (int i = 0; i < NACC; ++i) acc[rt][i] = (f32x4){0.f, 0.f, 0.f, 0.f};
  const bf16_t* ap = A + (size_t)(row0 + l15) * K + kbase;
  const bf16_t* bp = Bt + (size_t)(brow0 + l15) * K + kbase;
  for (int ks = 0; ks < nks; ks += 2) {
    const bool two = ks + 1 < nks;
    bf16x8 a0[8], a1[8], b0[NACC], b1[NACC];
#pragma unroll
    for (int rt = 0; rt < 8; ++rt) a0[rt] = *(const bf16x8*)(ap + (size_t)16 * rt * K + 32 * ks);
#pragma unroll
    for (int i = 0; i < NACC; ++i) b0[i] = *(const bf16x8*)(bp + (size_t)bstep * i * K + 32 * ks);
    if (two) {
#pragma unroll
      for (int rt = 0; rt < 8; ++rt) a1[rt] = *(const bf16x8*)(ap + (size_t)16 * rt * K + 32 * ks + 32);
#pragma unroll
      for (int i = 0; i < NACC; ++i) b1[i] = *(const bf16x8*)(bp + (size_t)bstep * i * K + 32 * ks + 32);
    }
#pragma unroll
    for (int rt = 0; rt < 8; ++rt)
#pragma unroll
      for (int i = 0; i < NACC; ++i) acc[rt][i] = __builtin_amdgcn_mfma_f32_16x16x32_bf16(b0[i], a0[rt], acc[rt][i], 0, 0, 0);
    if (two) {
#pragma unroll
      for (int rt = 0; rt < 8; ++rt)
#pragma unroll
        for (int i = 0; i < NACC; ++i) acc[rt][i] = __builtin_amdgcn_mfma_f32_16x16x32_bf16(b1[i], a1[rt], acc[rt][i], 0, 0, 0);
    }
  }
#pragma unroll
  for (int rt = 0; rt < 8; ++rt)
#pragma unroll
    for (int i = 0; i < NACC; ++i) *(f32x4*)(red + (size_t)(((w * 8 + rt) * NACC + i) * 64 + lane) * 4) = acc[rt][i];
  __syncthreads();
#pragma unroll
  for (int i = 0; i < NACC; ++i) {
    f32x4 t = (f32x4){0.f, 0.f, 0.f, 0.f};
#pragma unroll
    for (int ww = 0; ww < 8; ++ww) t += *(const f32x4*)(red + (size_t)(((ww * 8 + w) * NACC + i) * 64 + lane) * 4);
    out[i] = t;
  }
}
template <class F, int NA = 1>
__device__ __forceinline__ void skinny_run(const F& f, const bf16_t* A, int K, const bf16_t* Bt, int rowbase, int nrt, int ncu, int bid, int G, unsigned char* shm, int c0 = 0) {
  const int tid = tidx(), w = tid >> 6, lane = tid & 63, g = lane >> 4;
  const int ncu2 = ncu / NA, total = nrt * ncu2, nc = G - c0;
  if (bid < c0) return;
  for (int su = (G - 1 - bid); su < total; su += nc) {
    const int rt = su / ncu2, cu = su - rt * ncu2;
    const int row0 = rowbase + rt * 128, arow = row0 + 16 * w + (lane & 15);
    f32x4 acc[NA];
    const float rs = F::NEEDR ? f.rowscale(arow) : 1.f;
    skinny_unit<NA>(A, K, Bt, row0, 16 * NA * cu, 16, (float*)shm, acc);
#pragma unroll
    for (int i = 0; i < NA; ++i) {
      float ss = f(arow, 16 * (NA * cu + i) + 4 * g, acc[i], rs);
      if (F::STAT) { ss += __shfl_xor(ss, 16); ss += __shfl_xor(ss, 32); if (g == 0) ss_add(f.ss + arow, ss); }
    }
    __syncthreads();
  }
}
template <class F>
__device__ __forceinline__ void skinny_run_quarter(const F& f, const bf16_t* A, int K, const bf16_t* Bt, int ncu, int bid, int G, unsigned char* shm, int c0) {
  const int tid = tidx(), w = tid >> 6, lane = tid & 63, g4 = lane >> 4, l15 = lane & 15;
  const int total = 4 * ncu, nc = G - c0;
  if (bid < c0) return;
  float* red = (float*)shm;
  for (int su = (G - 1 - bid); su < total; su += nc) {
    const int cu = su >> 2, rq = su & 3, rt = w >> 2, kq = w & 3;
    const int arow = NP + 32 * rq + 16 * rt + l15;
    const int kspan = K >> 2, kbase = kq * kspan + 8 * g4;
    const bf16_t* ap = A + (size_t)arow * K + kbase;
    const bf16_t* bp = Bt + (size_t)(16 * cu + l15) * K + kbase;
    f32x4 acc = (f32x4){0.f, 0.f, 0.f, 0.f};
    typename F::Pre pre;
    if (kq == 0) pre = f.pre(arow, 16 * cu + 4 * g4);
    for (int k0 = 0; k0 < kspan; k0 += 256) {
      bf16x8 a[8], b[8];
#pragma unroll
      for (int s8 = 0; s8 < 8; ++s8) { if (k0 + 32 * s8 < kspan) { a[s8] = *(const bf16x8*)(ap + k0 + 32 * s8); b[s8] = *(const bf16x8*)(bp + k0 + 32 * s8); } }
#pragma unroll
      for (int s8 = 0; s8 < 8; ++s8) { if (k0 + 32 * s8 < kspan) acc = __builtin_amdgcn_mfma_f32_16x16x32_bf16(b[s8], a[s8], acc, 0, 0, 0); }
    }
    *(f32x4*)(red + (size_t)(w * 64 + lane) * 4) = acc;
    __syncthreads();
    if (kq == 0) {
      f32x4 t = acc;
#pragma unroll
      for (int q = 1; q < 4; ++q) t += *(const f32x4*)(red + (size_t)((w + q) * 64 + lane) * 4);
      float ss = f.post(arow, 16 * cu + 4 * g4, t, pre);
      if (F::STAT) { ss += __shfl_xor(ss, 16); ss += __shfl_xor(ss, 32); if (g4 == 0) ss_add(f.ss + arow, ss); }
    }
    __syncthreads();
  }
}
__device__ __forceinline__ void skinny_run13(const F13& f, const bf16_t* A, const bf16_t* Bt, int bid, int G, unsigned char* shm) {
  const int tid = tidx(), w = tid >> 6, lane = tid & 63, g = lane >> 4;
  const int c0 = ((NP / 256) * (2 * DFF / 256)) % G, nc = G - c0;
  if (bid < c0) return;
  for (int su = (G - 1 - bid); su < DFF / 16; su += nc) {
    const int arow = NP + 16 * w + (lane & 15);
    f32x4 acc[2];
    const float rs13 = f.rowscale(arow);
    skinny_unit<2>(A, 1024, Bt, NP, ((16 * su) >> 7) * 256 + ((16 * su) & 127), 128, (float*)shm, acc);
    f.pair(arow, 16 * su + 4 * g, acc[0], acc[1], rs13);
    __syncthreads();
  }
}
template <class F>
__device__ __forceinline__ void gemm_all(LAS unsigned char* lds, unsigned char* shm, const bf16_t* A, const bf16_t* Bt, int N, int K, const F& f, int bid, int G) {
  pg8::Gemm g; g.A = A; g.Bt = Bt; g.M = NP; g.N = N; g.K = K;
  pg8::StaticOrder S; S.init(NP, N, G, bid);
  EpiMain<F> E; E.f = f; E.coff = 0;
  REP(F::STAT ? 0 : 512) pg8::gemm_phase(lds, g, S, E);
  const int c0 = ((NP / 256) * (N / 256)) % G;
  if ((N / 16) * 2 <= G - c0) skinny_run_quarter(f, A, K, Bt, N / 16, bid, G, shm, c0);
  else skinny_run(f, A, K, Bt, NP, 1, N / 16, bid, G, shm, c0);
}

template <class F>
__device__ __forceinline__ void gemm_main_window(LAS unsigned char* lds, const bf16_t* A, const bf16_t* Bt, int N, int K, const F& f, int coff, int bid, int G) {
  pg8::Gemm g; g.A = A; g.Bt = Bt; g.M = NP; g.N = N; g.K = K;
  pg8::StaticOrder S; S.init(NP, N, G, bid);
  EpiMain<F> E; E.f = f; E.coff = coff;
  pg8::gemm_phase(lds, g, S, E);
}

__device__ __forceinline__ void prep_s5tables(const Params& P, int item, unsigned char* shm);
__device__ __forceinline__ void prep_phase(const Params& P, unsigned char* shm, int bid, int G) {
  const int tid = tidx(), w = tid >> 6, lane = tid & 63;
  bf16_t* T = (bf16_t*)shm;
  int jcur = 0;
  for (int t0 = 4 * bid; t0 < P.total_tiles; t0 += 4 * G) {
    f32x4 v0[4], v1[4]; float sc[4]; int jix[4];
    const int kk = tid >> 3, jq = tid & 7, nn = jq * 8;
#pragma unroll
    for (int u = 0; u < 4; ++u) {
      const int tile = t0 + u;
      v0[u] = (f32x4){0.f, 0.f, 0.f, 0.f}; v1[u] = v0[u]; sc[u] = 1.f;
      if (tile < P.total_tiles) {
        while (jcur + 1 < P.njobs && P.jobs[jcur + 1].tile0 <= tile) ++jcur;
        jix[u] = jcur;
        const TJob& J = P.jobs[jcur];
        const int lt = tile - J.tile0, tn = lt % J.ntn, tk = lt / J.ntn, k0 = tk * 64, n0 = tn * 64;
        if (n0 + nn < J.ncols) { const float* sp = J.src + (size_t)(k0 + kk) * J.ldn + J.c0 + n0 + nn; v0[u] = *(const f32x4*)sp; v1[u] = *(const f32x4*)(sp + 4); }
        if (J.scale) sc[u] = J.scale[k0 + kk];
      }
    }
#pragma unroll
    for (int u = 0; u < 4; ++u) {
      bf16_t* Tu = T + u * (64 * 72);
      const int kx = kk ^ (8 * jq);
#pragma unroll
      for (int i = 0; i < 4; ++i) { Tu[(nn + i) * 72 + kx] = f2bf(v0[u][i] * sc[u]); Tu[(nn + 4 + i) * 72 + kx] = f2bf(v1[u][i] * sc[u]); }
    }
    __syncthreads();
#pragma unroll
    for (int u = 0; u < 4; ++u) {
      const int tile = t0 + u;
      if (tile < P.total_tiles) {
        const TJob& J = P.jobs[jix[u]];
        const int lt = tile - J.tile0, tn = lt % J.ntn, tk = lt / J.ntn, k0 = tk * 64, n0 = tn * 64;
        const int n = tid >> 3, k8 = (tid & 7) * 8, gn = n0 + n;
        if (gn < J.nwrite) {
          const int dr = J.mode == 0 ? J.r0 + gn : ((gn >> 7) * 256 + (J.mode == 2 ? 128 : 0) + (gn & 127));
          *(u32x4*)(J.dst + (size_t)dr * J.K + k0 + k8) = *(const u32x4*)(T + u * (64 * 72) + n * 72 + (k8 ^ (8 * ((n >> 3) & 7))));
        }
      }
    }
    __syncthreads();
  }
  for (int i = bid * 512 + tid; i < 2 * 2048; i += G * 512) {
    const int l = i >> 11, gp = i & 2047, g = gp >> 6, p = gp & 63;
    const float dt = expf(P.log_dt[l * 32 + g]);
    const float Ar = P.A_re[l * 2048 + gp], Ai = P.A_im[l * 2048 + gp];
    const float mag = expf(dt * Ar);
    float sn, cs; sincosf(dt * Ai, &sn, &cs);
    const float abr = mag * cs, abi = mag * sn;
    const float den = Ar * Ar + Ai * Ai, nr = abr - 1.0f, ni = abi;
    const float fre = (nr * Ar + ni * Ai) / den, fim = (ni * Ar - nr * Ai) / den;
    P.abar[l][gp] = abr; P.abar[l][2048 + gp] = abi;
    for (int c = 0; c < 16; ++c) {
      const float Br = P.B_re[(size_t)l * 32768 + gp * 16 + c], Bi = P.B_im[(size_t)l * 32768 + gp * 16 + c];
      P.bbar[l][(g * 16 + c) * 64 + p] = fre * Br - fim * Bi;
      P.bbar[l][32768 + (g * 16 + c) * 64 + p] = fre * Bi + fim * Br;
    }
  }
  for (int it = bid; it < 256; it += G) prep_s5tables(P, it, shm);
  for (int row = bid * 8 + w; row < NT; row += 4 * G * 8) {
    f32x4 v[4][4]; int rr[4];
#pragma unroll
    for (int k = 0; k < 4; ++k) {
      const int r = row + k * G * 8; rr[k] = r < NT ? r : row;
      const float* xr = rr[k] < NP ? P.x_prompt + (size_t)rr[k] * DM : P.x_sample + (size_t)(rr[k] - NP) * DM;
#pragma unroll
      for (int i = 0; i < 4; ++i) v[k][i] = *(const f32x4*)(xr + 256 * i + 4 * lane);
    }
#pragma unroll
    for (int k = 0; k < 4; ++k) {
      if (k == 0 || row + k * G * 8 < NT) {
        float ss = 0.f;
#pragma unroll
        for (int i = 0; i < 4; ++i) {
          ss += (v[k][i][0] * v[k][i][0] + v[k][i][1] * v[k][i][1]) + (v[k][i][2] * v[k][i][2] + v[k][i][3] * v[k][i][3]);
          *(u32x2*)(P.xb + (size_t)rr[k] * DM + 256 * i + 4 * lane) = pack4(v[k][i]);
        }
        ss = wave_sum(ss);
        if (lane == 0) P.ssA[rr[k]] = ss_fix(ss);
      }
    }
  }
}

__device__ __forceinline__ void mlstm_scalars(const float* gat, int b, int h, float* sA, float* sM, float* sB, float* chain) {
  const int tid = tidx(), w = tid >> 6, lane = tid & 63;
  for (int cc = w; cc < 16; cc += 8) {
    const int t0 = cc * 128 + 2 * lane; const size_t r0 = (size_t)b * 2048 + t0;
    const float ig0 = gat[r0 * 8 + h], lf0 = gat[r0 * 8 + 4 + h], ig1 = gat[(r0 + 1) * 8 + h], lf1 = gat[(r0 + 1) * 8 + 4 + h];
    float x = lf0 + lf1;
    for (int off = 1; off < 64; off <<= 1) { const float y = __shfl_up(x, off); if (lane >= off) x += y; }
    const float b1 = x, b0 = x - lf1, a0 = ig0 - b0, a1 = ig1 - b1;
    float cm = fmaxf(a0, a1);
    for (int off = 1; off < 64; off <<= 1) { const float y = __shfl_up(cm, off); if (lane >= off) cm = fmaxf(cm, y); }
    const float prev = __shfl_up(cm, 1); const float cm0 = lane ? fmaxf(prev, a0) : a0;
    sB[t0] = b0; sB[t0 + 1] = b1; sA[t0] = a0; sA[t0 + 1] = a1; sM[t0] = cm0; sM[t0 + 1] = cm;
    if (lane == 63) { chain[33 + cc] = b1; chain[49 + cc] = cm; }
  }
  __syncthreads();
  if (tid == 0) { float m = 0.f; for (int cc = 0; cc < 16; ++cc) { chain[cc] = m; const float ml = fmaxf(m, chain[49 + cc]); chain[17 + cc] = ml; m = chain[33 + cc] + ml; } chain[16] = m; }
  __syncthreads();
  for (int t = tid; t < 2048; t += 512) sM[t] = fmaxf(chain[t >> 7], sM[t]);
  __syncthreads();
}

__device__ __forceinline__ void m1_item(const Params& P, int item, unsigned char* shm) {
  const int tid = tidx(), w = __builtin_amdgcn_readfirstlane(tid >> 6), lane = tid & 63, g = lane >> 4;
  const int b = item >> 6, h = (item >> 4) & 3, c = item & 15;
  float* sA = (float*)shm; float* sM = sA + 2048; float* sB = sM + 2048; float* chain = sB + 2048;
  mlstm_scalars(P.gat, b, h, sA, sM, sB, chain);
  const int row0 = b * 2048 + c * 128, t = 16 * w + (lane & 15);
  const bf16_t* qp = P.Pb + (size_t)(row0 + t) * NG1 + h * 256 + 8 * g;
  bf16x8 qf[8];
#pragma unroll
  for (int ks = 0; ks < 8; ++ks) qf[ks] = *(const bf16x8*)(qp + 32 * ks);
  const float Mt = sM[c * 128 + t];
  bf16_t* sp = P.St + (size_t)item * 16384 + t * 128;
#pragma unroll
  for (int sg = 0; sg < 8; sg += 4) {
    if (sg <= w) {
      bf16x8 kf[4][8];
#pragma unroll
      for (int u = 0; u < 4; ++u) {
        if (sg + u <= w) {
          const bf16_t* kp = P.Pb + (size_t)(row0 + 16 * (sg + u) + (lane & 15)) * NG1 + 1024 + h * 256 + 8 * g;
#pragma unroll
          for (int ks = 0; ks < 8; ++ks) kf[u][ks] = *(const bf16x8*)(kp + 32 * ks);
        }
      }
#pragma unroll
      for (int u = 0; u < 4; ++u) {
        const int st = sg + u;
        f32x4 acc = (f32x4){0.f, 0.f, 0.f, 0.f};
        if (st <= w) {
#pragma unroll
          for (int ks = 0; ks < 8; ++ks) acc = __builtin_amdgcn_mfma_f32_16x16x32_bf16(kf[u][ks], qf[ks], acc, 0, 0, 0);
#pragma unroll
          for (int r = 0; r < 4; ++r) { const int s2 = 16 * st + 4 * g + r; acc[r] = (s2 <= t) ? acc[r] * __expf(sA[c * 128 + s2] - Mt) : 0.f; }
        }
        *(u32x2*)(sp + 16 * st + 4 * g) = pack4(acc);
      }
    } else {
#pragma unroll
      for (int u = 0; u < 4; ++u) *(u32x2*)(sp + 16 * (sg + u) + 4 * g) = (u32x2){0u, 0u};
    }
  }
  __syncthreads();
}

__device__ __forceinline__ bf16x8 trread8(unsigned a0, unsigned a1) {
  bf16x4 lo, hi;
  asm volatile("ds_read_b64_tr_b16 %0, %2\n\tds_read_b64_tr_b16 %1, %3\n\ts_waitcnt lgkmcnt(0)" : "=&v"(lo), "=&v"(hi) : "v"(a0), "v"(a1) : "memory");
  return __builtin_shufflevector(lo, hi, 0, 1, 2, 3, 4, 5, 6, 7);
}
__device__ __forceinline__ void trread8x3(unsigned a0, unsigned a1, unsigned a2, unsigned dlt, bf16x8& r0, bf16x8& r1, bf16x8& r2) {
  bf16x4 l0, h0, l1, h1, l2, h2;
  asm volatile("ds_read_b64_tr_b16 %0, %6\n\tds_read_b64_tr_b16 %1, %7\n\tds_read_b64_tr_b16 %2, %8\n\tds_read_b64_tr_b16 %3, %9\n\tds_read_b64_tr_b16 %4, %10\n\tds_read_b64_tr_b16 %5, %11\n\ts_waitcnt lgkmcnt(0)"
               : "=&v"(l0), "=&v"(h0), "=&v"(l1), "=&v"(h1), "=&v"(l2), "=&v"(h2)
               : "v"(a0), "v"(a0 + dlt), "v"(a1), "v"(a1 + dlt), "v"(a2), "v"(a2 + dlt) : "memory");
  r0 = __builtin_shufflevector(l0, h0, 0, 1, 2, 3, 4, 5, 6, 7); r1 = __builtin_shufflevector(l1, h1, 0, 1, 2, 3, 4, 5, 6, 7); r2 = __builtin_shufflevector(l2, h2, 0, 1, 2, 3, 4, 5, 6, 7);
}
__device__ __forceinline__ void trread8x2(unsigned a0, unsigned a1, unsigned dlt, bf16x8& r0, bf16x8& r1) {
  bf16x4 l0, h0, l1, h1;
  asm volatile("ds_read_b64_tr_b16 %0, %4\n\tds_read_b64_tr_b16 %1, %5\n\tds_read_b64_tr_b16 %2, %6\n\tds_read_b64_tr_b16 %3, %7\n\ts_waitcnt lgkmcnt(0)"
               : "=&v"(l0), "=&v"(h0), "=&v"(l1), "=&v"(h1) : "v"(a0), "v"(a0 + dlt), "v"(a1), "v"(a1 + dlt) : "memory");
  r0 = __builtin_shufflevector(l0, h0, 0, 1, 2, 3, 4, 5, 6, 7); r1 = __builtin_shufflevector(l1, h1, 0, 1, 2, 3, 4, 5, 6, 7);
}

constexpr int KS_STRIDE = 272, VS_STRIDE = 56;
constexpr int M2_K = 0, M2_V = 69632, M2_CL = 83968, M2_SC = 110080;
__device__ __forceinline__ void m2_item(const Params& P, int l, int item, unsigned char* shm) {
  const int tid = tidx(), w = __builtin_amdgcn_readfirstlane(tid >> 6), lane = tid & 63, g = lane >> 4, l15 = lane & 15;
  const int bh = item >> 3, j = item & 7, b = bh >> 2, h = bh & 3;
  bf16_t* Ksh = (bf16_t*)(shm + M2_K); bf16_t* Vsh = (bf16_t*)(shm + M2_V); bf16_t* Cl = (bf16_t*)(shm + M2_CL);
  float* sA = (float*)(shm + M2_SC); float* sM = sA + 2048; float* sB = sM + 2048; float* chain = sB + 2048;
  const unsigned lbase = (unsigned)(size_t)shm;
  u32x4 kreg[8]; u32x4 vreg;
  const int vs = tid >> 2, vpc = tid & 3;
  {
    const int row0 = b * 2048;
#pragma unroll
    for (int i = 0; i < 8; ++i) { const int piece = tid + 512 * i, s = piece >> 5, pc = piece & 31; kreg[i] = *(const u32x4*)(P.Pb + (size_t)(row0 + s) * NG1 + 1024 + h * 256 + 8 * pc); }
    vreg = *(const u32x4*)(P.Pb + (size_t)(row0 + vs) * NG1 + 2048 + h * 256 + 32 * j + 8 * vpc);
  }
  bf16x8 qf[8], sf[4];
  {
    const int t = 16 * w + l15;
#pragma unroll
    for (int ks = 0; ks < 8; ++ks) qf[ks] = (bf16x8){0, 0, 0, 0, 0, 0, 0, 0};
    const bf16_t* sp0 = P.St + (size_t)(bh * 16) * 16384 + t * 128 + 8 * g;
#pragma unroll
    for (int ks = 0; ks < 4; ++ks) sf[ks] = *(const bf16x8*)(sp0 + 32 * ks);
  }
  mlstm_scalars(P.gat, b, h, sA, sM, sB, chain);
  f32x4 Cacc[2][3];
#pragma unroll
  for (int dt = 0; dt < 2; ++dt)
#pragma unroll
    for (int et = 0; et < 3; ++et) Cacc[dt][et] = (f32x4){0.f, 0.f, 0.f, 0.f};
  const int trq = l15 >> 2, trp = lane & 3;
#define M2_WRITE_KV(cc) do { \
    const float ml_ = chain[17 + (cc)]; \
    _Pragma("unroll") for (int i = 0; i < 8; ++i) { const int piece = tid + 512 * i, s = piece >> 5, pc = piece & 31; \
      const float wk = __expf(sA[(cc) * 128 + s] - ml_); u32x4 sc; \
      _Pragma("unroll") for (int e = 0; e < 4; ++e) { const unsigned u = kreg[i][e]; sc[e] = pack2(bf2f(u & 0xffffu) * wk, bf2f(u >> 16) * wk); } \
      *(u32x4*)(Ksh + s * KS_STRIDE + 8 * pc) = sc; } \
    *(u32x4*)(Vsh + vs * VS_STRIDE + 8 * vpc) = vreg; \
    if (vpc == 0) { unsigned zz = 0u; asm volatile("" : "+v"(zz)); const u32x4 z = (u32x4){zz, zz, zz, zz}; u32x4 o1 = z; o1[0] = 0x3F80u; \
      *(u32x4*)(Vsh + vs * VS_STRIDE + 32) = o1; *(u32x4*)(Vsh + vs * VS_STRIDE + 40) = z; } } while (0)
  M2_WRITE_KV(0);
  __syncthreads();
  for (int c = 0; c < 16; ++c) {
    const int row0 = b * 2048 + c * 128;
    const float mlast = chain[17 + c], mprev = chain[c];
    if (c < 15) {
      const int nrow0 = row0 + 128;
#pragma unroll
      for (int i = 0; i < 8; ++i) { const int piece = tid + 512 * i, s = piece >> 5, pc = piece & 31; kreg[i] = *(const u32x4*)(P.Pb + (size_t)(nrow0 + s) * NG1 + 1024 + h * 256 + 8 * pc); }
      vreg = *(const u32x4*)(P.Pb + (size_t)(nrow0 + vs) * NG1 + 2048 + h * 256 + 32 * j + 8 * vpc);
    }
    {
      const int t = 16 * w + l15, row = row0 + t;
      f32x4 acc[3]; acc[0] = (f32x4){0.f, 0.f, 0.f, 0.f}; acc[1] = acc[0]; acc[2] = acc[0];
      const float Mt = sM[c * 128 + t];
      if (c > 0) {
#pragma unroll
        for (int ks = 0; ks < 8; ++ks) {
          bf16x8 cf[3];
#pragma unroll
          for (int et = 0; et < 3; ++et) cf[et] = *(const bf16x8*)(Cl + (16 * et + l15) * KS_STRIDE + 32 * ks + 8 * g);
          __builtin_amdgcn_sched_barrier(0);
#pragma unroll
          for (int et = 0; et < 3; ++et) acc[et] = __builtin_amdgcn_mfma_f32_16x16x32_bf16(cf[et], qf[ks], acc[et], 0, 0, 0);
          __builtin_amdgcn_sched_barrier(0);
        }
        const float wi = __expf(mprev - Mt);
        acc[0] *= wi; acc[1] *= wi; acc[2] *= wi;
      }
      const float ac = __expf(mprev - mlast);
#pragma unroll
      for (int dt = 0; dt < 2; ++dt)
#pragma unroll
        for (int et = 0; et < 3; ++et) Cacc[dt][et] *= ac;
#pragma unroll
      for (int ks = 0; ks < 4; ++ks) {
        bf16x8 kf[2], vf[3];
        const unsigned va = lbase + M2_V + (unsigned)((32 * ks + 8 * g + trq) * VS_STRIDE + 4 * trp) * 2u;
        const unsigned ka = lbase + M2_K + (unsigned)((32 * ks + 8 * g + trq) * KS_STRIDE + 32 * w + 4 * trp) * 2u;
        trread8x3(va, va + 32u, va + 64u, 4u * VS_STRIDE * 2u, vf[0], vf[1], vf[2]);
        trread8x2(ka, ka + 32u, 4u * KS_STRIDE * 2u, kf[0], kf[1]);
#pragma unroll
        for (int et = 0; et < 3; ++et) acc[et] = __builtin_amdgcn_mfma_f32_16x16x32_bf16(vf[et], sf[ks], acc[et], 0, 0, 0);
#pragma unroll
        for (int dt = 0; dt < 2; ++dt)
#pragma unroll
          for (int et = 0; et < 3; ++et) Cacc[dt][et] = __builtin_amdgcn_mfma_f32_16x16x32_bf16(kf[dt], vf[et], Cacc[dt][et], 0, 0, 0);
      }
      if (c < 15) {
        const bf16_t* qp = P.Pb + (size_t)(row + 128) * NG1 + h * 256 + 8 * g;
#pragma unroll
        for (int ks = 0; ks < 8; ++ks) qf[ks] = *(const bf16x8*)(qp + 32 * ks);
        const bf16_t* sp = P.St + (size_t)(bh * 16 + c + 1) * 16384 + t * 128 + 8 * g;
#pragma unroll
        for (int ks = 0; ks < 4; ++ks) sf[ks] = *(const bf16x8*)(sp + 32 * ks);
      }
      const float den = __shfl(acc[2][0], l15);
      const float dd = fmaxf(fabsf(den), __expf(-(sB[c * 128 + t] + Mt)));
      const float inv = __builtin_amdgcn_rcpf(dd);
      const f32x4 o0 = acc[0] * inv, o1 = acc[1] * inv;
      bf16_t* hp = P.hA + (size_t)row * DM + h * 256 + 32 * j + 4 * g;
      *(u32x2*)hp = pack4(o0); *(u32x2*)(hp + 16) = pack4(o1);
      float ss = (o0[0] * o0[0] + o0[1] * o0[1]) + (o0[2] * o0[2] + o0[3] * o0[3]) + (o1[0] * o1[0] + o1[1] * o1[1]) + (o1[2] * o1[2] + o1[3] * o1[3]);
      ss += __shfl_xor(ss, 16); ss += __shfl_xor(ss, 32);
      if (g == 0) P.hss[(size_t)row * 32 + h * 8 + j] = ss;
    }
    LDS_BARRIER();
#pragma unroll
    for (int dt = 0; dt < 2; ++dt)
#pragma unroll
      for (int et = 0; et < 3; ++et) *(u32x2*)(Cl + (16 * et + l15) * KS_STRIDE + 32 * w + 16 * dt + 4 * g) = pack4(Cacc[dt][et]);
    if (c < 15) M2_WRITE_KV(c + 1);
    LDS_BARRIER();
  }
#undef M2_WRITE_KV
  const size_t sidx = (size_t)(l * 8 + b) * 4 + h;
#pragma unroll
  for (int dt = 0; dt < 2; ++dt)
#pragma unroll
    for (int r = 0; r < 4; ++r) {
      const int d = 32 * w + 16 * dt + 4 * g + r;
      P.out[O_CP + sidx * 65536 + (size_t)d * 256 + 32 * j + l15] = Cacc[dt][0][r];
      P.out[O_CP + sidx * 65536 + (size_t)d * 256 + 32 * j + 16 + l15] = Cacc[dt][1][r];
      if (j == 0 && l15 == 0) P.out[O_NP + sidx * 256 + d] = Cacc[dt][2][r];
    }
  if (j == 0 && tid == 0) P.out[O_MP + sidx] = chain[16];
  __syncthreads();
}

__device__ __forceinline__ void msample_item(const Params& P, int l, int item, unsigned char* shm) {
  const int tid = tidx(), w = tid >> 6, lane = tid & 63;
  const int b = item >> 2, h = item & 3, row = NP + b;
  float* q = (float*)shm; float* k = q + 256; float* v = k + 256; float* red = v + 256; float* red2 = red + 2048;
  if (tid < 256) {
    const bf16_t* pr = P.Pb + (size_t)row * NG1 + h * 256 + tid;
    q[tid] = bf2f(pr[0]); k[tid] = bf2f(pr[1024]); v[tid] = bf2f(pr[2048]);
  }
  const float ig = P.gat[(size_t)row * 8 + h], lf = P.gat[(size_t)row * 8 + 4 + h];
  const size_t sidx = (size_t)(l * 128 + b) * 4 + h;
  const float m0 = P.st_m[sidx];
  const float inter = lf + m0, mt = fmaxf(inter, ig), wi = __expf(inter - mt), wa = __expf(ig - mt);
  __syncthreads();
  const float* C0 = P.st_C + sidx * 65536; float* Co = P.out + O_CS + sidx * 65536;
  const float* n0 = P.st_n + sidx * 256;
  const f32x4 v4 = *(const f32x4*)(v + 4 * lane);
  f32x4 acc = (f32x4){0.f, 0.f, 0.f, 0.f};
#pragma unroll 16
  for (int dd = 0; dd < 32; ++dd) {
    const int d = 32 * w + dd;
    const f32x4 c4 = __builtin_nontemporal_load((const f32x4*)(C0 + (size_t)d * 256 + 4 * lane));
    const float kd = wa * k[d], qd = q[d];
    __builtin_nontemporal_store(c4 * wi + v4 * kd, (f32x4*)(Co + (size_t)d * 256 + 4 * lane));
    acc += c4 * qd;
  }
  *(f32x4*)(red + w * 256 + 4 * lane) = acc;
  float qk = 0.f, qn = 0.f;
#pragma unroll
  for (int i = 0; i < 4; ++i) { const int d = lane + 64 * i; qk += q[d] * k[d]; qn += q[d] * n0[d]; }
  qk = wave_sum(qk); qn = wave_sum(qn);
  __syncthreads();
  const float s = qk * wa, den = wi * qn + s, ddn = fmaxf(fabsf(den), __expf(-mt));
  float hval = 0.f;
  if (tid < 256) {
    float num = 0.f;
#pragma unroll
    for (int i = 0; i < 8; ++i) num += red[i * 256 + tid];
    hval = (wi * num + s * v[tid]) / ddn;
    P.hA[(size_t)row * DM + h * 256 + tid] = f2bf(hval);
    P.out[O_NS + sidx * 256 + tid] = wi * n0[tid] + wa * k[tid];
  }
  float ss = wave_sum(hval * hval);
  if (lane == 0) red2[w] = ss;
  __syncthreads();
  if (tid < 8) P.hss[(size_t)row * 32 + h * 8 + tid] = tid == 0 ? (red2[0] + red2[1] + red2[2] + red2[3]) : 0.f;
  if (tid == 0) P.out[O_MS + sidx] = mt;
  __syncthreads();
}

__device__ __forceinline__ void s5_load_C(const Params& P, int l, int g, float* Csh) {
  for (int i = tidx(); i < 2048; i += 512) { const int ri = i >> 10, c = (i >> 6) & 15, p = i & 63;
    Csh[ri * 1088 + c * 68 + p] = (ri ? P.C_im : P.C_re)[(size_t)l * 32768 + (g * 16 + c) * 64 + p]; }
}
__device__ __forceinline__ void s5_sample_item(const Params& P, int l, int item, unsigned char* shm) {
  const int tid = tidx(), w = tid >> 6, lane = tid & 63;
  const int g = item & 31, bs0 = (item >> 5) * 16 + 2 * w;
  float* Csh = (float*)shm; float* sbuf = Csh + 2176 + w * 2176;
  s5_load_C(P, l, g, Csh);
  const float are = P.abar[l][g * 64 + lane], aim = P.abar[l][2048 + g * 64 + lane];
  float bre[16], bim[16];
#pragma unroll
  for (int c = 0; c < 16; ++c) { bre[c] = P.bbar[l][(g * 16 + c) * 64 + lane]; bim[c] = P.bbar[l][32768 + (g * 16 + c) * 64 + lane]; }
  const int ch = lane >> 2, pq = lane & 3;
  const float Dc = P.D_skip[l * 512 + g * 16 + ch];
  __syncthreads();
#pragma unroll
  for (int rep = 0; rep < 2; ++rep) {
    const int bs = bs0 + rep, row = NP + bs;
    const size_t o = ((size_t)(l * 128 + bs) * 32 + g) * 64 + lane;
    const float s0r = P.st_sre[o], s0i = P.st_sim[o];
    const bf16_t* up = P.Pb + (size_t)row * NG1 + 4096 + g * 16;
    const u32x4 u0 = *(const u32x4*)up, u1 = *(const u32x4*)(up + 8);
    float br = 0.f, bi = 0.f;
#pragma unroll
    for (int i = 0; i < 4; ++i) {
      const float ua = bf2f(u0[i] & 0xffffu), ub = bf2f(u0[i] >> 16), uc = bf2f(u1[i] & 0xffffu), ud = bf2f(u1[i] >> 16);
      br += bre[2 * i] * ua + bre[2 * i + 1] * ub + bre[8 + 2 * i] * uc + bre[8 + 2 * i + 1] * ud;
      bi += bim[2 * i] * ua + bim[2 * i + 1] * ub + bim[8 + 2 * i] * uc + bim[8 + 2 * i + 1] * ud;
    }
    const float sr = are * s0r - aim * s0i + br, si = are * s0i + aim * s0r + bi;
    P.out[O_SRS + o] = sr; P.out[O_SIS + o] = si;
    sbuf[rep * 136 + lane] = sr; sbuf[rep * 136 + 68 + lane] = si;
    asm volatile("s_waitcnt lgkmcnt(0)" ::: "memory");
    float acc = 0.f;
#pragma unroll
    for (int p4 = 0; p4 < 4; ++p4) {
      const int p0 = 16 * pq + 4 * p4;
      const f32x4 vr = *(const f32x4*)(sbuf + rep * 136 + p0), vi = *(const f32x4*)(sbuf + rep * 136 + 68 + p0);
      const f32x4 cr = *(const f32x4*)(Csh + ch * 68 + p0), ci = *(const f32x4*)(Csh + 1088 + ch * 68 + p0);
      acc += (cr[0] * vr[0] + cr[1] * vr[1]) + (cr[2] * vr[2] + cr[3] * vr[3]) - (ci[0] * vi[0] + ci[1] * vi[1]) - (ci[2] * vi[2] + ci[3] * vi[3]);
    }
    acc += __shfl_xor(acc, 1); acc += __shfl_xor(acc, 2);
    if (pq == 0) {
      const float uc = bf2f(up[ch]);
      P.ysb[(size_t)row * 512 + g * 16 + ch] = f2bf(gelu_tanh(acc + Dc * uc));
    }
  }
  __syncthreads();
}

__device__ __forceinline__ void prep_s5tables(const Params& P, int item, unsigned char* shm) {
  const int tid = tidx(), qpart = item & 3, l = item >> 7, g = (item >> 2) & 31;
  float* pwr = (float*)shm; float* pwi = pwr + 17 * 64; float* bbr = pwi + 17 * 64; float* bbi = bbr + 1024; float* Ccr = bbi + 1024; float* Cci = Ccr + 1024;
  if (tid < 64) {
    const int p = tid, gp = g * 64 + p;
    const float dt = expf(P.log_dt[l * 32 + g]);
    const float Ar = P.A_re[l * 2048 + gp], Ai = P.A_im[l * 2048 + gp];
    const float mag = expf(dt * Ar);
    float sn, cs; sincosf(dt * Ai, &sn, &cs);
    const float abr = mag * cs, abi = mag * sn;
    const float den = Ar * Ar + Ai * Ai, nr = abr - 1.0f, ni = abi;
    const float fre = (nr * Ar + ni * Ai) / den, fim = (ni * Ar - nr * Ai) / den;
    float pr = 1.f, pi = 0.f;
    for (int t = 0; t <= 16; ++t) { pwr[t * 64 + p] = pr; pwi[t * 64 + p] = pi; const float a = pr * abr - pi * abi, b = pr * abi + pi * abr; pr = a; pi = b; }
    for (int c = 0; c < 16; ++c) {
      const float Br = P.B_re[(size_t)l * 32768 + gp * 16 + c], Bi = P.B_im[(size_t)l * 32768 + gp * 16 + c];
      bbr[p * 16 + c] = fre * Br - fim * Bi; bbi[p * 16 + c] = fre * Bi + fim * Br;
    }
  }
  for (int i = tid; i < 1024; i += 512) { Ccr[i] = P.C_re[(size_t)l * 32768 + g * 1024 + i]; Cci[i] = P.C_im[(size_t)l * 32768 + g * 1024 + i]; }
  __syncthreads();
  bf16_t* Kt = P.Kt[l] + (size_t)g * 17 * 256; bf16_t* Gm = P.Gm[l] + (size_t)g * 32768; bf16_t* Hm = P.Hm[l] + (size_t)g * 32768;
  for (int o = qpart * 1088 + tid; o < (qpart + 1) * 1088; o += 512) {
    const int tau = o >> 8, c = (o >> 4) & 15, c2 = o & 15;
    float acc = 0.f;
    if (tau < 16) for (int p = 0; p < 64; ++p) {
      const float pr = pwr[tau * 64 + p], pi = pwi[tau * 64 + p], br = bbr[p * 16 + c2], bi = bbi[p * 16 + c2];
      const float zr = pr * br - pi * bi, zi = pr * bi + pi * br;
      acc += Ccr[c * 64 + p] * zr - Cci[c * 64 + p] * zi;
    }
    Kt[o] = f2bf(acc);
  }
  for (int o = qpart * 8192 + tid; o < (qpart + 1) * 8192; o += 512) {
    { const int tc = o >> 7, q = o & 127, t = tc >> 4, c = tc & 15, p = q & 63;
      const float cr = Ccr[c * 64 + p], ci = Cci[c * 64 + p], pr = pwr[(t + 1) * 64 + p], pi = pwi[(t + 1) * 64 + p];
      Gm[o] = f2bf(q < 64 ? (cr * pr - ci * pi) : -(cr * pi + ci * pr)); }
    { const int q = o >> 8, jc = o & 255, j = jc >> 4, c2 = jc & 15, p = q & 63;
      const float pr = pwr[(15 - j) * 64 + p], pi = pwi[(15 - j) * 64 + p], br = bbr[p * 16 + c2], bi = bbi[p * 16 + c2];
      Hm[o] = f2bf(q < 64 ? (pr * br - pi * bi) : (pr * bi + pi * br)); }
  }
  if (tid < 64 && qpart == 0) { P.a16[l][g * 64 + tid] = pwr[16 * 64 + tid]; P.a16[l][2048 + g * 64 + tid] = pwi[16 * 64 + tid]; }
  __syncthreads();
}
constexpr int S3_R0 = 0, S3_SIN = 69632, S3_KT = 69632 + 34816;
__device__ __forceinline__ void s5_stage3_item(const Params& P, int l, int item, unsigned char* shm) {
  const int tid = tidx(), w = tid >> 6, lane = tid & 63, g4 = lane >> 4, l15 = lane & 15;
  const int b = item >> 5, g = item & 31;
  float* Ebuf = (float*)(shm + S3_R0); bf16_t* Gsh = (bf16_t*)(shm + S3_R0); bf16_t* Sin = (bf16_t*)(shm + S3_SIN); bf16_t* Ksh = (bf16_t*)(shm + S3_KT);
  { bf16_t* Hsh = (bf16_t*)(shm + S3_R0); const bf16_t* Hm = P.Hm[l] + (size_t)g * 32768;
#pragma unroll
    for (int i = 0; i < 8; ++i) { const int piece = tid + 512 * i, r = piece >> 5, pc = piece & 31; *(u32x4*)(Hsh + r * 264 + 8 * pc) = *(const u32x4*)(Hm + r * 256 + 8 * pc); } }
  { const bf16_t* Kt = P.Kt[l] + (size_t)g * 17 * 256; for (int i = tid; i < 544; i += 512) *(u32x4*)(Ksh + 8 * i) = *(const u32x4*)(Kt + 8 * i); }
  const int n = 16 * w + l15, r0 = b * 2048 + n * 16;
  bf16x8 uf[8];
#pragma unroll
  for (int ks = 0; ks < 8; ++ks) uf[ks] = *(const bf16x8*)(P.Pb + (size_t)(r0 + 2 * ks + (g4 >> 1)) * NG1 + 4096 + g * 16 + 8 * (g4 & 1));
  __syncthreads();
  {
    const bf16_t* Hsh = (const bf16_t*)(shm + S3_R0);
    f32x4 eacc[8];
#pragma unroll
    for (int qt = 0; qt < 8; ++qt) {
      eacc[qt] = (f32x4){0.f, 0.f, 0.f, 0.f};
#pragma unroll
      for (int ks = 0; ks < 8; ++ks) { const bf16x8 x = *(const bf16x8*)(Hsh + (16 * qt + l15) * 264 + 32 * ks + 8 * g4); eacc[qt] = __builtin_amdgcn_mfma_f32_16x16x32_bf16(x, uf[ks], eacc[qt], 0, 0, 0); }
    }
    __syncthreads();
#pragma unroll
    for (int qt = 0; qt < 8; ++qt) *(f32x4*)(Ebuf + n * 128 + 16 * qt + 4 * g4) = eacc[qt];
  }
  __syncthreads();
  {
    const float ar = P.a16[l][g * 64 + lane], ai = P.a16[l][2048 + g * 64 + lane];
    float lr[16], li[16], sr = 0.f, si = 0.f;
#pragma unroll
    for (int k = 0; k < 16; ++k) {
      lr[k] = sr; li[k] = si;
      const float er = Ebuf[(16 * w + k) * 128 + lane], ei = Ebuf[(16 * w + k) * 128 + 64 + lane];
      const float nr = ar * sr - ai * si + er, ni = ar * si + ai * sr + ei; sr = nr; si = ni;
    }
    float* wend = (float*)(shm + S3_KT + 8704);
    wend[w * 128 + lane] = sr; wend[w * 128 + 64 + lane] = si;
    float br = ar, bi = ai;
#pragma unroll
    for (int i = 0; i < 4; ++i) { const float nr = br * br - bi * bi, ni = 2.f * br * bi; br = nr; bi = ni; }
    __syncthreads();
    float cr = 0.f, ci = 0.f;
    for (int w2 = 0; w2 < w; ++w2) { const float er = wend[w2 * 128 + lane], ei = wend[w2 * 128 + 64 + lane]; const float nr = br * cr - bi * ci + er, ni = br * ci + bi * cr + ei; cr = nr; ci = ni; }
    float pr = 1.f, pi = 0.f;
#pragma unroll
    for (int k = 0; k < 16; ++k) {
      Sin[(16 * w + k) * 136 + lane] = f2bf(lr[k] + pr * cr - pi * ci); Sin[(16 * w + k) * 136 + 64 + lane] = f2bf(li[k] + pr * ci + pi * cr);
      const float nr = pr * ar - pi * ai, ni = pr * ai + pi * ar; pr = nr; pi = ni;
    }
    if (w == 7) { const size_t o = ((size_t)(l * 8 + b) * 32 + g) * 64 + lane; P.out[O_SRP + o] = sr + pr * cr - pi * ci; P.out[O_SIP + o] = si + pr * ci + pi * cr; }
  }
  __syncthreads();
  { const bf16_t* Gm = P.Gm[l] + (size_t)g * 32768;
#pragma unroll
    for (int i = 0; i < 8; ++i) { const int piece = tid + 512 * i, r = piece >> 4, pc = piece & 15; *(u32x4*)(Gsh + r * 136 + 8 * pc) = *(const u32x4*)(Gm + r * 128 + 8 * pc); } }
  __syncthreads();
  bf16x8 sf[4];
#pragma unroll
  for (int k2 = 0; k2 < 4; ++k2) sf[k2] = *(const bf16x8*)(Sin + n * 136 + 32 * k2 + 8 * g4);
  const f32x4 D4 = *(const f32x4*)(P.D_skip + l * 512 + g * 16 + 4 * g4);
#pragma unroll
  for (int t = 0; t < 16; ++t) {
    f32x4 acc = (f32x4){0.f, 0.f, 0.f, 0.f};
    const int row = r0 + t;
    const f32x4 u4 = unpack4(*(const u32x2*)(P.Pb + (size_t)row * NG1 + 4096 + g * 16 + 4 * g4));
#pragma unroll
    for (int ks = 0; ks <= (t >> 1); ++ks) {
      const int tau = t - (2 * ks + (g4 >> 1)), idx = tau >= 0 ? tau : 16;
      const bf16x8 x = *(const bf16x8*)(Ksh + (idx * 16 + l15) * 16 + 8 * (g4 & 1));
      acc = __builtin_amdgcn_mfma_f32_16x16x32_bf16(x, uf[ks], acc, 0, 0, 0);
    }
#pragma unroll
    for (int k2 = 0; k2 < 4; ++k2) { const bf16x8 x = *(const bf16x8*)(Gsh + (t * 16 + l15) * 136 + 32 * k2 + 8 * g4); acc = __builtin_amdgcn_mfma_f32_16x16x32_bf16(x, sf[k2], acc, 0, 0, 0); }
    f32x4 y;
#pragma unroll
    for (int r = 0; r < 4; ++r) y[r] = gelu_tanh(acc[r] + D4[r] * u4[r]);
    *(u32x2*)(P.ysb + (size_t)row * 512 + g * 16 + 4 * g4) = pack4(y);
  }
  __syncthreads();
}

__device__ __forceinline__ void headnorm_rows(const Params& P, int l, int bid, int G) {
  const int w = tidx() >> 6, lane = tidx() & 63;
  constexpr int R1 = 4736;
  const bool split = (G == 256);
  const int rbeg = split ? (bid < 128 ? bid * 8 + w : R1 + (bid - 128) * 8 + w) : bid * 8 + w;
  const int rend = split ? (bid < 128 ? R1 : NT) : NT, rstep = split ? 128 * 8 : G * 8;
  f32x4 gh[4];
#pragma unroll
  for (int h = 0; h < 4; ++h) gh[h] = *(const f32x4*)(P.g_hn + l * 1024 + h * 256 + 4 * lane);
  for (int row = rbeg; row < rend; row += 2 * rstep) {
    const int row2 = row + rstep; const bool has2 = row2 < rend; const int r2 = has2 ? row2 : row;
    if (lane == 0) { P.ssA[row] = 0ull; P.ssB[row] = 0ull; if (has2) { P.ssA[row2] = 0ull; P.ssB[row2] = 0ull; } }
    f32x4 s0[2][4], s1[2][4]; u32x2 hv[2][4], so[2][4];
#pragma unroll
    for (int k = 0; k < 2; ++k) { const int r = k ? r2 : row;
#pragma unroll
      for (int h = 0; h < 4; ++h) {
        s0[k][h] = *(const f32x4*)(P.hss + (size_t)r * 32 + h * 8); s1[k][h] = *(const f32x4*)(P.hss + (size_t)r * 32 + h * 8 + 4);
        hv[k][h] = *(const u32x2*)(P.hA + (size_t)r * DM + h * 256 + 4 * lane); so[k][h] = *(const u32x2*)(P.Pb + (size_t)r * NG1 + 3072 + h * 256 + 4 * lane);
      } }
#pragma unroll
    for (int k = 0; k < 2; ++k) { const int r = k ? r2 : row;
      if (k == 0 || has2) {
#pragma unroll
        for (int h = 0; h < 4; ++h) {
          const float ss = (s0[k][h][0] + s0[k][h][1]) + (s0[k][h][2] + s0[k][h][3]) + (s1[k][h][0] + s1[k][h][1]) + (s1[k][h][2] + s1[k][h][3]);
          const float rh = rsqrtf(ss * (1.0f / 256.0f) + 1e-6f);
          *(u32x2*)(P.xa + (size_t)r * DM + h * 256 + 4 * lane) = pack4(unpack4(so[k][h]) * unpack4(hv[k][h]) * gh[h] * rh);
        }
      } }
  }
}
__device__ __forceinline__ void final_rows(const Params& P, int bid, int G) {
  const int w = tidx() >> 6, lane = tidx() & 63;
  f32x4 gf[4];
#pragma unroll
  for (int i = 0; i < 4; ++i) gf[i] = *(const f32x4*)(P.g_final + 256 * i + 4 * lane);
  for (int row = bid * 8 + w; row < NT; row += 4 * G * 8) {
    f32x4 v[4][4]; u64 q[4]; int rr[4];
#pragma unroll
    for (int k = 0; k < 4; ++k) {
      const int r = row + k * G * 8; rr[k] = r < NT ? r : row;
      q[k] = P.ssA[rr[k]];
#pragma unroll
      for (int i = 0; i < 4; ++i) v[k][i] = *(const f32x4*)(P.X2 + (size_t)rr[k] * DM + 256 * i + 4 * lane);
    }
#pragma unroll
    for (int k = 0; k < 4; ++k) {
      if (k == 0 || row + k * G * 8 < NT) {
        const float rs = rs_of(q[k]);
        float* o = rr[k] < NP ? P.out + O_YP + (size_t)rr[k] * DM : P.out + O_YS + (size_t)(rr[k] - NP) * DM;
#pragma unroll
        for (int i = 0; i < 4; ++i) *(f32x4*)(o + 256 * i + 4 * lane) = v[k][i] * gf[i] * rs;
      }
    }
  }
}


#define XB_TMO      128
#define XB_XCNT(j)  (256  + 64 * (j))
#define XB_XSUB(j)  (1280 + 64 * (j))
#define XB_XGEN(j)  (2304 + 64 * (j))
#define XB_TOP      3328
#define XB_TOPGEN   3392
#define XCD_BAR_WORDS 3456
#define XB_SPIN_CAP (1u << 22)
__device__ __forceinline__ unsigned xb_ld(unsigned* p)              { return __hip_atomic_load(p, __ATOMIC_RELAXED, __HIP_MEMORY_SCOPE_AGENT); }
__device__ __forceinline__ unsigned xb_add(unsigned* p, unsigned v) { return __hip_atomic_fetch_add(p, v, __ATOMIC_RELAXED, __HIP_MEMORY_SCOPE_AGENT); }
__device__ __forceinline__ unsigned xb_xcc_id() { return (unsigned)__builtin_amdgcn_s_getreg((3 << 11) | 20) & 0xFu; }
#define XB_SPIN(cond, bar) do { unsigned _sp = 0; while (cond) { __builtin_amdgcn_s_sleep(1); \
    if ((++_sp & 255u) == 0u) { if (xb_ld(&(bar)[XB_TMO])) break; if (_sp > XB_SPIN_CAP) { atomicAdd(&(bar)[XB_TMO], 1u); break; } } } } while (0)
struct XcdBarrier { unsigned* bar; unsigned x; volatile LAS unsigned* st; };
__device__ __forceinline__ XcdBarrier xcd_barrier_post(unsigned* bar, volatile LAS unsigned* st) {
  XcdBarrier b; b.bar = bar; b.x = xb_xcc_id(); b.st = st;
  if (threadIdx.x == 0) (void)xb_add(&bar[XB_XCNT(b.x)], 1u);
  return b;
}
__device__ __forceinline__ void xcd_barrier_complete(unsigned* bar, unsigned x, unsigned& nloc, unsigned& nx) {
  const unsigned G = gridDim.x * gridDim.y * gridDim.z;
  unsigned sum, cnt, mine, sp = 0u;
  for (;;) {
    sum = 0u; cnt = 0u; mine = 0u;
#pragma unroll
    for (unsigned j = 0; j < 16; ++j) { const unsigned c = xb_ld(&bar[XB_XCNT(j)]); sum += c; cnt += (c > 0u) ? 1u : 0u; mine = (j == x) ? c : mine; }
    if (sum == G) break;
    __builtin_amdgcn_s_sleep(1);
    if ((++sp & 255u) == 0u) { if (xb_ld(&bar[XB_TMO])) break; if (sp > XB_SPIN_CAP) { atomicAdd(&bar[XB_TMO], 1u); break; } }
  }
  nloc = mine > 0u ? mine : 1u; nx = cnt > 0u ? cnt : 1u;
}
__device__ __forceinline__ void xcd_barrier(const XcdBarrier& b) {
  asm volatile("s_waitcnt vmcnt(0)" ::: "memory");
  __syncthreads();
  if (threadIdx.x == 0) {
    unsigned* bar = b.bar;
    __builtin_amdgcn_s_waitcnt(0);
    unsigned nloc = b.st[0], nx = b.st[1];
    if (nloc == 0u) { xcd_barrier_complete(bar, b.x, nloc, nx); b.st[0] = nloc; b.st[1] = nx; }
    const unsigned old = xb_add(&bar[XB_XSUB(b.x)], 1u);
    const unsigned gen = old / nloc;
    if (old + 1u == (gen + 1u) * nloc) {
      __builtin_amdgcn_fence(__ATOMIC_RELEASE, "agent");
      asm volatile("s_waitcnt vmcnt(0)" ::: "memory");
      const unsigned og = xb_add(&bar[XB_TOP], 1u);
      const unsigned tg = og / nx;
      if (og + 1u == (tg + 1u) * nx) xb_add(&bar[XB_TOPGEN], 1u);
      else XB_SPIN(xb_ld(&bar[XB_TOPGEN]) == tg, bar);
      __builtin_amdgcn_fence(__ATOMIC_ACQUIRE, "agent");
      xb_add(&bar[XB_XGEN(b.x)], 1u);
      asm volatile("s_waitcnt vmcnt(0)" ::: "memory");
    } else {
      XB_SPIN(xb_ld(&bar[XB_XGEN(b.x)]) == gen, bar);
      __builtin_amdgcn_fence(__ATOMIC_ACQUIRE, "agent");
      asm volatile("s_waitcnt vmcnt(0)" ::: "memory");
    }
  }
  __syncthreads();
}

__global__ void __launch_bounds__(512) mega(const Params P) {
  extern __shared__ __attribute__((aligned(16))) unsigned char shm[];
  cg::grid_group grid = cg::this_grid();
  LAS unsigned char* lds = (LAS unsigned char*)shm;
  const int bid = blockIdx.x, G = gridDim.x;

  volatile LAS unsigned* xst = (volatile LAS unsigned*)(lds + LDS_BYTES - 16);
  if (threadIdx.x == 0) { xst[0] = 0u; xst[1] = 0u; }
  if (bid == 0) for (int i = threadIdx.x; i < XCD_BAR_WORDS; i += 512) P.bar[i] = 0u;
  REP(1) prep_phase(P, shm, bid, G);
  grid.sync();
  const XcdBarrier xb = xcd_barrier_post(P.bar, xst);

  for (int l = 0; l < 2; ++l) {
    REP(2) {
      F1 f; f.bias = P.b_in + l * PTOT; f.Pb = P.Pb; f.rs = P.ssA; f.ss = nullptr;
      gemm_main_window(lds, P.xb, P.WinT[l], 4096, 1024, f, 0, bid, G);
      gemm_main_window(lds, P.xb, P.WinT[l] + (size_t)4608 * 1024, 2048, 1024, f, 4608, bid, G);
      skinny_run<F1, 2>(f, P.xb, 1024, P.WinT[l], NP, 1, NG1 / 16, bid, G, shm, 0);
      Fg fg; fg.bias = P.b_in + l * PTOT + 4096; fg.gat = P.gat; fg.rs = P.ssA; fg.ss = nullptr;
      REP(256) skinny_run(fg, P.xb, 1024, P.WgT[l], 0, 129, 1, bid, G, shm, 0);
    }
    xcd_barrier(xb);
    { F1 f; f.bias = P.b_in + l * PTOT; f.Pb = P.Pb; f.rs = P.ssA; f.ss = nullptr;
      gemm_main_window(lds, P.xb, P.WinT[l] + (size_t)4096 * 1024, 512, 1024, f, 4096, bid, G); }
    {
      const int n1 = G == 256 ? (bid < 128 ? 1 : 3) : (512 - bid + G - 1) / G;
      for (int j = 0; j < n1; ++j) m1_item(P, G == 256 ? (bid < 128 ? bid : 128 + (bid - 128) * 3 + j) : bid + j * G, shm);
      for (int it = bid; it < 512; it += G) msample_item(P, l, it, shm);
      for (int it = bid; it < 256; it += G) s5_sample_item(P, l, it, shm);
    }
    xcd_barrier(xb);
    REP(8) for (int it = bid; it < 256; it += G) m2_item(P, l, G == 256 ? (((it & 7) * 4 + (it >> 6)) * 8 + ((it >> 3) & 7)) : it, shm);
    REP(16) for (int it = bid; it < 256; it += G) s5_stage3_item(P, l, G == 256 ? ((it & 7) * 32 + (it >> 3)) : it, shm);
    xcd_barrier(xb);
    REP(32) {
      Fglu f; f.bias = P.b_glu + l * 512; f.ysb = P.ysb; f.ys2 = P.ys2; f.ss = nullptr;
      gemm_all(lds, shm, P.ysb, P.WgluT[l], 512, 512, f, bid, G);
      headnorm_rows(P, l, bid, G);
    }
    xcd_barrier(xb);
    REP(32) {
      Fa fa; fa.Pb = P.Pb; fa.t1 = P.t1; fa.ss = nullptr;
      gemm_all(lds, shm, P.xa, P.WaT[l], 1024, 1024, fa, bid, G);
      Fb fb; fb.Pb = P.Pb; fb.t1 = P.t1; fb.mg = P.mg; fb.ss = nullptr;
      gemm_all(lds, shm, P.ys2, P.WbT[l], 1024, 512, fb, bid, G);
    }
    xcd_barrier(xb);
    REP(32) {
      Fres f; f.xinP = l == 0 ? P.x_prompt : P.X2; f.xinS = l == 0 ? P.x_sample : P.X2 + (size_t)NP * DM; f.xo = P.X1; f.xb = P.xb; f.ss = P.ssB;
      gemm_all(lds, shm, P.mg, P.WoT[l], 1024, 1024, f, bid, G);
    }
    xcd_barrier(xb);
    REP(64) {
      F13 f; f.rs = P.ssB; f.act = P.act;
      pg8::Gemm g; g.A = P.xb; g.Bt = P.W13T[l]; g.M = NP; g.N = 2 * DFF; g.K = 1024;
      pg8::StaticOrder S; S.init(NP, 2 * DFF, G, bid);
      EpiMain13 E; E.f = f;
      REP(512) pg8::gemm_phase(lds, g, S, E);
      REP(256) skinny_run13(f, P.xb, P.W13T[l], bid, G, shm);
    }
    xcd_barrier(xb);
    REP(64) {
      Fres f; f.xinP = P.X1; f.xinS = P.X1 + (size_t)NP * DM; f.xo = P.X2; f.xb = P.xb; f.ss = P.ssA;
      gemm_all(lds, shm, P.act, P.W2T[l], 1024, DFF, f, bid, G);
    }
    xcd_barrier(xb);
  }
  final_rows(P, bid, G);
}

extern "C" void kernel_launch(void* const* d_in, const int* in_sizes, int n_in, void* d_out, int out_size, void* d_ws, size_t ws_size, hipStream_t stream) {
  constexpr size_t kDynLds = LDS_BYTES;
  static int grid_blocks = 0;
  if (!grid_blocks) {
    int dev = 0, cus = 0, per_cu = 0;
    (void)hipGetDevice(&dev);
    (void)hipDeviceGetAttribute(&cus, hipDeviceAttributeMultiprocessorCount, dev);
    (void)hipFuncSetAttribute((const void*)mega, hipFuncAttributeMaxDynamicSharedMemorySize, (int)kDynLds);
    (void)hipOccupancyMaxActiveBlocksPerMultiprocessor(&per_cu, mega, 512, kDynLds);
    if (per_cu > 1) per_cu = 1;
    grid_blocks = cus * per_cu;
    if (grid_blocks > 256) grid_blocks = 256;
  }
  Params p;
  memset(&p, 0, sizeof(p));
  const float* const* in = (const float* const*)d_in;
  p.x_prompt = in[0]; p.x_sample = in[1]; p.st_C = in[2]; p.st_n = in[3]; p.st_m = in[4]; p.st_sre = in[5]; p.st_sim = in[6];
  p.g_mix = in[7]; p.w_in = in[8]; p.b_in = in[9]; p.g_hn = in[10]; p.w_a = in[11]; p.A_re = in[12]; p.A_im = in[13]; p.log_dt = in[14];
  p.B_re = in[15]; p.B_im = in[16]; p.C_re = in[17]; p.C_im = in[18]; p.D_skip = in[19]; p.w_glu = in[20]; p.b_glu = in[21]; p.w_b = in[22]; p.w_out = in[23];
  p.g_ffn = in[24]; p.w_ff1 = in[25]; p.w_ff3 = in[26]; p.w_ff2 = in[27]; p.g_final = in[28];
  p.out = (float*)d_out;
  char* base = (char*)d_ws; size_t off = 0;
  auto alloc = [&](size_t bytes) { char* r = base + off; off += (bytes + 255) & ~(size_t)255; return r; };
  for (int l = 0; l < 2; ++l) {
    p.WinT[l] = (bf16_t*)alloc((size_t)NG1 * 1024 * 2); p.WgT[l] = (bf16_t*)alloc(16 * 1024 * 2); p.WgluT[l] = (bf16_t*)alloc(512 * 512 * 2);
    p.WaT[l] = (bf16_t*)alloc(1024 * 1024 * 2); p.WbT[l] = (bf16_t*)alloc(1024 * 512 * 2); p.WoT[l] = (bf16_t*)alloc(1024 * 1024 * 2);
    p.W13T[l] = (bf16_t*)alloc((size_t)2 * DFF * 1024 * 2); p.W2T[l] = (bf16_t*)alloc((size_t)1024 * DFF * 2);
    p.abar[l] = (float*)alloc(4096 * 4); p.bbar[l] = (float*)alloc(65536 * 4);
  }
  p.xb = (bf16_t*)alloc((size_t)NT * DM * 2); p.Pb = (bf16_t*)alloc((size_t)NT * NG1 * 2); p.St = (bf16_t*)alloc((size_t)512 * 16384 * 2);
  p.ysb = (bf16_t*)alloc((size_t)NT * 512 * 2); p.ys2 = (bf16_t*)alloc((size_t)NT * 512 * 2); p.xa = (bf16_t*)alloc((size_t)NT * DM * 2);
  p.mg = (bf16_t*)alloc((size_t)NT * DM * 2); p.act = (bf16_t*)alloc((size_t)NT * DFF * 2);
  p.X1 = (float*)alloc((size_t)NT * DM * 4); p.X2 = (float*)alloc((size_t)NT * DM * 4);
  p.ssA = (unsigned long long*)alloc((size_t)NT * 8); p.ssB = (unsigned long long*)alloc((size_t)NT * 8); p.bar = (unsigned*)alloc(XCD_BAR_WORDS * 4);
  for (int l = 0; l < 2; ++l) { p.Kt[l] = (bf16_t*)alloc(32 * 17 * 256 * 2); p.Gm[l] = (bf16_t*)alloc(32 * 32768 * 2); p.Hm[l] = (bf16_t*)alloc(32 * 32768 * 2); p.a16[l] = (float*)alloc(4096 * 4); }
  p.E2 = (float*)alloc((size_t)8 * 128 * 32 * 128 * 4);
  p.gat = (float*)alloc((size_t)NT * 8 * 4); p.hA = (bf16_t*)alloc((size_t)NT * DM * 2); p.hss = (float*)alloc((size_t)NT * 32 * 4);
  p.t1 = (bf16_t*)alloc((size_t)NT * DM * 2); p.Eend = (float*)alloc((size_t)2 * 524288 * 4);
  int nj = 0, tile0 = 0;
  auto job = [&](const float* src, const float* scale, bf16_t* dst, int ldn, int c0, int ncols, int K, int mode, int r0, int nwrite) {
    TJob& J = p.jobs[nj++]; J.src = src; J.scale = scale; J.dst = dst; J.ldn = ldn; J.c0 = c0; J.ncols = ncols; J.K = K; J.mode = mode; J.r0 = r0;
    J.tile0 = tile0; J.ntn = (ncols + 63) / 64; J.nwrite = nwrite; J.pad = 0; tile0 += J.ntn * (K / 64);
  };
  for (int l = 0; l < 2; ++l) {
    const float* win = p.w_in + (size_t)l * 1024 * PTOT; const float* gm = p.g_mix + l * 1024; const float* gf = p.g_ffn + l * 1024;
    job(win, gm, p.WinT[l], PTOT, 0, 4096, 1024, 0, 0, 4096);
    job(win, gm, p.WinT[l], PTOT, 4104, 512, 1024, 0, 4096, 512);
    job(win, gm, p.WinT[l], PTOT, 4616, 2048, 1024, 0, 4608, 2048);
    job(win, gm, p.WgT[l], PTOT, 4096, 8, 1024, 0, 0, 16);
    job(p.w_glu + (size_t)l * 512 * 512, nullptr, p.WgluT[l], 512, 0, 512, 512, 0, 0, 512);
    job(p.w_a + (size_t)l * 1024 * 1024, nullptr, p.WaT[l], 1024, 0, 1024, 1024, 0, 0, 1024);
    job(p.w_b + (size_t)l * 512 * 1024, nullptr, p.WbT[l], 1024, 0, 1024, 512, 0, 0, 1024);
    job(p.w_out + (size_t)l * 1024 * 1024, nullptr, p.WoT[l], 1024, 0, 1024, 1024, 0, 0, 1024);
    job(p.w_ff1 + (size_t)l * 1024 * DFF, gf, p.W13T[l], DFF, 0, DFF, 1024, 1, 0, DFF);
    job(p.w_ff3 + (size_t)l * 1024 * DFF, gf, p.W13T[l], DFF, 0, DFF, 1024, 2, 0, DFF);
    job(p.w_ff2 + (size_t)l * DFF * 1024, nullptr, p.W2T[l], 1024, 0, 1024, DFF, 0, 0, 1024);
  }
  p.njobs = nj; p.total_tiles = tile0;
  void* args[] = {&p};
  hipError_t e = hipLaunchCooperativeKernel((void*)mega, dim3(grid_blocks), dim3(512), args, kDynLds, stream);
  if (e != hipSuccess) fprintf(stderr, "cooperative launch failed: %s (grid %d)\n", hipGetErrorString(e), grid_blocks);
}
```
